# Optimizing an MI355X kernel written in HIP

```python
import math
import jax
import jax.numpy as jnp
from jax import lax
import numpy as np

D_MODEL = 1024
BATCH = 1
SEQ = 16384
DEPTH = 1

PLE_DIM = 256
D_MIX = D_MODEL
GLA_WIDTH = D_MIX // 2
GDN_WIDTH = D_MIX - GLA_WIDTH
GLA_HEADS = 4
GLA_DV = GLA_WIDTH // GLA_HEADS
GLA_DK = GLA_DV // 2
GLA_GATE_RANK = 16
GLA_GATE_NORM = 16.0
GDN_HEADS = 4
GDN_DK = GDN_WIDTH // GDN_HEADS
GDN_DV = GDN_WIDTH // GDN_HEADS
GDN_QKV = 2 * GDN_HEADS * GDN_DK + GDN_HEADS * GDN_DV
CONV_WIDTH = 4
CHUNK = 64
N_EXPERTS = 32
TOP_K = 4
D_FF = D_MODEL
SWIGLU_LIMIT = 7.0
SWIGLU_ALPHA = 1.702
MOE_BLOCK = 128
EPS = 1e-6
IN_SPLITS = (GLA_HEADS * GLA_DK, GLA_HEADS * GLA_DK, GLA_WIDTH, GLA_WIDTH, GLA_GATE_RANK,
             GDN_QKV, GDN_WIDTH, GDN_HEADS, GDN_HEADS)
D_IN = 2 * GLA_HEADS * GLA_DK + 2 * GLA_WIDTH + GLA_GATE_RANK + GDN_QKV + GDN_WIDTH + 2 * GDN_HEADS

kernel_name = 'hybrid_gla_gdn_moe_ple_block'


def rmsnorm(x, g):
    xf = x.astype(jnp.float32)
    y = xf * lax.rsqrt(jnp.mean(xf * xf, axis=-1, keepdims=True) + EPS)
    return (y * g.astype(jnp.float32)).astype(x.dtype)


def l2norm(t):
    return t * lax.rsqrt(jnp.sum(t * t, axis=-1, keepdims=True) + EPS)


def to_chunks(t):
    B, S, H, d = t.shape
    return t.reshape(B, S // CHUNK, CHUNK, H, d).transpose(0, 3, 1, 2, 4).astype(jnp.float32)


def to_chunks_scalar(t):
    B, S, H = t.shape
    return t.reshape(B, S // CHUNK, CHUNK, H).transpose(0, 3, 1, 2).astype(jnp.float32)


def from_chunks(o):
    B, H, N, C, d = o.shape
    return o.transpose(0, 2, 3, 1, 4).reshape(B, N * C, H, d)


def causal_dwconv(x, w):
    K, Ch = w.shape
    return lax.conv_general_dilated(x, w[:, None, :].astype(x.dtype), window_strides=(1,),
                                    padding=[(K - 1, 0)], dimension_numbers=('NWC', 'WIO', 'NWC'),
                                    feature_group_count=Ch)


def gla_chunked(q, k, v, log_a):
    C = q.shape[-2]
    causal = jnp.tril(jnp.ones((C, C), bool))[:, :, None]

    def step(S, inp):
        q_c, k_c, v_c, a_c = inp
        b = jnp.cumsum(a_c, axis=-2)
        diff = b[..., :, None, :] - b[..., None, :, :]
        dec = jnp.exp(jnp.where(causal, diff, -jnp.inf))
        attn = jnp.einsum('bhid,bhjd,bhijd->bhij', q_c, k_c, dec)
        o = (jnp.einsum('bhid,bhde->bhie', q_c * jnp.exp(b), S)
             + jnp.einsum('bhij,bhje->bhie', attn, v_c))
        b_last = b[..., -1:, :]
        S = (jnp.exp(b_last)[..., 0, :, None] * S
             + jnp.einsum('bhjd,bhje->bhde', k_c * jnp.exp(b_last - b), v_c))
        return S, o

    B, H = q.shape[:2]
    S0 = jnp.zeros((B, H, q.shape[-1], v.shape[-1]), jnp.float32)
    xs = tuple(jnp.moveaxis(t, 2, 0) for t in (q, k, v, log_a))
    _, o = lax.scan(step, S0, xs)
    return jnp.moveaxis(o, 0, 2)


def gated_delta_chunked(q, k, v, g, beta):
    C = q.shape[-2]
    dv = v.shape[-1]
    strict = jnp.tril(jnp.ones((C, C), bool), -1)
    causal = jnp.tril(jnp.ones((C, C), bool))
    b = jnp.cumsum(g, axis=-1)
    diff = b[..., :, None] - b[..., None, :]
    kk = jnp.einsum('bhnid,bhnjd->bhnij', k, k)
    L = jnp.where(strict, beta[..., :, None] * jnp.exp(jnp.where(strict, diff, 0.0)) * kk, 0.0)
    eye = jnp.eye(C, dtype=jnp.float32)
    rhs = jnp.concatenate([beta[..., None] * v, (beta * jnp.exp(b))[..., None] * k], axis=-1)
    sol = lax.linalg.triangular_solve(eye + L, rhs, left_side=True, lower=True, unit_diagonal=True)
    u, w = sol[..., :dv], sol[..., dv:]
    qk = jnp.einsum('bhnid,bhnjd->bhnij', q, k)
    a_qk = jnp.where(causal, jnp.exp(jnp.where(causal, diff, 0.0)) * qk, 0.0)
    q_dec = q * jnp.exp(b)[..., None]
    k_dec = k * jnp.exp(b[..., -1:] - b)[..., None]
    chunk_dec = jnp.exp(b[..., -1])

    def step(S, inp):
        u_c, w_c, q_c, k_c, a_c, d_c = inp
        delta = u_c - jnp.einsum('bhcd,bhde->bhce', w_c, S)
        o = jnp.einsum('bhcd,bhde->bhce', q_c, S) + jnp.einsum('bhij,bhje->bhie', a_c, delta)
        S = d_c[..., None, None] * S + jnp.einsum('bhcd,bhce->bhde', k_c, delta)
        return S, o

    B, H = q.shape[:2]
    S0 = jnp.zeros((B, H, q.shape[-1], dv), jnp.float32)
    xs = tuple(jnp.moveaxis(t, 2, 0) for t in (u, w, q_dec, k_dec, a_qk, chunk_dec))
    _, o = lax.scan(step, S0, xs)
    return jnp.moveaxis(o, 0, 2)


def moe_ffn(xn, w_router, b_router, w_gate_up, b_gate_up, w_down, b_down):
    B, S, D = xn.shape
    T = B * S
    A = T * TOP_K
    xt = xn.reshape(T, D)
    logits = (xt @ w_router + b_router).astype(jnp.float32)
    top_logit, top_e = lax.top_k(logits, TOP_K)
    gates = jax.nn.softmax(top_logit, axis=-1)
    flat_e = top_e.reshape(A).astype(jnp.int32)
    order = jnp.argsort(flat_e)
    e_sorted = flat_e[order]
    tok_sorted = order // TOP_K
    gate_sorted = gates.reshape(A)[order]
    counts = jnp.zeros((N_EXPERTS,), jnp.int32).at[flat_e].add(1)
    padded = (counts + MOE_BLOCK - 1) // MOE_BLOCK * MOE_BLOCK
    start = jnp.cumsum(counts) - counts
    pad_end = jnp.cumsum(padded)
    pad_start = pad_end - padded
    dest = pad_start[e_sorted] + jnp.arange(A, dtype=jnp.int32) - start[e_sorted]
    n_blocks = -(-A // MOE_BLOCK) + N_EXPERTS
    x_pad = jnp.zeros((n_blocks * MOE_BLOCK, D), xn.dtype).at[dest].set(xt[tok_sorted])
    block_e = jnp.minimum(jnp.searchsorted(pad_end, jnp.arange(n_blocks, dtype=jnp.int32) * MOE_BLOCK,
                                           side='right'), N_EXPERTS - 1)

    def expert_block(args):
        xb, e = args
        hgu = xb @ w_gate_up[e] + b_gate_up[e]
        gate, up = jnp.split(hgu, 2, axis=-1)
        gate = jnp.minimum(gate, SWIGLU_LIMIT)
        up = jnp.clip(up, -SWIGLU_LIMIT, SWIGLU_LIMIT)
        act = (up + 1.0) * gate * jax.nn.sigmoid(SWIGLU_ALPHA * gate)
        return act @ w_down[e] + b_down[e]

    y_pad = lax.map(expert_block, (x_pad.reshape(n_blocks, MOE_BLOCK, D), block_e))
    y_sorted = y_pad.reshape(n_blocks * MOE_BLOCK, D)[dest]
    y = jnp.zeros((T, D), y_sorted.dtype).at[tok_sorted].add(
        y_sorted * gate_sorted[:, None].astype(y_sorted.dtype))
    return y.reshape(B, S, D)


def setup_inputs(seed: int = 0) -> dict:
    key = jax.random.key(seed)
    ks = jax.random.split(key, 24)
    f32 = jnp.float32

    def nrm(k, shape, scale):
        return jax.random.normal(k, shape, f32) * scale

    def gain(k, shape):
        return 1.0 + 0.02 * jax.random.normal(k, shape, f32)

    dt = jnp.exp(jax.random.uniform(ks[9], (DEPTH, GDN_HEADS), f32, math.log(1e-3), math.log(1e-1)))
    return {
        'x': nrm(ks[0], (BATCH, SEQ, D_MODEL), 1.0),
        'p': nrm(ks[1], (DEPTH, BATCH, SEQ, PLE_DIM), 1.0),
        'g_mix': gain(ks[2], (DEPTH, D_MODEL)),
        'w_in': nrm(ks[3], (DEPTH, D_MODEL, D_IN), D_MODEL ** -0.5),
        'w_gla_gate': nrm(ks[4], (DEPTH, GLA_GATE_RANK, GLA_HEADS * GLA_DK), GLA_GATE_RANK ** -0.5),
        'b_gla_gate': nrm(ks[5], (DEPTH, GLA_HEADS * GLA_DK), 0.1),
        'g_gla_out': gain(ks[6], (DEPTH, GLA_DV)),
        'w_conv': nrm(ks[7], (DEPTH, CONV_WIDTH, GDN_QKV), CONV_WIDTH ** -0.5),
        'gdn_a_log': jnp.log(jax.random.uniform(ks[8], (DEPTH, GDN_HEADS), f32, 1.0, 16.0)),
        'gdn_dt_bias': dt + jnp.log(-jnp.expm1(-dt)),
        'g_gdn_out': gain(ks[10], (DEPTH, GDN_DV)),
        'w_out': nrm(ks[11], (DEPTH, D_MIX, D_MODEL), D_MIX ** -0.5),
        'g_moe': gain(ks[12], (DEPTH, D_MODEL)),
        'w_router': nrm(ks[13], (DEPTH, D_MODEL, N_EXPERTS), D_MODEL ** -0.5),
        'b_router': nrm(ks[14], (DEPTH, N_EXPERTS), 0.01),
        'w_gate_up': nrm(ks[15], (DEPTH, N_EXPERTS, D_MODEL, 2 * D_FF), D_MODEL ** -0.5),
        'b_gate_up': nrm(ks[16], (DEPTH, N_EXPERTS, 2 * D_FF), 0.01),
        'w_down': nrm(ks[17], (DEPTH, N_EXPERTS, D_FF, D_MODEL), D_FF ** -0.5),
        'b_down': nrm(ks[18], (DEPTH, N_EXPERTS, D_MODEL), 0.01),
        'g_ple_in': gain(ks[19], (DEPTH, D_MODEL)),
        'w_ple_gate': nrm(ks[20], (DEPTH, D_MODEL, D_MODEL), D_MODEL ** -0.5),
        'w_ple_proj': nrm(ks[21], (DEPTH, PLE_DIM, D_MODEL), PLE_DIM ** -0.5),
        'g_ple_post': gain(ks[22], (DEPTH, D_MODEL)),
        'g_final': gain(ks[23], (D_MODEL,)),
    }


def reference(x, p, g_mix, w_in, w_gla_gate, b_gla_gate, g_gla_out, w_conv, gdn_a_log, gdn_dt_bias,
              g_gdn_out, w_out, g_moe, w_router, b_router, w_gate_up, b_gate_up, w_down, b_down,
              g_ple_in, w_ple_gate, w_ple_proj, g_ple_post, g_final):
    B, S, D = x.shape
    split_idx = np.cumsum(IN_SPLITS)[:-1].tolist()
    h = x
    for i in range(DEPTH):
        n = rmsnorm(h, g_mix[i])
        proj = n @ w_in[i]
        gq, gk, gv, gr, glr, dqkv, dz, da, db = jnp.split(proj, split_idx, axis=-1)

        log_a = jax.nn.log_sigmoid((glr @ w_gla_gate[i] + b_gla_gate[i]).astype(jnp.float32)) / GLA_GATE_NORM
        o_gla = gla_chunked(
            to_chunks(gq.reshape(B, S, GLA_HEADS, GLA_DK).astype(jnp.float32) * GLA_DK ** -0.5),
            to_chunks(gk.reshape(B, S, GLA_HEADS, GLA_DK)),
            to_chunks(gv.reshape(B, S, GLA_HEADS, GLA_DV)),
            to_chunks(log_a.reshape(B, S, GLA_HEADS, GLA_DK)))
        o_gla = rmsnorm(from_chunks(o_gla), g_gla_out[i]).reshape(B, S, GLA_WIDTH) * jax.nn.silu(gr)

        qkv = jax.nn.silu(causal_dwconv(dqkv, w_conv[i]))
        dq = qkv[..., :GDN_HEADS * GDN_DK].reshape(B, S, GDN_HEADS, GDN_DK).astype(jnp.float32)
        dk = qkv[..., GDN_HEADS * GDN_DK:2 * GDN_HEADS * GDN_DK].reshape(B, S, GDN_HEADS, GDN_DK).astype(jnp.float32)
        dv = qkv[..., 2 * GDN_HEADS * GDN_DK:].reshape(B, S, GDN_HEADS, GDN_DV)
        dq = l2norm(dq) * GDN_DK ** -0.5
        dk = l2norm(dk)
        g_dec = -jnp.exp(gdn_a_log[i].astype(jnp.float32)) * jax.nn.softplus(
            (da + gdn_dt_bias[i]).astype(jnp.float32))
        beta = jax.nn.sigmoid(db.astype(jnp.float32))
        o_gdn = gated_delta_chunked(to_chunks(dq), to_chunks(dk), to_chunks(dv),
                                    to_chunks_scalar(g_dec), to_chunks_scalar(beta))
        o_gdn = rmsnorm(from_chunks(o_gdn), g_gdn_out[i]).reshape(B, S, GDN_WIDTH) * jax.nn.silu(dz)

        mixed = jnp.concatenate([o_gla, o_gdn], axis=-1).astype(h.dtype)
        h = h + mixed @ w_out[i]

        h = h + moe_ffn(rmsnorm(h, g_moe[i]), w_router[i], b_router[i], w_gate_up[i], b_gate_up[i],
                        w_down[i], b_down[i])

        pe = rmsnorm(p[i] @ w_ple_proj[i], g_ple_post[i])
        gate = jax.nn.sigmoid(rmsnorm(h, g_ple_in[i]) @ w_ple_gate[i])
        h = h + gate * pe
    return rmsnorm(h, g_final)
```

```cpp
#include <hip/hip_runtime.h>
#include <cstdio>
#include <cstdint>
#ifndef MK_ONE_LAUNCH
#define MK_ONE_LAUNCH 1
#endif
#ifndef MK_SKIP
#define MK_SKIP 0
#endif
#ifndef MK_DBG
#define MK_DBG 0
#endif
namespace pg8 {
#define PG8_LAS __attribute__((address_space(3)))
typedef unsigned short bf16_t;
typedef short bf16x8 __attribute__((ext_vector_type(8)));
typedef float f32x4 __attribute__((ext_vector_type(4)));
typedef unsigned u32x4 __attribute__((ext_vector_type(4)));
constexpr int BM = 256, BK = 64, HALF = 128, HTB = HALF * BK * 2  , STAGE_BYTES = 8 * HTB, NXCD = 8, WGM = 8;

__host__ __device__ __forceinline__ int lds_byte(int r, int c) { const int st = (r >> 4) * 2 + (c >> 5), rr = r & 15, cc = c & 31, ob = rr * 64 + cc * 2; return st * 1024 + (ob ^ (((ob >> 9) & 1) << 5)); }
__host__ __device__ __forceinline__ void stage_rc(int b, int& R, int& C) { const int st = b / 1024, sb = b % 1024, swz = sb ^ (((sb >> 9) & 1) << 5); R = (st >> 1) * 16 + swz / 64; C = (st & 1) * 32 + (swz % 64) / 2; }
__host__ __device__ __forceinline__ int perm32(int rho) { const int n = rho >> 4, i = rho & 15; return 8 * (i >> 2) + 4 * n + (i & 3); }

struct Unit { int pm, pn, pb, e; };
struct Gemm { const bf16_t* A; const bf16_t* Bt; int M, N, K; };

struct StaticOrder {
    int nM, nN, nwg, G, c;
    __host__ __device__ void init(int M, int N, int G_, int c_) { nM = M / BM; nN = N / BM; nwg = nM * nN; G = G_; c = c_; }
    __host__ __device__ bool next(int i, Unit& u) const {
        const long L = (long)i * G + c; if (L >= nwg) return false;
        int wgid = (int)L; { const int q = nwg / NXCD, r = nwg % NXCD, xcd = wgid % NXCD, off = wgid / NXCD; wgid = (xcd < r ? xcd * (q + 1) : r * (q + 1) + (xcd - r) * q) + off; }
        const int nig = WGM * nN, gid = wgid / nig, fm = gid * WGM, gsz = (nM - fm) < WGM ? (nM - fm) : WGM;
        u.pm = fm + ((wgid % nig) % gsz); u.pn = (wgid % nig) / gsz; u.pb = u.pn; u.e = 0; return true;
    }
    __device__ __forceinline__ void a_ready(const Unit&) const {}
    __device__ __forceinline__ void done(const Unit&) const {}
};

__device__ __forceinline__ unsigned cvt_pk_bf16(float lo, float hi) { unsigned r; asm volatile("v_cvt_pk_bf16_f32 %0, %1, %2" : "=v"(r) : "v"(lo), "v"(hi)); return r; }

typedef float f32x2 __attribute__((ext_vector_type(2)));
typedef unsigned u32x2 __attribute__((ext_vector_type(2)));
typedef __bf16 bf16x2v __attribute__((ext_vector_type(2)));
__device__ __forceinline__ unsigned cvtpk(float lo, float hi) { f32x2 v = {lo, hi}; bf16x2v b = __builtin_convertvector(v, bf16x2v); return __builtin_bit_cast(unsigned, b); }
__device__ __forceinline__ float sigmoidf_(float x) { return __builtin_amdgcn_rcpf(1.0f + __expf(-x)); }

struct EpiBf16P {
    static constexpr bool PERM = true, AFTER_DRAIN = false;
    bf16_t* O; int ldc;
    __device__ __forceinline__ void operator()(const f32x4 (&acc)[2][2][4][2], const Unit& u, int wr, int wc, int fr, int fq) const {
        const int row0 = u.pm * BM + wr * 64 + fr, col0 = u.pn * BM + wc * 32 + 8 * fq;
#pragma unroll
        for (int ai = 0; ai < 2; ++ai)
#pragma unroll
            for (int m = 0; m < 4; ++m) { bf16_t* rowp = O + (size_t)(row0 + ai * HALF + m * 16) * ldc + col0;
#pragma unroll
                for (int bj = 0; bj < 2; ++bj) { const f32x4 v0 = acc[ai][bj][m][0], v1 = acc[ai][bj][m][1];
                    u32x4 w; w.x = cvtpk(v0[0], v0[1]); w.y = cvtpk(v0[2], v0[3]); w.z = cvtpk(v1[0], v1[1]); w.w = cvtpk(v1[2], v1[3]);
                    *(u32x4*)(rowp + bj * HALF) = w; } }
    }
};
struct EpiResF32 {
    static constexpr bool PERM = false, AFTER_DRAIN = false;
    const float* base; float* out; int ldc;
    __device__ __forceinline__ void operator()(const f32x4 (&acc)[2][2][4][2], const Unit& u, int wr, int wc, int fr, int fq) const {
        const int row0 = u.pm * BM + wr * 64 + fr, col0 = u.pn * BM + wc * 32 + 4 * fq;
#pragma unroll
        for (int ai = 0; ai < 2; ++ai)
#pragma unroll
            for (int m = 0; m < 4; ++m) { const size_t off = (size_t)(row0 + ai * HALF + m * 16) * ldc + col0;
#pragma unroll
                for (int bj = 0; bj < 2; ++bj)
#pragma unroll
                    for (int n = 0; n < 2; ++n) *(f32x4*)(out + off + bj * HALF + n * 16) = *(const f32x4*)(base + off + bj * HALF + n * 16) + acc[ai][bj][m][n]; }
    }
};
struct EpiMoeAct {
    static constexpr bool PERM = true, AFTER_DRAIN = false;
    bf16_t* O; const float* bgu;
    __device__ __forceinline__ void operator()(const f32x4 (&acc)[2][2][4][2], const Unit& u, int wr, int wc, int fr, int fq) const {
        const int row0 = u.pm * BM + wr * 64 + fr, ch0 = u.pn * HALF + wc * 32 + 8 * fq;
        const float* bb = bgu + (size_t)u.e * 2048 + ch0;
        f32x4 bg[2], bu[2];
#pragma unroll
        for (int n = 0; n < 2; ++n) { bg[n] = *(const f32x4*)(bb + 4 * n); bu[n] = *(const f32x4*)(bb + 1024 + 4 * n); }
#pragma unroll
        for (int ai = 0; ai < 2; ++ai)
#pragma unroll
            for (int m = 0; m < 4; ++m) {
                float a[8];
#pragma unroll
                for (int n = 0; n < 2; ++n)
#pragma unroll
                    for (int i = 0; i < 4; ++i) {
                        float g = acc[ai][0][m][n][i] + bg[n][i], up = acc[ai][1][m][n][i] + bu[n][i];
                        g = fminf(g, 7.0f); up = fminf(fmaxf(up, -7.0f), 7.0f);
                        a[n * 4 + i] = (up + 1.0f) * g * sigmoidf_(1.702f * g);
                    }
                u32x4 w; w.x = cvtpk(a[0], a[1]); w.y = cvtpk(a[2], a[3]); w.z = cvtpk(a[4], a[5]); w.w = cvtpk(a[6], a[7]);
                *(u32x4*)(O + (size_t)(row0 + ai * HALF + m * 16) * 1024 + ch0) = w;
            }
    }
};
struct EpiMoeDown {
    static constexpr bool PERM = true, AFTER_DRAIN = false;
    bf16_t* O; const float* bd; const float* gpos;
    __device__ __forceinline__ void operator()(const f32x4 (&acc)[2][2][4][2], const Unit& u, int wr, int wc, int fr, int fq) const {
        const int row0 = u.pm * BM + wr * 64 + fr, col0 = u.pn * BM + wc * 32 + 8 * fq;
        const float* bb = bd + (size_t)u.e * 1024 + col0;
        f32x4 bv[2][2];
#pragma unroll
        for (int bj = 0; bj < 2; ++bj)
#pragma unroll
            for (int n = 0; n < 2; ++n) bv[bj][n] = *(const f32x4*)(bb + bj * HALF + 4 * n);
#pragma unroll
        for (int ai = 0; ai < 2; ++ai)
#pragma unroll
            for (int m = 0; m < 4; ++m) { const int r = row0 + ai * HALF + m * 16; const float gt = gpos[r];
#pragma unroll
                for (int bj = 0; bj < 2; ++bj) { const f32x4 v0 = (acc[ai][bj][m][0] + bv[bj][0]) * gt, v1 = (acc[ai][bj][m][1] + bv[bj][1]) * gt;
                    u32x4 w; w.x = cvtpk(v0[0], v0[1]); w.y = cvtpk(v0[2], v0[3]); w.z = cvtpk(v1[0], v1[1]); w.w = cvtpk(v1[2], v1[3]);
                    *(u32x4*)(O + (size_t)r * 1024 + col0 + bj * HALF) = w; } }
    }
};
struct EpiPle {
    static constexpr bool PERM = false, AFTER_DRAIN = false;
    float* out; const bf16_t* pe; const float* rstd; const float* gpost;
    __device__ __forceinline__ void operator()(const f32x4 (&acc)[2][2][4][2], const Unit& u, int wr, int wc, int fr, int fq) const {
        const int row0 = u.pm * BM + wr * 64 + fr, col0 = u.pn * BM + wc * 32 + 4 * fq;
        f32x4 gp[2][2];
#pragma unroll
        for (int bj = 0; bj < 2; ++bj)
#pragma unroll
            for (int n = 0; n < 2; ++n) gp[bj][n] = *(const f32x4*)(gpost + col0 + bj * HALF + n * 16);
#pragma unroll
        for (int ai = 0; ai < 2; ++ai)
#pragma unroll
            for (int m = 0; m < 4; ++m) { const int r = row0 + ai * HALF + m * 16; const float rs = rstd[r];
#pragma unroll
                for (int bj = 0; bj < 2; ++bj)
#pragma unroll
                    for (int n = 0; n < 2; ++n) { const size_t off = (size_t)r * 1024 + col0 + bj * HALF + n * 16;
                        const u32x2 pw = *(const u32x2*)(pe + off); const f32x4 a = acc[ai][bj][m][n];
                        f32x4 p4; p4[0] = __uint_as_float(pw.x << 16); p4[1] = __uint_as_float(pw.x & 0xffff0000u); p4[2] = __uint_as_float(pw.y << 16); p4[3] = __uint_as_float(pw.y & 0xffff0000u);
                        f32x4 o = *(const f32x4*)(out + off);
#pragma unroll
                        for (int i = 0; i < 4; ++i) o[i] += sigmoidf_(a[i]) * p4[i] * rs * gp[bj][n][i];
                        *(f32x4*)(out + off) = o; } }
    }
};
struct MoeOrder {
    const PG8_LAS int* tile_e; int ntiles, NT, G, c;
    __device__ __forceinline__ bool next(int i, Unit& u) const {
        const int L = (G % 8 == 0) ? i * G + (c & 7) * (G >> 3) + (c >> 3) : i * G + c;
        if (L >= ntiles * NT) return false;
        const int mt = L / NT, nt = L - mt * NT;
        const int e = __builtin_amdgcn_readfirstlane(tile_e[mt]);
        u.pm = mt; u.pn = nt; u.e = e; u.pb = e * NT + nt; return true;
    }
    __device__ __forceinline__ void a_ready(const Unit&) const {}
    __device__ __forceinline__ void done(const Unit&) const {}
};
template <class Epi, class Sched, bool ALIGN_EPI = false, bool SP2 = false>
__device__ __forceinline__ void gemm_phase(PG8_LAS unsigned char* lds, const Gemm g, const Sched& S, const Epi& E) {
    const int tid = threadIdx.x, wid = __builtin_amdgcn_readfirstlane(tid >> 6), lane = tid & 63, wr = wid >> 2, wc = wid & 3, fr = lane & 15, fq = lane >> 4;
    const int K = g.K, nt = K / BK;
    unsigned voffA[2], voffB[2];
#pragma unroll
    for (int i = 0; i < 2; ++i) { int R, C; stage_rc(tid * 16 + i * 8192, R, C); const int Rb = Epi::PERM ? ((R & ~31) + perm32(R & 31)) : R;
        voffA[i] = (unsigned)(R * K + C) * 2u; voffB[i] = (unsigned)(Rb * K + C) * 2u; }
    const size_t kstep = (size_t)(BK * 2);
    const size_t hstep = (size_t)HALF * K * 2;
    const size_t tstep = 2 * hstep;
    const unsigned ldsw = (unsigned)wid * 1024u;
    const int aoff = lds_byte(wr * 64 + fr, fq * 8), boff = lds_byte(wc * 32 + fr, fq * 8);
#define PG8_SA(b, h) (((b) * 2 + (h)) * HTB)
#define PG8_SB(b, h) ((4 + (b) * 2 + (h)) * HTB)
#define PG8_STAGE(bufoff, gbase, voff) do { _Pragma("unroll") for (int _i = 0; _i < 2; ++_i) \
        __builtin_amdgcn_global_load_lds((const unsigned*)((const char*)(gbase) + (voff)[_i]), (PG8_LAS unsigned*)(lds + (bufoff) + ldsw + _i * 8192), 16, 0, 0); } while (0)
#define PG8_LDA(dst, b, h) do { _Pragma("unroll") for (int m = 0; m < 4; ++m) _Pragma("unroll") for (int k = 0; k < 2; ++k) dst[m][k] = *(const PG8_LAS bf16x8*)(lds + PG8_SA(b, h) + aoff + m * 2048 + k * 1024); } while (0)
#define PG8_LDB(dst, b, h) do { _Pragma("unroll") for (int n = 0; n < 2; ++n) _Pragma("unroll") for (int k = 0; k < 2; ++k) dst[n][k] = *(const PG8_LAS bf16x8*)(lds + PG8_SB(b, h) + boff + n * 2048 + k * 1024); } while (0)
#define PG8_MMA(ai, bj, At, Bt) do { __builtin_amdgcn_s_setprio(1); _Pragma("unroll") for (int m = 0; m < 4; ++m) _Pragma("unroll") for (int n = 0; n < 2; ++n) _Pragma("unroll") for (int k = 0; k < 2; ++k) \
        acc[ai][bj][m][n] = __builtin_amdgcn_mfma_f32_16x16x32_bf16(Bt[n][k], At[m][k], acc[ai][bj][m][n], 0, 0, 0); __builtin_amdgcn_s_setprio(0); } while (0)
#define PG8_WAIT_V(n) asm volatile("s_waitcnt vmcnt(" #n ")" ::: "memory")
#define PG8_WAIT_L(n) asm volatile("s_waitcnt lgkmcnt(" #n ")" ::: "memory")
#define PG8_BAR __builtin_amdgcn_s_barrier()
#define PG8_SCHED __builtin_amdgcn_sched_barrier(0)
    Unit cur, nxt; int ui = 0;
    if (!S.next(0, cur)) return;
    f32x4 acc[2][2][4][2];
#pragma unroll
    for (int a = 0; a < 2; ++a)
#pragma unroll
        for (int b = 0; b < 2; ++b)
#pragma unroll
            for (int m = 0; m < 4; ++m)
#pragma unroll
                for (int n = 0; n < 2; ++n) acc[a][b][m][n] = (f32x4){0.f, 0.f, 0.f, 0.f};
    bf16x8 At[4][2], B0[2][2], B1[2][2];
    const char* cA = (const char*)g.A + (size_t)cur.pm * tstep; const char* cB = (const char*)g.Bt + (size_t)cur.pb * tstep;
    S.a_ready(cur);
    if constexpr (SP2) {
        PG8_STAGE(PG8_SB(0, 0), cB, voffB); PG8_STAGE(PG8_SB(0, 1), cB + hstep, voffB); PG8_STAGE(PG8_SA(0, 0), cA, voffA); PG8_STAGE(PG8_SA(0, 1), cA + hstep, voffA);
        if (wr == 1) PG8_BAR;
        PG8_WAIT_V(2); PG8_BAR;
        PG8_STAGE(PG8_SB(1, 0), cB + kstep, voffB); PG8_STAGE(PG8_SA(1, 0), cA + kstep, voffA); PG8_STAGE(PG8_SB(1, 1), cB + hstep + kstep, voffB);
        PG8_WAIT_V(6); PG8_BAR;
    } else {
        PG8_STAGE(PG8_SB(0, 0), cB, voffB); PG8_STAGE(PG8_SA(0, 0), cA, voffA); PG8_STAGE(PG8_SB(0, 1), cB + hstep, voffB); PG8_STAGE(PG8_SA(0, 1), cA + hstep, voffA);
        if (wr == 1) PG8_BAR;
        PG8_WAIT_V(4); PG8_BAR;
        PG8_STAGE(PG8_SB(1, 0), cB + kstep, voffB); PG8_STAGE(PG8_SA(1, 0), cA + kstep, voffA); PG8_STAGE(PG8_SB(1, 1), cB + hstep + kstep, voffB);
        PG8_WAIT_V(6); PG8_BAR;
    }
    for (;;) {
        const bool has_next = S.next(ui + 1, nxt);
        const char* nA = has_next ? (const char*)g.A + (size_t)nxt.pm * tstep : cA; const char* nB = has_next ? (const char*)g.Bt + (size_t)nxt.pb * tstep : cB;
        for (int t = 0; t < nt; t += 2) {
            const bool last = (t == nt - 2);
            const char* a1 = cA + (size_t)(t + 1) * kstep;
            const char* a2 = last ? nA : cA + (size_t)(t + 2) * kstep; const char* b2 = last ? nB : cB + (size_t)(t + 2) * kstep;
            const char* a3 = a2 + kstep; const char* b3 = b2 + kstep;
            if (last && has_next) S.a_ready(nxt);
            if constexpr (SP2) {
            PG8_LDB(B0, 0, 0); PG8_LDB(B1, 0, 1); PG8_SCHED; PG8_LDA(At, 0, 0); PG8_STAGE(PG8_SA(1, 1), a1 + hstep, voffA);
            PG8_WAIT_V(8); PG8_WAIT_L(0); PG8_BAR; PG8_MMA(0, 0, At, B0); PG8_MMA(0, 1, At, B1); PG8_BAR; PG8_SCHED;
            PG8_LDA(At, 0, 1); PG8_STAGE(PG8_SB(0, 0), b2, voffB); PG8_STAGE(PG8_SB(0, 1), b2 + hstep, voffB); PG8_STAGE(PG8_SA(0, 0), a2, voffA);
            PG8_WAIT_V(8); PG8_WAIT_L(0); PG8_BAR; PG8_MMA(1, 0, At, B0); PG8_MMA(1, 1, At, B1); PG8_BAR; PG8_SCHED;
            PG8_LDB(B0, 1, 0); PG8_LDB(B1, 1, 1); PG8_SCHED; PG8_LDA(At, 1, 0); PG8_STAGE(PG8_SA(0, 1), a2 + hstep, voffA);
            PG8_WAIT_V(8); PG8_WAIT_L(0); PG8_BAR; PG8_MMA(0, 0, At, B0); PG8_MMA(0, 1, At, B1); PG8_BAR; PG8_SCHED;
            PG8_LDA(At, 1, 1); PG8_STAGE(PG8_SB(1, 0), b3, voffB); PG8_STAGE(PG8_SB(1, 1), b3 + hstep, voffB); PG8_STAGE(PG8_SA(1, 0), a3, voffA);
            PG8_WAIT_V(8); PG8_WAIT_L(0); PG8_BAR; PG8_MMA(1, 0, At, B0); PG8_MMA(1, 1, At, B1); PG8_BAR; PG8_SCHED;
            } else {
            PG8_LDB(B0, 0, 0); PG8_SCHED; PG8_LDA(At, 0, 0); PG8_STAGE(PG8_SA(1, 1), a1 + hstep, voffA);
            PG8_WAIT_L(8); PG8_BAR; PG8_WAIT_L(0); PG8_MMA(0, 0, At, B0); PG8_BAR; PG8_SCHED;
            PG8_LDB(B1, 0, 1); PG8_STAGE(PG8_SB(0, 0), b2, voffB);
            PG8_BAR; PG8_WAIT_L(0); PG8_MMA(0, 1, At, B1); PG8_BAR;
            PG8_LDA(At, 0, 1); PG8_STAGE(PG8_SA(0, 0), a2, voffA);
            PG8_BAR; PG8_WAIT_L(0); PG8_MMA(1, 0, At, B0); PG8_BAR; PG8_SCHED;
            PG8_STAGE(PG8_SB(0, 1), b2 + hstep, voffB);
            PG8_WAIT_V(6); PG8_BAR; PG8_MMA(1, 1, At, B1); PG8_BAR;
            PG8_LDB(B0, 1, 0); PG8_SCHED; PG8_LDA(At, 1, 0); PG8_STAGE(PG8_SA(0, 1), a2 + hstep, voffA);
            PG8_WAIT_L(8); PG8_BAR; PG8_WAIT_L(0); PG8_MMA(0, 0, At, B0); PG8_BAR; PG8_SCHED;
            PG8_LDB(B1, 1, 1); PG8_STAGE(PG8_SB(1, 0), b3, voffB);
            PG8_BAR; PG8_WAIT_L(0); PG8_MMA(0, 1, At, B1); PG8_BAR;
            PG8_LDA(At, 1, 1); PG8_STAGE(PG8_SA(1, 0), a3, voffA);
            PG8_BAR; PG8_WAIT_L(0); PG8_MMA(1, 0, At, B0); PG8_BAR; PG8_SCHED;
            PG8_STAGE(PG8_SB(1, 1), b3 + hstep, voffB);
            PG8_WAIT_V(6); PG8_BAR; PG8_MMA(1, 1, At, B1); PG8_BAR;
            }
        }
        if constexpr (ALIGN_EPI) { if (wr == 0) PG8_BAR; }
        if constexpr (!Epi::AFTER_DRAIN) { E(acc, cur, wr, wc, fr, fq); S.done(cur); }
        if (!has_next) break;
#pragma unroll
        for (int a = 0; a < 2; ++a)
#pragma unroll
            for (int b = 0; b < 2; ++b)
#pragma unroll
                for (int m = 0; m < 4; ++m)
#pragma unroll
                    for (int n = 0; n < 2; ++n) acc[a][b][m][n] = (f32x4){0.f, 0.f, 0.f, 0.f};
        cur = nxt; cA = nA; cB = nB; ++ui;
        if constexpr (ALIGN_EPI) { if (wr == 1) PG8_BAR; }
    }
    PG8_WAIT_V(0);
    if constexpr (!ALIGN_EPI) { if (wr == 0) PG8_BAR; }
    PG8_BAR;
    if constexpr (Epi::AFTER_DRAIN) { E.fused(acc, cur, wr, wc, fr, fq, lds, wid, lane); S.done(cur); }
#undef PG8_SA
#undef PG8_SB
#undef PG8_STAGE
#undef PG8_LDA
#undef PG8_LDB
#undef PG8_MMA
#undef PG8_WAIT_V
#undef PG8_WAIT_L
#undef PG8_BAR
#undef PG8_SCHED
}
}

constexpr int NWAVES = 8;
constexpr int T = 16384, D = 1024, NCH = 256, LDP = 3840, DIN = 3608, PLE = 256, NE = 32;
constexpr int C_GQ = 0, C_GK = 256, C_GV = 512, C_GR = 1024, C_DQ = 1536, C_DZ = 3072, C_GLR = 3584, C_DA = 3600, C_DB = 3604;
constexpr float EPS = 1e-6f;
constexpr int XS_ROWS = 65536 + NE * 256;

constexpr size_t MiB = 1u << 20;
constexpr size_t WS_CTL = 0, CTL_ZERO_BYTES = 1 * MiB;
constexpr size_t WS_WIN = 2 * MiB, WS_WPP = 10 * MiB, WS_WOUT = 11 * MiB, WS_WPG = 13 * MiB, WS_W1 = 16 * MiB, WS_W2 = 144 * MiB;
constexpr size_t WS_XN = 208 * MiB, WS_PB = 240 * MiB, WS_PROJ = 248 * MiB, WS_PERAW = 368 * MiB;
constexpr size_t WS_KVT = 400 * MiB, WS_DVEC = 432 * MiB, WS_SGLA = 433 * MiB, WS_WF = 449 * MiB, WS_KDF = 465 * MiB, WS_UF = 481 * MiB, WS_CDEC = 513 * MiB;
constexpr size_t WS_QDEC = 514 * MiB, WS_AQK = 530 * MiB, WS_SGDN = 538 * MiB, WS_DELTA = 570 * MiB, WS_MIX = 586 * MiB;
constexpr size_t WS_TOKE = 618 * MiB, WS_TOKS = WS_TOKE + 256 * 1024, WS_TOKG = WS_TOKS + 256 * 1024, WS_TOKP = WS_TOKG + 256 * 1024;
constexpr size_t WS_GPOS = 619 * MiB, WS_PERSTD = 620 * MiB, WS_XS = 621 * MiB, WS_HS = 765 * MiB, WS_END = 909 * MiB;
static_assert(WS_XS + (size_t)XS_ROWS * 2048 <= WS_HS && WS_HS + (size_t)XS_ROWS * 2048 <= WS_END, "d_ws map");
constexpr int CW_TMO = 0, CW_CODE = 1, CW_BAR = 4096, CW_CNT = 8192;

constexpr int RING_OFF = 0, RING_BYTES = 131072;
constexpr int LDSCTL_OFF = RING_BYTES, MISC_OFF = LDSCTL_OFF + 320;
constexpr int TILEE_OFF = MISC_OFF + 128;
constexpr int BASE_OFF = TILEE_OFF + 320 * 4;
constexpr int LDS_BYTES = 147456;
static_assert(BASE_OFF + 128 <= LDS_BYTES, "LDS map");

#define GAS __attribute__((address_space(1)))
#define LAS __attribute__((address_space(3)))
typedef unsigned short bf16;
typedef unsigned v4u __attribute__((ext_vector_type(4)));
typedef float f32x4 __attribute__((ext_vector_type(4)));
typedef short bf16x8 __attribute__((ext_vector_type(8)));
typedef GAS unsigned gu32;
typedef GAS unsigned long long gu64;
#define RLX_AGENT __ATOMIC_RELAXED, __HIP_MEMORY_SCOPE_AGENT
#define LDS_WAIT() asm volatile("s_waitcnt lgkmcnt(0)" ::: "memory")
#define VM_WAIT() asm volatile("s_waitcnt vmcnt(0)" ::: "memory")
__device__ __forceinline__ unsigned long long rt() { return __builtin_amdgcn_s_memrealtime(); }
__device__ __forceinline__ unsigned f2bf(float f) { unsigned u = __builtin_bit_cast(unsigned, f); return (u + 0x7fffu + ((u >> 16) & 1u)) >> 16; }
__device__ __forceinline__ unsigned pk2(float lo, float hi) { return f2bf(lo) | (f2bf(hi) << 16); }

#define XB_TMO      128
#define XB_XCNT(j)  (256  + 64 * (j))
#define XB_XSUB(j)  (1280 + 64 * (j))
#define XB_XGEN(j)  (2304 + 64 * (j))
#define XB_TOP      3328
#define XB_TOPGEN   3392
#define XCD_BAR_WORDS 3456
#define XB_SPIN_CAP (1u << 18)

__device__ __forceinline__ unsigned xb_ld(unsigned* p)              { return __hip_atomic_load(p, __ATOMIC_RELAXED, __HIP_MEMORY_SCOPE_AGENT); }
__device__ __forceinline__ unsigned xb_add(unsigned* p, unsigned v) { return __hip_atomic_fetch_add(p, v, __ATOMIC_RELAXED, __HIP_MEMORY_SCOPE_AGENT); }
__device__ __forceinline__ unsigned xb_xcc_id() { return (unsigned)__builtin_amdgcn_s_getreg((3 << 11) | 20) & 0xFu; }
#define XB_SPIN(cond, bar) do { unsigned _sp = 0; while (cond) { __builtin_amdgcn_s_sleep(1); \
    if ((++_sp & 255u) == 0u) { if (xb_ld(&(bar)[XB_TMO])) break; if (_sp > XB_SPIN_CAP) { atomicAdd(&(bar)[XB_TMO], 1u); break; } } } } while (0)

struct XcdBarrier {
    unsigned* bar; unsigned x;
    volatile LAS unsigned* st;
};

__device__ __forceinline__ XcdBarrier xcd_barrier_post(unsigned* bar, volatile LAS unsigned* st) {
    XcdBarrier b; b.bar = bar; b.x = xb_xcc_id(); b.st = st;
    if (threadIdx.x == 0) (void)xb_add(&bar[XB_XCNT(b.x)], 1u);
    return b;
}
__device__ __forceinline__ void xcd_barrier_complete(unsigned* bar, unsigned x, unsigned& nloc, unsigned& nx) {
    const unsigned G = gridDim.x * gridDim.y * gridDim.z;
    unsigned sum, cnt, mine, sp = 0u;
    for (;;) {
        sum = 0u; cnt = 0u; mine = 0u;
#pragma unroll
        for (unsigned j = 0; j < 16; ++j) { const unsigned c = xb_ld(&bar[XB_XCNT(j)]); sum += c; cnt += (c > 0u) ? 1u : 0u; mine = (j == x) ? c : mine; }
        if (sum == G) break;
        __builtin_amdgcn_s_sleep(1);
        if ((++sp & 255u) == 0u) { if (xb_ld(&bar[XB_TMO])) break; if (sp > XB_SPIN_CAP) { atomicAdd(&bar[XB_TMO], 1u); break; } }
    }
    nloc = mine > 0u ? mine : 1u; nx = cnt > 0u ? cnt : 1u;
}

__device__ __forceinline__ void xcd_barrier(const XcdBarrier& b) {
    asm volatile("s_waitcnt vmcnt(0)" ::: "memory");
    __syncthreads();
    if (threadIdx.x == 0) {
        unsigned* bar = b.bar;
        __builtin_amdgcn_s_waitcnt(0);
        unsigned nloc = b.st[0], nx = b.st[1];
        if (nloc == 0u) { xcd_barrier_complete(bar, b.x, nloc, nx); b.st[0] = nloc; b.st[1] = nx; }
        const unsigned old = xb_add(&bar[XB_XSUB(b.x)], 1u);
        const unsigned gen = old / nloc;
        if (old + 1u == (gen + 1u) * nloc) {
            __builtin_amdgcn_fence(__ATOMIC_RELEASE, "agent");
            asm volatile("s_waitcnt vmcnt(0)" ::: "memory");
            const unsigned og = xb_add(&bar[XB_TOP], 1u);
            const unsigned tg = og / nx;
            if (og + 1u == (tg + 1u) * nx) xb_add(&bar[XB_TOPGEN], 1u);
            else XB_SPIN(xb_ld(&bar[XB_TOPGEN]) == tg, bar);
            __builtin_amdgcn_fence(__ATOMIC_ACQUIRE, "agent");
            xb_add(&bar[XB_XGEN(b.x)], 1u);
            asm volatile("s_waitcnt vmcnt(0)" ::: "memory");
        } else {
            XB_SPIN(xb_ld(&bar[XB_XGEN(b.x)]) == gen, bar);
            __builtin_amdgcn_fence(__ATOMIC_ACQUIRE, "agent");
            asm volatile("s_waitcnt vmcnt(0)" ::: "memory");
        }
    }
    __syncthreads();
}


__device__ __forceinline__ float bflo(unsigned w) { return __uint_as_float(w << 16); }
__device__ __forceinline__ float bfhi(unsigned w) { return __uint_as_float(w & 0xffff0000u); }
__device__ __forceinline__ float bf2f(bf16 h) { return __uint_as_float((unsigned)h << 16); }
using pg8::cvtpk;
__device__ __forceinline__ bf16 f2bf1(float f) { return (bf16)(cvtpk(f, 0.f) & 0xffffu); }
__device__ __forceinline__ float wave_sum(float v) {
#pragma unroll
    for (int o = 1; o < 64; o <<= 1) v += __shfl_xor(v, o);
    return v;
}
__device__ __forceinline__ float sigm(float x) { return __builtin_amdgcn_rcpf(1.0f + __expf(-x)); }
__device__ __forceinline__ float siluf_(float x) { return x * sigm(x); }
__device__ __forceinline__ float softplusf_(float x) { return fmaxf(x, 0.f) + __logf(1.0f + __expf(-fabsf(x))); }
__device__ __forceinline__ float logsigf_(float x) { return fminf(x, 0.f) - __logf(1.0f + __expf(-fabsf(x))); }
#define MFMA16(a, b, c) __builtin_amdgcn_mfma_f32_16x16x32_bf16((a), (b), (c), 0, 0, 0)
typedef short bf16x4 __attribute__((ext_vector_type(4)));
typedef unsigned u32x2 __attribute__((ext_vector_type(2)));
__device__ __forceinline__ bf16x8 cat8(bf16x4 lo, bf16x4 hi) { return __builtin_shufflevector(lo, hi, 0, 1, 2, 3, 4, 5, 6, 7); }
__device__ __forceinline__ bf16x8 pack8(const f32x4& a, const f32x4& b) {
    v4u w; w.x = cvtpk(a[0], a[1]); w.y = cvtpk(a[2], a[3]); w.z = cvtpk(b[0], b[1]); w.w = cvtpk(b[2], b[3]); return __builtin_bit_cast(bf16x8, w);
}
__device__ __forceinline__ u32x2 pack4(const f32x4& a) { u32x2 w; w.x = cvtpk(a[0], a[1]); w.y = cvtpk(a[2], a[3]); return w; }

struct Frame {
    LAS unsigned char* lds;
    volatile LAS unsigned* MISC;
    gu32* ctl;
    int tid, lane, wave;
    int vcu, G;
    unsigned char* ws;
    const float* in[24];
    float* out;
};
#define WSP(T_, off) ((T_*)(F.ws + (off)))

template <class RowMap>
__device__ __forceinline__ void transpose_item(const float* W, int K, int N, bf16* WT, LAS float* scr, int item, int lane, RowMap rm) {
    const int nblk = (N + 31) >> 5, kb = item / nblk, nb = item - kb * nblk, k0 = 64 * kb, n0 = 32 * nb;
    const int cq = (lane & 7) * 4, rr = lane >> 3;
#pragma unroll
    for (int i = 0; i < 8; ++i) { const int kk = 8 * i + rr; f32x4 v = {0.f, 0.f, 0.f, 0.f};
        if (n0 + cq < N) v = *(const GAS f32x4*)(W + (size_t)(k0 + kk) * N + n0 + cq);
        LAS float* s = scr + kk * 33 + cq; s[0] = v[0]; s[1] = v[1]; s[2] = v[2]; s[3] = v[3]; }
    LDS_WAIT(); asm volatile("" ::: "memory");
    const int c = lane & 7;
#pragma unroll
    for (int j = 0; j < 4; ++j) { const int n = (lane >> 3) + 8 * j; const LAS float* s = scr + (8 * c) * 33 + n;
        v4u o; o.x = cvtpk(s[0 * 33], s[1 * 33]); o.y = cvtpk(s[2 * 33], s[3 * 33]); o.z = cvtpk(s[4 * 33], s[5 * 33]); o.w = cvtpk(s[6 * 33], s[7 * 33]);
        if (n0 + n < N) *(GAS v4u*)(WT + (size_t)rm(n0 + n) * K + k0 + 8 * c) = o; }
    LDS_WAIT(); asm volatile("" ::: "memory");
}
struct RmId { __device__ __forceinline__ int operator()(int n) const { return n; } };
struct RmWin { __device__ __forceinline__ int operator()(int c) const { return c < 1536 ? c : (c < 1552 ? c + 2048 : (c < 3600 ? c - 16 : c)); } };
struct RmW1 { __device__ __forceinline__ int operator()(int c) const { const int j = c & 1023, up = c >> 10; return (j >> 7) * 256 + up * 128 + (j & 127); } };

__device__ __forceinline__ void rms_row_to_bf16(const float* xrow, const float* g, bf16* orow, int lane) {
    const GAS f32x4* xr = (const GAS f32x4*)xrow + lane; const GAS f32x4* gr = (const GAS f32x4*)g + lane;
    f32x4 v[4]; float s = 0.f;
#pragma unroll
    for (int j = 0; j < 4; ++j) { v[j] = xr[64 * j]; s += (v[j].x * v[j].x + v[j].y * v[j].y) + (v[j].z * v[j].z + v[j].w * v[j].w); }
    const float rstd = 1.f / sqrtf(wave_sum(s) * (1.f / D) + EPS);
    GAS u32x2* o8 = (GAS u32x2*)orow + lane;
#pragma unroll
    for (int j = 0; j < 4; ++j) { const f32x4 gg = gr[64 * j]; u32x2 w; w.x = cvtpk(v[j].x * rstd * gg.x, v[j].y * rstd * gg.y); w.y = cvtpk(v[j].z * rstd * gg.z, v[j].w * rstd * gg.w); o8[64 * j] = w; }
}

__device__ __forceinline__ void p0_prologue(Frame& F) {
    LAS float* scr = (LAS float*)(F.lds + RING_OFF + F.wave * 16384);
    const int gw = F.vcu * NWAVES + F.wave, NGW = F.G * NWAVES, lane = F.lane;
    bf16* Win_t = WSP(bf16, WS_WIN);
    for (int it = gw; it < 16 * 113; it += NGW) transpose_item(F.in[3], 1024, DIN, Win_t, scr, it, lane, RmWin());
    for (int r = DIN + gw; r < LDP; r += NGW) { GAS v4u* o = (GAS v4u*)(Win_t + (size_t)r * 1024) + lane; o[0] = (v4u){0, 0, 0, 0}; o[64] = (v4u){0, 0, 0, 0}; }
    for (int it = gw; it < 4 * 32; it += NGW) transpose_item(F.in[21], PLE, D, WSP(bf16, WS_WPP), scr, it, lane, RmId());
    for (int it = gw; it < 512; it += NGW) transpose_item(F.in[11], D, D, WSP(bf16, WS_WOUT), scr, it, lane, RmId());
    for (int it = gw; it < 512; it += NGW) transpose_item(F.in[20], D, D, WSP(bf16, WS_WPG), scr, it, lane, RmId());
    for (int it = gw; it < NE * 1024; it += NGW) { const int e = it >> 10; transpose_item(F.in[15] + (size_t)e * 1024 * 2048, 1024, 2048, WSP(bf16, WS_W1) + (size_t)e * 2048 * 1024, scr, it & 1023, lane, RmW1()); }
    for (int it = gw; it < NE * 512; it += NGW) { const int e = it >> 9; transpose_item(F.in[17] + (size_t)e * 1024 * 1024, 1024, 1024, WSP(bf16, WS_W2) + (size_t)e * 1024 * 1024, scr, it & 511, lane, RmId()); }
    for (int m = gw; m < T; m += NGW) rms_row_to_bf16(F.in[0] + (size_t)m * D, F.in[2], WSP(bf16, WS_XN) + (size_t)m * D, lane);
    for (int m = gw; m < T; m += NGW) { const f32x4 v = *((const GAS f32x4*)(F.in[1] + (size_t)m * PLE) + lane); u32x2 w; w.x = cvtpk(v.x, v.y); w.y = cvtpk(v.z, v.w); *((GAS u32x2*)(WSP(bf16, WS_PB) + (size_t)m * PLE) + lane) = w; }
}

constexpr int GL_B = 0, GL_GLR = 16640, GL_T1 = 20992, GL_T2 = 30208, GL_VT = 39424, GL_RED = 57856;
__device__ __forceinline__ void gla_b(Frame& F, int n, int h) {
    LAS float* bL = (LAS float*)(F.lds + GL_B); LAS float* glrL = (LAS float*)(F.lds + GL_GLR);
    const bf16* PROJ = WSP(bf16, WS_PROJ); const int tid = F.tid, t0 = n * 64;
    { const int idx = tid * 2, t = idx >> 4, r = idx & 15; const unsigned w = *(const GAS unsigned*)(PROJ + (size_t)(t0 + t) * LDP + C_GLR + r); glrL[t * 17 + r] = bflo(w); glrL[t * 17 + r + 1] = bfhi(w); }
    const int d = tid & 63, tg = tid >> 6;
    float wg[16];
#pragma unroll
    for (int r = 0; r < 16; ++r) wg[r] = F.in[4][r * 256 + h * 64 + d];
    const float bias = F.in[5][h * 64 + d];
    __syncthreads();
#pragma unroll
    for (int tt = 0; tt < 8; ++tt) { const int t = tg * 8 + tt; float a = bias;
#pragma unroll
        for (int r = 0; r < 16; ++r) a += glrL[t * 17 + r] * wg[r];
        bL[t * 65 + d] = logsigf_(a) * 0.0625f; }
    __syncthreads();
    if (tid < 64) { float run = 0.f;
#pragma unroll 16
        for (int t = 0; t < 64; ++t) { run += bL[t * 65 + tid]; bL[t * 65 + tid] = run; } }
    __syncthreads();
}
__device__ __forceinline__ void gla_load_vT(Frame& F, int n, int h) {
    LAS bf16* vT = (LAS bf16*)(F.lds + GL_VT); const bf16* PROJ = WSP(bf16, WS_PROJ);
    const int t = F.tid >> 3, eg = F.tid & 7;
    const GAS v4u* src = (const GAS v4u*)(PROJ + (size_t)(n * 64 + t) * LDP + C_GV + h * 128 + eg * 16);
#pragma unroll
    for (int half = 0; half < 2; ++half) { const v4u w = src[half];
#pragma unroll
        for (int i = 0; i < 4; ++i) { const int e = eg * 16 + half * 8 + 2 * i; vT[e * 72 + t] = (bf16)(w[i] & 0xffffu); vT[(e + 1) * 72 + t] = (bf16)(w[i] >> 16); } }
}

__device__ __forceinline__ void gla_prep_item(Frame& F, int n, int h) {
    gla_b(F, n, h);
    LAS float* bL = (LAS float*)(F.lds + GL_B); LAS bf16* T1 = (LAS bf16*)(F.lds + GL_T1); LAS bf16* vT = (LAS bf16*)(F.lds + GL_VT);
    const bf16* PROJ = WSP(bf16, WS_PROJ); const int tid = F.tid, lane = F.lane, w = F.wave;
    { const int t = tid >> 3, dg = tid & 7; const v4u kw = *(const GAS v4u*)(PROJ + (size_t)(n * 64 + t) * LDP + C_GK + h * 64 + dg * 8);
#pragma unroll
        for (int i = 0; i < 4; ++i) { const int d0 = dg * 8 + 2 * i;
            T1[d0 * 72 + t] = f2bf1(bflo(kw[i]) * __expf(bL[63 * 65 + d0] - bL[t * 65 + d0]));
            T1[(d0 + 1) * 72 + t] = f2bf1(bfhi(kw[i]) * __expf(bL[63 * 65 + d0 + 1] - bL[t * 65 + d0 + 1])); } }
    gla_load_vT(F, n, h);
    __syncthreads();
    const int c = lane & 15, kq = lane >> 4;
    bf16x8 a[2];
#pragma unroll
    for (int ks = 0; ks < 2; ++ks) a[ks] = *(const LAS bf16x8*)(vT + (16 * w + c) * 72 + 32 * ks + 8 * kq);
    float* KVT = WSP(float, WS_KVT) + (size_t)(n * 4 + h) * 128 * 64;
#pragma unroll
    for (int dt = 0; dt < 4; ++dt) { f32x4 acc = {0.f, 0.f, 0.f, 0.f};
#pragma unroll
        for (int ks = 0; ks < 2; ++ks) { const bf16x8 b = *(const LAS bf16x8*)(T1 + (16 * dt + c) * 72 + 32 * ks + 8 * kq); acc = MFMA16(a[ks], b, acc); }
#pragma unroll
        for (int r = 0; r < 4; ++r) KVT[(16 * w + 4 * kq + r) * 64 + 16 * dt + c] = acc[r]; }
    if (tid < 64) WSP(float, WS_DVEC)[(n * 4 + h) * 64 + tid] = __expf(bL[63 * 65 + tid]);
    __syncthreads();
}

__device__ __forceinline__ void mix_epilogue(Frame& F, const f32x4 (&o)[4], int n, int it, int eh, const float* gain, int gate_col, int mix_col) {
    LAS float* red = (LAS float*)(F.lds + GL_RED);
    const int lane = F.lane, c = lane & 15, kq = lane >> 4, w = F.wave;
    float ss = 0.f;
#pragma unroll
    for (int q = 0; q < 4; ++q)
#pragma unroll
        for (int r = 0; r < 4; ++r) ss += o[q][r] * o[q][r];
    ss += __shfl_xor(ss, 16); ss += __shfl_xor(ss, 32);
    if (kq == 0) red[w * 64 + c] = ss;
    __syncthreads();
    const float tot = red[it * 64 + c] + red[(it + 4) * 64 + c];
    const float rstd = 1.f / sqrtf(tot * (1.f / 128.f) + EPS);
    const int t = n * 64 + 16 * it + c;
    const bf16* PROJ = WSP(bf16, WS_PROJ); bf16* MIX = WSP(bf16, WS_MIX);
#pragma unroll
    for (int q = 0; q < 4; ++q) { const int e = 16 * (4 * eh + q) + 4 * kq;
        const u32x2 gw = *(const GAS u32x2*)(PROJ + (size_t)t * LDP + gate_col + e); const f32x4 gn = *(const GAS f32x4*)(gain + e);
        f32x4 v; v[0] = o[q][0] * rstd * gn[0] * siluf_(bflo(gw.x)); v[1] = o[q][1] * rstd * gn[1] * siluf_(bfhi(gw.x)); v[2] = o[q][2] * rstd * gn[2] * siluf_(bflo(gw.y)); v[3] = o[q][3] * rstd * gn[3] * siluf_(bfhi(gw.y));
        *(GAS u32x2*)(MIX + (size_t)t * D + mix_col + e) = pack4(v); }
    __syncthreads();
}

__device__ __forceinline__ void gla_out_item(Frame& F, int n, int h) {
    gla_b(F, n, h);
    LAS float* bL = (LAS float*)(F.lds + GL_B); LAS bf16* T1 = (LAS bf16*)(F.lds + GL_T1); LAS bf16* T2 = (LAS bf16*)(F.lds + GL_T2); LAS bf16* vT = (LAS bf16*)(F.lds + GL_VT);
    const bf16* PROJ = WSP(bf16, WS_PROJ); const int tid = F.tid, lane = F.lane, w = F.wave;
    { const int t = tid >> 3, dg = tid & 7;
        const v4u qw = *(const GAS v4u*)(PROJ + (size_t)(n * 64 + t) * LDP + C_GQ + h * 64 + dg * 8); const v4u kw = *(const GAS v4u*)(PROJ + (size_t)(n * 64 + t) * LDP + C_GK + h * 64 + dg * 8);
        v4u qo, ko;
#pragma unroll
        for (int i = 0; i < 4; ++i) { const int d0 = dg * 8 + 2 * i; const float b0 = bL[t * 65 + d0], b1 = bL[t * 65 + d0 + 1];
            qo[i] = cvtpk(bflo(qw[i]) * 0.125f * __expf(b0), bfhi(qw[i]) * 0.125f * __expf(b1));
            ko[i] = cvtpk(bflo(kw[i]) * __expf(-b0), bfhi(kw[i]) * __expf(-b1)); }
        *(LAS v4u*)(T1 + t * 72 + dg * 8) = qo; *(LAS v4u*)(T2 + t * 72 + dg * 8) = ko; }
    gla_load_vT(F, n, h);
    __syncthreads();
    const int c = lane & 15, kq = lane >> 4, it = w & 3, eh = w >> 2;
    bf16x8 bq[2];
#pragma unroll
    for (int ks = 0; ks < 2; ++ks) bq[ks] = *(const LAS bf16x8*)(T1 + (16 * it + c) * 72 + 32 * ks + 8 * kq);
    f32x4 at[4];
#pragma unroll
    for (int jt = 0; jt < 4; ++jt) { f32x4 acc = {0.f, 0.f, 0.f, 0.f};
        if (jt <= it) {
#pragma unroll
            for (int ks = 0; ks < 2; ++ks) { const bf16x8 a = *(const LAS bf16x8*)(T2 + (16 * jt + c) * 72 + 32 * ks + 8 * kq); acc = MFMA16(a, bq[ks], acc); }
            if (jt == it) {
#pragma unroll
                for (int r = 0; r < 4; ++r) if (4 * kq + r > c) acc[r] = 0.f; }
        }
        at[jt] = acc; }
    bf16x8 pb[2]; pb[0] = pack8(at[0], at[1]); pb[1] = pack8(at[2], at[3]);
    const bf16* ST = WSP(bf16, WS_SGLA) + (size_t)(n * 4 + h) * 128 * 64;
    f32x4 o[4];
#pragma unroll
    for (int q = 0; q < 4; ++q) { const int et = 4 * eh + q; f32x4 acc = {0.f, 0.f, 0.f, 0.f};
#pragma unroll
        for (int s = 0; s < 2; ++s) { const bf16x4 lo = *(const LAS bf16x4*)(vT + (16 * et + c) * 72 + 32 * s + 4 * kq), hi = *(const LAS bf16x4*)(vT + (16 * et + c) * 72 + 32 * s + 16 + 4 * kq);
            acc = MFMA16(cat8(lo, hi), pb[s], acc); }
#pragma unroll
        for (int ks = 0; ks < 2; ++ks) { const bf16x8 a = *(const GAS bf16x8*)(ST + (16 * et + c) * 64 + 32 * ks + 8 * kq); acc = MFMA16(a, bq[ks], acc); }
        o[q] = acc; }
    mix_epilogue(F, o, n, it, eh, F.in[6], C_GR + h * 128, h * 128);
}

__device__ __forceinline__ void gdn_out_item(Frame& F, int n, int h) {
    const int lane = F.lane, w = F.wave, c = lane & 15, kq = lane >> 4, it = w & 3, eh = w >> 2;
    const bf16* QD = WSP(bf16, WS_QDEC) + ((size_t)(n * 4 + h) * 64 + 16 * it + c) * 128; const bf16* AQ = WSP(bf16, WS_AQK) + ((size_t)(n * 4 + h) * 64 + 16 * it + c) * 64;
    bf16x8 bqd[4], baq[2];
#pragma unroll
    for (int ks = 0; ks < 4; ++ks) bqd[ks] = *(const GAS bf16x8*)(QD + 32 * ks + 8 * kq);
#pragma unroll
    for (int s = 0; s < 2; ++s) baq[s] = *(const GAS bf16x8*)(AQ + 32 * s + 8 * kq);
    const bf16* ST = WSP(bf16, WS_SGDN) + (size_t)(n * 4 + h) * 128 * 128; const bf16* DT = WSP(bf16, WS_DELTA) + (size_t)(n * 4 + h) * 128 * 64;
    f32x4 o[4];
#pragma unroll
    for (int q = 0; q < 4; ++q) { const int et = 4 * eh + q; f32x4 acc = {0.f, 0.f, 0.f, 0.f};
#pragma unroll
        for (int ks = 0; ks < 4; ++ks) { const bf16x8 a = *(const GAS bf16x8*)(ST + (16 * et + c) * 128 + 32 * ks + 8 * kq); acc = MFMA16(a, bqd[ks], acc); }
#pragma unroll
        for (int s = 0; s < 2; ++s) { const bf16x8 a = *(const GAS bf16x8*)(DT + (16 * et + c) * 64 + 32 * s + 8 * kq); acc = MFMA16(a, baq[s], acc); }
        o[q] = acc; }
    mix_epilogue(F, o, n, it, eh, F.in[10], C_DZ + h * 128, 512 + h * 128);
}

constexpr int GD_QB = 0, GD_KB = 17408, GD_VF = 34816, GD_LS = 67840, GD_WL = 84224, GD_SC = 101632;
__device__ __forceinline__ void gdn_prep_item(Frame& F, int n, int h) {
    LAS bf16* qb = (LAS bf16*)(F.lds + GD_QB); LAS bf16* kb = (LAS bf16*)(F.lds + GD_KB); LAS float* vf = (LAS float*)(F.lds + GD_VF);
    LAS float* Ls = (LAS float*)(F.lds + GD_LS); LAS bf16* wL = (LAS bf16*)(F.lds + GD_WL);
    LAS float* bS = (LAS float*)(F.lds + GD_SC); LAS float* betaS = bS + 64; LAS float* ebS = bS + 128;
    const bf16* PROJ = WSP(bf16, WS_PROJ); const int tid = F.tid, lane = F.lane, w = F.wave, t0 = n * 64;
    const size_t nh = (size_t)(n * 4 + h);
    if (tid < 64) {
        const float da = bf2f(PROJ[(size_t)(t0 + tid) * LDP + C_DA + h]), db = bf2f(PROJ[(size_t)(t0 + tid) * LDP + C_DB + h]);
        float g = -__expf(F.in[8][h]) * softplusf_(da + F.in[9][h]);
#pragma unroll
        for (int off = 1; off < 64; off <<= 1) { const float v = __shfl_up(g, off); if (lane >= off) g += v; }
        bS[tid] = g; betaS[tid] = sigm(db); ebS[tid] = __expf(g);
    }
    if (!(MK_DBG & 2) && lane < 48) {
        const int grp = lane >> 4, c8 = (lane & 15) * 8;
        const int colP = C_DQ + grp * 512 + h * 128 + c8;
        f32x4 wc[4][2];
#pragma unroll
        for (int j = 0; j < 4; ++j) { const GAS f32x4* wp = (const GAS f32x4*)(F.in[7] + (size_t)j * 1536 + grp * 512 + h * 128 + c8); wc[j][0] = wp[0]; wc[j][1] = wp[1]; }
        v4u xin[11];
#pragma unroll
        for (int rr = 0; rr < 11; ++rr) { const int r = t0 + w * 8 - 3 + rr; xin[rr] = (v4u){0, 0, 0, 0}; if (r >= 0) xin[rr] = *(const GAS v4u*)(PROJ + (size_t)r * LDP + colP); }
#pragma unroll
        for (int tt = 0; tt < 8; ++tt) {
            float y[8];
#pragma unroll
            for (int i = 0; i < 8; ++i) y[i] = 0.f;
#pragma unroll
            for (int j = 0; j < 4; ++j)
#pragma unroll
                for (int i = 0; i < 4; ++i) { const unsigned xw = xin[tt + j][i]; y[2 * i] += wc[j][i >> 1][(2 * i) & 3] * bflo(xw); y[2 * i + 1] += wc[j][i >> 1][(2 * i + 1) & 3] * bfhi(xw); }
            float ss = 0.f;
#pragma unroll
            for (int i = 0; i < 8; ++i) { y[i] = siluf_(y[i]); ss += y[i] * y[i]; }
            ss += __shfl_xor(ss, 1); ss += __shfl_xor(ss, 2); ss += __shfl_xor(ss, 4); ss += __shfl_xor(ss, 8);
            const int row = w * 8 + tt;
            if (grp < 2) { const float sc = (1.f / sqrtf(ss + EPS)) * (grp == 0 ? 0.08838834764831845f : 1.0f);
                v4u o; o.x = cvtpk(y[0] * sc, y[1] * sc); o.y = cvtpk(y[2] * sc, y[3] * sc); o.z = cvtpk(y[4] * sc, y[5] * sc); o.w = cvtpk(y[6] * sc, y[7] * sc);
                *(LAS v4u*)((grp == 0 ? qb : kb) + row * 136 + c8) = o;
            } else {
#pragma unroll
                for (int i = 0; i < 8; ++i) vf[row * 129 + c8 + i] = y[i]; }
        }
    }
    __syncthreads();
    if (!(MK_DBG & 4)) {
        const int c = lane & 15, kq = lane >> 4;
        bf16* AQ = WSP(bf16, WS_AQK) + nh * 64 * 64;
        for (int job = w; job < 20; job += 8) {
            const int kind = job >= 10 ? 1 : 0, idx = job - 10 * kind;
            const int it = idx >= 6 ? 3 : (idx >= 3 ? 2 : (idx >= 1 ? 1 : 0)), jt = idx - (it * (it + 1)) / 2;
            const LAS bf16* Am = kind ? qb : kb;
            f32x4 acc = {0.f, 0.f, 0.f, 0.f};
#pragma unroll
            for (int ks = 0; ks < 4; ++ks) { const bf16x8 a = *(const LAS bf16x8*)(Am + (16 * it + c) * 136 + 32 * ks + 8 * kq), b = *(const LAS bf16x8*)(kb + (16 * jt + c) * 136 + 32 * ks + 8 * kq); acc = MFMA16(a, b, acc); }
            const int j = 16 * jt + c; const float bj = bS[j];
#pragma unroll
            for (int r = 0; r < 4; ++r) { const int i = 16 * it + 4 * kq + r; const float dec = __expf(fminf(bS[i] - bj, 0.f));
                if (kind == 0) Ls[i * 64 + j] = (j < i) ? betaS[i] * dec * acc[r] : 0.f;
                else { AQ[i * 64 + j] = (j <= i) ? f2bf1(dec * acc[r]) : (bf16)0; if (jt < it) AQ[(16 * jt + 4 * kq + r) * 64 + 16 * it + c] = (bf16)0; } }
        }
    }
    __syncthreads();
    if ((MK_DBG & 8) && tid < 256) {} else if (tid < 256) {
        const int cc = tid; const bool isu = cc < 128;
        const int vidx = isu ? cc : 0, kidx = isu ? 0 : cc - 128;
        int zlane; asm volatile("v_mov_b32 %0, 0" : "=v"(zlane));
        float sol[64];
#pragma unroll
        for (int i = 0; i < 64; ++i) {
            int z = zlane; if (i >= 2) asm volatile("v_and_b32 %0, 0, %1" : "=v"(z) : "v"(sol[i - 2]));
            const LAS float* Lz = Ls + z;
            float a = isu ? betaS[i + z] * vf[i * 129 + vidx + z] : betaS[i + z] * ebS[i + z] * bf2f(kb[i * 136 + kidx + z]);
#pragma unroll
            for (int j = 0; j < i; ++j) a -= Lz[i * 64 + j] * sol[j];
            sol[i] = a;
        }
        if (isu) { const int s = cc >> 4, c16 = cc & 15; float* Uf = WSP(float, WS_UF) + ((nh * 8 + s) * 4) * 256;
#pragma unroll
            for (int mt = 0; mt < 4; ++mt)
#pragma unroll
                for (int q = 0; q < 4; ++q) { f32x4 v = {sol[16 * mt + 4 * q], sol[16 * mt + 4 * q + 1], sol[16 * mt + 4 * q + 2], sol[16 * mt + 4 * q + 3]}; *(GAS f32x4*)(Uf + (mt * 64 + q * 16 + c16) * 4) = v; }
        } else { const int d = cc - 128;
#pragma unroll
            for (int i = 0; i < 64; ++i) wL[i * 136 + d] = f2bf1(-sol[i]); }
    } else if (!(MK_DBG & 16)) {
        const int tt = tid - 256; const float bl = bS[63];
        bf16* QD = WSP(bf16, WS_QDEC) + nh * 64 * 128;
#pragma unroll
        for (int j = 0; j < 4; ++j) { const int id = tt + 256 * j, i = id >> 4, c8 = (id & 15) * 8; const v4u qw = *(const LAS v4u*)(qb + i * 136 + c8); const float e = ebS[i];
            v4u o; o.x = cvtpk(bflo(qw.x) * e, bfhi(qw.x) * e); o.y = cvtpk(bflo(qw.y) * e, bfhi(qw.y) * e); o.z = cvtpk(bflo(qw.z) * e, bfhi(qw.z) * e); o.w = cvtpk(bflo(qw.w) * e, bfhi(qw.w) * e);
            *(GAS v4u*)(QD + i * 128 + c8) = o; }
        bf16* KDF = WSP(bf16, WS_KDF) + nh * 16 * 512;
#pragma unroll
        for (int j = 0; j < 4; ++j) { const int id = tt + 256 * j, f = id >> 6, ln = id & 63, dt = f >> 1, ks2 = f & 1, q = ln >> 4, m = ln & 15, d = 16 * dt + m;
            float v[8];
#pragma unroll
            for (int x = 0; x < 8; ++x) { const int i = 32 * ks2 + (x < 4 ? 4 * q + x : 16 + 4 * q + (x - 4)); v[x] = bf2f(kb[i * 136 + d]) * __expf(bl - bS[i]); }
            v4u o; o.x = cvtpk(v[0], v[1]); o.y = cvtpk(v[2], v[3]); o.z = cvtpk(v[4], v[5]); o.w = cvtpk(v[6], v[7]);
            *(GAS v4u*)(KDF + ((size_t)f * 64 + ln) * 8) = o; }
        if (tt == 0) WSP(float, WS_CDEC)[nh] = __expf(bl);
    }
    __syncthreads();
    if (!(MK_DBG & 32)) { bf16* WF = WSP(bf16, WS_WF) + nh * 16 * 512;
#pragma unroll
        for (int j = 0; j < 2; ++j) { const int id = tid + 512 * j, f = id >> 6, ln = id & 63, mt = f >> 2, ks = f & 3, q = ln >> 4, m = ln & 15;
            const u32x2 lo = *(const LAS u32x2*)(wL + (16 * mt + m) * 136 + 32 * ks + 4 * q), hi = *(const LAS u32x2*)(wL + (16 * mt + m) * 136 + 32 * ks + 16 + 4 * q);
            *(GAS v4u*)(WF + ((size_t)f * 64 + ln) * 8) = (v4u){lo.x, lo.y, hi.x, hi.y}; } }
    __syncthreads();
}

__device__ __forceinline__ void gdn_scan(Frame& F, int h, int s) {
    const int lane = F.lane, c = lane & 15, kq = lane >> 4;
    const bf16x8* WF = (const bf16x8*)WSP(bf16, WS_WF); const bf16x8* KDF = (const bf16x8*)WSP(bf16, WS_KDF); const f32x4* UF = (const f32x4*)WSP(float, WS_UF);
    const float* CDEC = WSP(float, WS_CDEC); bf16* SG = WSP(bf16, WS_SGDN); bf16* DL = WSP(bf16, WS_DELTA);
    f32x4 S[8];
#pragma unroll
    for (int i = 0; i < 8; ++i) S[i] = (f32x4){0.f, 0.f, 0.f, 0.f};
    bf16x8 wf[16], kf[16]; f32x4 u[4];
    {   const size_t nh = (size_t)h;
#pragma unroll
        for (int f = 0; f < 16; ++f) wf[f] = WF[(nh * 16 + f) * 64 + lane];
#pragma unroll
        for (int mt = 0; mt < 4; ++mt) u[mt] = UF[((nh * 8 + s) * 4 + mt) * 64 + lane]; }
    for (int n = 0; n < NCH; ++n) {
        const size_t nh = (size_t)(n * 4 + h);
#pragma unroll
        for (int f = 0; f < 16; ++f) kf[f] = KDF[(nh * 16 + f) * 64 + lane];
        const float cd = CDEC[nh];
        bf16* sg = SG + (nh * 128 + 16 * s + c) * 128 + 4 * kq;
#pragma unroll
        for (int dt = 0; dt < 8; ++dt) *(GAS u32x2*)(sg + 16 * dt) = pack4(S[dt]);
        f32x4 dl[4];
#pragma unroll
        for (int mt = 0; mt < 4; ++mt) dl[mt] = u[mt];
#pragma unroll
        for (int ks = 0; ks < 4; ++ks) { const bf16x8 sb = pack8(S[2 * ks], S[2 * ks + 1]);
#pragma unroll
            for (int mt = 0; mt < 4; ++mt) dl[mt] = MFMA16(wf[mt * 4 + ks], sb, dl[mt]); }
        bf16* dp = DL + (nh * 128 + 16 * s + c) * 64 + 4 * kq;
#pragma unroll
        for (int mt = 0; mt < 4; ++mt) *(GAS u32x2*)(dp + 16 * mt) = pack4(dl[mt]);
        if (n + 1 < NCH) { const size_t nh1 = (size_t)((n + 1) * 4 + h);
#pragma unroll
            for (int f = 0; f < 16; ++f) wf[f] = WF[(nh1 * 16 + f) * 64 + lane];
#pragma unroll
            for (int mt = 0; mt < 4; ++mt) u[mt] = UF[((nh1 * 8 + s) * 4 + mt) * 64 + lane]; }
#pragma unroll
        for (int dt = 0; dt < 8; ++dt) S[dt] = S[dt] * cd;
#pragma unroll
        for (int ks2 = 0; ks2 < 2; ++ks2) { const bf16x8 db = pack8(dl[2 * ks2], dl[2 * ks2 + 1]);
#pragma unroll
            for (int dt = 0; dt < 8; ++dt) S[dt] = MFMA16(kf[dt * 2 + ks2], db, S[dt]); }
    }
}
__device__ __forceinline__ void gla_scan(Frame& F, int gid) {
    const int h = gid >> 11, rem = gid & 2047, e = rem >> 4, dg = rem & 15;
    const float* KVT = WSP(float, WS_KVT); const float* DV = WSP(float, WS_DVEC); bf16* SG = WSP(bf16, WS_SGLA);
    f32x4 S = {0.f, 0.f, 0.f, 0.f};
#pragma unroll 8
    for (int n = 0; n < NCH; ++n) { const size_t nh = (size_t)(n * 4 + h);
        const f32x4 kv = *(const GAS f32x4*)(KVT + (nh * 128 + e) * 64 + 4 * dg), dv = *(const GAS f32x4*)(DV + nh * 64 + 4 * dg);
        *(GAS u32x2*)(SG + (nh * 128 + e) * 64 + 4 * dg) = pack4(S);
        S = dv * S + kv; }
}

__device__ __forceinline__ void route_phase(Frame& F) {
    LAS float* WrT = (LAS float*)(F.lds + RING_OFF);
    const int tid = F.tid, lane = F.lane;
    for (int idx = tid; idx < 8192; idx += 512) { const int d = idx & 1023, e4 = (idx >> 10) * 4; const f32x4 v = *(const GAS f32x4*)(F.in[13] + (size_t)d * 32 + e4);
        WrT[(e4 + 0) * 1024 + d] = v[0]; WrT[(e4 + 1) * 1024 + d] = v[1]; WrT[(e4 + 2) * 1024 + d] = v[2]; WrT[(e4 + 3) * 1024 + d] = v[3]; }
    __syncthreads();
    const int gw = F.vcu * NWAVES + F.wave, NGW = F.G * NWAVES;
    const float brt = F.in[14][lane >> 1];
    unsigned* cnt = (unsigned*)(F.ctl + CW_CNT);
    for (int t = gw; t < T; t += NGW) {
        const GAS f32x4* xr = (const GAS f32x4*)(F.out + (size_t)t * D) + lane; const GAS f32x4* gr = (const GAS f32x4*)F.in[12] + lane;
        f32x4 v[4]; float s = 0.f;
#pragma unroll
        for (int j = 0; j < 4; ++j) { v[j] = xr[64 * j]; s += (v[j].x * v[j].x + v[j].y * v[j].y) + (v[j].z * v[j].z + v[j].w * v[j].w); }
        const float rstd = 1.f / sqrtf(wave_sum(s) * (1.f / D) + EPS);
        GAS u32x2* o8 = (GAS u32x2*)(WSP(bf16, WS_XN) + (size_t)t * D) + lane;
#pragma unroll
        for (int j = 0; j < 4; ++j) { const f32x4 gg = gr[64 * j]; v[j].x *= rstd * gg.x; v[j].y *= rstd * gg.y; v[j].z *= rstd * gg.z; v[j].w *= rstd * gg.w; o8[64 * j] = pack4(v[j]); }
        float p[32];
#pragma unroll
        for (int e = 0; e < 32; ++e) { float a = 0.f;
#pragma unroll
            for (int j = 0; j < 4; ++j) { const f32x4 wv = *(const LAS f32x4*)(WrT + e * 1024 + 4 * lane + 256 * j); a += (v[j].x * wv.x + v[j].y * wv.y) + (v[j].z * wv.z + v[j].w * wv.w); }
            p[e] = a; if ((e & 3) == 3) __builtin_amdgcn_sched_barrier(0); }
        float q16[16], q8[8], q4[4], q2[2], q1;
        { const bool hi = lane & 32;
#pragma unroll
            for (int k = 0; k < 16; ++k) { const float send = hi ? p[k] : p[k + 16], keep = hi ? p[k + 16] : p[k]; q16[k] = keep + __shfl_xor(send, 32); } }
        { const bool hi = lane & 16;
#pragma unroll
            for (int k = 0; k < 8; ++k) { const float send = hi ? q16[k] : q16[k + 8], keep = hi ? q16[k + 8] : q16[k]; q8[k] = keep + __shfl_xor(send, 16); } }
        { const bool hi = lane & 8;
#pragma unroll
            for (int k = 0; k < 4; ++k) { const float send = hi ? q8[k] : q8[k + 4], keep = hi ? q8[k + 4] : q8[k]; q4[k] = keep + __shfl_xor(send, 8); } }
        { const bool hi = lane & 4;
#pragma unroll
            for (int k = 0; k < 2; ++k) { const float send = hi ? q4[k] : q4[k + 2], keep = hi ? q4[k + 2] : q4[k]; q2[k] = keep + __shfl_xor(send, 4); } }
        { const bool hi = lane & 2; const float send = hi ? q2[0] : q2[1], keep = hi ? q2[1] : q2[0]; q1 = keep + __shfl_xor(send, 2); }
        q1 += __shfl_xor(q1, 1);
        const float mylogit = q1 + brt;
        float lg[32];
#pragma unroll
        for (int e = 0; e < 32; ++e) lg[e] = __shfl(mylogit, 2 * e);
        unsigned used = 0u; int sel[4]; float val[4];
#pragma unroll
        for (int k = 0; k < 4; ++k) { float best = -3.0e38f; int bi = 0;
#pragma unroll
            for (int e = 0; e < 32; ++e) { const bool ok = (lg[e] > best) && !((used >> e) & 1u); best = ok ? lg[e] : best; bi = ok ? e : bi; }
            sel[k] = bi; val[k] = best; used |= 1u << bi; }
        const float e1 = __expf(val[1] - val[0]), e2 = __expf(val[2] - val[0]), e3 = __expf(val[3] - val[0]); const float inv = 1.f / (1.f + e1 + e2 + e3);
        if (lane < 4) { const int ek = lane == 0 ? sel[0] : (lane == 1 ? sel[1] : (lane == 2 ? sel[2] : sel[3])); const float gk = (lane == 0 ? 1.f : (lane == 1 ? e1 : (lane == 2 ? e2 : e3))) * inv;
            const unsigned slot = atomicAdd(cnt + ek, 1u);
            WSP(int, WS_TOKE)[t * 4 + lane] = ek; WSP(int, WS_TOKS)[t * 4 + lane] = (int)slot; WSP(float, WS_TOKG)[t * 4 + lane] = gk; }
    }
}
__device__ __forceinline__ void moe_tables(Frame& F) {
    LAS int* tile_e = (LAS int*)(F.lds + TILEE_OFF); LAS int* baseL = (LAS int*)(F.lds + BASE_OFF);
    if (F.tid < 64) { const int e = F.lane & 31; const unsigned c = __hip_atomic_load((unsigned*)(F.ctl + CW_CNT) + e, RLX_AGENT);
        const int nt = (int)((c + 255u) >> 8); int incl = nt;
#pragma unroll
        for (int off = 1; off < 32; off <<= 1) { const int v = __shfl_up(incl, off); if ((F.lane & 31) >= off) incl += v; }
        const int tb = incl - nt;
        if (F.lane < 32) { baseL[e] = tb * 256; for (int i = 0; i < nt; ++i) tile_e[tb + i] = e; if (e == 31) tile_e[319] = incl; } }
    __syncthreads();
}
__device__ __forceinline__ void scatter_phase(Frame& F) {
    moe_tables(F);
    LAS int* baseL = (LAS int*)(F.lds + BASE_OFF);
    const int gw = F.vcu * NWAVES + F.wave, NGW = F.G * NWAVES, lane = F.lane;
    for (int t = gw; t < T; t += NGW) {
        int pos = 0;
        if (lane < 4) { const int e = WSP(int, WS_TOKE)[t * 4 + lane], sl = WSP(int, WS_TOKS)[t * 4 + lane]; pos = baseL[e] + sl; WSP(int, WS_TOKP)[t * 4 + lane] = pos; WSP(float, WS_GPOS)[pos] = WSP(float, WS_TOKG)[t * 4 + lane]; }
        const GAS v4u* src = (const GAS v4u*)(WSP(bf16, WS_XN) + (size_t)t * D) + lane; const v4u a = src[0], b = src[64];
#pragma unroll
        for (int k = 0; k < 4; ++k) { const int pk = __shfl(pos, k); GAS v4u* dst = (GAS v4u*)(WSP(bf16, WS_XS) + (size_t)pk * D) + lane; dst[0] = a; dst[64] = b; }
    }
}
__device__ __forceinline__ void combine_phase(Frame& F) {
    const int gw = F.vcu * NWAVES + F.wave, NGW = F.G * NWAVES, lane = F.lane;
    for (int t = gw; t < T; t += NGW) {
        GAS f32x4* xr = (GAS f32x4*)(F.out + (size_t)t * D) + lane;
        f32x4 v[4];
#pragma unroll
        for (int j = 0; j < 4; ++j) v[j] = xr[64 * j];
#pragma unroll
        for (int k = 0; k < 4; ++k) { const int pk = WSP(int, WS_TOKP)[t * 4 + k]; const GAS u32x2* yr = (const GAS u32x2*)(WSP(bf16, WS_XS) + (size_t)pk * D) + lane;
#pragma unroll
            for (int j = 0; j < 4; ++j) { const u32x2 w = yr[64 * j]; v[j].x += bflo(w.x); v[j].y += bfhi(w.x); v[j].z += bflo(w.y); v[j].w += bfhi(w.y); } }
        float s = 0.f;
#pragma unroll
        for (int j = 0; j < 4; ++j) { xr[64 * j] = v[j]; s += (v[j].x * v[j].x + v[j].y * v[j].y) + (v[j].z * v[j].z + v[j].w * v[j].w); }
        const float rstd = 1.f / sqrtf(wave_sum(s) * (1.f / D) + EPS);
        const GAS f32x4* gr = (const GAS f32x4*)F.in[19] + lane; GAS u32x2* o8 = (GAS u32x2*)(WSP(bf16, WS_XN) + (size_t)t * D) + lane;
#pragma unroll
        for (int j = 0; j < 4; ++j) { const f32x4 gg = gr[64 * j]; f32x4 a = {v[j].x * rstd * gg.x, v[j].y * rstd * gg.y, v[j].z * rstd * gg.z, v[j].w * rstd * gg.w}; o8[64 * j] = pack4(a); }
        const GAS u32x2* pr = (const GAS u32x2*)(WSP(bf16, WS_PERAW) + (size_t)t * D) + lane; float ps = 0.f;
#pragma unroll
        for (int j = 0; j < 4; ++j) { const u32x2 w = pr[64 * j]; const float a = bflo(w.x), b = bfhi(w.x), c = bflo(w.y), d = bfhi(w.y); ps += (a * a + b * b) + (c * c + d * d); }
        ps = wave_sum(ps);
        if (lane == 0) WSP(float, WS_PERSTD)[t] = 1.f / sqrtf(ps * (1.f / D) + EPS);
    }
}
__device__ __forceinline__ void final_phase(Frame& F) {
    const int gw = F.vcu * NWAVES + F.wave, NGW = F.G * NWAVES, lane = F.lane;
    for (int t = gw; t < T; t += NGW) {
        GAS f32x4* xr = (GAS f32x4*)(F.out + (size_t)t * D) + lane; const GAS f32x4* gr = (const GAS f32x4*)F.in[23] + lane;
        f32x4 v[4]; float s = 0.f;
#pragma unroll
        for (int j = 0; j < 4; ++j) { v[j] = xr[64 * j]; s += (v[j].x * v[j].x + v[j].y * v[j].y) + (v[j].z * v[j].z + v[j].w * v[j].w); }
        const float rstd = 1.f / sqrtf(wave_sum(s) * (1.f / D) + EPS);
#pragma unroll
        for (int j = 0; j < 4; ++j) { const f32x4 gg = gr[64 * j]; xr[64 * j] = (f32x4){v[j].x * rstd * gg.x, v[j].y * rstd * gg.y, v[j].z * rstd * gg.z, v[j].w * rstd * gg.w}; }
    }
}

constexpr int NPH = 13;
struct Args { const float* in[24]; float* out; unsigned char* ws; int ph_lo, ph_hi; };
static_assert(sizeof(Args) == 24 * 8 + 8 + 8 + 8, "Args has no padding");
__global__ void __launch_bounds__(NWAVES * 64, 2) fwd_kernel(Args args) {
    extern __shared__ __attribute__((aligned(16))) unsigned char lds[];
    Frame F;
    F.lds = (LAS unsigned char*)lds;
    F.MISC = (volatile LAS unsigned*)(F.lds + MISC_OFF);
    F.tid = threadIdx.x; F.lane = F.tid & 63; F.wave = __builtin_amdgcn_readfirstlane(F.tid >> 6);
    F.G = gridDim.x; { const int bx = blockIdx.x; F.vcu = (F.G % 8 == 0) ? (bx % 8) * (F.G / 8) + bx / 8 : bx; }
    F.ws = args.ws; F.ctl = (gu32*)(args.ws + WS_CTL); F.out = args.out;
#pragma unroll
    for (int i = 0; i < 24; ++i) F.in[i] = args.in[i];
    for (int u = F.tid; u < (LDS_BYTES - LDSCTL_OFF) / 4; u += NWAVES * 64) ((LAS unsigned*)(F.lds + LDSCTL_OFF))[u] = 0u;
    __syncthreads();
    const int lo = args.ph_lo, hi = args.ph_hi;
    XcdBarrier bar; bar.bar = (unsigned*)(F.ctl + CW_BAR); bar.x = 0; bar.st = nullptr;
    if (hi - lo > 1) bar = xcd_barrier_post((unsigned*)(F.ctl + CW_BAR), F.MISC + 8);
#define IN(k) (lo <= (k) && (k) < hi && !((MK_SKIP >> (k)) & 1))
#define SEAM(k) do { if ((lo <= (k)) && ((k) + 1 < hi)) xcd_barrier(bar); } while (0)

    if (IN(0)) { p0_prologue(F); SEAM(0); }
    if (IN(1)) {
        { pg8::Gemm g{WSP(bf16, WS_XN), WSP(bf16, WS_WIN), T, LDP, D}; pg8::StaticOrder S; S.init(T, LDP, F.G, (int)blockIdx.x);
          pg8::EpiBf16P E{WSP(bf16, WS_PROJ), LDP};
          pg8::gemm_phase<pg8::EpiBf16P, pg8::StaticOrder, true, true>(F.lds + RING_OFF, g, S, E); }
        { pg8::Gemm g{WSP(bf16, WS_PB), WSP(bf16, WS_WPP), T, D, PLE}; pg8::StaticOrder S; S.init(T, D, F.G, (int)blockIdx.x);
          pg8::EpiBf16P E{WSP(bf16, WS_PERAW), D};
          pg8::gemm_phase<pg8::EpiBf16P, pg8::StaticOrder, true, true>(F.lds + RING_OFF, g, S, E); }
        SEAM(1);
    }
    if (IN(2)) {
        for (int i = blockIdx.x; i < NCH * 8; i += F.G) { const int n = i >> 3, hh = (i + (i >> 8)) & 7;
            if (hh < 4) { if (!(MK_DBG & 1)) gla_prep_item(F, n, hh); } else gdn_prep_item(F, n, hh - 4); }
        SEAM(2);
    }
    if (IN(3)) {
        if (F.wave == 0) { if (F.vcu < 32) gdn_scan(F, F.vcu >> 3, F.vcu & 7); else if (F.vcu < 160) gla_scan(F, (F.vcu - 32) * 64 + F.lane); }
        SEAM(3);
    }
    if (IN(4)) {
        for (int i = blockIdx.x; i < NCH * 8; i += F.G) { const int n = i >> 3, hh = (i + (i >> 8)) & 7;
            if (hh < 4) gla_out_item(F, n, hh); else gdn_out_item(F, n, hh - 4); }
        SEAM(4);
    }
    if (IN(5)) {
        pg8::Gemm g{WSP(bf16, WS_MIX), WSP(bf16, WS_WOUT), T, D, D}; pg8::StaticOrder S; S.init(T, D, F.G, (int)blockIdx.x);
        pg8::EpiResF32 E{F.in[0], F.out, D};
        pg8::gemm_phase<pg8::EpiResF32, pg8::StaticOrder, true, true>(F.lds + RING_OFF, g, S, E);
        SEAM(5);
    }
    if (IN(6)) { route_phase(F); SEAM(6); }
    if (IN(7)) { scatter_phase(F); SEAM(7); }
    if (IN(8)) {
        moe_tables(F);
        const LAS int* tile_e = (const LAS int*)(F.lds + TILEE_OFF); const int ntiles = __builtin_amdgcn_readfirstlane(tile_e[319]);
        pg8::Gemm g{WSP(bf16, WS_XS), WSP(bf16, WS_W1), XS_ROWS, 2048, D}; pg8::MoeOrder S{tile_e, ntiles, 8, F.G, (int)blockIdx.x};
        pg8::EpiMoeAct E{WSP(bf16, WS_HS), F.in[16]};
        pg8::gemm_phase<pg8::EpiMoeAct, pg8::MoeOrder, true, true>(F.lds + RING_OFF, g, S, E);
        SEAM(8);
    }
    if (IN(9)) {
        moe_tables(F);
        const LAS int* tile_e = (const LAS int*)(F.lds + TILEE_OFF); const int ntiles = __builtin_amdgcn_readfirstlane(tile_e[319]);
        pg8::Gemm g{WSP(bf16, WS_HS), WSP(bf16, WS_W2), XS_ROWS, D, D}; pg8::MoeOrder S{tile_e, ntiles, 4, F.G, (int)blockIdx.x};
        pg8::EpiMoeDown E{WSP(bf16, WS_XS), F.in[18], WSP(float, WS_GPOS)};
        pg8::gemm_phase<pg8::EpiMoeDown, pg8::MoeOrder, true, true>(F.lds + RING_OFF, g, S, E);
        SEAM(9);
    }
    if (IN(10)) { combine_phase(F); SEAM(10); }
    if (IN(11)) {
        pg8::Gemm g{WSP(bf16, WS_XN), WSP(bf16, WS_WPG), T, D, D}; pg8::StaticOrder S; S.init(T, D, F.G, (int)blockIdx.x);
        pg8::EpiPle E{F.out, WSP(bf16, WS_PERAW), WSP(float, WS_PERSTD), F.in[22]};
        pg8::gemm_phase<pg8::EpiPle, pg8::StaticOrder, true, true>(F.lds + RING_OFF, g, S, E);
        SEAM(11);
    }
    if (IN(12)) { final_phase(F); }
#undef IN
#undef SEAM
}

extern "C" void kernel_launch(void* const* d_in, const int* in_sizes, int n_in, void* d_out, int out_size, void* d_ws, size_t ws_size, hipStream_t stream) {
    static int grid = 0;
    if (grid == 0) {
        if (n_in != 24 || in_sizes[0] != T * D || out_size != T * D || ws_size < WS_END) { fprintf(stderr, "kernel_launch: unexpected shapes (n_in %d, in0 %d, out %d, ws %zu); nothing launched\n", n_in, n_in > 0 ? in_sizes[0] : -1, out_size, ws_size); grid = -1; return; }
        int dev = 0, cus = 0;
        if (hipGetDevice(&dev) != hipSuccess || hipDeviceGetAttribute(&cus, hipDeviceAttributeMultiprocessorCount, dev) != hipSuccess) { grid = -1; return; }
        if (hipFuncSetAttribute((const void*)fwd_kernel, hipFuncAttributeMaxDynamicSharedMemorySize, LDS_BYTES) != hipSuccess) { fprintf(stderr, "kernel_launch: hipFuncSetAttribute failed\n"); grid = -1; return; }
        int per_cu = 0;
        if (hipOccupancyMaxActiveBlocksPerMultiprocessor(&per_cu, (const void*)fwd_kernel, NWAVES * 64, LDS_BYTES) != hipSuccess || per_cu < 1) fprintf(stderr, "kernel_launch: occupancy query reports %d blocks per CU\n", per_cu);
        (void)hipGetLastError();
        grid = cus;
    }
    if (grid < 0) return;
    if (hipMemsetAsync((char*)d_ws + WS_CTL, 0, CTL_ZERO_BYTES, stream) != hipSuccess) return;
    Args a{};
    for (int i = 0; i < 24; ++i) a.in[i] = (const float*)d_in[i];
    a.out = (float*)d_out; a.ws = (unsigned char*)d_ws;
#if MK_ONE_LAUNCH
    a.ph_lo = 0; a.ph_hi = NPH;
    hipLaunchKernelGGL(fwd_kernel, dim3(grid), dim3(NWAVES * 64), LDS_BYTES, stream, a);
#else
    for (int p = 0; p < NPH; ++p) { a.ph_lo = p; a.ph_hi = p + 1; hipLaunchKernelGGL(fwd_kernel, dim3(grid), dim3(NWAVES * 64), LDS_BYTES, stream, a); }
#endif
}
```

```cpp
#include <hip/hip_runtime.h>
#include <cstdio>
#include <cstdint>
#ifndef MK_ONE_LAUNCH
#define MK_ONE_LAUNCH 1
#endif
#ifndef MK_SKIP
#define MK_SKIP 0
#endif
#ifndef MK_DBG
#define MK_DBG 0
#endif
#ifndef MK_REP
#define MK_REP 0
#endif
namespace pg8 {
#define PG8_LAS __attribute__((address_space(3)))
typedef unsigned short bf16_t;
typedef short bf16x8 __attribute__((ext_vector_type(8)));
typedef float f32x4 __attribute__((ext_vector_type(4)));
typedef unsigned u32x4 __attribute__((ext_vector_type(4)));
constexpr int BM = 256, BK = 64, HALF = 128, HTB = HALF * BK * 2  , STAGE_BYTES = 8 * HTB, NXCD = 8, WGM = 8;

__host__ __device__ __forceinline__ int lds_byte(int r, int c) { const int st = (r >> 4) * 2 + (c >> 5), rr = r & 15, cc = c & 31, ob = rr * 64 + cc * 2; return st * 1024 + (ob ^ (((ob >> 9) & 1) << 5)); }
__host__ __device__ __forceinline__ void stage_rc(int b, int& R, int& C) { const int st = b / 1024, sb = b % 1024, swz = sb ^ (((sb >> 9) & 1) << 5); R = (st >> 1) * 16 + swz / 64; C = (st & 1) * 32 + (swz % 64) / 2; }
__host__ __device__ __forceinline__ int perm32(int rho) { const int n = rho >> 4, i = rho & 15; return 8 * (i >> 2) + 4 * n + (i & 3); }

struct Unit { int pm, pn, pb, e; };
struct Gemm { const bf16_t* A; const bf16_t* Bt; int M, N, K; };

struct StaticOrder {
    int nM, nN, nwg, G, c;
    __host__ __device__ void init(int M, int N, int G_, int c_) { nM = M / BM; nN = N / BM; nwg = nM * nN; G = G_; c = c_; }
    __host__ __device__ bool next(int i, Unit& u) const {
        const long L = (long)i * G + c; if (L >= nwg) return false;
        int wgid = (int)L; { const int q = nwg / NXCD, r = nwg % NXCD, xcd = wgid % NXCD, off = wgid / NXCD; wgid = (xcd < r ? xcd * (q + 1) : r * (q + 1) + (xcd - r) * q) + off; }
        const int nig = WGM * nN, gid = wgid / nig, fm = gid * WGM, gsz = (nM - fm) < WGM ? (nM - fm) : WGM;
        u.pm = fm + ((wgid % nig) % gsz); u.pn = (wgid % nig) / gsz; u.pb = u.pn; u.e = 0; return true;
    }
    __device__ __forceinline__ void a_ready(const Unit&) const {}
    __device__ __forceinline__ void done(const Unit&) const {}
};

__device__ __forceinline__ unsigned cvt_pk_bf16(float lo, float hi) { unsigned r; asm volatile("v_cvt_pk_bf16_f32 %0, %1, %2" : "=v"(r) : "v"(lo), "v"(hi)); return r; }

typedef float f32x2 __attribute__((ext_vector_type(2)));
typedef unsigned u32x2 __attribute__((ext_vector_type(2)));
typedef __bf16 bf16x2v __attribute__((ext_vector_type(2)));
__device__ __forceinline__ unsigned cvtpk(float lo, float hi) { f32x2 v = {lo, hi}; bf16x2v b = __builtin_convertvector(v, bf16x2v); return __builtin_bit_cast(unsigned, b); }
__device__ __forceinline__ float sigmoidf_(float x) { return __builtin_amdgcn_rcpf(1.0f + __expf(-x)); }

struct EpiBf16P {
    static constexpr bool PERM = true, AFTER_DRAIN = false;
    bf16_t* O; int ldc;
    __device__ __forceinline__ void operator()(const f32x4 (&acc)[2][2][4][2], const Unit& u, int wr, int wc, int fr, int fq) const {
        const int row0 = u.pm * BM + wr * 64 + fr, col0 = u.pn * BM + wc * 32 + 8 * fq;
#pragma unroll
        for (int ai = 0; ai < 2; ++ai)
#pragma unroll
            for (int m = 0; m < 4; ++m) { bf16_t* rowp = O + (size_t)(row0 + ai * HALF + m * 16) * ldc + col0;
#pragma unroll
                for (int bj = 0; bj < 2; ++bj) { const f32x4 v0 = acc[ai][bj][m][0], v1 = acc[ai][bj][m][1];
                    u32x4 w; w.x = cvtpk(v0[0], v0[1]); w.y = cvtpk(v0[2], v0[3]); w.z = cvtpk(v1[0], v1[1]); w.w = cvtpk(v1[2], v1[3]);
                    *(u32x4*)(rowp + bj * HALF) = w; } }
    }
};
struct EpiResF32 {
    static constexpr bool PERM = false, AFTER_DRAIN = false;
    const float* base; float* out; int ldc;
    __device__ __forceinline__ void operator()(const f32x4 (&acc)[2][2][4][2], const Unit& u, int wr, int wc, int fr, int fq) const {
        const int row0 = u.pm * BM + wr * 64 + fr, col0 = u.pn * BM + wc * 32 + 4 * fq;
#pragma unroll
        for (int ai = 0; ai < 2; ++ai)
#pragma unroll
            for (int m = 0; m < 4; ++m) { const size_t off = (size_t)(row0 + ai * HALF + m * 16) * ldc + col0;
#pragma unroll
                for (int bj = 0; bj < 2; ++bj)
#pragma unroll
                    for (int n = 0; n < 2; ++n) *(f32x4*)(out + off + bj * HALF + n * 16) = *(const f32x4*)(base + off + bj * HALF + n * 16) + acc[ai][bj][m][n]; }
    }
};
struct EpiMoeAct {
    static constexpr bool PERM = true, AFTER_DRAIN = false;
    bf16_t* O; const float* bgu;
    __device__ __forceinline__ void operator()(const f32x4 (&acc)[2][2][4][2], const Unit& u, int wr, int wc, int fr, int fq) const {
        const int row0 = u.pm * BM + wr * 64 + fr, ch0 = u.pn * HALF + wc * 32 + 8 * fq;
        const float* bb = bgu + (size_t)u.e * 2048 + ch0;
        f32x4 bg[2], bu[2];
#pragma unroll
        for (int n = 0; n < 2; ++n) { bg[n] = *(const f32x4*)(bb + 4 * n); bu[n] = *(const f32x4*)(bb + 1024 + 4 * n); }
#pragma unroll
        for (int ai = 0; ai < 2; ++ai)
#pragma unroll
            for (int m = 0; m < 4; ++m) {
                float a[8];
#pragma unroll
                for (int n = 0; n < 2; ++n)
#pragma unroll
                    for (int i = 0; i < 4; ++i) {
                        float g = acc[ai][0][m][n][i] + bg[n][i], up = acc[ai][1][m][n][i] + bu[n][i];
                        g = fminf(g, 7.0f); up = fminf(fmaxf(up, -7.0f), 7.0f);
                        a[n * 4 + i] = (up + 1.0f) * g * sigmoidf_(1.702f * g);
                    }
                u32x4 w; w.x = cvtpk(a[0], a[1]); w.y = cvtpk(a[2], a[3]); w.z = cvtpk(a[4], a[5]); w.w = cvtpk(a[6], a[7]);
                *(u32x4*)(O + (size_t)(row0 + ai * HALF + m * 16) * 1024 + ch0) = w;
            }
    }
};
struct EpiMoeDown {
    static constexpr bool PERM = true, AFTER_DRAIN = false;
    bf16_t* O; const float* bd; const float* gpos;
    __device__ __forceinline__ void operator()(const f32x4 (&acc)[2][2][4][2], const Unit& u, int wr, int wc, int fr, int fq) const {
        const int row0 = u.pm * BM + wr * 64 + fr, col0 = u.pn * BM + wc * 32 + 8 * fq;
        const float* bb = bd + (size_t)u.e * 1024 + col0;
        f32x4 bv[2][2];
#pragma unroll
        for (int bj = 0; bj < 2; ++bj)
#pragma unroll
            for (int n = 0; n < 2; ++n) bv[bj][n] = *(const f32x4*)(bb + bj * HALF + 4 * n);
#pragma unroll
        for (int ai = 0; ai < 2; ++ai)
#pragma unroll
            for (int m = 0; m < 4; ++m) { const int r = row0 + ai * HALF + m * 16; const float gt = gpos[r];
#pragma unroll
                for (int bj = 0; bj < 2; ++bj) { const f32x4 v0 = (acc[ai][bj][m][0] + bv[bj][0]) * gt, v1 = (acc[ai][bj][m][1] + bv[bj][1]) * gt;
                    u32x4 w; w.x = cvtpk(v0[0], v0[1]); w.y = cvtpk(v0[2], v0[3]); w.z = cvtpk(v1[0], v1[1]); w.w = cvtpk(v1[2], v1[3]);
                    *(u32x4*)(O + (size_t)r * 1024 + col0 + bj * HALF) = w; } }
    }
};
struct EpiPle {
    static constexpr bool PERM = false, AFTER_DRAIN = false;
    float* out; const bf16_t* pe; const float* rstd; const float* gpost;
    __device__ __forceinline__ void operator()(const f32x4 (&acc)[2][2][4][2], const Unit& u, int wr, int wc, int fr, int fq) const {
        const int row0 = u.pm * BM + wr * 64 + fr, col0 = u.pn * BM + wc * 32 + 4 * fq;
        f32x4 gp[2][2];
#pragma unroll
        for (int bj = 0; bj < 2; ++bj)
#pragma unroll
            for (int n = 0; n < 2; ++n) gp[bj][n] = *(const f32x4*)(gpost + col0 + bj * HALF + n * 16);
#pragma unroll
        for (int ai = 0; ai < 2; ++ai)
#pragma unroll
            for (int m = 0; m < 4; ++m) { const int r = row0 + ai * HALF + m * 16; const float rs = rstd[r];
#pragma unroll
                for (int bj = 0; bj < 2; ++bj)
#pragma unroll
                    for (int n = 0; n < 2; ++n) { const size_t off = (size_t)r * 1024 + col0 + bj * HALF + n * 16;
                        const u32x2 pw = *(const u32x2*)(pe + off); const f32x4 a = acc[ai][bj][m][n];
                        f32x4 p4; p4[0] = __uint_as_float(pw.x << 16); p4[1] = __uint_as_float(pw.x & 0xffff0000u); p4[2] = __uint_as_float(pw.y << 16); p4[3] = __uint_as_float(pw.y & 0xffff0000u);
                        f32x4 o = *(const f32x4*)(out + off);
#pragma unroll
                        for (int i = 0; i < 4; ++i) o[i] += sigmoidf_(a[i]) * p4[i] * rs * gp[bj][n][i];
                        *(f32x4*)(out + off) = o; } }
    }
};
struct MoeOrder {
    const PG8_LAS int* tile_e; int ntiles, NT, G, c;
    __device__ __forceinline__ bool next(int i, Unit& u) const {
        const int L = (G % 8 == 0) ? i * G + (c & 7) * (G >> 3) + (c >> 3) : i * G + c;
        if (L >= ntiles * NT) return false;
        const int mt = L / NT, nt = L - mt * NT;
        const int e = __builtin_amdgcn_readfirstlane(tile_e[mt]);
        u.pm = mt; u.pn = nt; u.e = e; u.pb = e * NT + nt; return true;
    }
    __device__ __forceinline__ void a_ready(const Unit&) const {}
    __device__ __forceinline__ void done(const Unit&) const {}
};
template <class Epi, class Sched, bool ALIGN_EPI = false, bool SP2 = false>
__device__ __forceinline__ void gemm_phase(PG8_LAS unsigned char* lds, const Gemm g, const Sched& S, const Epi& E) {
    const int tid = threadIdx.x, wid = __builtin_amdgcn_readfirstlane(tid >> 6), lane = tid & 63, wr = wid >> 2, wc = wid & 3, fr = lane & 15, fq = lane >> 4;
    const int K = g.K, nt = K / BK;
    unsigned voffA[2], voffB[2];
#pragma unroll
    for (int i = 0; i < 2; ++i) { int R, C; stage_rc(tid * 16 + i * 8192, R, C); const int Rb = Epi::PERM ? ((R & ~31) + perm32(R & 31)) : R;
        voffA[i] = (unsigned)(R * K + C) * 2u; voffB[i] = (unsigned)(Rb * K + C) * 2u; }
    const size_t kstep = (size_t)(BK * 2);
    const size_t hstep = (size_t)HALF * K * 2;
    const size_t tstep = 2 * hstep;
    const unsigned ldsw = (unsigned)wid * 1024u;
    const int aoff = lds_byte(wr * 64 + fr, fq * 8), boff = lds_byte(wc * 32 + fr, fq * 8);
#define PG8_SA(b, h) (((b) * 2 + (h)) * HTB)
#define PG8_SB(b, h) ((4 + (b) * 2 + (h)) * HTB)
#define PG8_STAGE(bufoff, gbase, voff) do { _Pragma("unroll") for (int _i = 0; _i < 2; ++_i) \
        __builtin_amdgcn_global_load_lds((const unsigned*)((const char*)(gbase) + (voff)[_i]), (PG8_LAS unsigned*)(lds + (bufoff) + ldsw + _i * 8192), 16, 0, 0); } while (0)
#define PG8_LDA(dst, b, h) do { _Pragma("unroll") for (int m = 0; m < 4; ++m) _Pragma("unroll") for (int k = 0; k < 2; ++k) dst[m][k] = *(const PG8_LAS bf16x8*)(lds + PG8_SA(b, h) + aoff + m * 2048 + k * 1024); } while (0)
#define PG8_LDB(dst, b, h) do { _Pragma("unroll") for (int n = 0; n < 2; ++n) _Pragma("unroll") for (int k = 0; k < 2; ++k) dst[n][k] = *(const PG8_LAS bf16x8*)(lds + PG8_SB(b, h) + boff + n * 2048 + k * 1024); } while (0)
#define PG8_MMA(ai, bj, At, Bt) do { __builtin_amdgcn_s_setprio(1); _Pragma("unroll") for (int m = 0; m < 4; ++m) _Pragma("unroll") for (int n = 0; n < 2; ++n) _Pragma("unroll") for (int k = 0; k < 2; ++k) \
        acc[ai][bj][m][n] = __builtin_amdgcn_mfma_f32_16x16x32_bf16(Bt[n][k], At[m][k], acc[ai][bj][m][n], 0, 0, 0); __builtin_amdgcn_s_setprio(0); } while (0)
#define PG8_WAIT_V(n) asm volatile("s_waitcnt vmcnt(" #n ")" ::: "memory")
#define PG8_WAIT_L(n) asm volatile("s_waitcnt lgkmcnt(" #n ")" ::: "memory")
#define PG8_BAR __builtin_amdgcn_s_barrier()
#define PG8_SCHED __builtin_amdgcn_sched_barrier(0)
    Unit cur, nxt; int ui = 0;
    if (!S.next(0, cur)) return;
    f32x4 acc[2][2][4][2];
#pragma unroll
    for (int a = 0; a < 2; ++a)
#pragma unroll
        for (int b = 0; b < 2; ++b)
#pragma unroll
            for (int m = 0; m < 4; ++m)
#pragma unroll
                for (int n = 0; n < 2; ++n) acc[a][b][m][n] = (f32x4){0.f, 0.f, 0.f, 0.f};
    bf16x8 At[4][2], B0[2][2], B1[2][2];
    const char* cA = (const char*)g.A + (size_t)cur.pm * tstep; const char* cB = (const char*)g.Bt + (size_t)cur.pb * tstep;
    S.a_ready(cur);
    if constexpr (SP2) {
        PG8_STAGE(PG8_SB(0, 0), cB, voffB); PG8_STAGE(PG8_SB(0, 1), cB + hstep, voffB); PG8_STAGE(PG8_SA(0, 0), cA, voffA); PG8_STAGE(PG8_SA(0, 1), cA + hstep, voffA);
        if (wr == 1) PG8_BAR;
        PG8_WAIT_V(2); PG8_BAR;
        PG8_STAGE(PG8_SB(1, 0), cB + kstep, voffB); PG8_STAGE(PG8_SA(1, 0), cA + kstep, voffA); PG8_STAGE(PG8_SB(1, 1), cB + hstep + kstep, voffB);
        PG8_WAIT_V(6); PG8_BAR;
    } else {
        PG8_STAGE(PG8_SB(0, 0), cB, voffB); PG8_STAGE(PG8_SA(0, 0), cA, voffA); PG8_STAGE(PG8_SB(0, 1), cB + hstep, voffB); PG8_STAGE(PG8_SA(0, 1), cA + hstep, voffA);
        if (wr == 1) PG8_BAR;
        PG8_WAIT_V(4); PG8_BAR;
        PG8_STAGE(PG8_SB(1, 0), cB + kstep, voffB); PG8_STAGE(PG8_SA(1, 0), cA + kstep, voffA); PG8_STAGE(PG8_SB(1, 1), cB + hstep + kstep, voffB);
        PG8_WAIT_V(6); PG8_BAR;
    }
    for (;;) {
        const bool has_next = S.next(ui + 1, nxt);
        const char* nA = has_next ? (const char*)g.A + (size_t)nxt.pm * tstep : cA; const char* nB = has_next ? (const char*)g.Bt + (size_t)nxt.pb * tstep : cB;
        for (int t = 0; t < nt; t += 2) {
            const bool last = (t == nt - 2);
            const char* a1 = cA + (size_t)(t + 1) * kstep;
            const char* a2 = last ? nA : cA + (size_t)(t + 2) * kstep; const char* b2 = last ? nB : cB + (size_t)(t + 2) * kstep;
            const char* a3 = a2 + kstep; const char* b3 = b2 + kstep;
            if (last && has_next) S.a_ready(nxt);
            if constexpr (SP2) {
            PG8_LDB(B0, 0, 0); PG8_LDB(B1, 0, 1); PG8_SCHED; PG8_LDA(At, 0, 0); PG8_STAGE(PG8_SA(1, 1), a1 + hstep, voffA);
            PG8_WAIT_V(8); PG8_WAIT_L(0); PG8_BAR; PG8_MMA(0, 0, At, B0); PG8_MMA(0, 1, At, B1); PG8_BAR; PG8_SCHED;
            PG8_LDA(At, 0, 1); PG8_STAGE(PG8_SB(0, 0), b2, voffB); PG8_STAGE(PG8_SB(0, 1), b2 + hstep, voffB); PG8_STAGE(PG8_SA(0, 0), a2, voffA);
            PG8_WAIT_V(8); PG8_WAIT_L(0); PG8_BAR; PG8_MMA(1, 0, At, B0); PG8_MMA(1, 1, At, B1); PG8_BAR; PG8_SCHED;
            PG8_LDB(B0, 1, 0); PG8_LDB(B1, 1, 1); PG8_SCHED; PG8_LDA(At, 1, 0); PG8_STAGE(PG8_SA(0, 1), a2 + hstep, voffA);
            PG8_WAIT_V(8); PG8_WAIT_L(0); PG8_BAR; PG8_MMA(0, 0, At, B0); PG8_MMA(0, 1, At, B1); PG8_BAR; PG8_SCHED;
            PG8_LDA(At, 1, 1); PG8_STAGE(PG8_SB(1, 0), b3, voffB); PG8_STAGE(PG8_SB(1, 1), b3 + hstep, voffB); PG8_STAGE(PG8_SA(1, 0), a3, voffA);
            PG8_WAIT_V(8); PG8_WAIT_L(0); PG8_BAR; PG8_MMA(1, 0, At, B0); PG8_MMA(1, 1, At, B1); PG8_BAR; PG8_SCHED;
            } else {
            PG8_LDB(B0, 0, 0); PG8_SCHED; PG8_LDA(At, 0, 0); PG8_STAGE(PG8_SA(1, 1), a1 + hstep, voffA);
            PG8_WAIT_L(8); PG8_BAR; PG8_WAIT_L(0); PG8_MMA(0, 0, At, B0); PG8_BAR; PG8_SCHED;
            PG8_LDB(B1, 0, 1); PG8_STAGE(PG8_SB(0, 0), b2, voffB);
            PG8_BAR; PG8_WAIT_L(0); PG8_MMA(0, 1, At, B1); PG8_BAR;
            PG8_LDA(At, 0, 1); PG8_STAGE(PG8_SA(0, 0), a2, voffA);
            PG8_BAR; PG8_WAIT_L(0); PG8_MMA(1, 0, At, B0); PG8_BAR; PG8_SCHED;
            PG8_STAGE(PG8_SB(0, 1), b2 + hstep, voffB);
            PG8_WAIT_V(6); PG8_BAR; PG8_MMA(1, 1, At, B1); PG8_BAR;
            PG8_LDB(B0, 1, 0); PG8_SCHED; PG8_LDA(At, 1, 0); PG8_STAGE(PG8_SA(0, 1), a2 + hstep, voffA);
            PG8_WAIT_L(8); PG8_BAR; PG8_WAIT_L(0); PG8_MMA(0, 0, At, B0); PG8_BAR; PG8_SCHED;
            PG8_LDB(B1, 1, 1); PG8_STAGE(PG8_SB(1, 0), b3, voffB);
            PG8_BAR; PG8_WAIT_L(0); PG8_MMA(0, 1, At, B1); PG8_BAR;
            PG8_LDA(At, 1, 1); PG8_STAGE(PG8_SA(1, 0), a3, voffA);
            PG8_BAR; PG8_WAIT_L(0); PG8_MMA(1, 0, At, B0); PG8_BAR; PG8_SCHED;
            PG8_STAGE(PG8_SB(1, 1), b3 + hstep, voffB);
            PG8_WAIT_V(6); PG8_BAR; PG8_MMA(1, 1, At, B1); PG8_BAR;
            }
        }
        if constexpr (ALIGN_EPI) { if (wr == 0) PG8_BAR; }
        if constexpr (!Epi::AFTER_DRAIN) { E(acc, cur, wr, wc, fr, fq); S.done(cur); }
        if (!has_next) break;
#pragma unroll
        for (int a = 0; a < 2; ++a)
#pragma unroll
            for (int b = 0; b < 2; ++b)
#pragma unroll
                for (int m = 0; m < 4; ++m)
#pragma unroll
                    for (int n = 0; n < 2; ++n) acc[a][b][m][n] = (f32x4){0.f, 0.f, 0.f, 0.f};
        cur = nxt; cA = nA; cB = nB; ++ui;
        if constexpr (ALIGN_EPI) { if (wr == 1) PG8_BAR; }
    }
    PG8_WAIT_V(0);
    if constexpr (!ALIGN_EPI) { if (wr == 0) PG8_BAR; }
    PG8_BAR;
    if constexpr (Epi::AFTER_DRAIN) { E.fused(acc, cur, wr, wc, fr, fq, lds, wid, lane); S.done(cur); }
#undef PG8_SA
#undef PG8_SB
#undef PG8_STAGE
#undef PG8_LDA
#undef PG8_LDB
#undef PG8_MMA
#undef PG8_WAIT_V
#undef PG8_WAIT_L
#undef PG8_BAR
#undef PG8_SCHED
}
}

constexpr int NWAVES = 8;
constexpr int T = 16384, D = 1024, NCH = 256, LDP = 3840, DIN = 3608, PLE = 256, NE = 32;
constexpr int C_GQ = 0, C_GK = 256, C_GV = 512, C_GR = 1024, C_DQ = 1536, C_DZ = 3072, C_GLR = 3584, C_DA = 3600, C_DB = 3604;
constexpr float EPS = 1e-6f;
constexpr int XS_ROWS = 65536 + NE * 256;

constexpr size_t MiB = 1u << 20;
constexpr size_t WS_CTL = 0, CTL_ZERO_BYTES = 1 * MiB;
constexpr size_t WS_WIN = 2 * MiB, WS_WPP = 10 * MiB, WS_WOUT = 11 * MiB, WS_WPG = 13 * MiB, WS_W1 = 16 * MiB, WS_W2 = 144 * MiB;
constexpr size_t WS_XN = 208 * MiB, WS_PB = 240 * MiB, WS_PROJ = 248 * MiB, WS_PERAW = 368 * MiB;
constexpr size_t WS_KVT = 400 * MiB, WS_DVEC = 432 * MiB, WS_SGLA = 433 * MiB, WS_WF = 449 * MiB, WS_KDF = 465 * MiB, WS_UF = 481 * MiB, WS_CDEC = 513 * MiB;
constexpr size_t WS_QDEC = 514 * MiB, WS_AQK = 530 * MiB, WS_SGDN = 538 * MiB, WS_DELTA = 570 * MiB, WS_MIX = 586 * MiB;
constexpr size_t WS_TOKE = 618 * MiB, WS_TOKS = WS_TOKE + 256 * 1024, WS_TOKG = WS_TOKS + 256 * 1024, WS_TOKP = WS_TOKG + 256 * 1024;
constexpr size_t WS_GPOS = 619 * MiB, WS_PERSTD = 620 * MiB, WS_XS = 621 * MiB, WS_HS = 765 * MiB;
constexpr size_t WS_PEND = 909 * MiB, WS_SLE = 917 * MiB, WS_SST = 933 * MiB, WS_GSLE = 949 * MiB, WS_GPD = 957 * MiB, WS_GSST = 965 * MiB, WS_END = 973 * MiB;
constexpr int GRP = 4, NGRP = NCH / GRP;
static_assert(WS_XS + (size_t)XS_ROWS * 2048 <= WS_HS && WS_HS + (size_t)XS_ROWS * 2048 <= WS_END, "d_ws map");
constexpr int CW_TMO = 0, CW_CODE = 1, CW_BAR = 4096, CW_CNT = 8192;

constexpr int RING_OFF = 0, RING_BYTES = 131072;
constexpr int LDSCTL_OFF = RING_BYTES, MISC_OFF = LDSCTL_OFF + 320;
constexpr int TILEE_OFF = MISC_OFF + 128;
constexpr int BASE_OFF = TILEE_OFF + 320 * 4;
constexpr int ROUTE_OFF = BASE_OFF + 128;
constexpr int LDS_BYTES = 147456;
static_assert(ROUTE_OFF + 256 + 3072 <= LDS_BYTES, "LDS map");

#define GAS __attribute__((address_space(1)))
#define LAS __attribute__((address_space(3)))
typedef unsigned short bf16;
typedef unsigned v4u __attribute__((ext_vector_type(4)));
typedef float f32x4 __attribute__((ext_vector_type(4)));
typedef short bf16x8 __attribute__((ext_vector_type(8)));
typedef GAS unsigned gu32;
typedef GAS unsigned long long gu64;
#define RLX_AGENT __ATOMIC_RELAXED, __HIP_MEMORY_SCOPE_AGENT
#define LDS_WAIT() asm volatile("s_waitcnt lgkmcnt(0)" ::: "memory")
#define VM_WAIT() asm volatile("s_waitcnt vmcnt(0)" ::: "memory")
__device__ __forceinline__ unsigned long long rt() { return __builtin_amdgcn_s_memrealtime(); }
__device__ __forceinline__ unsigned f2bf(float f) { unsigned u = __builtin_bit_cast(unsigned, f); return (u + 0x7fffu + ((u >> 16) & 1u)) >> 16; }
__device__ __forceinline__ unsigned pk2(float lo, float hi) { return f2bf(lo) | (f2bf(hi) << 16); }

#define XB_TMO      128
#define XB_XCNT(j)  (256  + 64 * (j))
#define XB_XSUB(j)  (1280 + 64 * (j))
#define XB_XGEN(j)  (2304 + 64 * (j))
#define XB_TOP      3328
#define XB_TOPGEN   3392
#define XCD_BAR_WORDS 3456
#define XB_SPIN_CAP (1u << 18)

__device__ __forceinline__ unsigned xb_ld(unsigned* p)              { return __hip_atomic_load(p, __ATOMIC_RELAXED, __HIP_MEMORY_SCOPE_AGENT); }
__device__ __forceinline__ unsigned xb_add(unsigned* p, unsigned v) { return __hip_atomic_fetch_add(p, v, __ATOMIC_RELAXED, __HIP_MEMORY_SCOPE_AGENT); }
__device__ __forceinline__ unsigned xb_xcc_id() { return (unsigned)__builtin_amdgcn_s_getreg((3 << 11) | 20) & 0xFu; }
#define XB_SPIN(cond, bar) do { unsigned _sp = 0; while (cond) { __builtin_amdgcn_s_sleep(1); \
    if ((++_sp & 255u) == 0u) { if (xb_ld(&(bar)[XB_TMO])) break; if (_sp > XB_SPIN_CAP) { atomicAdd(&(bar)[XB_TMO], 1u); break; } } } } while (0)

struct XcdBarrier {
    unsigned* bar; unsigned x;
    volatile LAS unsigned* st;
};

__device__ __forceinline__ XcdBarrier xcd_barrier_post(unsigned* bar, volatile LAS unsigned* st) {
    XcdBarrier b; b.bar = bar; b.x = xb_xcc_id(); b.st = st;
    if (threadIdx.x == 0) (void)xb_add(&bar[XB_XCNT(b.x)], 1u);
    return b;
}
__device__ __forceinline__ void xcd_barrier_complete(unsigned* bar, unsigned x, unsigned& nloc, unsigned& nx) {
    const unsigned G = gridDim.x * gridDim.y * gridDim.z;
    unsigned sum, cnt, mine, sp = 0u;
    for (;;) {
        sum = 0u; cnt = 0u; mine = 0u;
#pragma unroll
        for (unsigned j = 0; j < 16; ++j) { const unsigned c = xb_ld(&bar[XB_XCNT(j)]); sum += c; cnt += (c > 0u) ? 1u : 0u; mine = (j == x) ? c : mine; }
        if (sum == G) break;
        __builtin_amdgcn_s_sleep(1);
        if ((++sp & 255u) == 0u) { if (xb_ld(&bar[XB_TMO])) break; if (sp > XB_SPIN_CAP) { atomicAdd(&bar[XB_TMO], 1u); break; } }
    }
    nloc = mine > 0u ? mine : 1u; nx = cnt > 0u ? cnt : 1u;
}

__device__ __forceinline__ void xcd_barrier(const XcdBarrier& b) {
    asm volatile("s_waitcnt vmcnt(0)" ::: "memory");
    __syncthreads();
    if (threadIdx.x == 0) {
        unsigned* bar = b.bar;
        __builtin_amdgcn_s_waitcnt(0);
        unsigned nloc = b.st[0], nx = b.st[1];
        if (nloc == 0u) { xcd_barrier_complete(bar, b.x, nloc, nx); b.st[0] = nloc; b.st[1] = nx; }
        const unsigned old = xb_add(&bar[XB_XSUB(b.x)], 1u);
        const unsigned gen = old / nloc;
        if (old + 1u == (gen + 1u) * nloc) {
            __builtin_amdgcn_fence(__ATOMIC_RELEASE, "agent");
            asm volatile("s_waitcnt vmcnt(0)" ::: "memory");
            const unsigned og = xb_add(&bar[XB_TOP], 1u);
            const unsigned tg = og / nx;
            if (og + 1u == (tg + 1u) * nx) xb_add(&bar[XB_TOPGEN], 1u);
            else XB_SPIN(xb_ld(&bar[XB_TOPGEN]) == tg, bar);
            __builtin_amdgcn_fence(__ATOMIC_ACQUIRE, "agent");
            xb_add(&bar[XB_XGEN(b.x)], 1u);
            asm volatile("s_waitcnt vmcnt(0)" ::: "memory");
        } else {
            XB_SPIN(xb_ld(&bar[XB_XGEN(b.x)]) == gen, bar);
            __builtin_amdgcn_fence(__ATOMIC_ACQUIRE, "agent");
            asm volatile("s_waitcnt vmcnt(0)" ::: "memory");
        }
    }
    __syncthreads();
}


__device__ __forceinline__ float bflo(unsigned w) { return __uint_as_float(w << 16); }
__device__ __forceinline__ float bfhi(unsigned w) { return __uint_as_float(w & 0xffff0000u); }
__device__ __forceinline__ float bf2f(bf16 h) { return __uint_as_float((unsigned)h << 16); }
using pg8::cvtpk;
__device__ __forceinline__ bf16 f2bf1(float f) { return (bf16)(cvtpk(f, 0.f) & 0xffffu); }
__device__ __forceinline__ float wave_sum(float v) {
#pragma unroll
    for (int o = 1; o < 64; o <<= 1) v += __shfl_xor(v, o);
    return v;
}
__device__ __forceinline__ float sigm(float x) { return __builtin_amdgcn_rcpf(1.0f + __expf(-x)); }
__device__ __forceinline__ float siluf_(float x) { return x * sigm(x); }
__device__ __forceinline__ float softplusf_(float x) { return fmaxf(x, 0.f) + __logf(1.0f + __expf(-fabsf(x))); }
__device__ __forceinline__ float logsigf_(float x) { return fminf(x, 0.f) - __logf(1.0f + __expf(-fabsf(x))); }
#define MFMA16(a, b, c) __builtin_amdgcn_mfma_f32_16x16x32_bf16((a), (b), (c), 0, 0, 0)
typedef short bf16x4 __attribute__((ext_vector_type(4)));
typedef unsigned u32x2 __attribute__((ext_vector_type(2)));
__device__ __forceinline__ bf16x8 cat8(bf16x4 lo, bf16x4 hi) { return __builtin_shufflevector(lo, hi, 0, 1, 2, 3, 4, 5, 6, 7); }
__device__ __forceinline__ bf16x8 pack8(const f32x4& a, const f32x4& b) {
    v4u w; w.x = cvtpk(a[0], a[1]); w.y = cvtpk(a[2], a[3]); w.z = cvtpk(b[0], b[1]); w.w = cvtpk(b[2], b[3]); return __builtin_bit_cast(bf16x8, w);
}
__device__ __forceinline__ u32x2 pack4(const f32x4& a) { u32x2 w; w.x = cvtpk(a[0], a[1]); w.y = cvtpk(a[2], a[3]); return w; }

struct Frame {
    LAS unsigned char* lds;
    volatile LAS unsigned* MISC;
    gu32* ctl;
    int tid, lane, wave;
    int vcu, G;
    unsigned char* ws;
    const float* in[24];
    float* out;
};
#define WSP(T_, off) ((T_*)(F.ws + (off)))

template <class RowMap>
__device__ __forceinline__ void transpose_item(const float* W, int K, int N, bf16* WT, LAS float* scr, int item, int lane, RowMap rm) {
    const int nblk = (N + 31) >> 5, kb = item / nblk, nb = item - kb * nblk, k0 = 64 * kb, n0 = 32 * nb;
    const int cq = (lane & 7) * 4, rr = lane >> 3;
#pragma unroll
    for (int i = 0; i < 8; ++i) { const int kk = 8 * i + rr; f32x4 v = {0.f, 0.f, 0.f, 0.f};
        if (n0 + cq < N) v = *(const GAS f32x4*)(W + (size_t)(k0 + kk) * N + n0 + cq);
        LAS float* s = scr + kk * 33 + cq; s[0] = v[0]; s[1] = v[1]; s[2] = v[2]; s[3] = v[3]; }
    LDS_WAIT(); asm volatile("" ::: "memory");
    const int c = lane & 7;
#pragma unroll
    for (int j = 0; j < 4; ++j) { const int n = (lane >> 3) + 8 * j; const LAS float* s = scr + (8 * c) * 33 + n;
        v4u o; o.x = cvtpk(s[0 * 33], s[1 * 33]); o.y = cvtpk(s[2 * 33], s[3 * 33]); o.z = cvtpk(s[4 * 33], s[5 * 33]); o.w = cvtpk(s[6 * 33], s[7 * 33]);
        if (n0 + n < N) *(GAS v4u*)(WT + (size_t)rm(n0 + n) * K + k0 + 8 * c) = o; }
    LDS_WAIT(); asm volatile("" ::: "memory");
}
struct RmId { __device__ __forceinline__ int operator()(int n) const { return n; } };
struct RmWin { __device__ __forceinline__ int operator()(int c) const { return c < 1536 ? c : (c < 1552 ? c + 2048 : (c < 3600 ? c - 16 : c)); } };
struct RmW1 { __device__ __forceinline__ int operator()(int c) const { const int j = c & 1023, up = c >> 10; return (j >> 7) * 256 + up * 128 + (j & 127); } };

__device__ __forceinline__ void rms_row_to_bf16(const float* xrow, const float* g, bf16* orow, int lane) {
    const GAS f32x4* xr = (const GAS f32x4*)xrow + lane; const GAS f32x4* gr = (const GAS f32x4*)g + lane;
    f32x4 v[4]; float s = 0.f;
#pragma unroll
    for (int j = 0; j < 4; ++j) { v[j] = xr[64 * j]; s += (v[j].x * v[j].x + v[j].y * v[j].y) + (v[j].z * v[j].z + v[j].w * v[j].w); }
    const float rstd = 1.f / sqrtf(wave_sum(s) * (1.f / D) + EPS);
    GAS u32x2* o8 = (GAS u32x2*)orow + lane;
#pragma unroll
    for (int j = 0; j < 4; ++j) { const f32x4 gg = gr[64 * j]; u32x2 w; w.x = cvtpk(v[j].x * rstd * gg.x, v[j].y * rstd * gg.y); w.y = cvtpk(v[j].z * rstd * gg.z, v[j].w * rstd * gg.w); o8[64 * j] = w; }
}

__device__ __forceinline__ void p0_prologue(Frame& F) {
    LAS float* scr = (LAS float*)(F.lds + RING_OFF + F.wave * 16384);
    const int gw = F.vcu * NWAVES + F.wave, NGW = F.G * NWAVES, lane = F.lane;
    bf16* Win_t = WSP(bf16, WS_WIN);
    for (int it = gw; it < 16 * 113; it += NGW) transpose_item(F.in[3], 1024, DIN, Win_t, scr, it, lane, RmWin());
    for (int r = DIN + gw; r < LDP; r += NGW) { GAS v4u* o = (GAS v4u*)(Win_t + (size_t)r * 1024) + lane; o[0] = (v4u){0, 0, 0, 0}; o[64] = (v4u){0, 0, 0, 0}; }
    for (int it = gw; it < 4 * 32; it += NGW) transpose_item(F.in[21], PLE, D, WSP(bf16, WS_WPP), scr, it, lane, RmId());
    for (int it = gw; it < 512; it += NGW) transpose_item(F.in[11], D, D, WSP(bf16, WS_WOUT), scr, it, lane, RmId());
    for (int it = gw; it < 512; it += NGW) transpose_item(F.in[20], D, D, WSP(bf16, WS_WPG), scr, it, lane, RmId());
    for (int it = gw; it < NE * 1024; it += NGW) { const int e = it >> 10; transpose_item(F.in[15] + (size_t)e * 1024 * 2048, 1024, 2048, WSP(bf16, WS_W1) + (size_t)e * 2048 * 1024, scr, it & 1023, lane, RmW1()); }
    for (int it = gw; it < NE * 512; it += NGW) { const int e = it >> 9; transpose_item(F.in[17] + (size_t)e * 1024 * 1024, 1024, 1024, WSP(bf16, WS_W2) + (size_t)e * 1024 * 1024, scr, it & 511, lane, RmId()); }
    for (int m = gw; m < T; m += NGW) rms_row_to_bf16(F.in[0] + (size_t)m * D, F.in[2], WSP(bf16, WS_XN) + (size_t)m * D, lane);
    for (int m = gw; m < T; m += NGW) { const f32x4 v = *((const GAS f32x4*)(F.in[1] + (size_t)m * PLE) + lane); u32x2 w; w.x = cvtpk(v.x, v.y); w.y = cvtpk(v.z, v.w); *((GAS u32x2*)(WSP(bf16, WS_PB) + (size_t)m * PLE) + lane) = w; }
}

constexpr int GL_B = 0, GL_GLR = 16640, GL_T1 = 20992, GL_T2 = 30208, GL_VT = 39424, GL_RED = 57856;
__device__ __forceinline__ void gla_b(Frame& F, int n, int h) {
    LAS float* bL = (LAS float*)(F.lds + GL_B); LAS float* glrL = (LAS float*)(F.lds + GL_GLR);
    const bf16* PROJ = WSP(bf16, WS_PROJ); const int tid = F.tid, t0 = n * 64;
    { const int idx = tid * 2, t = idx >> 4, r = idx & 15; const unsigned w = *(const GAS unsigned*)(PROJ + (size_t)(t0 + t) * LDP + C_GLR + r); glrL[t * 17 + r] = bflo(w); glrL[t * 17 + r + 1] = bfhi(w); }
    const int d = tid & 63, tg = tid >> 6;
    float wg[16];
#pragma unroll
    for (int r = 0; r < 16; ++r) wg[r] = F.in[4][r * 256 + h * 64 + d];
    const float bias = F.in[5][h * 64 + d];
    __syncthreads();
#pragma unroll
    for (int tt = 0; tt < 8; ++tt) { const int t = tg * 8 + tt; float a = bias;
#pragma unroll
        for (int r = 0; r < 16; ++r) a += glrL[t * 17 + r] * wg[r];
        bL[t * 65 + d] = logsigf_(a) * 0.0625f; }
    __syncthreads();
    if (tid < 64) { float run = 0.f;
#pragma unroll 16
        for (int t = 0; t < 64; ++t) { run += bL[t * 65 + tid]; bL[t * 65 + tid] = run; } }
    __syncthreads();
}
__device__ __forceinline__ void gla_load_vT(Frame& F, int n, int h) {
    LAS bf16* vT = (LAS bf16*)(F.lds + GL_VT); const bf16* PROJ = WSP(bf16, WS_PROJ);
    const int t = F.tid >> 3, eg = F.tid & 7;
    const GAS v4u* src = (const GAS v4u*)(PROJ + (size_t)(n * 64 + t) * LDP + C_GV + h * 128 + eg * 16);
#pragma unroll
    for (int half = 0; half < 2; ++half) { const v4u w = src[half];
#pragma unroll
        for (int i = 0; i < 4; ++i) { const int e = eg * 16 + half * 8 + 2 * i; vT[e * 72 + t] = (bf16)(w[i] & 0xffffu); vT[(e + 1) * 72 + t] = (bf16)(w[i] >> 16); } }
}

__device__ __forceinline__ void gla_prep_item(Frame& F, int n, int h) {
    gla_b(F, n, h);
    LAS float* bL = (LAS float*)(F.lds + GL_B); LAS bf16* T1 = (LAS bf16*)(F.lds + GL_T1); LAS bf16* vT = (LAS bf16*)(F.lds + GL_VT);
    const bf16* PROJ = WSP(bf16, WS_PROJ); const int tid = F.tid, lane = F.lane, w = F.wave;
    { const int t = tid >> 3, dg = tid & 7; const v4u kw = *(const GAS v4u*)(PROJ + (size_t)(n * 64 + t) * LDP + C_GK + h * 64 + dg * 8);
#pragma unroll
        for (int i = 0; i < 4; ++i) { const int d0 = dg * 8 + 2 * i;
            T1[d0 * 72 + t] = f2bf1(bflo(kw[i]) * __expf(bL[63 * 65 + d0] - bL[t * 65 + d0]));
            T1[(d0 + 1) * 72 + t] = f2bf1(bfhi(kw[i]) * __expf(bL[63 * 65 + d0 + 1] - bL[t * 65 + d0 + 1])); } }
    gla_load_vT(F, n, h);
    __syncthreads();
    const int c = lane & 15, kq = lane >> 4;
    bf16x8 a[2];
#pragma unroll
    for (int ks = 0; ks < 2; ++ks) a[ks] = *(const LAS bf16x8*)(vT + (16 * w + c) * 72 + 32 * ks + 8 * kq);
    float* KVT = WSP(float, WS_KVT) + (size_t)(n * 4 + h) * 128 * 64;
#pragma unroll
    for (int dt = 0; dt < 4; ++dt) { f32x4 acc = {0.f, 0.f, 0.f, 0.f};
#pragma unroll
        for (int ks = 0; ks < 2; ++ks) { const bf16x8 b = *(const LAS bf16x8*)(T1 + (16 * dt + c) * 72 + 32 * ks + 8 * kq); acc = MFMA16(a[ks], b, acc); }
#pragma unroll
        for (int r = 0; r < 4; ++r) KVT[(16 * w + 4 * kq + r) * 64 + 16 * dt + c] = acc[r]; }
    if (tid < 64) WSP(float, WS_DVEC)[(n * 4 + h) * 64 + tid] = __expf(bL[63 * 65 + tid]);
    __syncthreads();
}

__device__ __forceinline__ void mix_epilogue(Frame& F, const f32x4 (&o)[4], int n, int it, int eh, const float* gain, int gate_col, int mix_col) {
    LAS float* red = (LAS float*)(F.lds + GL_RED);
    const int lane = F.lane, c = lane & 15, kq = lane >> 4, w = F.wave;
    float ss = 0.f;
#pragma unroll
    for (int q = 0; q < 4; ++q)
#pragma unroll
        for (int r = 0; r < 4; ++r) ss += o[q][r] * o[q][r];
    ss += __shfl_xor(ss, 16); ss += __shfl_xor(ss, 32);
    if (kq == 0) red[w * 64 + c] = ss;
    __syncthreads();
    const float tot = red[it * 64 + c] + red[(it + 4) * 64 + c];
    const float rstd = 1.f / sqrtf(tot * (1.f / 128.f) + EPS);
    const int t = n * 64 + 16 * it + c;
    const bf16* PROJ = WSP(bf16, WS_PROJ); bf16* MIX = WSP(bf16, WS_MIX);
#pragma unroll
    for (int q = 0; q < 4; ++q) { const int e = 16 * (4 * eh + q) + 4 * kq;
        const u32x2 gw = *(const GAS u32x2*)(PROJ + (size_t)t * LDP + gate_col + e); const f32x4 gn = *(const GAS f32x4*)(gain + e);
        f32x4 v; v[0] = o[q][0] * rstd * gn[0] * siluf_(bflo(gw.x)); v[1] = o[q][1] * rstd * gn[1] * siluf_(bfhi(gw.x)); v[2] = o[q][2] * rstd * gn[2] * siluf_(bflo(gw.y)); v[3] = o[q][3] * rstd * gn[3] * siluf_(bfhi(gw.y));
        *(GAS u32x2*)(MIX + (size_t)t * D + mix_col + e) = pack4(v); }
    __syncthreads();
}

__device__ __forceinline__ void gla_out_item(Frame& F, int n, int h) {
    gla_b(F, n, h);
    LAS float* bL = (LAS float*)(F.lds + GL_B); LAS bf16* T1 = (LAS bf16*)(F.lds + GL_T1); LAS bf16* T2 = (LAS bf16*)(F.lds + GL_T2); LAS bf16* vT = (LAS bf16*)(F.lds + GL_VT);
    const bf16* PROJ = WSP(bf16, WS_PROJ); const int tid = F.tid, lane = F.lane, w = F.wave;
    { const int t = tid >> 3, dg = tid & 7;
        const v4u qw = *(const GAS v4u*)(PROJ + (size_t)(n * 64 + t) * LDP + C_GQ + h * 64 + dg * 8); const v4u kw = *(const GAS v4u*)(PROJ + (size_t)(n * 64 + t) * LDP + C_GK + h * 64 + dg * 8);
        v4u qo, ko;
#pragma unroll
        for (int i = 0; i < 4; ++i) { const int d0 = dg * 8 + 2 * i; const float b0 = bL[t * 65 + d0], b1 = bL[t * 65 + d0 + 1];
            qo[i] = cvtpk(bflo(qw[i]) * 0.125f * __expf(b0), bfhi(qw[i]) * 0.125f * __expf(b1));
            ko[i] = cvtpk(bflo(kw[i]) * __expf(-b0), bfhi(kw[i]) * __expf(-b1)); }
        *(LAS v4u*)(T1 + t * 72 + dg * 8) = qo; *(LAS v4u*)(T2 + t * 72 + dg * 8) = ko; }
    gla_load_vT(F, n, h);
    __syncthreads();
    const int c = lane & 15, kq = lane >> 4, it = w & 3, eh = w >> 2;
    bf16x8 bq[2];
#pragma unroll
    for (int ks = 0; ks < 2; ++ks) bq[ks] = *(const LAS bf16x8*)(T1 + (16 * it + c) * 72 + 32 * ks + 8 * kq);
    f32x4 at[4];
#pragma unroll
    for (int jt = 0; jt < 4; ++jt) { f32x4 acc = {0.f, 0.f, 0.f, 0.f};
        if (jt <= it) {
#pragma unroll
            for (int ks = 0; ks < 2; ++ks) { const bf16x8 a = *(const LAS bf16x8*)(T2 + (16 * jt + c) * 72 + 32 * ks + 8 * kq); acc = MFMA16(a, bq[ks], acc); }
            if (jt == it) {
#pragma unroll
                for (int r = 0; r < 4; ++r) if (4 * kq + r > c) acc[r] = 0.f; }
        }
        at[jt] = acc; }
    bf16x8 pb[2]; pb[0] = pack8(at[0], at[1]); pb[1] = pack8(at[2], at[3]);
    const bf16* ST = WSP(bf16, WS_SGLA) + (size_t)(n * 4 + h) * 128 * 64;
    f32x4 o[4];
#pragma unroll
    for (int q = 0; q < 4; ++q) { const int et = 4 * eh + q; f32x4 acc = {0.f, 0.f, 0.f, 0.f};
#pragma unroll
        for (int s = 0; s < 2; ++s) { const bf16x4 lo = *(const LAS bf16x4*)(vT + (16 * et + c) * 72 + 32 * s + 4 * kq), hi = *(const LAS bf16x4*)(vT + (16 * et + c) * 72 + 32 * s + 16 + 4 * kq);
            acc = MFMA16(cat8(lo, hi), pb[s], acc); }
#pragma unroll
        for (int ks = 0; ks < 2; ++ks) { const bf16x8 a = *(const GAS bf16x8*)(ST + (16 * et + c) * 64 + 32 * ks + 8 * kq); acc = MFMA16(a, bq[ks], acc); }
        o[q] = acc; }
    mix_epilogue(F, o, n, it, eh, F.in[6], C_GR + h * 128, h * 128);
}

__device__ __forceinline__ void gdn_out_item(Frame& F, int n, int h) {
    const int lane = F.lane, w = F.wave, c = lane & 15, kq = lane >> 4, it = w & 3, eh = w >> 2;
    const bf16* QD = WSP(bf16, WS_QDEC) + ((size_t)(n * 4 + h) * 64 + 16 * it + c) * 128; const bf16* AQ = WSP(bf16, WS_AQK) + ((size_t)(n * 4 + h) * 64 + 16 * it + c) * 64;
    bf16x8 bqd[4], baq[2];
#pragma unroll
    for (int ks = 0; ks < 4; ++ks) bqd[ks] = *(const GAS bf16x8*)(QD + 32 * ks + 8 * kq);
#pragma unroll
    for (int s = 0; s < 2; ++s) baq[s] = *(const GAS bf16x8*)(AQ + 32 * s + 8 * kq);
    const bf16* ST = WSP(bf16, WS_SGDN) + (size_t)(n * 4 + h) * 128 * 128; const bf16* DT = WSP(bf16, WS_DELTA) + (size_t)(n * 4 + h) * 128 * 64;
    f32x4 o[4];
#pragma unroll
    for (int q = 0; q < 4; ++q) { const int et = 4 * eh + q; f32x4 acc = {0.f, 0.f, 0.f, 0.f};
#pragma unroll
        for (int ks = 0; ks < 4; ++ks) { const bf16x8 a = *(const GAS bf16x8*)(ST + (16 * et + c) * 128 + 32 * ks + 8 * kq); acc = MFMA16(a, bqd[ks], acc); }
#pragma unroll
        for (int s = 0; s < 2; ++s) { const bf16x8 a = *(const GAS bf16x8*)(DT + (16 * et + c) * 64 + 32 * s + 8 * kq); acc = MFMA16(a, baq[s], acc); }
        o[q] = acc; }
    mix_epilogue(F, o, n, it, eh, F.in[10], C_DZ + h * 128, 512 + h * 128);
}

constexpr int GD_QB = 0, GD_KB = 17408, GD_VF = 34816, GD_LS = 67840, GD_WL = 84224, GD_SC = 101632;
__device__ __forceinline__ void gdn_prep_item(Frame& F, int n, int h) {
    LAS bf16* qb = (LAS bf16*)(F.lds + GD_QB); LAS bf16* kb = (LAS bf16*)(F.lds + GD_KB); LAS float* vf = (LAS float*)(F.lds + GD_VF);
    LAS float* Ls = (LAS float*)(F.lds + GD_LS); LAS bf16* wL = (LAS bf16*)(F.lds + GD_WL);
    LAS float* bS = (LAS float*)(F.lds + GD_SC); LAS float* betaS = bS + 64; LAS float* ebS = bS + 128;
    const bf16* PROJ = WSP(bf16, WS_PROJ); const int tid = F.tid, lane = F.lane, w = F.wave, t0 = n * 64;
    const size_t nh = (size_t)(n * 4 + h);
    if (tid < 64) {
        const float da = bf2f(PROJ[(size_t)(t0 + tid) * LDP + C_DA + h]), db = bf2f(PROJ[(size_t)(t0 + tid) * LDP + C_DB + h]);
        float g = -__expf(F.in[8][h]) * softplusf_(da + F.in[9][h]);
#pragma unroll
        for (int off = 1; off < 64; off <<= 1) { const float v = __shfl_up(g, off); if (lane >= off) g += v; }
        bS[tid] = g; betaS[tid] = sigm(db); ebS[tid] = __expf(g);
    }
    if (!(MK_DBG & 2) && lane < 48) {
        const int grp = lane >> 4, c8 = (lane & 15) * 8;
        const int colP = C_DQ + grp * 512 + h * 128 + c8;
        f32x4 wc[4][2];
#pragma unroll
        for (int j = 0; j < 4; ++j) { const GAS f32x4* wp = (const GAS f32x4*)(F.in[7] + (size_t)j * 1536 + grp * 512 + h * 128 + c8); wc[j][0] = wp[0]; wc[j][1] = wp[1]; }
        v4u xin[11];
#pragma unroll
        for (int rr = 0; rr < 11; ++rr) { const int r = t0 + w * 8 - 3 + rr; xin[rr] = (v4u){0, 0, 0, 0}; if (r >= 0) xin[rr] = *(const GAS v4u*)(PROJ + (size_t)r * LDP + colP); }
#pragma unroll
        for (int tt = 0; tt < 8; ++tt) {
            float y[8];
#pragma unroll
            for (int i = 0; i < 8; ++i) y[i] = 0.f;
#pragma unroll
            for (int j = 0; j < 4; ++j)
#pragma unroll
                for (int i = 0; i < 4; ++i) { const unsigned xw = xin[tt + j][i]; y[2 * i] += wc[j][i >> 1][(2 * i) & 3] * bflo(xw); y[2 * i + 1] += wc[j][i >> 1][(2 * i + 1) & 3] * bfhi(xw); }
            float ss = 0.f;
#pragma unroll
            for (int i = 0; i < 8; ++i) { y[i] = siluf_(y[i]); ss += y[i] * y[i]; }
            ss += __shfl_xor(ss, 1); ss += __shfl_xor(ss, 2); ss += __shfl_xor(ss, 4); ss += __shfl_xor(ss, 8);
            const int row = w * 8 + tt;
            if (grp < 2) { const float sc = (1.f / sqrtf(ss + EPS)) * (grp == 0 ? 0.08838834764831845f : 1.0f);
                v4u o; o.x = cvtpk(y[0] * sc, y[1] * sc); o.y = cvtpk(y[2] * sc, y[3] * sc); o.z = cvtpk(y[4] * sc, y[5] * sc); o.w = cvtpk(y[6] * sc, y[7] * sc);
                *(LAS v4u*)((grp == 0 ? qb : kb) + row * 136 + c8) = o;
            } else {
#pragma unroll
                for (int i = 0; i < 8; ++i) vf[row * 129 + c8 + i] = y[i]; }
        }
    }
    __syncthreads();
    if (!(MK_DBG & 4)) {
        const int c = lane & 15, kq = lane >> 4;
        bf16* AQ = WSP(bf16, WS_AQK) + nh * 64 * 64;
        for (int job = w; job < 20; job += 8) {
            const int kind = job >= 10 ? 1 : 0, idx = job - 10 * kind;
            const int it = idx >= 6 ? 3 : (idx >= 3 ? 2 : (idx >= 1 ? 1 : 0)), jt = idx - (it * (it + 1)) / 2;
            const LAS bf16* Am = kind ? qb : kb;
            f32x4 acc = {0.f, 0.f, 0.f, 0.f};
#pragma unroll
            for (int ks = 0; ks < 4; ++ks) { const bf16x8 a = *(const LAS bf16x8*)(Am + (16 * it + c) * 136 + 32 * ks + 8 * kq), b = *(const LAS bf16x8*)(kb + (16 * jt + c) * 136 + 32 * ks + 8 * kq); acc = MFMA16(a, b, acc); }
            const int j = 16 * jt + c; const float bj = bS[j];
#pragma unroll
            for (int r = 0; r < 4; ++r) { const int i = 16 * it + 4 * kq + r; const float dec = __expf(fminf(bS[i] - bj, 0.f));
                if (kind == 0) Ls[i * 64 + j] = (j < i) ? betaS[i] * dec * acc[r] : 0.f;
                else { AQ[i * 64 + j] = (j <= i) ? f2bf1(dec * acc[r]) : (bf16)0; if (jt < it) AQ[(16 * jt + 4 * kq + r) * 64 + 16 * it + c] = (bf16)0; } }
        }
    }
    __syncthreads();
    if ((MK_DBG & 8) && tid < 256) {} else if (tid < 256) {
        const int cc = tid; const bool isu = cc < 128;
        const int vidx = isu ? cc : 0, kidx = isu ? 0 : cc - 128;
        int zlane; asm volatile("v_mov_b32 %0, 0" : "=v"(zlane));
        float sol[64];
#pragma unroll
        for (int i = 0; i < 64; ++i) {
            int z = zlane; if (i >= 2) asm volatile("v_and_b32 %0, 0, %1" : "=v"(z) : "v"(sol[i - 2]));
            const LAS float* Lz = Ls + z;
            float a = isu ? betaS[i + z] * vf[i * 129 + vidx + z] : betaS[i + z] * ebS[i + z] * bf2f(kb[i * 136 + kidx + z]);
#pragma unroll
            for (int j = 0; j < i; ++j) a -= Lz[i * 64 + j] * sol[j];
            sol[i] = a;
        }
        if (isu) { const int s = cc >> 4, c16 = cc & 15; float* Uf = WSP(float, WS_UF) + ((nh * 8 + s) * 4) * 256;
#pragma unroll
            for (int mt = 0; mt < 4; ++mt)
#pragma unroll
                for (int q = 0; q < 4; ++q) { f32x4 v = {sol[16 * mt + 4 * q], sol[16 * mt + 4 * q + 1], sol[16 * mt + 4 * q + 2], sol[16 * mt + 4 * q + 3]}; *(GAS f32x4*)(Uf + (mt * 64 + q * 16 + c16) * 4) = v; }
        } else { const int d = cc - 128;
#pragma unroll
            for (int i = 0; i < 64; ++i) wL[i * 136 + d] = f2bf1(-sol[i]); }
    } else if (!(MK_DBG & 16)) {
        const int tt = tid - 256; const float bl = bS[63];
        bf16* QD = WSP(bf16, WS_QDEC) + nh * 64 * 128;
#pragma unroll
        for (int j = 0; j < 4; ++j) { const int id = tt + 256 * j, i = id >> 4, c8 = (id & 15) * 8; const v4u qw = *(const LAS v4u*)(qb + i * 136 + c8); const float e = ebS[i];
            v4u o; o.x = cvtpk(bflo(qw.x) * e, bfhi(qw.x) * e); o.y = cvtpk(bflo(qw.y) * e, bfhi(qw.y) * e); o.z = cvtpk(bflo(qw.z) * e, bfhi(qw.z) * e); o.w = cvtpk(bflo(qw.w) * e, bfhi(qw.w) * e);
            *(GAS v4u*)(QD + i * 128 + c8) = o; }
        bf16* KDF = WSP(bf16, WS_KDF) + nh * 16 * 512;
#pragma unroll
        for (int j = 0; j < 4; ++j) { const int id = tt + 256 * j, f = id >> 6, ln = id & 63, dt = f >> 1, ks2 = f & 1, q = ln >> 4, m = ln & 15, d = 16 * dt + m;
            float v[8];
#pragma unroll
            for (int x = 0; x < 8; ++x) { const int i = 32 * ks2 + (x < 4 ? 4 * q + x : 16 + 4 * q + (x - 4)); v[x] = bf2f(kb[i * 136 + d]) * __expf(bl - bS[i]); }
            v4u o; o.x = cvtpk(v[0], v[1]); o.y = cvtpk(v[2], v[3]); o.z = cvtpk(v[4], v[5]); o.w = cvtpk(v[6], v[7]);
            *(GAS v4u*)(KDF + ((size_t)f * 64 + ln) * 8) = o; }
        if (tt == 0) WSP(float, WS_CDEC)[nh] = __expf(bl);
    }
    __syncthreads();
    if (!(MK_DBG & 32)) { bf16* WF = WSP(bf16, WS_WF) + nh * 16 * 512;
#pragma unroll
        for (int j = 0; j < 2; ++j) { const int id = tid + 512 * j, f = id >> 6, ln = id & 63, mt = f >> 2, ks = f & 3, q = ln >> 4, m = ln & 15;
            const u32x2 lo = *(const LAS u32x2*)(wL + (16 * mt + m) * 136 + 32 * ks + 4 * q), hi = *(const LAS u32x2*)(wL + (16 * mt + m) * 136 + 32 * ks + 16 + 4 * q);
            *(GAS v4u*)(WF + ((size_t)f * 64 + ln) * 8) = (v4u){lo.x, lo.y, hi.x, hi.y}; } }
    __syncthreads();
}

template <int MODE>
__device__ __forceinline__ void gdn_group_scan(Frame& F, int grp, int h) {
    const int tid = F.tid, lane = F.lane, w = F.wave, c = lane & 15, kq = lane >> 4, n0 = grp * GRP;
    const v4u* WF = (const v4u*)WSP(bf16, WS_WF); const v4u* KDF = (const v4u*)WSP(bf16, WS_KDF); const f32x4* UF = (const f32x4*)WSP(float, WS_UF);
    const float* CDEC = WSP(float, WS_CDEC); bf16* SG = WSP(bf16, WS_SGDN); bf16* DL = WSP(bf16, WS_DELTA);
    {   v4u t[GRP][4];
#pragma unroll
        for (int i = 0; i < GRP; ++i) { const size_t nh = (size_t)((n0 + i) * 4 + h);
#pragma unroll
            for (int j = 0; j < 2; ++j) { t[i][j] = WF[nh * 1024 + tid + 512 * j]; t[i][2 + j] = KDF[nh * 1024 + tid + 512 * j]; } }
#pragma unroll
        for (int i = 0; i < GRP; ++i)
#pragma unroll
            for (int j = 0; j < 2; ++j) { *(LAS v4u*)(F.lds + i * 32768 + (tid + 512 * j) * 16) = t[i][j]; *(LAS v4u*)(F.lds + i * 32768 + 16384 + (tid + 512 * j) * 16) = t[i][2 + j]; } }
    f32x4 S[8], P[8];
    if (MODE == 1) { const f32x4* SST = (const f32x4*)WSP(float, WS_SST) + (size_t)(((grp * 4 + h) * 8 + w) * 8) * 64;
#pragma unroll
        for (int i = 0; i < 8; ++i) S[i] = SST[i * 64 + lane];
    } else {
#pragma unroll
        for (int i = 0; i < 8; ++i) { S[i] = (f32x4){0.f, 0.f, 0.f, 0.f};
#pragma unroll
            for (int r = 0; r < 4; ++r) P[i][r] = ((16 * i + 4 * kq + r) == 16 * w + c) ? 1.f : 0.f; }
    }
    f32x4 u[GRP][4]; float cd[GRP];
#pragma unroll
    for (int i = 0; i < GRP; ++i) { const size_t nh = (size_t)((n0 + i) * 4 + h); cd[i] = CDEC[nh];
#pragma unroll
        for (int mt = 0; mt < 4; ++mt) u[i][mt] = UF[((nh * 8 + w) * 4 + mt) * 64 + lane]; }
    __syncthreads();
#pragma unroll
    for (int i = 0; i < GRP; ++i) {
        const size_t nh = (size_t)((n0 + i) * 4 + h);
        const LAS unsigned char* wl = F.lds + i * 32768 + lane * 16; const LAS unsigned char* kl = wl + 16384;
        if (MODE == 1) { bf16* sg = SG + (nh * 128 + 16 * w + c) * 128 + 4 * kq;
#pragma unroll
            for (int dt = 0; dt < 8; ++dt) *(GAS u32x2*)(sg + 16 * dt) = pack4(S[dt]); }
        f32x4 dl[4], dp[4];
#pragma unroll
        for (int mt = 0; mt < 4; ++mt) { dl[mt] = u[i][mt]; dp[mt] = (f32x4){0.f, 0.f, 0.f, 0.f}; }
#pragma unroll
        for (int ks = 0; ks < 4; ++ks) { const bf16x8 sb = pack8(S[2 * ks], S[2 * ks + 1]); bf16x8 pb; if (MODE == 0) pb = pack8(P[2 * ks], P[2 * ks + 1]);
#pragma unroll
            for (int mt = 0; mt < 4; ++mt) { const bf16x8 a = *(const LAS bf16x8*)(wl + (mt * 4 + ks) * 1024); dl[mt] = MFMA16(a, sb, dl[mt]); if (MODE == 0) dp[mt] = MFMA16(a, pb, dp[mt]); } }
        if (MODE == 1) { bf16* dq = DL + (nh * 128 + 16 * w + c) * 64 + 4 * kq;
#pragma unroll
            for (int mt = 0; mt < 4; ++mt) *(GAS u32x2*)(dq + 16 * mt) = pack4(dl[mt]); }
#pragma unroll
        for (int dt = 0; dt < 8; ++dt) { S[dt] = S[dt] * cd[i]; if (MODE == 0) P[dt] = P[dt] * cd[i]; }
#pragma unroll
        for (int ks2 = 0; ks2 < 2; ++ks2) { const bf16x8 db = pack8(dl[2 * ks2], dl[2 * ks2 + 1]); bf16x8 qb; if (MODE == 0) qb = pack8(dp[2 * ks2], dp[2 * ks2 + 1]);
#pragma unroll
            for (int dt = 0; dt < 8; ++dt) { const bf16x8 a = *(const LAS bf16x8*)(kl + (dt * 2 + ks2) * 1024); S[dt] = MFMA16(a, db, S[dt]); if (MODE == 0) P[dt] = MFMA16(a, qb, P[dt]); } }
    }
    if (MODE == 0) {
        f32x4* SLE = (f32x4*)WSP(float, WS_SLE) + (size_t)(((grp * 4 + h) * 8 + w) * 8) * 64;
#pragma unroll
        for (int dt = 0; dt < 8; ++dt) SLE[dt * 64 + lane] = S[dt];
        bf16* PE = WSP(bf16, WS_PEND) + (size_t)(grp * 4 + h) * 32 * 512; const int ks = w >> 1, lq = (2 * (w & 1) + (c >> 3)) * 16 + 4 * kq, idx = c & 7;
#pragma unroll
        for (int dt = 0; dt < 8; ++dt)
#pragma unroll
            for (int r = 0; r < 4; ++r) PE[((size_t)(dt * 4 + ks) * 64 + lq + r) * 8 + idx] = f2bf1(P[dt][r]);
    }
    __syncthreads();
}
__device__ __forceinline__ void gdn_scan_groups(Frame& F, int h, int s) {
    const int lane = F.lane, w = F.wave, c = lane & 15, kq = lane >> 4;
    LAS bf16* STb = (LAS bf16*)F.lds;
    const bf16x8* PEND = (const bf16x8*)WSP(bf16, WS_PEND); const f32x4* SLE = (const f32x4*)WSP(float, WS_SLE); f32x4* SST = (f32x4*)WSP(float, WS_SST);
    f32x4 S = {0.f, 0.f, 0.f, 0.f};
    *(LAS u32x2*)(STb + c * 136 + 16 * w + 4 * kq) = (u32x2){0u, 0u};
    bf16x8 pe[4], pn[4]; f32x4 sle, sln;
#pragma unroll
    for (int ks = 0; ks < 4; ++ks) pe[ks] = PEND[((size_t)h * 32 + w * 4 + ks) * 64 + lane];
    sle = SLE[(((size_t)h * 8 + s) * 8 + w) * 64 + lane];
    __syncthreads();
    for (int g = 0; g < NGRP; ++g) {
        const size_t gh = (size_t)(g * 4 + h);
        SST[((gh * 8 + s) * 8 + w) * 64 + lane] = S;
        if (g + 1 == NGRP) break;
        { const size_t gh1 = (size_t)((g + 1) * 4 + h);
#pragma unroll
          for (int ks = 0; ks < 4; ++ks) pn[ks] = PEND[(gh1 * 32 + w * 4 + ks) * 64 + lane];
          sln = SLE[((gh1 * 8 + s) * 8 + w) * 64 + lane]; }
        const LAS bf16* st = STb + (g & 1) * 16 * 136 + c * 136 + 8 * kq;
        f32x4 acc = sle;
#pragma unroll
        for (int ks = 0; ks < 4; ++ks) acc = MFMA16(pe[ks], *(const LAS bf16x8*)(st + 32 * ks), acc);
        S = acc;
        *(LAS u32x2*)(STb + ((g + 1) & 1) * 16 * 136 + c * 136 + 16 * w + 4 * kq) = pack4(S);
#pragma unroll
        for (int ks = 0; ks < 4; ++ks) pe[ks] = pn[ks];
        sle = sln;
        __syncthreads();
    }
    __syncthreads();
}
template <int MODE>
__device__ __forceinline__ void gla_scan_range(Frame& F, int grp, int gid) {
    const int h = gid >> 11, rem = gid & 2047, e = rem >> 4, dg = rem & 15, n0 = grp * GRP;
    const float* KVT = WSP(float, WS_KVT); const float* DV = WSP(float, WS_DVEC); bf16* SG = WSP(bf16, WS_SGLA);
    f32x4 kv[GRP], dv[GRP];
#pragma unroll
    for (int i = 0; i < GRP; ++i) { const size_t nh = (size_t)((n0 + i) * 4 + h); kv[i] = *(const GAS f32x4*)(KVT + (nh * 128 + e) * 64 + 4 * dg); dv[i] = *(const GAS f32x4*)(DV + nh * 64 + 4 * dg); }
    f32x4 S = {0.f, 0.f, 0.f, 0.f}, P = {1.f, 1.f, 1.f, 1.f};
    if (MODE == 1) S = *((const GAS f32x4*)WSP(float, WS_GSST) + (size_t)grp * 8192 + gid);
#pragma unroll
    for (int i = 0; i < GRP; ++i) { const size_t nh = (size_t)((n0 + i) * 4 + h);
        if (MODE == 1) *(GAS u32x2*)(SG + (nh * 128 + e) * 64 + 4 * dg) = pack4(S);
        S = dv[i] * S + kv[i]; if (MODE == 0) P = P * dv[i]; }
    if (MODE == 0) { *((GAS f32x4*)WSP(float, WS_GSLE) + (size_t)grp * 8192 + gid) = S; *((GAS f32x4*)WSP(float, WS_GPD) + (size_t)grp * 8192 + gid) = P; }
}
__device__ __forceinline__ void gla_scan_groups(Frame& F, int gid) {
    f32x4 S = {0.f, 0.f, 0.f, 0.f};
    for (int g0 = 0; g0 < NGRP; g0 += 16) {
        f32x4 sl[16], pd[16];
#pragma unroll
        for (int g = 0; g < 16; ++g) { sl[g] = *((const GAS f32x4*)WSP(float, WS_GSLE) + (size_t)(g0 + g) * 8192 + gid); pd[g] = *((const GAS f32x4*)WSP(float, WS_GPD) + (size_t)(g0 + g) * 8192 + gid); }
#pragma unroll
        for (int g = 0; g < 16; ++g) { *((GAS f32x4*)WSP(float, WS_GSST) + (size_t)(g0 + g) * 8192 + gid) = S; S = pd[g] * S + sl[g]; }
    }
}

__device__ __forceinline__ void route_phase(Frame& F, int rep) {
    LAS float* WrT = (LAS float*)(F.lds + RING_OFF);
    const int tid = F.tid, lane = F.lane;
    for (int idx = tid; idx < 8192; idx += 512) { const int d = idx & 1023, e4 = (idx >> 10) * 4; const f32x4 v = *(const GAS f32x4*)(F.in[13] + (size_t)d * 32 + e4);
        WrT[(e4 + 0) * 1024 + d] = v[0]; WrT[(e4 + 1) * 1024 + d] = v[1]; WrT[(e4 + 2) * 1024 + d] = v[2]; WrT[(e4 + 3) * 1024 + d] = v[3]; }
    __syncthreads();
    const float brt = F.in[14][lane >> 1];
    unsigned* cnt = (unsigned*)(F.ctl + CW_CNT) + rep * 32;
    LAS int* lcnt = (LAS int*)(F.lds + ROUTE_OFF); LAS int* gbase = lcnt + 32; LAS int* te = lcnt + 64; LAS int* ts = te + 256; LAS float* tg = (LAS float*)(ts + 256);
    const size_t roff = (size_t)rep * (WS_HS - WS_TOKE), xoff = (size_t)rep * (WS_HS + 8 * MiB - WS_XN);
    for (int blk = F.vcu; blk < T / 64; blk += F.G) {
    if (tid < 32) lcnt[tid] = 0;
    __syncthreads();
    for (int ti = 0; ti < 8; ++ti) {
        const int tl = F.wave * 8 + ti, t = blk * 64 + tl;
        const GAS f32x4* xr = (const GAS f32x4*)(F.out + (size_t)t * D) + lane; const GAS f32x4* gr = (const GAS f32x4*)F.in[12] + lane;
        f32x4 v[4]; float s = 0.f;
#pragma unroll
        for (int j = 0; j < 4; ++j) { v[j] = xr[64 * j]; s += (v[j].x * v[j].x + v[j].y * v[j].y) + (v[j].z * v[j].z + v[j].w * v[j].w); }
        const float rstd = 1.f / sqrtf(wave_sum(s) * (1.f / D) + EPS);
        GAS u32x2* o8 = (GAS u32x2*)(WSP(bf16, WS_XN + xoff) + (size_t)t * D) + lane;
#pragma unroll
        for (int j = 0; j < 4; ++j) { const f32x4 gg = gr[64 * j]; v[j].x *= rstd * gg.x; v[j].y *= rstd * gg.y; v[j].z *= rstd * gg.z; v[j].w *= rstd * gg.w; o8[64 * j] = pack4(v[j]); }
        float p[32];
#pragma unroll
        for (int e = 0; e < 32; ++e) { float a = 0.f;
#pragma unroll
            for (int j = 0; j < 4; ++j) { const f32x4 wv = *(const LAS f32x4*)(WrT + e * 1024 + 4 * lane + 256 * j); a += (v[j].x * wv.x + v[j].y * wv.y) + (v[j].z * wv.z + v[j].w * wv.w); }
            p[e] = a; if ((e & 3) == 3) __builtin_amdgcn_sched_barrier(0); }
        float q16[16], q8[8], q4[4], q2[2], q1;
        { const bool hi = lane & 32;
#pragma unroll
            for (int k = 0; k < 16; ++k) { const float send = hi ? p[k] : p[k + 16], keep = hi ? p[k + 16] : p[k]; q16[k] = keep + __shfl_xor(send, 32); } }
        { const bool hi = lane & 16;
#pragma unroll
            for (int k = 0; k < 8; ++k) { const float send = hi ? q16[k] : q16[k + 8], keep = hi ? q16[k + 8] : q16[k]; q8[k] = keep + __shfl_xor(send, 16); } }
        { const bool hi = lane & 8;
#pragma unroll
            for (int k = 0; k < 4; ++k) { const float send = hi ? q8[k] : q8[k + 4], keep = hi ? q8[k + 4] : q8[k]; q4[k] = keep + __shfl_xor(send, 8); } }
        { const bool hi = lane & 4;
#pragma unroll
            for (int k = 0; k < 2; ++k) { const float send = hi ? q4[k] : q4[k + 2], keep = hi ? q4[k + 2] : q4[k]; q2[k] = keep + __shfl_xor(send, 4); } }
        { const bool hi = lane & 2; const float send = hi ? q2[0] : q2[1], keep = hi ? q2[1] : q2[0]; q1 = keep + __shfl_xor(send, 2); }
        q1 += __shfl_xor(q1, 1);
        const float mylogit = q1 + brt;
        float lg[32];
#pragma unroll
        for (int e = 0; e < 32; ++e) lg[e] = __shfl(mylogit, 2 * e);
        unsigned used = 0u; int sel[4]; float val[4];
#pragma unroll
        for (int k = 0; k < 4; ++k) { float best = -3.0e38f; int bi = 0;
#pragma unroll
            for (int e = 0; e < 32; ++e) { const bool ok = (lg[e] > best) && !((used >> e) & 1u); best = ok ? lg[e] : best; bi = ok ? e : bi; }
            sel[k] = bi; val[k] = best; used |= 1u << bi; }
        const float e1 = __expf(val[1] - val[0]), e2 = __expf(val[2] - val[0]), e3 = __expf(val[3] - val[0]); const float inv = 1.f / (1.f + e1 + e2 + e3);
        if (lane < 4) { const int ek = lane == 0 ? sel[0] : (lane == 1 ? sel[1] : (lane == 2 ? sel[2] : sel[3])); const float gk = (lane == 0 ? 1.f : (lane == 1 ? e1 : (lane == 2 ? e2 : e3))) * inv;
            const int ls = __hip_atomic_fetch_add(lcnt + ek, 1, __ATOMIC_RELAXED, __HIP_MEMORY_SCOPE_WORKGROUP);
            te[tl * 4 + lane] = ek; ts[tl * 4 + lane] = ls; tg[tl * 4 + lane] = gk; }
    }
    __syncthreads();
    if (tid < 32) gbase[tid] = (int)atomicAdd(cnt + tid * 64, (unsigned)lcnt[tid]);
    __syncthreads();
    if (tid < 256) { const int t = blk * 64 + (tid >> 2), k = tid & 3, e = te[tid];
        WSP(int, WS_TOKE + roff)[t * 4 + k] = e; WSP(int, WS_TOKS + roff)[t * 4 + k] = gbase[e] + ts[tid]; WSP(float, WS_TOKG + roff)[t * 4 + k] = tg[tid]; }
    __syncthreads();
    }
}
__device__ __forceinline__ void moe_tables(Frame& F) {
    LAS int* tile_e = (LAS int*)(F.lds + TILEE_OFF); LAS int* baseL = (LAS int*)(F.lds + BASE_OFF);
    if (F.tid < 64) { const int e = F.lane & 31; const unsigned c = __hip_atomic_load((unsigned*)(F.ctl + CW_CNT) + e * 64, RLX_AGENT);
        const int nt = (int)((c + 255u) >> 8); int incl = nt;
#pragma unroll
        for (int off = 1; off < 32; off <<= 1) { const int v = __shfl_up(incl, off); if ((F.lane & 31) >= off) incl += v; }
        const int tb = incl - nt;
        if (F.lane < 32) { baseL[e] = tb * 256; for (int i = 0; i < nt; ++i) tile_e[tb + i] = e; if (e == 31) tile_e[319] = incl; } }
    __syncthreads();
}
__device__ __forceinline__ void scatter_phase(Frame& F) {
    moe_tables(F);
    LAS int* baseL = (LAS int*)(F.lds + BASE_OFF);
    const int gw = F.vcu * NWAVES + F.wave, NGW = F.G * NWAVES, lane = F.lane;
    for (int t = gw; t < T; t += NGW) {
        int pos = 0;
        if (lane < 4) { const int e = WSP(int, WS_TOKE)[t * 4 + lane], sl = WSP(int, WS_TOKS)[t * 4 + lane]; pos = baseL[e] + sl; WSP(int, WS_TOKP)[t * 4 + lane] = pos; WSP(float, WS_GPOS)[pos] = WSP(float, WS_TOKG)[t * 4 + lane]; }
        const GAS v4u* src = (const GAS v4u*)(WSP(bf16, WS_XN) + (size_t)t * D) + lane; const v4u a = src[0], b = src[64];
#pragma unroll
        for (int k = 0; k < 4; ++k) { const int pk = __shfl(pos, k); GAS v4u* dst = (GAS v4u*)(WSP(bf16, WS_XS) + (size_t)pk * D) + lane; dst[0] = a; dst[64] = b; }
    }
}
__device__ __forceinline__ void combine_phase(Frame& F, int rep) {
    const int gw = F.vcu * NWAVES + F.wave, NGW = F.G * NWAVES, lane = F.lane;
    for (int t = gw; t < T; t += NGW) {
        GAS f32x4* xr = (GAS f32x4*)(F.out + (size_t)t * D) + lane;
        GAS f32x4* xw = rep ? (GAS f32x4*)(WSP(float, WS_HS) + (size_t)t * D) + lane : xr;
        const size_t xoff = (size_t)rep * (WS_HS + 64 * MiB - WS_XN), poff = (size_t)rep * (WS_HS + 100 * MiB - WS_PERSTD);
        f32x4 v[4];
#pragma unroll
        for (int j = 0; j < 4; ++j) v[j] = xr[64 * j];
#pragma unroll
        for (int k = 0; k < 4; ++k) { const int pk = WSP(int, WS_TOKP)[t * 4 + k]; const GAS u32x2* yr = (const GAS u32x2*)(WSP(bf16, WS_XS) + (size_t)pk * D) + lane;
#pragma unroll
            for (int j = 0; j < 4; ++j) { const u32x2 w = yr[64 * j]; v[j].x += bflo(w.x); v[j].y += bfhi(w.x); v[j].z += bflo(w.y); v[j].w += bfhi(w.y); } }
        float s = 0.f;
#pragma unroll
        for (int j = 0; j < 4; ++j) { xw[64 * j] = v[j]; s += (v[j].x * v[j].x + v[j].y * v[j].y) + (v[j].z * v[j].z + v[j].w * v[j].w); }
        const float rstd = 1.f / sqrtf(wave_sum(s) * (1.f / D) + EPS);
        const GAS f32x4* gr = (const GAS f32x4*)F.in[19] + lane; GAS u32x2* o8 = (GAS u32x2*)(WSP(bf16, WS_XN + xoff) + (size_t)t * D) + lane;
#pragma unroll
        for (int j = 0; j < 4; ++j) { const f32x4 gg = gr[64 * j]; f32x4 a = {v[j].x * rstd * gg.x, v[j].y * rstd * gg.y, v[j].z * rstd * gg.z, v[j].w * rstd * gg.w}; o8[64 * j] = pack4(a); }
        const GAS u32x2* pr = (const GAS u32x2*)(WSP(bf16, WS_PERAW) + (size_t)t * D) + lane; float ps = 0.f;
#pragma unroll
        for (int j = 0; j < 4; ++j) { const u32x2 w = pr[64 * j]; const float a = bflo(w.x), b = bfhi(w.x), c = bflo(w.y), d = bfhi(w.y); ps += (a * a + b * b) + (c * c + d * d); }
        ps = wave_sum(ps);
        if (lane == 0) WSP(float, WS_PERSTD + poff)[t] = 1.f / sqrtf(ps * (1.f / D) + EPS);
    }
}
__device__ __forceinline__ void final_phase(Frame& F, int rep) {
    const int gw = F.vcu * NWAVES + F.wave, NGW = F.G * NWAVES, lane = F.lane;
    for (int t = gw; t < T; t += NGW) {
        GAS f32x4* xr = (GAS f32x4*)(F.out + (size_t)t * D) + lane; const GAS f32x4* gr = (const GAS f32x4*)F.in[23] + lane;
        f32x4 v[4]; float s = 0.f;
#pragma unroll
        for (int j = 0; j < 4; ++j) { v[j] = xr[64 * j]; s += (v[j].x * v[j].x + v[j].y * v[j].y) + (v[j].z * v[j].z + v[j].w * v[j].w); }
        const float rstd = 1.f / sqrtf(wave_sum(s) * (1.f / D) + EPS);
        GAS f32x4* xw = rep ? (GAS f32x4*)(WSP(float, WS_HS) + (size_t)t * D) + lane : xr;
#pragma unroll
        for (int j = 0; j < 4; ++j) { const f32x4 gg = gr[64 * j]; xw[64 * j] = (f32x4){v[j].x * rstd * gg.x, v[j].y * rstd * gg.y, v[j].z * rstd * gg.z, v[j].w * rstd * gg.w}; }
    }
}

constexpr int NPH = 13;
struct Args { const float* in[24]; float* out; unsigned char* ws; int ph_lo, ph_hi; };
static_assert(sizeof(Args) == 24 * 8 + 8 + 8 + 8, "Args has no padding");
__global__ void __launch_bounds__(NWAVES * 64, 2) fwd_kernel(Args args) {
    extern __shared__ __attribute__((aligned(16))) unsigned char lds[];
    Frame F;
    F.lds = (LAS unsigned char*)lds;
    F.MISC = (volatile LAS unsigned*)(F.lds + MISC_OFF);
    F.tid = threadIdx.x; F.lane = F.tid & 63; F.wave = __builtin_amdgcn_readfirstlane(F.tid >> 6);
    F.G = gridDim.x; { const int bx = blockIdx.x; F.vcu = (F.G % 8 == 0) ? (bx % 8) * (F.G / 8) + bx / 8 : bx; }
    F.ws = args.ws; F.ctl = (gu32*)(args.ws + WS_CTL); F.out = args.out;
#pragma unroll
    for (int i = 0; i < 24; ++i) F.in[i] = args.in[i];
    for (int u = F.tid; u < (LDS_BYTES - LDSCTL_OFF) / 4; u += NWAVES * 64) ((LAS unsigned*)(F.lds + LDSCTL_OFF))[u] = 0u;
    __syncthreads();
    const int lo = args.ph_lo, hi = args.ph_hi;
    XcdBarrier bar; bar.bar = (unsigned*)(F.ctl + CW_BAR); bar.x = 0; bar.st = nullptr;
    bar = xcd_barrier_post((unsigned*)(F.ctl + CW_BAR), F.MISC + 8);
#define IN(k) (lo <= (k) && (k) < hi && !((MK_SKIP >> (k)) & 1))
#define SEAM(k) do { if ((lo <= (k)) && ((k) + 1 < hi)) xcd_barrier(bar); } while (0)

    if (IN(0)) { for (int rep_ = 0; rep_ <= ((MK_REP >> 0) & 1); ++rep_) { p0_prologue(F); } SEAM(0); }
    if (IN(1)) { for (int rep_ = 0; rep_ <= ((MK_REP >> 1) & 1); ++rep_) {
        { pg8::Gemm g{WSP(bf16, WS_XN), WSP(bf16, WS_WIN), T, LDP, D}; pg8::StaticOrder S; S.init(T, LDP, F.G, (int)blockIdx.x);
          pg8::EpiBf16P E{WSP(bf16, WS_PROJ), LDP};
          pg8::gemm_phase<pg8::EpiBf16P, pg8::StaticOrder, true, true>(F.lds + RING_OFF, g, S, E); }
        { pg8::Gemm g{WSP(bf16, WS_PB), WSP(bf16, WS_WPP), T, D, PLE}; pg8::StaticOrder S; S.init(T, D, F.G, (int)blockIdx.x);
          pg8::EpiBf16P E{WSP(bf16, WS_PERAW), D};
          pg8::gemm_phase<pg8::EpiBf16P, pg8::StaticOrder, true, true>(F.lds + RING_OFF, g, S, E); }
        }
        SEAM(1);
    }
    if (IN(2)) { for (int rep_ = 0; rep_ <= ((MK_REP >> 2) & 1); ++rep_) {
        for (int i = blockIdx.x; i < NCH * 8; i += F.G) { const int n = i >> 3, hh = (i + (i >> 8)) & 7;
            if (hh < 4) { if (!(MK_DBG & 1)) gla_prep_item(F, n, hh); } else gdn_prep_item(F, n, hh - 4); }
        }
        SEAM(2);
    }
    if (IN(3)) { for (int rep_ = 0; rep_ <= ((MK_REP >> 3) & 1); ++rep_) {
        for (int r3_ = 0; r3_ <= ((MK_REP >> 13) & 1); ++r3_) {
        for (int it = F.vcu; it < NGRP * 4; it += F.G) gdn_group_scan<0>(F, it >> 2, it & 3);
        for (int id = F.vcu * 8 + F.wave; id < NGRP * 128; id += F.G * 8) gla_scan_range<0>(F, id >> 7, (id & 127) * 64 + F.lane); }
        xcd_barrier(bar);
        for (int r3_ = 0; r3_ <= ((MK_REP >> 14) & 1); ++r3_) {
        if (F.vcu < 32) gdn_scan_groups(F, F.vcu >> 3, F.vcu & 7);
        else if (F.vcu < 160 && F.wave == 0) gla_scan_groups(F, (F.vcu - 32) * 64 + F.lane); }
        xcd_barrier(bar);
        for (int r3_ = 0; r3_ <= ((MK_REP >> 15) & 1); ++r3_) {
        for (int it = F.vcu; it < NGRP * 4; it += F.G) gdn_group_scan<1>(F, it >> 2, it & 3);
        for (int id = F.vcu * 8 + F.wave; id < NGRP * 128; id += F.G * 8) gla_scan_range<1>(F, id >> 7, (id & 127) * 64 + F.lane); }
        }
        SEAM(3);
    }
    if (IN(4)) { for (int rep_ = 0; rep_ <= ((MK_REP >> 4) & 1); ++rep_) {
        for (int i = blockIdx.x; i < NCH * 8; i += F.G) { const int n = i >> 3, hh = (i + (i >> 8)) & 7;
            if (hh < 4) gla_out_item(F, n, hh); else gdn_out_item(F, n, hh - 4); }
        }
        SEAM(4);
    }
    if (IN(5)) { for (int rep_ = 0; rep_ <= ((MK_REP >> 5) & 1); ++rep_) {
        pg8::Gemm g{WSP(bf16, WS_MIX), WSP(bf16, WS_WOUT), T, D, D}; pg8::StaticOrder S; S.init(T, D, F.G, (int)blockIdx.x);
        pg8::EpiResF32 E{F.in[0], F.out, D};
        pg8::gemm_phase<pg8::EpiResF32, pg8::StaticOrder, true, true>(F.lds + RING_OFF, g, S, E);
        }
        SEAM(5);
    }
    if (IN(6)) { for (int rep_ = 0; rep_ <= ((MK_REP >> 6) & 1); ++rep_) { route_phase(F, rep_); } SEAM(6); }
    if (IN(7)) { for (int rep_ = 0; rep_ <= ((MK_REP >> 7) & 1); ++rep_) { scatter_phase(F); } SEAM(7); }
    if (IN(8)) { for (int rep_ = 0; rep_ <= ((MK_REP >> 8) & 1); ++rep_) {
        moe_tables(F);
        const LAS int* tile_e = (const LAS int*)(F.lds + TILEE_OFF); const int ntiles = __builtin_amdgcn_readfirstlane(tile_e[319]);
        pg8::Gemm g{WSP(bf16, WS_XS), WSP(bf16, WS_W1), XS_ROWS, 2048, D}; pg8::MoeOrder S{tile_e, ntiles, 8, F.G, (int)blockIdx.x};
        pg8::EpiMoeAct E{WSP(bf16, WS_HS), F.in[16]};
        pg8::gemm_phase<pg8::EpiMoeAct, pg8::MoeOrder, true, true>(F.lds + RING_OFF, g, S, E);
        }
        SEAM(8);
    }
    if (IN(9)) { for (int rep_ = 0; rep_ <= ((MK_REP >> 9) & 1); ++rep_) {
        moe_tables(F);
        const LAS int* tile_e = (const LAS int*)(F.lds + TILEE_OFF); const int ntiles = __builtin_amdgcn_readfirstlane(tile_e[319]);
        pg8::Gemm g{WSP(bf16, WS_HS), WSP(bf16, WS_W2), XS_ROWS, D, D}; pg8::MoeOrder S{tile_e, ntiles, 4, F.G, (int)blockIdx.x};
        pg8::EpiMoeDown E{WSP(bf16, WS_XS), F.in[18], WSP(float, WS_GPOS)};
        pg8::gemm_phase<pg8::EpiMoeDown, pg8::MoeOrder, true, true>(F.lds + RING_OFF, g, S, E);
        }
        SEAM(9);
    }
    if (IN(10)) { for (int rep_ = 0; rep_ <= ((MK_REP >> 10) & 1); ++rep_) { combine_phase(F, rep_); } SEAM(10); }
    if (IN(11)) { for (int rep_ = 0; rep_ <= ((MK_REP >> 11) & 1); ++rep_) {
        pg8::Gemm g{WSP(bf16, WS_XN), WSP(bf16, WS_WPG), T, D, D}; pg8::StaticOrder S; S.init(T, D, F.G, (int)blockIdx.x);
        pg8::EpiPle E{F.out, WSP(bf16, WS_PERAW), WSP(float, WS_PERSTD), F.in[22]};
        pg8::gemm_phase<pg8::EpiPle, pg8::StaticOrder, true, true>(F.lds + RING_OFF, g, S, E);
        }
        SEAM(11);
    }
    if (IN(12)) { for (int rep_ = 0; rep_ <= ((MK_REP >> 12) & 1); ++rep_) { final_phase(F, rep_); } }
#undef IN
#undef SEAM
}

extern "C" void kernel_launch(void* const* d_in, const int* in_sizes, int n_in, void* d_out, int out_size, void* d_ws, size_t ws_size, hipStream_t stream) {
    static int grid = 0;
    if (grid == 0) {
        if (n_in != 24 || in_sizes[0] != T * D || out_size != T * D || ws_size < WS_END) { fprintf(stderr, "kernel_launch: unexpected shapes (n_in %d, in0 %d, out %d, ws %zu); nothing launched\n", n_in, n_in > 0 ? in_sizes[0] : -1, out_size, ws_size); grid = -1; return; }
        int dev = 0, cus = 0;
        if (hipGetDevice(&dev) != hipSuccess || hipDeviceGetAttribute(&cus, hipDeviceAttributeMultiprocessorCount, dev) != hipSuccess) { grid = -1; return; }
        if (hipFuncSetAttribute((const void*)fwd_kernel, hipFuncAttributeMaxDynamicSharedMemorySize, LDS_BYTES) != hipSuccess) { fprintf(stderr, "kernel_launch: hipFuncSetAttribute failed\n"); grid = -1; return; }
        int per_cu = 0;
        if (hipOccupancyMaxActiveBlocksPerMultiprocessor(&per_cu, (const void*)fwd_kernel, NWAVES * 64, LDS_BYTES) != hipSuccess || per_cu < 1) fprintf(stderr, "kernel_launch: occupancy query reports %d blocks per CU\n", per_cu);
        (void)hipGetLastError();
        grid = cus;
    }
    if (grid < 0) return;
    if (hipMemsetAsync((char*)d_ws + WS_CTL, 0, CTL_ZERO_BYTES, stream) != hipSuccess) return;
    Args a{};
    for (int i = 0; i < 24; ++i) a.in[i] = (const float*)d_in[i];
    a.out = (float*)d_out; a.ws = (unsigned char*)d_ws;
#if MK_ONE_LAUNCH
    a.ph_lo = 0; a.ph_hi = NPH;
    hipLaunchKernelGGL(fwd_kernel, dim3(grid), dim3(NWAVES * 64), LDS_BYTES, stream, a);
#else
    for (int p = 0; p < NPH; ++p) { a.ph_lo = p; a.ph_hi = p + 1; hipLaunchKernelGGL(fwd_kernel, dim3(grid), dim3(NWAVES * 64), LDS_BYTES, stream, a); }
#endif
}
```

```cpp
#include <hip/hip_runtime.h>
#include <cstdio>
#include <cstdint>
#ifndef MK_ONE_LAUNCH
#define MK_ONE_LAUNCH 1
#endif
#ifndef MK_SKIP
#define MK_SKIP 0
#endif
#ifndef MK_DBG
#define MK_DBG 0
#endif
#ifndef MK_REP
#define MK_REP 0
#endif
namespace pg8 {
#define PG8_LAS __attribute__((address_space(3)))
typedef unsigned short bf16_t;
typedef short bf16x8 __attribute__((ext_vector_type(8)));
typedef float f32x4 __attribute__((ext_vector_type(4)));
typedef unsigned u32x4 __attribute__((ext_vector_type(4)));
constexpr int BM = 256, BK = 64, HALF = 128, HTB = HALF * BK * 2  , STAGE_BYTES = 8 * HTB, NXCD = 8, WGM = 8;

__host__ __device__ __forceinline__ int lds_byte(int r, int c) { const int st = (r >> 4) * 2 + (c >> 5), rr = r & 15, cc = c & 31, ob = rr * 64 + cc * 2; return st * 1024 + (ob ^ (((ob >> 9) & 1) << 5)); }
__host__ __device__ __forceinline__ void stage_rc(int b, int& R, int& C) { const int st = b / 1024, sb = b % 1024, swz = sb ^ (((sb >> 9) & 1) << 5); R = (st >> 1) * 16 + swz / 64; C = (st & 1) * 32 + (swz % 64) / 2; }
__host__ __device__ __forceinline__ int perm32(int rho) { const int n = rho >> 4, i = rho & 15; return 8 * (i >> 2) + 4 * n + (i & 3); }

struct Unit { int pm, pn, pb, e; };
struct Gemm { const bf16_t* A; const bf16_t* Bt; int M, N, K; };

struct StaticOrder {
    int nM, nN, nwg, G, c;
    __host__ __device__ void init(int M, int N, int G_, int c_) { nM = M / BM; nN = N / BM; nwg = nM * nN; G = G_; c = c_; }
    __host__ __device__ bool next(int i, Unit& u) const {
        const long L = (long)i * G + c; if (L >= nwg) return false;
        int wgid = (int)L; { const int q = nwg / NXCD, r = nwg % NXCD, xcd = wgid % NXCD, off = wgid / NXCD; wgid = (xcd < r ? xcd * (q + 1) : r * (q + 1) + (xcd - r) * q) + off; }
        const int nig = WGM * nN, gid = wgid / nig, fm = gid * WGM, gsz = (nM - fm) < WGM ? (nM - fm) : WGM;
        u.pm = fm + ((wgid % nig) % gsz); u.pn = (wgid % nig) / gsz; u.pb = u.pn; u.e = 0; return true;
    }
    __device__ __forceinline__ void a_ready(const Unit&) const {}
    __device__ __forceinline__ void done(const Unit&) const {}
};

__device__ __forceinline__ unsigned cvt_pk_bf16(float lo, float hi) { unsigned r; asm volatile("v_cvt_pk_bf16_f32 %0, %1, %2" : "=v"(r) : "v"(lo), "v"(hi)); return r; }

typedef float f32x2 __attribute__((ext_vector_type(2)));
typedef unsigned u32x2 __attribute__((ext_vector_type(2)));
typedef __bf16 bf16x2v __attribute__((ext_vector_type(2)));
__device__ __forceinline__ unsigned cvtpk(float lo, float hi) { f32x2 v = {lo, hi}; bf16x2v b = __builtin_convertvector(v, bf16x2v); return __builtin_bit_cast(unsigned, b); }
typedef int v4i_t __attribute__((ext_vector_type(4)));
typedef int v8i_t __attribute__((ext_vector_type(8)));
__device__ __forceinline__ v8i_t cat16(bf16x8 lo, bf16x8 hi) { return __builtin_shufflevector(__builtin_bit_cast(v4i_t, lo), __builtin_bit_cast(v4i_t, hi), 0, 1, 2, 3, 4, 5, 6, 7); }
__device__ __forceinline__ unsigned cvt4_fp8(float a, float b, float c, float d) { int w = __builtin_amdgcn_cvt_pk_fp8_f32(a, b, 0, false); w = __builtin_amdgcn_cvt_pk_fp8_f32(c, d, w, true); return (unsigned)w; }
__device__ __forceinline__ float sigmoidf_(float x) { return __builtin_amdgcn_rcpf(1.0f + __expf(-x)); }

struct EpiBf16P {
    static constexpr bool PERM = true, AFTER_DRAIN = false;
    bf16_t* O; int ldc;
    __device__ __forceinline__ void operator()(const f32x4 (&acc)[2][2][4][2], const Unit& u, int wr, int wc, int fr, int fq) const {
        const int row0 = u.pm * BM + wr * 64 + fr, col0 = u.pn * BM + wc * 32 + 8 * fq;
#pragma unroll
        for (int ai = 0; ai < 2; ++ai)
#pragma unroll
            for (int m = 0; m < 4; ++m) { bf16_t* rowp = O + (size_t)(row0 + ai * HALF + m * 16) * ldc + col0;
#pragma unroll
                for (int bj = 0; bj < 2; ++bj) { const f32x4 v0 = acc[ai][bj][m][0], v1 = acc[ai][bj][m][1];
                    u32x4 w; w.x = cvtpk(v0[0], v0[1]); w.y = cvtpk(v0[2], v0[3]); w.z = cvtpk(v1[0], v1[1]); w.w = cvtpk(v1[2], v1[3]);
                    *(u32x4*)(rowp + bj * HALF) = w; } }
    }
};
struct EpiResF32 {
    static constexpr bool PERM = false, AFTER_DRAIN = false;
    const float* base; float* out; int ldc;
    __device__ __forceinline__ void operator()(const f32x4 (&acc)[2][2][4][2], const Unit& u, int wr, int wc, int fr, int fq) const {
        const int row0 = u.pm * BM + wr * 64 + fr, col0 = u.pn * BM + wc * 32 + 4 * fq;
#pragma unroll
        for (int ai = 0; ai < 2; ++ai)
#pragma unroll
            for (int m = 0; m < 4; ++m) { const size_t off = (size_t)(row0 + ai * HALF + m * 16) * ldc + col0;
#pragma unroll
                for (int bj = 0; bj < 2; ++bj)
#pragma unroll
                    for (int n = 0; n < 2; ++n) *(f32x4*)(out + off + bj * HALF + n * 16) = *(const f32x4*)(base + off + bj * HALF + n * 16) + acc[ai][bj][m][n]; }
    }
};
struct EpiMoeAct {
    static constexpr bool PERM = true, AFTER_DRAIN = false;
    bf16_t* O; const float* bgu;
    __device__ __forceinline__ void operator()(const f32x4 (&acc)[2][2][4][2], const Unit& u, int wr, int wc, int fr, int fq) const {
        const int row0 = u.pm * BM + wr * 64 + fr, ch0 = u.pn * HALF + wc * 32 + 8 * fq;
        const float* bb = bgu + (size_t)u.e * 2048 + ch0;
        f32x4 bg[2], bu[2];
#pragma unroll
        for (int n = 0; n < 2; ++n) { bg[n] = *(const f32x4*)(bb + 4 * n); bu[n] = *(const f32x4*)(bb + 1024 + 4 * n); }
#pragma unroll
        for (int ai = 0; ai < 2; ++ai)
#pragma unroll
            for (int m = 0; m < 4; ++m) {
                float a[8];
#pragma unroll
                for (int n = 0; n < 2; ++n)
#pragma unroll
                    for (int i = 0; i < 4; ++i) {
                        float g = acc[ai][0][m][n][i] + bg[n][i], up = acc[ai][1][m][n][i] + bu[n][i];
                        g = fminf(g, 7.0f); up = fminf(fmaxf(up, -7.0f), 7.0f);
                        a[n * 4 + i] = (up + 1.0f) * g * sigmoidf_(1.702f * g);
                    }
                u32x2 w; w.x = cvt4_fp8(a[0], a[1], a[2], a[3]); w.y = cvt4_fp8(a[4], a[5], a[6], a[7]);
                *(u32x2*)((unsigned char*)O + (size_t)(row0 + ai * HALF + m * 16) * 1024 + ch0) = w;
            }
    }
};
struct EpiMoeDown {
    static constexpr bool PERM = true, AFTER_DRAIN = false;
    bf16_t* O; const float* bd; const float* gpos;
    __device__ __forceinline__ void operator()(const f32x4 (&acc)[2][2][4][2], const Unit& u, int wr, int wc, int fr, int fq) const {
        const int row0 = u.pm * BM + wr * 64 + fr, col0 = u.pn * BM + wc * 32 + 8 * fq;
        const float* bb = bd + (size_t)u.e * 1024 + col0;
        f32x4 bv[2][2];
#pragma unroll
        for (int bj = 0; bj < 2; ++bj)
#pragma unroll
            for (int n = 0; n < 2; ++n) bv[bj][n] = *(const f32x4*)(bb + bj * HALF + 4 * n);
#pragma unroll
        for (int ai = 0; ai < 2; ++ai)
#pragma unroll
            for (int m = 0; m < 4; ++m) { const int r = row0 + ai * HALF + m * 16; const float gt = gpos[r];
#pragma unroll
                for (int bj = 0; bj < 2; ++bj) { const f32x4 v0 = (acc[ai][bj][m][0] + bv[bj][0]) * gt, v1 = (acc[ai][bj][m][1] + bv[bj][1]) * gt;
                    u32x4 w; w.x = cvtpk(v0[0], v0[1]); w.y = cvtpk(v0[2], v0[3]); w.z = cvtpk(v1[0], v1[1]); w.w = cvtpk(v1[2], v1[3]);
                    *(u32x4*)(O + (size_t)r * 1024 + col0 + bj * HALF) = w; } }
    }
};
struct EpiPle {
    static constexpr bool PERM = false, AFTER_DRAIN = false;
    float* out; const bf16_t* pe; const float* rstd; const float* gpost;
    __device__ __forceinline__ void operator()(const f32x4 (&acc)[2][2][4][2], const Unit& u, int wr, int wc, int fr, int fq) const {
        const int row0 = u.pm * BM + wr * 64 + fr, col0 = u.pn * BM + wc * 32 + 4 * fq;
        f32x4 gp[2][2];
#pragma unroll
        for (int bj = 0; bj < 2; ++bj)
#pragma unroll
            for (int n = 0; n < 2; ++n) gp[bj][n] = *(const f32x4*)(gpost + col0 + bj * HALF + n * 16);
#pragma unroll
        for (int ai = 0; ai < 2; ++ai)
#pragma unroll
            for (int m = 0; m < 4; ++m) { const int r = row0 + ai * HALF + m * 16; const float rs = rstd[r];
#pragma unroll
                for (int bj = 0; bj < 2; ++bj)
#pragma unroll
                    for (int n = 0; n < 2; ++n) { const size_t off = (size_t)r * 1024 + col0 + bj * HALF + n * 16;
                        const u32x2 pw = *(const u32x2*)(pe + off); const f32x4 a = acc[ai][bj][m][n];
                        f32x4 p4; p4[0] = __uint_as_float(pw.x << 16); p4[1] = __uint_as_float(pw.x & 0xffff0000u); p4[2] = __uint_as_float(pw.y << 16); p4[3] = __uint_as_float(pw.y & 0xffff0000u);
                        f32x4 o = *(const f32x4*)(out + off);
#pragma unroll
                        for (int i = 0; i < 4; ++i) o[i] += sigmoidf_(a[i]) * p4[i] * rs * gp[bj][n][i];
                        *(f32x4*)(out + off) = o; } }
    }
};
struct MoeOrder {
    const PG8_LAS int* tile_e; int ntiles, NT, G, c;
    __device__ __forceinline__ bool next(int i, Unit& u) const {
        const int L = (G % 8 == 0) ? i * G + (c & 7) * (G >> 3) + (c >> 3) : i * G + c;
        if (L >= ntiles * NT) return false;
        const int mt = L / NT, nt = L - mt * NT;
        const int e = __builtin_amdgcn_readfirstlane(tile_e[mt]);
        u.pm = mt; u.pn = nt; u.e = e; u.pb = e * NT + nt; return true;
    }
    __device__ __forceinline__ void a_ready(const Unit&) const {}
    __device__ __forceinline__ void done(const Unit&) const {}
};
template <class Epi, class Sched, bool ALIGN_EPI = false, bool SP2 = false, bool FP8 = false>
__device__ __forceinline__ void gemm_phase(PG8_LAS unsigned char* lds, const Gemm g, const Sched& S, const Epi& E) {
    const int tid = threadIdx.x, wid = __builtin_amdgcn_readfirstlane(tid >> 6), lane = tid & 63, wr = wid >> 2, wc = wid & 3, fr = lane & 15, fq = lane >> 4;
    const int K = g.K, nt = K / BK;
    unsigned voffA[2], voffB[2];
#pragma unroll
    for (int i = 0; i < 2; ++i) { int R, C; stage_rc(tid * 16 + i * 8192, R, C); const int Rb = Epi::PERM ? ((R & ~31) + perm32(R & 31)) : R;
        voffA[i] = (unsigned)(R * K + C) * 2u; voffB[i] = (unsigned)(Rb * K + C) * 2u; }
    const size_t kstep = (size_t)(BK * 2);
    const size_t hstep = (size_t)HALF * K * 2;
    const size_t tstep = 2 * hstep;
    const unsigned ldsw = (unsigned)wid * 1024u;
    const int aoff = lds_byte(wr * 64 + fr, fq * 8), boff = lds_byte(wc * 32 + fr, fq * 8);
#define PG8_SA(b, h) (((b) * 2 + (h)) * HTB)
#define PG8_SB(b, h) ((4 + (b) * 2 + (h)) * HTB)
#define PG8_STAGE(bufoff, gbase, voff) do { _Pragma("unroll") for (int _i = 0; _i < 2; ++_i) \
        __builtin_amdgcn_global_load_lds((const unsigned*)((const char*)(gbase) + (voff)[_i]), (PG8_LAS unsigned*)(lds + (bufoff) + ldsw + _i * 8192), 16, 0, 0); } while (0)
#define PG8_LD1(off) (*(const PG8_LAS bf16x8*)(lds + (off)))
#define PG8_LDA(dst, b, h) do { if constexpr (FP8) { _Pragma("unroll") for (int m = 0; m < 4; ++m) dst##8[m] = cat16(PG8_LD1(PG8_SA(b, h) + aoff + m * 2048), PG8_LD1(PG8_SA(b, h) + aoff + m * 2048 + 1024)); } \
        else { _Pragma("unroll") for (int m = 0; m < 4; ++m) _Pragma("unroll") for (int k = 0; k < 2; ++k) dst[m][k] = PG8_LD1(PG8_SA(b, h) + aoff + m * 2048 + k * 1024); } } while (0)
#define PG8_LDB(dst, b, h) do { if constexpr (FP8) { _Pragma("unroll") for (int n = 0; n < 2; ++n) dst##8[n] = cat16(PG8_LD1(PG8_SB(b, h) + boff + n * 2048), PG8_LD1(PG8_SB(b, h) + boff + n * 2048 + 1024)); } \
        else { _Pragma("unroll") for (int n = 0; n < 2; ++n) _Pragma("unroll") for (int k = 0; k < 2; ++k) dst[n][k] = PG8_LD1(PG8_SB(b, h) + boff + n * 2048 + k * 1024); } } while (0)
#define PG8_MMA(ai, bj, At, Bt) do { if constexpr (FP8) __builtin_amdgcn_sched_barrier(0); __builtin_amdgcn_s_setprio(1); _Pragma("unroll") for (int m = 0; m < 4; ++m) _Pragma("unroll") for (int n = 0; n < 2; ++n) { \
        if constexpr (FP8) { acc[ai][bj][m][n] = __builtin_amdgcn_mfma_scale_f32_16x16x128_f8f6f4(Bt##8[n], At##8[m], acc[ai][bj][m][n], 0, 0, 0, 0x79797979, 0, 0x7f7f7f7f); } \
        else { _Pragma("unroll") for (int k = 0; k < 2; ++k) acc[ai][bj][m][n] = __builtin_amdgcn_mfma_f32_16x16x32_bf16(Bt[n][k], At[m][k], acc[ai][bj][m][n], 0, 0, 0); } } \
        if constexpr (FP8) { _Pragma("unroll") for (int m = 0; m < 4; ++m) _Pragma("unroll") for (int n = 0; n < 2; ++n) asm volatile("" : "+v"(acc[ai][bj][m][n])); }     \
        __builtin_amdgcn_s_setprio(0); if constexpr (FP8) __builtin_amdgcn_sched_barrier(0); } while (0)
#define PG8_WAIT_V(n) asm volatile("s_waitcnt vmcnt(" #n ")" ::: "memory")
#define PG8_WAIT_L(n) asm volatile("s_waitcnt lgkmcnt(" #n ")" ::: "memory")
#define PG8_BAR __builtin_amdgcn_s_barrier()
#define PG8_SCHED __builtin_amdgcn_sched_barrier(0)
    Unit cur, nxt; int ui = 0;
    if (!S.next(0, cur)) return;
    f32x4 acc[2][2][4][2];
#pragma unroll
    for (int a = 0; a < 2; ++a)
#pragma unroll
        for (int b = 0; b < 2; ++b)
#pragma unroll
            for (int m = 0; m < 4; ++m)
#pragma unroll
                for (int n = 0; n < 2; ++n) acc[a][b][m][n] = (f32x4){0.f, 0.f, 0.f, 0.f};
    bf16x8 At[4][2], B0[2][2], B1[2][2]; v8i_t At8[4], B08[2], B18[2];
    const char* cA = (const char*)g.A + (size_t)cur.pm * tstep; const char* cB = (const char*)g.Bt + (size_t)cur.pb * tstep;
    S.a_ready(cur);
    if constexpr (SP2) {
        PG8_STAGE(PG8_SB(0, 0), cB, voffB); PG8_STAGE(PG8_SB(0, 1), cB + hstep, voffB); PG8_STAGE(PG8_SA(0, 0), cA, voffA); PG8_STAGE(PG8_SA(0, 1), cA + hstep, voffA);
        if (wr == 1) PG8_BAR;
        PG8_WAIT_V(2); PG8_BAR;
        PG8_STAGE(PG8_SB(1, 0), cB + kstep, voffB); PG8_STAGE(PG8_SA(1, 0), cA + kstep, voffA); PG8_STAGE(PG8_SB(1, 1), cB + hstep + kstep, voffB);
        PG8_WAIT_V(6); PG8_BAR;
    } else {
        PG8_STAGE(PG8_SB(0, 0), cB, voffB); PG8_STAGE(PG8_SA(0, 0), cA, voffA); PG8_STAGE(PG8_SB(0, 1), cB + hstep, voffB); PG8_STAGE(PG8_SA(0, 1), cA + hstep, voffA);
        if (wr == 1) PG8_BAR;
        PG8_WAIT_V(4); PG8_BAR;
        PG8_STAGE(PG8_SB(1, 0), cB + kstep, voffB); PG8_STAGE(PG8_SA(1, 0), cA + kstep, voffA); PG8_STAGE(PG8_SB(1, 1), cB + hstep + kstep, voffB);
        PG8_WAIT_V(6); PG8_BAR;
    }
    for (;;) {
        const bool has_next = S.next(ui + 1, nxt);
        const char* nA = has_next ? (const char*)g.A + (size_t)nxt.pm * tstep : cA; const char* nB = has_next ? (const char*)g.Bt + (size_t)nxt.pb * tstep : cB;
        for (int t = 0; t < nt; t += 2) {
            const bool last = (t == nt - 2);
            const char* a1 = cA + (size_t)(t + 1) * kstep;
            const char* a2 = last ? nA : cA + (size_t)(t + 2) * kstep; const char* b2 = last ? nB : cB + (size_t)(t + 2) * kstep;
            const char* a3 = a2 + kstep; const char* b3 = b2 + kstep;
            if (last && has_next) S.a_ready(nxt);
            if constexpr (SP2) {
            PG8_LDB(B0, 0, 0); PG8_LDB(B1, 0, 1); PG8_SCHED; PG8_LDA(At, 0, 0); PG8_STAGE(PG8_SA(1, 1), a1 + hstep, voffA);
            PG8_WAIT_V(8); PG8_WAIT_L(0); PG8_BAR; PG8_MMA(0, 0, At, B0); PG8_MMA(0, 1, At, B1); PG8_BAR; PG8_SCHED;
            PG8_LDA(At, 0, 1); PG8_STAGE(PG8_SB(0, 0), b2, voffB); PG8_STAGE(PG8_SB(0, 1), b2 + hstep, voffB); PG8_STAGE(PG8_SA(0, 0), a2, voffA);
            PG8_WAIT_V(8); PG8_WAIT_L(0); PG8_BAR; PG8_MMA(1, 0, At, B0); PG8_MMA(1, 1, At, B1); PG8_BAR; PG8_SCHED;
            PG8_LDB(B0, 1, 0); PG8_LDB(B1, 1, 1); PG8_SCHED; PG8_LDA(At, 1, 0); PG8_STAGE(PG8_SA(0, 1), a2 + hstep, voffA);
            PG8_WAIT_V(8); PG8_WAIT_L(0); PG8_BAR; PG8_MMA(0, 0, At, B0); PG8_MMA(0, 1, At, B1); PG8_BAR; PG8_SCHED;
            PG8_LDA(At, 1, 1); PG8_STAGE(PG8_SB(1, 0), b3, voffB); PG8_STAGE(PG8_SB(1, 1), b3 + hstep, voffB); PG8_STAGE(PG8_SA(1, 0), a3, voffA);
            PG8_WAIT_V(8); PG8_WAIT_L(0); PG8_BAR; PG8_MMA(1, 0, At, B0); PG8_MMA(1, 1, At, B1); PG8_BAR; PG8_SCHED;
            } else {
            PG8_LDB(B0, 0, 0); PG8_SCHED; PG8_LDA(At, 0, 0); PG8_STAGE(PG8_SA(1, 1), a1 + hstep, voffA);
            PG8_WAIT_L(8); PG8_BAR; PG8_WAIT_L(0); PG8_MMA(0, 0, At, B0); PG8_BAR; PG8_SCHED;
            PG8_LDB(B1, 0, 1); PG8_STAGE(PG8_SB(0, 0), b2, voffB);
            PG8_BAR; PG8_WAIT_L(0); PG8_MMA(0, 1, At, B1); PG8_BAR;
            PG8_LDA(At, 0, 1); PG8_STAGE(PG8_SA(0, 0), a2, voffA);
            PG8_BAR; PG8_WAIT_L(0); PG8_MMA(1, 0, At, B0); PG8_BAR; PG8_SCHED;
            PG8_STAGE(PG8_SB(0, 1), b2 + hstep, voffB);
            PG8_WAIT_V(6); PG8_BAR; PG8_MMA(1, 1, At, B1); PG8_BAR;
            PG8_LDB(B0, 1, 0); PG8_SCHED; PG8_LDA(At, 1, 0); PG8_STAGE(PG8_SA(0, 1), a2 + hstep, voffA);
            PG8_WAIT_L(8); PG8_BAR; PG8_WAIT_L(0); PG8_MMA(0, 0, At, B0); PG8_BAR; PG8_SCHED;
            PG8_LDB(B1, 1, 1); PG8_STAGE(PG8_SB(1, 0), b3, voffB);
            PG8_BAR; PG8_WAIT_L(0); PG8_MMA(0, 1, At, B1); PG8_BAR;
            PG8_LDA(At, 1, 1); PG8_STAGE(PG8_SA(1, 0), a3, voffA);
            PG8_BAR; PG8_WAIT_L(0); PG8_MMA(1, 0, At, B0); PG8_BAR; PG8_SCHED;
            PG8_STAGE(PG8_SB(1, 1), b3 + hstep, voffB);
            PG8_WAIT_V(6); PG8_BAR; PG8_MMA(1, 1, At, B1); PG8_BAR;
            }
        }
        if constexpr (ALIGN_EPI) { if (wr == 0) PG8_BAR; }
        if constexpr (!Epi::AFTER_DRAIN) { E(acc, cur, wr, wc, fr, fq); S.done(cur); }
        if (!has_next) break;
#pragma unroll
        for (int a = 0; a < 2; ++a)
#pragma unroll
            for (int b = 0; b < 2; ++b)
#pragma unroll
                for (int m = 0; m < 4; ++m)
#pragma unroll
                    for (int n = 0; n < 2; ++n) acc[a][b][m][n] = (f32x4){0.f, 0.f, 0.f, 0.f};
        cur = nxt; cA = nA; cB = nB; ++ui;
        if constexpr (ALIGN_EPI) { if (wr == 1) PG8_BAR; }
    }
    PG8_WAIT_V(0);
    if constexpr (!ALIGN_EPI) { if (wr == 0) PG8_BAR; }
    PG8_BAR;
    if constexpr (Epi::AFTER_DRAIN) { E.fused(acc, cur, wr, wc, fr, fq, lds, wid, lane); S.done(cur); }
#undef PG8_SA
#undef PG8_SB
#undef PG8_STAGE
#undef PG8_LD1
#undef PG8_LDA
#undef PG8_LDB
#undef PG8_MMA
#undef PG8_WAIT_V
#undef PG8_WAIT_L
#undef PG8_BAR
#undef PG8_SCHED
}
}

constexpr int NWAVES = 8;
constexpr int T = 16384, D = 1024, NCH = 256, LDP = 3840, DIN = 3608, PLE = 256, NE = 32;
constexpr int C_GQ = 0, C_GK = 256, C_GV = 512, C_GR = 1024, C_DQ = 1536, C_DZ = 3072, C_GLR = 3584, C_DA = 3600, C_DB = 3604;
constexpr float EPS = 1e-6f;
constexpr int XS_ROWS = 65536 + NE * 256;

constexpr size_t MiB = 1u << 20;
constexpr size_t WS_CTL = 0, CTL_ZERO_BYTES = 1 * MiB;
constexpr size_t WS_WIN = 2 * MiB, WS_WPP = 10 * MiB, WS_WOUT = 11 * MiB, WS_WPG = 13 * MiB, WS_W1 = 16 * MiB, WS_W2 = 80 * MiB;
constexpr size_t WS_XN = 112 * MiB, WS_PB = 144 * MiB, WS_PROJ = 152 * MiB, WS_PERAW = 272 * MiB;
constexpr size_t WS_KVT = 304 * MiB, WS_DVEC = 336 * MiB, WS_SGLA = 337 * MiB, WS_WF = 353 * MiB, WS_KDF = 369 * MiB, WS_UF = 385 * MiB, WS_CDEC = 417 * MiB;
constexpr size_t WS_QDEC = 418 * MiB, WS_AQK = 434 * MiB, WS_SGDN = 442 * MiB, WS_DELTA = 474 * MiB, WS_MIX = 490 * MiB;
constexpr size_t WS_TOKE = 522 * MiB, WS_TOKS = WS_TOKE + 256 * 1024, WS_TOKG = WS_TOKS + 256 * 1024, WS_TOKP = WS_TOKG + 256 * 1024;
constexpr size_t WS_GPOS = 523 * MiB, WS_PERSTD = 524 * MiB, WS_XS = 525 * MiB, WS_HS = 597 * MiB, WS_YS = 669 * MiB;
constexpr size_t WS_PEND = 813 * MiB, WS_SLE = 821 * MiB, WS_SST = 837 * MiB, WS_GSLE = 853 * MiB, WS_GPD = 861 * MiB, WS_GSST = 869 * MiB, WS_END = 877 * MiB;
static_assert(WS_XS + (size_t)XS_ROWS * 1024 <= WS_HS && WS_HS + (size_t)XS_ROWS * 1024 <= WS_YS && WS_YS + (size_t)XS_ROWS * 2048 <= WS_PEND, "d_ws map");
constexpr int GRP = 4, NGRP = NCH / GRP;
constexpr int CW_TMO = 0, CW_CODE = 1, CW_BAR = 4096, CW_CNT = 8192;

constexpr int RING_OFF = 0, RING_BYTES = 131072;
constexpr int LDSCTL_OFF = RING_BYTES, MISC_OFF = LDSCTL_OFF + 320;
constexpr int TILEE_OFF = MISC_OFF + 128;
constexpr int BASE_OFF = TILEE_OFF + 320 * 4;
constexpr int ROUTE_OFF = BASE_OFF + 128;
constexpr int LDS_BYTES = 147456;
static_assert(ROUTE_OFF + 256 + 3072 <= LDS_BYTES, "LDS map");

#define GAS __attribute__((address_space(1)))
#define LAS __attribute__((address_space(3)))
typedef unsigned short bf16;
typedef unsigned v4u __attribute__((ext_vector_type(4)));
typedef float f32x4 __attribute__((ext_vector_type(4)));
typedef short bf16x8 __attribute__((ext_vector_type(8)));
typedef GAS unsigned gu32;
typedef GAS unsigned long long gu64;
#define RLX_AGENT __ATOMIC_RELAXED, __HIP_MEMORY_SCOPE_AGENT
#define LDS_WAIT() asm volatile("s_waitcnt lgkmcnt(0)" ::: "memory")
#define VM_WAIT() asm volatile("s_waitcnt vmcnt(0)" ::: "memory")
__device__ __forceinline__ unsigned long long rt() { return __builtin_amdgcn_s_memrealtime(); }
__device__ __forceinline__ unsigned f2bf(float f) { unsigned u = __builtin_bit_cast(unsigned, f); return (u + 0x7fffu + ((u >> 16) & 1u)) >> 16; }
__device__ __forceinline__ unsigned pk2(float lo, float hi) { return f2bf(lo) | (f2bf(hi) << 16); }

#define XB_TMO      128
#define XB_XCNT(j)  (256  + 64 * (j))
#define XB_XSUB(j)  (1280 + 64 * (j))
#define XB_XGEN(j)  (2304 + 64 * (j))
#define XB_TOP      3328
#define XB_TOPGEN   3392
#define XCD_BAR_WORDS 3456
#define XB_SPIN_CAP (1u << 18)

__device__ __forceinline__ unsigned xb_ld(unsigned* p)              { return __hip_atomic_load(p, __ATOMIC_RELAXED, __HIP_MEMORY_SCOPE_AGENT); }
__device__ __forceinline__ unsigned xb_add(unsigned* p, unsigned v) { return __hip_atomic_fetch_add(p, v, __ATOMIC_RELAXED, __HIP_MEMORY_SCOPE_AGENT); }
__device__ __forceinline__ unsigned xb_xcc_id() { return (unsigned)__builtin_amdgcn_s_getreg((3 << 11) | 20) & 0xFu; }
#define XB_SPIN(cond, bar) do { unsigned _sp = 0; while (cond) { __builtin_amdgcn_s_sleep(1); \
    if ((++_sp & 255u) == 0u) { if (xb_ld(&(bar)[XB_TMO])) break; if (_sp > XB_SPIN_CAP) { atomicAdd(&(bar)[XB_TMO], 1u); break; } } } } while (0)

struct XcdBarrier {
    unsigned* bar; unsigned x;
    volatile LAS unsigned* st;
};

__device__ __forceinline__ XcdBarrier xcd_barrier_post(unsigned* bar, volatile LAS unsigned* st) {
    XcdBarrier b; b.bar = bar; b.x = xb_xcc_id(); b.st = st;
    if (threadIdx.x == 0) (void)xb_add(&bar[XB_XCNT(b.x)], 1u);
    return b;
}
__device__ __forceinline__ void xcd_barrier_complete(unsigned* bar, unsigned x, unsigned& nloc, unsigned& nx) {
    const unsigned G = gridDim.x * gridDim.y * gridDim.z;
    unsigned sum, cnt, mine, sp = 0u;
    for (;;) {
        sum = 0u; cnt = 0u; mine = 0u;
#pragma unroll
        for (unsigned j = 0; j < 16; ++j) { const unsigned c = xb_ld(&bar[XB_XCNT(j)]); sum += c; cnt += (c > 0u) ? 1u : 0u; mine = (j == x) ? c : mine; }
        if (sum == G) break;
        __builtin_amdgcn_s_sleep(1);
        if ((++sp & 255u) == 0u) { if (xb_ld(&bar[XB_TMO])) break; if (sp > XB_SPIN_CAP) { atomicAdd(&bar[XB_TMO], 1u); break; } }
    }
    nloc = mine > 0u ? mine : 1u; nx = cnt > 0u ? cnt : 1u;
}

__device__ __forceinline__ void xcd_barrier(const XcdBarrier& b) {
    asm volatile("s_waitcnt vmcnt(0)" ::: "memory");
    __syncthreads();
    if (threadIdx.x == 0) {
        unsigned* bar = b.bar;
        __builtin_amdgcn_s_waitcnt(0);
        unsigned nloc = b.st[0], nx = b.st[1];
        if (nloc == 0u) { xcd_barrier_complete(bar, b.x, nloc, nx); b.st[0] = nloc; b.st[1] = nx; }
        const unsigned old = xb_add(&bar[XB_XSUB(b.x)], 1u);
        const unsigned gen = old / nloc;
        if (old + 1u == (gen + 1u) * nloc) {
            __builtin_amdgcn_fence(__ATOMIC_RELEASE, "agent");
            asm volatile("s_waitcnt vmcnt(0)" ::: "memory");
            const unsigned og = xb_add(&bar[XB_TOP], 1u);
            const unsigned tg = og / nx;
            if (og + 1u == (tg + 1u) * nx) xb_add(&bar[XB_TOPGEN], 1u);
            else XB_SPIN(xb_ld(&bar[XB_TOPGEN]) == tg, bar);
            __builtin_amdgcn_fence(__ATOMIC_ACQUIRE, "agent");
            xb_add(&bar[XB_XGEN(b.x)], 1u);
            asm volatile("s_waitcnt vmcnt(0)" ::: "memory");
        } else {
            XB_SPIN(xb_ld(&bar[XB_XGEN(b.x)]) == gen, bar);
            __builtin_amdgcn_fence(__ATOMIC_ACQUIRE, "agent");
            asm volatile("s_waitcnt vmcnt(0)" ::: "memory");
        }
    }
    __syncthreads();
}


__device__ __forceinline__ float bflo(unsigned w) { return __uint_as_float(w << 16); }
__device__ __forceinline__ float bfhi(unsigned w) { return __uint_as_float(w & 0xffff0000u); }
__device__ __forceinline__ float bf2f(bf16 h) { return __uint_as_float((unsigned)h << 16); }
using pg8::cvtpk;
__device__ __forceinline__ bf16 f2bf1(float f) { return (bf16)(cvtpk(f, 0.f) & 0xffffu); }
__device__ __forceinline__ float wave_sum(float v) {
#pragma unroll
    for (int o = 1; o < 64; o <<= 1) v += __shfl_xor(v, o);
    return v;
}
__device__ __forceinline__ float sigm(float x) { return __builtin_amdgcn_rcpf(1.0f + __expf(-x)); }
__device__ __forceinline__ float siluf_(float x) { return x * sigm(x); }
__device__ __forceinline__ float softplusf_(float x) { return fmaxf(x, 0.f) + __logf(1.0f + __expf(-fabsf(x))); }
__device__ __forceinline__ float logsigf_(float x) { return fminf(x, 0.f) - __logf(1.0f + __expf(-fabsf(x))); }
#define MFMA16(a, b, c) __builtin_amdgcn_mfma_f32_16x16x32_bf16((a), (b), (c), 0, 0, 0)
typedef short bf16x4 __attribute__((ext_vector_type(4)));
typedef unsigned u32x2 __attribute__((ext_vector_type(2)));
__device__ __forceinline__ bf16x8 cat8(bf16x4 lo, bf16x4 hi) { return __builtin_shufflevector(lo, hi, 0, 1, 2, 3, 4, 5, 6, 7); }
__device__ __forceinline__ bf16x8 pack8(const f32x4& a, const f32x4& b) {
    v4u w; w.x = cvtpk(a[0], a[1]); w.y = cvtpk(a[2], a[3]); w.z = cvtpk(b[0], b[1]); w.w = cvtpk(b[2], b[3]); return __builtin_bit_cast(bf16x8, w);
}
__device__ __forceinline__ u32x2 pack4(const f32x4& a) { u32x2 w; w.x = cvtpk(a[0], a[1]); w.y = cvtpk(a[2], a[3]); return w; }

struct Frame {
    LAS unsigned char* lds;
    volatile LAS unsigned* MISC;
    gu32* ctl;
    int tid, lane, wave;
    int vcu, G;
    unsigned char* ws;
    const float* in[24];
    float* out;
};
#define WSP(T_, off) ((T_*)(F.ws + (off)))

template <class RowMap>
__device__ __forceinline__ void transpose_item(const float* W, int K, int N, bf16* WT, LAS float* scr, int item, int lane, RowMap rm) {
    const int nblk = (N + 31) >> 5, kb = item / nblk, nb = item - kb * nblk, k0 = 64 * kb, n0 = 32 * nb;
    const int cq = (lane & 7) * 4, rr = lane >> 3;
#pragma unroll
    for (int i = 0; i < 8; ++i) { const int kk = 8 * i + rr; f32x4 v = {0.f, 0.f, 0.f, 0.f};
        if (n0 + cq < N) v = *(const GAS f32x4*)(W + (size_t)(k0 + kk) * N + n0 + cq);
        LAS float* s = scr + kk * 33 + cq; s[0] = v[0]; s[1] = v[1]; s[2] = v[2]; s[3] = v[3]; }
    LDS_WAIT(); asm volatile("" ::: "memory");
    const int c = lane & 7;
#pragma unroll
    for (int j = 0; j < 4; ++j) { const int n = (lane >> 3) + 8 * j; const LAS float* s = scr + (8 * c) * 33 + n;
        v4u o; o.x = cvtpk(s[0 * 33], s[1 * 33]); o.y = cvtpk(s[2 * 33], s[3 * 33]); o.z = cvtpk(s[4 * 33], s[5 * 33]); o.w = cvtpk(s[6 * 33], s[7 * 33]);
        if (n0 + n < N) *(GAS v4u*)(WT + (size_t)rm(n0 + n) * K + k0 + 8 * c) = o; }
    LDS_WAIT(); asm volatile("" ::: "memory");
}
template <class RowMap>
__device__ __forceinline__ void transpose_item_fp8(const float* W, int K, int N, unsigned char* WT, LAS float* scr, int item, int lane, RowMap rm) {
    const int nblk = (N + 31) >> 5, kb = item / nblk, nb = item - kb * nblk, k0 = 64 * kb, n0 = 32 * nb;
    const int cq = (lane & 7) * 4, rr = lane >> 3;
#pragma unroll
    for (int i = 0; i < 8; ++i) { const int kk = 8 * i + rr; const f32x4 v = *(const GAS f32x4*)(W + (size_t)(k0 + kk) * N + n0 + cq);
        LAS float* s = scr + kk * 33 + cq; s[0] = v[0] * 64.f; s[1] = v[1] * 64.f; s[2] = v[2] * 64.f; s[3] = v[3] * 64.f; }
    LDS_WAIT(); asm volatile("" ::: "memory");
    const int c = lane & 7;
#pragma unroll
    for (int j = 0; j < 4; ++j) { const int n = (lane >> 3) + 8 * j; const LAS float* s = scr + (8 * c) * 33 + n;
        u32x2 o; o.x = pg8::cvt4_fp8(s[0 * 33], s[1 * 33], s[2 * 33], s[3 * 33]); o.y = pg8::cvt4_fp8(s[4 * 33], s[5 * 33], s[6 * 33], s[7 * 33]);
        *(GAS u32x2*)(WT + (size_t)rm(n0 + n) * K + k0 + 8 * c) = o; }
    LDS_WAIT(); asm volatile("" ::: "memory");
}
struct RmId { __device__ __forceinline__ int operator()(int n) const { return n; } };
struct RmWin { __device__ __forceinline__ int operator()(int c) const { return c < 1536 ? c : (c < 1552 ? c + 2048 : (c < 3600 ? c - 16 : c)); } };
struct RmW1 { __device__ __forceinline__ int operator()(int c) const { const int j = c & 1023, up = c >> 10; return (j >> 7) * 256 + up * 128 + (j & 127); } };

__device__ __forceinline__ void rms_row_to_bf16(const float* xrow, const float* g, bf16* orow, int lane) {
    const GAS f32x4* xr = (const GAS f32x4*)xrow + lane; const GAS f32x4* gr = (const GAS f32x4*)g + lane;
    f32x4 v[4]; float s = 0.f;
#pragma unroll
    for (int j = 0; j < 4; ++j) { v[j] = xr[64 * j]; s += (v[j].x * v[j].x + v[j].y * v[j].y) + (v[j].z * v[j].z + v[j].w * v[j].w); }
    const float rstd = 1.f / sqrtf(wave_sum(s) * (1.f / D) + EPS);
    GAS u32x2* o8 = (GAS u32x2*)orow + lane;
#pragma unroll
    for (int j = 0; j < 4; ++j) { const f32x4 gg = gr[64 * j]; u32x2 w; w.x = cvtpk(v[j].x * rstd * gg.x, v[j].y * rstd * gg.y); w.y = cvtpk(v[j].z * rstd * gg.z, v[j].w * rstd * gg.w); o8[64 * j] = w; }
}

__device__ __forceinline__ void p0_prologue(Frame& F) {
    LAS float* scr = (LAS float*)(F.lds + RING_OFF + F.wave * 16384);
    const int gw = F.vcu * NWAVES + F.wave, NGW = F.G * NWAVES, lane = F.lane;
    bf16* Win_t = WSP(bf16, WS_WIN);
    for (int it = gw; it < 16 * 113; it += NGW) transpose_item(F.in[3], 1024, DIN, Win_t, scr, it, lane, RmWin());
    for (int r = DIN + gw; r < LDP; r += NGW) { GAS v4u* o = (GAS v4u*)(Win_t + (size_t)r * 1024) + lane; o[0] = (v4u){0, 0, 0, 0}; o[64] = (v4u){0, 0, 0, 0}; }
    for (int it = gw; it < 4 * 32; it += NGW) transpose_item(F.in[21], PLE, D, WSP(bf16, WS_WPP), scr, it, lane, RmId());
    for (int it = gw; it < 512; it += NGW) transpose_item(F.in[11], D, D, WSP(bf16, WS_WOUT), scr, it, lane, RmId());
    for (int it = gw; it < 512; it += NGW) transpose_item(F.in[20], D, D, WSP(bf16, WS_WPG), scr, it, lane, RmId());
    for (int it = gw; it < NE * 1024; it += NGW) { const int e = it >> 10; transpose_item_fp8(F.in[15] + (size_t)e * 1024 * 2048, 1024, 2048, WSP(unsigned char, WS_W1) + (size_t)e * 2048 * 1024, scr, it & 1023, lane, RmW1()); }
    for (int it = gw; it < NE * 512; it += NGW) { const int e = it >> 9; transpose_item_fp8(F.in[17] + (size_t)e * 1024 * 1024, 1024, 1024, WSP(unsigned char, WS_W2) + (size_t)e * 1024 * 1024, scr, it & 511, lane, RmId()); }
    for (int m = gw; m < T; m += NGW) rms_row_to_bf16(F.in[0] + (size_t)m * D, F.in[2], WSP(bf16, WS_XN) + (size_t)m * D, lane);
    for (int m = gw; m < T; m += NGW) { const f32x4 v = *((const GAS f32x4*)(F.in[1] + (size_t)m * PLE) + lane); u32x2 w; w.x = cvtpk(v.x, v.y); w.y = cvtpk(v.z, v.w); *((GAS u32x2*)(WSP(bf16, WS_PB) + (size_t)m * PLE) + lane) = w; }
}

constexpr int GL_B = 0, GL_GLR = 16640, GL_T1 = 20992, GL_T2 = 30208, GL_VT = 39424, GL_RED = 57856;
__device__ __forceinline__ void gla_b(Frame& F, int n, int h) {
    LAS float* bL = (LAS float*)(F.lds + GL_B); LAS float* glrL = (LAS float*)(F.lds + GL_GLR);
    const bf16* PROJ = WSP(bf16, WS_PROJ); const int tid = F.tid, t0 = n * 64;
    { const int idx = tid * 2, t = idx >> 4, r = idx & 15; const unsigned w = *(const GAS unsigned*)(PROJ + (size_t)(t0 + t) * LDP + C_GLR + r); glrL[t * 17 + r] = bflo(w); glrL[t * 17 + r + 1] = bfhi(w); }
    const int d = tid & 63, tg = tid >> 6;
    float wg[16];
#pragma unroll
    for (int r = 0; r < 16; ++r) wg[r] = F.in[4][r * 256 + h * 64 + d];
    const float bias = F.in[5][h * 64 + d];
    __syncthreads();
#pragma unroll
    for (int tt = 0; tt < 8; ++tt) { const int t = tg * 8 + tt; float a = bias;
#pragma unroll
        for (int r = 0; r < 16; ++r) a += glrL[t * 17 + r] * wg[r];
        bL[t * 65 + d] = logsigf_(a) * 0.0625f; }
    __syncthreads();
    if (tid < 64) { float run = 0.f;
#pragma unroll 16
        for (int t = 0; t < 64; ++t) { run += bL[t * 65 + tid]; bL[t * 65 + tid] = run; } }
    __syncthreads();
}
__device__ __forceinline__ void gla_load_vT(Frame& F, int n, int h) {
    LAS bf16* vT = (LAS bf16*)(F.lds + GL_VT); const bf16* PROJ = WSP(bf16, WS_PROJ);
    const int t = F.tid >> 3, eg = F.tid & 7;
    const GAS v4u* src = (const GAS v4u*)(PROJ + (size_t)(n * 64 + t) * LDP + C_GV + h * 128 + eg * 16);
#pragma unroll
    for (int half = 0; half < 2; ++half) { const v4u w = src[half];
#pragma unroll
        for (int i = 0; i < 4; ++i) { const int e = eg * 16 + half * 8 + 2 * i; vT[e * 72 + t] = (bf16)(w[i] & 0xffffu); vT[(e + 1) * 72 + t] = (bf16)(w[i] >> 16); } }
}

__device__ __forceinline__ void gla_prep_item(Frame& F, int n, int h) {
    gla_b(F, n, h);
    LAS float* bL = (LAS float*)(F.lds + GL_B); LAS bf16* T1 = (LAS bf16*)(F.lds + GL_T1); LAS bf16* vT = (LAS bf16*)(F.lds + GL_VT);
    const bf16* PROJ = WSP(bf16, WS_PROJ); const int tid = F.tid, lane = F.lane, w = F.wave;
    { const int t = tid >> 3, dg = tid & 7; const v4u kw = *(const GAS v4u*)(PROJ + (size_t)(n * 64 + t) * LDP + C_GK + h * 64 + dg * 8);
#pragma unroll
        for (int i = 0; i < 4; ++i) { const int d0 = dg * 8 + 2 * i;
            T1[d0 * 72 + t] = f2bf1(bflo(kw[i]) * __expf(bL[63 * 65 + d0] - bL[t * 65 + d0]));
            T1[(d0 + 1) * 72 + t] = f2bf1(bfhi(kw[i]) * __expf(bL[63 * 65 + d0 + 1] - bL[t * 65 + d0 + 1])); } }
    gla_load_vT(F, n, h);
    __syncthreads();
    const int c = lane & 15, kq = lane >> 4;
    bf16x8 a[2];
#pragma unroll
    for (int ks = 0; ks < 2; ++ks) a[ks] = *(const LAS bf16x8*)(vT + (16 * w + c) * 72 + 32 * ks + 8 * kq);
    float* KVT = WSP(float, WS_KVT) + (size_t)(n * 4 + h) * 128 * 64;
#pragma unroll
    for (int dt = 0; dt < 4; ++dt) { f32x4 acc = {0.f, 0.f, 0.f, 0.f};
#pragma unroll
        for (int ks = 0; ks < 2; ++ks) { const bf16x8 b = *(const LAS bf16x8*)(T1 + (16 * dt + c) * 72 + 32 * ks + 8 * kq); acc = MFMA16(a[ks], b, acc); }
#pragma unroll
        for (int r = 0; r < 4; ++r) KVT[(16 * w + 4 * kq + r) * 64 + 16 * dt + c] = acc[r]; }
    if (tid < 64) WSP(float, WS_DVEC)[(n * 4 + h) * 64 + tid] = __expf(bL[63 * 65 + tid]);
    __syncthreads();
}

__device__ __forceinline__ void mix_epilogue(Frame& F, const f32x4 (&o)[4], int n, int it, int eh, const float* gain, int gate_col, int mix_col) {
    LAS float* red = (LAS float*)(F.lds + GL_RED);
    const int lane = F.lane, c = lane & 15, kq = lane >> 4, w = F.wave;
    float ss = 0.f;
#pragma unroll
    for (int q = 0; q < 4; ++q)
#pragma unroll
        for (int r = 0; r < 4; ++r) ss += o[q][r] * o[q][r];
    ss += __shfl_xor(ss, 16); ss += __shfl_xor(ss, 32);
    if (kq == 0) red[w * 64 + c] = ss;
    __syncthreads();
    const float tot = red[it * 64 + c] + red[(it + 4) * 64 + c];
    const float rstd = 1.f / sqrtf(tot * (1.f / 128.f) + EPS);
    const int t = n * 64 + 16 * it + c;
    const bf16* PROJ = WSP(bf16, WS_PROJ); bf16* MIX = WSP(bf16, WS_MIX);
#pragma unroll
    for (int q = 0; q < 4; ++q) { const int e = 16 * (4 * eh + q) + 4 * kq;
        const u32x2 gw = *(const GAS u32x2*)(PROJ + (size_t)t * LDP + gate_col + e); const f32x4 gn = *(const GAS f32x4*)(gain + e);
        f32x4 v; v[0] = o[q][0] * rstd * gn[0] * siluf_(bflo(gw.x)); v[1] = o[q][1] * rstd * gn[1] * siluf_(bfhi(gw.x)); v[2] = o[q][2] * rstd * gn[2] * siluf_(bflo(gw.y)); v[3] = o[q][3] * rstd * gn[3] * siluf_(bfhi(gw.y));
        *(GAS u32x2*)(MIX + (size_t)t * D + mix_col + e) = pack4(v); }
    __syncthreads();
}

__device__ __forceinline__ void gla_out_item(Frame& F, int n, int h) {
    const int c = F.lane & 15, kq = F.lane >> 4, it = F.wave & 3, eh = F.wave >> 2;
    const bf16* ST = WSP(bf16, WS_SGLA) + (size_t)(n * 4 + h) * 128 * 64;
    bf16x8 as[4][2];
#pragma unroll
    for (int q = 0; q < 4; ++q)
#pragma unroll
        for (int ks = 0; ks < 2; ++ks) as[q][ks] = *(const GAS bf16x8*)(ST + (16 * (4 * eh + q) + c) * 64 + 32 * ks + 8 * kq);
    __builtin_amdgcn_sched_barrier(0);
    gla_b(F, n, h);
    LAS float* bL = (LAS float*)(F.lds + GL_B); LAS bf16* T1 = (LAS bf16*)(F.lds + GL_T1); LAS bf16* T2 = (LAS bf16*)(F.lds + GL_T2); LAS bf16* vT = (LAS bf16*)(F.lds + GL_VT);
    const bf16* PROJ = WSP(bf16, WS_PROJ); const int tid = F.tid, lane = F.lane, w = F.wave;
    { const int t = tid >> 3, dg = tid & 7;
        const v4u qw = *(const GAS v4u*)(PROJ + (size_t)(n * 64 + t) * LDP + C_GQ + h * 64 + dg * 8); const v4u kw = *(const GAS v4u*)(PROJ + (size_t)(n * 64 + t) * LDP + C_GK + h * 64 + dg * 8);
        v4u qo, ko;
#pragma unroll
        for (int i = 0; i < 4; ++i) { const int d0 = dg * 8 + 2 * i; const float b0 = bL[t * 65 + d0], b1 = bL[t * 65 + d0 + 1];
            qo[i] = cvtpk(bflo(qw[i]) * 0.125f * __expf(b0), bfhi(qw[i]) * 0.125f * __expf(b1));
            ko[i] = cvtpk(bflo(kw[i]) * __expf(-b0), bfhi(kw[i]) * __expf(-b1)); }
        *(LAS v4u*)(T1 + t * 72 + dg * 8) = qo; *(LAS v4u*)(T2 + t * 72 + dg * 8) = ko; }
    gla_load_vT(F, n, h);
    __syncthreads();
    bf16x8 bq[2];
#pragma unroll
    for (int ks = 0; ks < 2; ++ks) bq[ks] = *(const LAS bf16x8*)(T1 + (16 * it + c) * 72 + 32 * ks + 8 * kq);
    f32x4 at[4];
#pragma unroll
    for (int jt = 0; jt < 4; ++jt) { f32x4 acc = {0.f, 0.f, 0.f, 0.f};
        if (jt <= it) {
#pragma unroll
            for (int ks = 0; ks < 2; ++ks) { const bf16x8 a = *(const LAS bf16x8*)(T2 + (16 * jt + c) * 72 + 32 * ks + 8 * kq); acc = MFMA16(a, bq[ks], acc); }
            if (jt == it) {
#pragma unroll
                for (int r = 0; r < 4; ++r) if (4 * kq + r > c) acc[r] = 0.f; }
        }
        at[jt] = acc; }
    bf16x8 pb[2]; pb[0] = pack8(at[0], at[1]); pb[1] = pack8(at[2], at[3]);
    f32x4 o[4];
#pragma unroll
    for (int q = 0; q < 4; ++q) { const int et = 4 * eh + q; f32x4 acc = {0.f, 0.f, 0.f, 0.f};
#pragma unroll
        for (int s = 0; s < 2; ++s) { const bf16x4 lo = *(const LAS bf16x4*)(vT + (16 * et + c) * 72 + 32 * s + 4 * kq), hi = *(const LAS bf16x4*)(vT + (16 * et + c) * 72 + 32 * s + 16 + 4 * kq);
            acc = MFMA16(cat8(lo, hi), pb[s], acc); }
#pragma unroll
        for (int ks = 0; ks < 2; ++ks) acc = MFMA16(as[q][ks], bq[ks], acc);
        o[q] = acc; }
    mix_epilogue(F, o, n, it, eh, F.in[6], C_GR + h * 128, h * 128);
}

__device__ __forceinline__ void gdn_out_item(Frame& F, int n, int h) {
    const int lane = F.lane, w = F.wave, c = lane & 15, kq = lane >> 4, it = w & 3, eh = w >> 2;
    const bf16* QD = WSP(bf16, WS_QDEC) + ((size_t)(n * 4 + h) * 64 + 16 * it + c) * 128; const bf16* AQ = WSP(bf16, WS_AQK) + ((size_t)(n * 4 + h) * 64 + 16 * it + c) * 64;
    bf16x8 bqd[4], baq[2];
#pragma unroll
    for (int ks = 0; ks < 4; ++ks) bqd[ks] = *(const GAS bf16x8*)(QD + 32 * ks + 8 * kq);
#pragma unroll
    for (int s = 0; s < 2; ++s) baq[s] = *(const GAS bf16x8*)(AQ + 32 * s + 8 * kq);
    const bf16* ST = WSP(bf16, WS_SGDN) + (size_t)(n * 4 + h) * 128 * 128; const bf16* DT = WSP(bf16, WS_DELTA) + (size_t)(n * 4 + h) * 128 * 64;
    bf16x8 as[4][4], ad[4][2];
#pragma unroll
    for (int q = 0; q < 4; ++q) { const int et = 4 * eh + q;
#pragma unroll
        for (int ks = 0; ks < 4; ++ks) as[q][ks] = *(const GAS bf16x8*)(ST + (16 * et + c) * 128 + 32 * ks + 8 * kq);
#pragma unroll
        for (int s = 0; s < 2; ++s) ad[q][s] = *(const GAS bf16x8*)(DT + (16 * et + c) * 64 + 32 * s + 8 * kq); }
    __builtin_amdgcn_sched_barrier(0);
    f32x4 o[4];
#pragma unroll
    for (int q = 0; q < 4; ++q) { f32x4 acc = {0.f, 0.f, 0.f, 0.f};
#pragma unroll
        for (int ks = 0; ks < 4; ++ks) acc = MFMA16(as[q][ks], bqd[ks], acc);
#pragma unroll
        for (int s = 0; s < 2; ++s) acc = MFMA16(ad[q][s], baq[s], acc);
        o[q] = acc; }
    mix_epilogue(F, o, n, it, eh, F.in[10], C_DZ + h * 128, 512 + h * 128);
}

constexpr int GD_QB = 0, GD_KB = 17408, GD_VF = 34816, GD_LS = 67840, GD_WL = 84224, GD_SC = 101632;
__device__ __forceinline__ void gdn_prep_item(Frame& F, int n, int h) {
    LAS bf16* qb = (LAS bf16*)(F.lds + GD_QB); LAS bf16* kb = (LAS bf16*)(F.lds + GD_KB); LAS float* vf = (LAS float*)(F.lds + GD_VF);
    LAS float* Ls = (LAS float*)(F.lds + GD_LS); LAS bf16* wL = (LAS bf16*)(F.lds + GD_WL);
    LAS float* bS = (LAS float*)(F.lds + GD_SC); LAS float* betaS = bS + 64; LAS float* ebS = bS + 128;
    const bf16* PROJ = WSP(bf16, WS_PROJ); const int tid = F.tid, lane = F.lane, w = F.wave, t0 = n * 64;
    const size_t nh = (size_t)(n * 4 + h);
    if (tid < 64) {
        const float da = bf2f(PROJ[(size_t)(t0 + tid) * LDP + C_DA + h]), db = bf2f(PROJ[(size_t)(t0 + tid) * LDP + C_DB + h]);
        float g = -__expf(F.in[8][h]) * softplusf_(da + F.in[9][h]);
#pragma unroll
        for (int off = 1; off < 64; off <<= 1) { const float v = __shfl_up(g, off); if (lane >= off) g += v; }
        bS[tid] = g; betaS[tid] = sigm(db); ebS[tid] = __expf(g);
    }
    if (!(MK_DBG & 2) && lane < 48) {
        const int grp = lane >> 4, c8 = (lane & 15) * 8;
        const int colP = C_DQ + grp * 512 + h * 128 + c8;
        f32x4 wc[4][2];
#pragma unroll
        for (int j = 0; j < 4; ++j) { const GAS f32x4* wp = (const GAS f32x4*)(F.in[7] + (size_t)j * 1536 + grp * 512 + h * 128 + c8); wc[j][0] = wp[0]; wc[j][1] = wp[1]; }
        v4u xin[11];
#pragma unroll
        for (int rr = 0; rr < 11; ++rr) { const int r = t0 + w * 8 - 3 + rr; xin[rr] = (v4u){0, 0, 0, 0}; if (r >= 0) xin[rr] = *(const GAS v4u*)(PROJ + (size_t)r * LDP + colP); }
#pragma unroll
        for (int tt = 0; tt < 8; ++tt) {
            float y[8];
#pragma unroll
            for (int i = 0; i < 8; ++i) y[i] = 0.f;
#pragma unroll
            for (int j = 0; j < 4; ++j)
#pragma unroll
                for (int i = 0; i < 4; ++i) { const unsigned xw = xin[tt + j][i]; y[2 * i] += wc[j][i >> 1][(2 * i) & 3] * bflo(xw); y[2 * i + 1] += wc[j][i >> 1][(2 * i + 1) & 3] * bfhi(xw); }
            float ss = 0.f;
#pragma unroll
            for (int i = 0; i < 8; ++i) { y[i] = siluf_(y[i]); ss += y[i] * y[i]; }
            ss += __shfl_xor(ss, 1); ss += __shfl_xor(ss, 2); ss += __shfl_xor(ss, 4); ss += __shfl_xor(ss, 8);
            const int row = w * 8 + tt;
            if (grp < 2) { const float sc = (1.f / sqrtf(ss + EPS)) * (grp == 0 ? 0.08838834764831845f : 1.0f);
                v4u o; o.x = cvtpk(y[0] * sc, y[1] * sc); o.y = cvtpk(y[2] * sc, y[3] * sc); o.z = cvtpk(y[4] * sc, y[5] * sc); o.w = cvtpk(y[6] * sc, y[7] * sc);
                *(LAS v4u*)((grp == 0 ? qb : kb) + row * 136 + c8) = o;
            } else {
#pragma unroll
                for (int i = 0; i < 8; ++i) vf[row * 129 + c8 + i] = y[i]; }
        }
    }
    __syncthreads();
    if (!(MK_DBG & 4)) {
        const int c = lane & 15, kq = lane >> 4;
        bf16* AQ = WSP(bf16, WS_AQK) + nh * 64 * 64;
        for (int job = w; job < 20; job += 8) {
            const int kind = job >= 10 ? 1 : 0, idx = job - 10 * kind;
            const int it = idx >= 6 ? 3 : (idx >= 3 ? 2 : (idx >= 1 ? 1 : 0)), jt = idx - (it * (it + 1)) / 2;
            const LAS bf16* Am = kind ? qb : kb;
            f32x4 acc = {0.f, 0.f, 0.f, 0.f};
#pragma unroll
            for (int ks = 0; ks < 4; ++ks) { const bf16x8 a = *(const LAS bf16x8*)(Am + (16 * it + c) * 136 + 32 * ks + 8 * kq), b = *(const LAS bf16x8*)(kb + (16 * jt + c) * 136 + 32 * ks + 8 * kq); acc = MFMA16(a, b, acc); }
            const int j = 16 * jt + c; const float bj = bS[j];
#pragma unroll
            for (int r = 0; r < 4; ++r) { const int i = 16 * it + 4 * kq + r; const float dec = __expf(fminf(bS[i] - bj, 0.f));
                if (kind == 0) Ls[i * 64 + j] = (j < i) ? betaS[i] * dec * acc[r] : 0.f;
                else { AQ[i * 64 + j] = (j <= i) ? f2bf1(dec * acc[r]) : (bf16)0; if (jt < it) AQ[(16 * jt + 4 * kq + r) * 64 + 16 * it + c] = (bf16)0; } }
        }
    }
    __syncthreads();
    if ((MK_DBG & 8) && tid < 256) {} else if (tid < 256) {
        const int cc = tid; const bool isu = cc < 128;
        const int vidx = isu ? cc : 0, kidx = isu ? 0 : cc - 128;
        int zlane; asm volatile("v_mov_b32 %0, 0" : "=v"(zlane));
        float sol[64];
#pragma unroll
        for (int i = 0; i < 64; ++i) {
            int z = zlane; if (i >= 2) asm volatile("v_and_b32 %0, 0, %1" : "=v"(z) : "v"(sol[i - 2]));
            const LAS float* Lz = Ls + z;
            float a = isu ? betaS[i + z] * vf[i * 129 + vidx + z] : betaS[i + z] * ebS[i + z] * bf2f(kb[i * 136 + kidx + z]);
#pragma unroll
            for (int j = 0; j < i; ++j) a -= Lz[i * 64 + j] * sol[j];
            sol[i] = a;
        }
        if (isu) { const int s = cc >> 4, c16 = cc & 15; float* Uf = WSP(float, WS_UF) + ((nh * 8 + s) * 4) * 256;
#pragma unroll
            for (int mt = 0; mt < 4; ++mt)
#pragma unroll
                for (int q = 0; q < 4; ++q) { f32x4 v = {sol[16 * mt + 4 * q], sol[16 * mt + 4 * q + 1], sol[16 * mt + 4 * q + 2], sol[16 * mt + 4 * q + 3]}; *(GAS f32x4*)(Uf + (mt * 64 + q * 16 + c16) * 4) = v; }
        } else { const int d = cc - 128;
#pragma unroll
            for (int i = 0; i < 64; ++i) wL[i * 136 + d] = f2bf1(-sol[i]); }
    } else if (!(MK_DBG & 16)) {
        const int tt = tid - 256; const float bl = bS[63];
        bf16* QD = WSP(bf16, WS_QDEC) + nh * 64 * 128;
#pragma unroll
        for (int j = 0; j < 4; ++j) { const int id = tt + 256 * j, i = id >> 4, c8 = (id & 15) * 8; const v4u qw = *(const LAS v4u*)(qb + i * 136 + c8); const float e = ebS[i];
            v4u o; o.x = cvtpk(bflo(qw.x) * e, bfhi(qw.x) * e); o.y = cvtpk(bflo(qw.y) * e, bfhi(qw.y) * e); o.z = cvtpk(bflo(qw.z) * e, bfhi(qw.z) * e); o.w = cvtpk(bflo(qw.w) * e, bfhi(qw.w) * e);
            *(GAS v4u*)(QD + i * 128 + c8) = o; }
        bf16* KDF = WSP(bf16, WS_KDF) + nh * 16 * 512;
#pragma unroll
        for (int j = 0; j < 4; ++j) { const int id = tt + 256 * j, f = id >> 6, ln = id & 63, dt = f >> 1, ks2 = f & 1, q = ln >> 4, m = ln & 15, d = 16 * dt + m;
            float v[8];
#pragma unroll
            for (int x = 0; x < 8; ++x) { const int i = 32 * ks2 + (x < 4 ? 4 * q + x : 16 + 4 * q + (x - 4)); v[x] = bf2f(kb[i * 136 + d]) * __expf(bl - bS[i]); }
            v4u o; o.x = cvtpk(v[0], v[1]); o.y = cvtpk(v[2], v[3]); o.z = cvtpk(v[4], v[5]); o.w = cvtpk(v[6], v[7]);
            *(GAS v4u*)(KDF + ((size_t)f * 64 + ln) * 8) = o; }
        if (tt == 0) WSP(float, WS_CDEC)[nh] = __expf(bl);
    }
    __syncthreads();
    if (!(MK_DBG & 32)) { bf16* WF = WSP(bf16, WS_WF) + nh * 16 * 512;
#pragma unroll
        for (int j = 0; j < 2; ++j) { const int id = tid + 512 * j, f = id >> 6, ln = id & 63, mt = f >> 2, ks = f & 3, q = ln >> 4, m = ln & 15;
            const u32x2 lo = *(const LAS u32x2*)(wL + (16 * mt + m) * 136 + 32 * ks + 4 * q), hi = *(const LAS u32x2*)(wL + (16 * mt + m) * 136 + 32 * ks + 16 + 4 * q);
            *(GAS v4u*)(WF + ((size_t)f * 64 + ln) * 8) = (v4u){lo.x, lo.y, hi.x, hi.y}; } }
    __syncthreads();
}

template <int MODE>
__device__ __forceinline__ void gdn_group_scan(Frame& F, int grp, int h) {
    const int tid = F.tid, lane = F.lane, w = F.wave, c = lane & 15, kq = lane >> 4, n0 = grp * GRP;
    const v4u* WF = (const v4u*)WSP(bf16, WS_WF); const v4u* KDF = (const v4u*)WSP(bf16, WS_KDF); const f32x4* UF = (const f32x4*)WSP(float, WS_UF);
    const float* CDEC = WSP(float, WS_CDEC); bf16* SG = WSP(bf16, WS_SGDN); bf16* DL = WSP(bf16, WS_DELTA);
    {   v4u t[GRP][4];
#pragma unroll
        for (int i = 0; i < GRP; ++i) { const size_t nh = (size_t)((n0 + i) * 4 + h);
#pragma unroll
            for (int j = 0; j < 2; ++j) { t[i][j] = WF[nh * 1024 + tid + 512 * j]; t[i][2 + j] = KDF[nh * 1024 + tid + 512 * j]; } }
#pragma unroll
        for (int i = 0; i < GRP; ++i)
#pragma unroll
            for (int j = 0; j < 2; ++j) { *(LAS v4u*)(F.lds + i * 32768 + (tid + 512 * j) * 16) = t[i][j]; *(LAS v4u*)(F.lds + i * 32768 + 16384 + (tid + 512 * j) * 16) = t[i][2 + j]; } }
    f32x4 S[8], P[8];
    if (MODE == 1) { const f32x4* SST = (const f32x4*)WSP(float, WS_SST) + (size_t)(((grp * 4 + h) * 8 + w) * 8) * 64;
#pragma unroll
        for (int i = 0; i < 8; ++i) S[i] = SST[i * 64 + lane];
    } else {
#pragma unroll
        for (int i = 0; i < 8; ++i) { S[i] = (f32x4){0.f, 0.f, 0.f, 0.f};
#pragma unroll
            for (int r = 0; r < 4; ++r) P[i][r] = ((16 * i + 4 * kq + r) == 16 * w + c) ? 1.f : 0.f; }
    }
    f32x4 u[GRP][4]; float cd[GRP];
#pragma unroll
    for (int i = 0; i < GRP; ++i) { const size_t nh = (size_t)((n0 + i) * 4 + h); cd[i] = CDEC[nh];
#pragma unroll
        for (int mt = 0; mt < 4; ++mt) u[i][mt] = UF[((nh * 8 + w) * 4 + mt) * 64 + lane]; }
    __syncthreads();
#pragma unroll
    for (int i = 0; i < GRP; ++i) {
        const size_t nh = (size_t)((n0 + i) * 4 + h);
        const LAS unsigned char* wl = F.lds + i * 32768 + lane * 16; const LAS unsigned char* kl = wl + 16384;
        if (MODE == 1) { bf16* sg = SG + (nh * 128 + 16 * w + c) * 128 + 4 * kq;
#pragma unroll
            for (int dt = 0; dt < 8; ++dt) *(GAS u32x2*)(sg + 16 * dt) = pack4(S[dt]); }
        f32x4 dl[4], dp[4];
#pragma unroll
        for (int mt = 0; mt < 4; ++mt) { dl[mt] = u[i][mt]; dp[mt] = (f32x4){0.f, 0.f, 0.f, 0.f}; }
#pragma unroll
        for (int ks = 0; ks < 4; ++ks) { const bf16x8 sb = pack8(S[2 * ks], S[2 * ks + 1]); bf16x8 pb; if (MODE == 0) pb = pack8(P[2 * ks], P[2 * ks + 1]);
#pragma unroll
            for (int mt = 0; mt < 4; ++mt) { const bf16x8 a = *(const LAS bf16x8*)(wl + (mt * 4 + ks) * 1024); dl[mt] = MFMA16(a, sb, dl[mt]); if (MODE == 0) dp[mt] = MFMA16(a, pb, dp[mt]); } }
        if (MODE == 1) { bf16* dq = DL + (nh * 128 + 16 * w + c) * 64 + 4 * kq;
#pragma unroll
            for (int mt = 0; mt < 4; ++mt) *(GAS u32x2*)(dq + 16 * mt) = pack4(dl[mt]); }
#pragma unroll
        for (int dt = 0; dt < 8; ++dt) { S[dt] = S[dt] * cd[i]; if (MODE == 0) P[dt] = P[dt] * cd[i]; }
#pragma unroll
        for (int ks2 = 0; ks2 < 2; ++ks2) { const bf16x8 db = pack8(dl[2 * ks2], dl[2 * ks2 + 1]); bf16x8 qb; if (MODE == 0) qb = pack8(dp[2 * ks2], dp[2 * ks2 + 1]);
#pragma unroll
            for (int dt = 0; dt < 8; ++dt) { const bf16x8 a = *(const LAS bf16x8*)(kl + (dt * 2 + ks2) * 1024); S[dt] = MFMA16(a, db, S[dt]); if (MODE == 0) P[dt] = MFMA16(a, qb, P[dt]); } }
    }
    if (MODE == 0) {
        f32x4* SLE = (f32x4*)WSP(float, WS_SLE) + (size_t)(((grp * 4 + h) * 8 + w) * 8) * 64;
#pragma unroll
        for (int dt = 0; dt < 8; ++dt) SLE[dt * 64 + lane] = S[dt];
        bf16* PE = WSP(bf16, WS_PEND) + (size_t)(grp * 4 + h) * 32 * 512; const int ks = w >> 1, lq = (2 * (w & 1) + (c >> 3)) * 16 + 4 * kq, idx = c & 7;
#pragma unroll
        for (int dt = 0; dt < 8; ++dt)
#pragma unroll
            for (int r = 0; r < 4; ++r) PE[((size_t)(dt * 4 + ks) * 64 + lq + r) * 8 + idx] = f2bf1(P[dt][r]);
    }
    __syncthreads();
}
__device__ __forceinline__ void gdn_scan_groups(Frame& F, int h, int s) {
    const int lane = F.lane, w = F.wave, c = lane & 15, kq = lane >> 4;
    LAS bf16* STb = (LAS bf16*)F.lds;
    const bf16x8* PEND = (const bf16x8*)WSP(bf16, WS_PEND); const f32x4* SLE = (const f32x4*)WSP(float, WS_SLE); f32x4* SST = (f32x4*)WSP(float, WS_SST);
    f32x4 S = {0.f, 0.f, 0.f, 0.f};
    *(LAS u32x2*)(STb + c * 136 + 16 * w + 4 * kq) = (u32x2){0u, 0u};
    bf16x8 pe[4], pn[4]; f32x4 sle, sln;
#pragma unroll
    for (int ks = 0; ks < 4; ++ks) pe[ks] = PEND[((size_t)h * 32 + w * 4 + ks) * 64 + lane];
    sle = SLE[(((size_t)h * 8 + s) * 8 + w) * 64 + lane];
    __syncthreads();
    for (int g = 0; g < NGRP; ++g) {
        const size_t gh = (size_t)(g * 4 + h);
        SST[((gh * 8 + s) * 8 + w) * 64 + lane] = S;
        if (g + 1 == NGRP) break;
        { const size_t gh1 = (size_t)((g + 1) * 4 + h);
#pragma unroll
          for (int ks = 0; ks < 4; ++ks) pn[ks] = PEND[(gh1 * 32 + w * 4 + ks) * 64 + lane];
          sln = SLE[((gh1 * 8 + s) * 8 + w) * 64 + lane]; }
        const LAS bf16* st = STb + (g & 1) * 16 * 136 + c * 136 + 8 * kq;
        f32x4 acc = sle;
#pragma unroll
        for (int ks = 0; ks < 4; ++ks) acc = MFMA16(pe[ks], *(const LAS bf16x8*)(st + 32 * ks), acc);
        S = acc;
        *(LAS u32x2*)(STb + ((g + 1) & 1) * 16 * 136 + c * 136 + 16 * w + 4 * kq) = pack4(S);
#pragma unroll
        for (int ks = 0; ks < 4; ++ks) pe[ks] = pn[ks];
        sle = sln;
        __syncthreads();
    }
    __syncthreads();
}
template <int MODE>
__device__ __forceinline__ void gla_scan_range(Frame& F, int grp, int gid) {
    const int h = gid >> 11, rem = gid & 2047, e = rem >> 4, dg = rem & 15, n0 = grp * GRP;
    const float* KVT = WSP(float, WS_KVT); const float* DV = WSP(float, WS_DVEC); bf16* SG = WSP(bf16, WS_SGLA);
    f32x4 kv[GRP], dv[GRP];
#pragma unroll
    for (int i = 0; i < GRP; ++i) { const size_t nh = (size_t)((n0 + i) * 4 + h); kv[i] = *(const GAS f32x4*)(KVT + (nh * 128 + e) * 64 + 4 * dg); dv[i] = *(const GAS f32x4*)(DV + nh * 64 + 4 * dg); }
    f32x4 S = {0.f, 0.f, 0.f, 0.f}, P = {1.f, 1.f, 1.f, 1.f};
    if (MODE == 1) S = *((const GAS f32x4*)WSP(float, WS_GSST) + (size_t)grp * 8192 + gid);
#pragma unroll
    for (int i = 0; i < GRP; ++i) { const size_t nh = (size_t)((n0 + i) * 4 + h);
        if (MODE == 1) *(GAS u32x2*)(SG + (nh * 128 + e) * 64 + 4 * dg) = pack4(S);
        S = dv[i] * S + kv[i]; if (MODE == 0) P = P * dv[i]; }
    if (MODE == 0) { *((GAS f32x4*)WSP(float, WS_GSLE) + (size_t)grp * 8192 + gid) = S; *((GAS f32x4*)WSP(float, WS_GPD) + (size_t)grp * 8192 + gid) = P; }
}
__device__ __forceinline__ void gla_scan_groups(Frame& F, int gid) {
    f32x4 S = {0.f, 0.f, 0.f, 0.f};
    for (int g0 = 0; g0 < NGRP; g0 += 16) {
        f32x4 sl[16], pd[16];
#pragma unroll
        for (int g = 0; g < 16; ++g) { sl[g] = *((const GAS f32x4*)WSP(float, WS_GSLE) + (size_t)(g0 + g) * 8192 + gid); pd[g] = *((const GAS f32x4*)WSP(float, WS_GPD) + (size_t)(g0 + g) * 8192 + gid); }
#pragma unroll
        for (int g = 0; g < 16; ++g) { *((GAS f32x4*)WSP(float, WS_GSST) + (size_t)(g0 + g) * 8192 + gid) = S; S = pd[g] * S + sl[g]; }
    }
}

__device__ __forceinline__ void route_phase(Frame& F, int rep) {
    LAS float* WrT = (LAS float*)(F.lds + RING_OFF);
    const int tid = F.tid, lane = F.lane;
    for (int idx = tid; idx < 8192; idx += 512) { const int d = idx & 1023, e4 = (idx >> 10) * 4; const f32x4 v = *(const GAS f32x4*)(F.in[13] + (size_t)d * 32 + e4);
        WrT[(e4 + 0) * 1024 + d] = v[0]; WrT[(e4 + 1) * 1024 + d] = v[1]; WrT[(e4 + 2) * 1024 + d] = v[2]; WrT[(e4 + 3) * 1024 + d] = v[3]; }
    __syncthreads();
    const float brt = F.in[14][lane >> 1];
    unsigned* cnt = (unsigned*)(F.ctl + CW_CNT) + rep * 32;
    LAS int* lcnt = (LAS int*)(F.lds + ROUTE_OFF); LAS int* gbase = lcnt + 32; LAS int* te = lcnt + 64; LAS int* ts = te + 256; LAS float* tg = (LAS float*)(ts + 256);
    const size_t roff = (size_t)rep * (WS_PROJ - WS_TOKE), xoff = (size_t)rep * (WS_PROJ + 8 * MiB - WS_XN);
    for (int blk = F.vcu; blk < T / 64; blk += F.G) {
    if (tid < 32) lcnt[tid] = 0;
    __syncthreads();
    for (int ti = 0; ti < 8; ++ti) {
        const int tl = F.wave * 8 + ti, t = blk * 64 + tl;
        const GAS f32x4* xr = (const GAS f32x4*)(F.out + (size_t)t * D) + lane; const GAS f32x4* gr = (const GAS f32x4*)F.in[12] + lane;
        f32x4 v[4]; float s = 0.f;
#pragma unroll
        for (int j = 0; j < 4; ++j) { v[j] = xr[64 * j]; s += (v[j].x * v[j].x + v[j].y * v[j].y) + (v[j].z * v[j].z + v[j].w * v[j].w); }
        const float rstd = 1.f / sqrtf(wave_sum(s) * (1.f / D) + EPS);
        GAS unsigned* o8 = (GAS unsigned*)(WSP(unsigned char, WS_XN + xoff) + (size_t)t * D) + lane;
#pragma unroll
        for (int j = 0; j < 4; ++j) { const f32x4 gg = gr[64 * j]; v[j].x *= rstd * gg.x; v[j].y *= rstd * gg.y; v[j].z *= rstd * gg.z; v[j].w *= rstd * gg.w; o8[64 * j] = pg8::cvt4_fp8(v[j].x, v[j].y, v[j].z, v[j].w); }
        float p[32];
#pragma unroll
        for (int e = 0; e < 32; ++e) { float a = 0.f;
#pragma unroll
            for (int j = 0; j < 4; ++j) { const f32x4 wv = *(const LAS f32x4*)(WrT + e * 1024 + 4 * lane + 256 * j); a += (v[j].x * wv.x + v[j].y * wv.y) + (v[j].z * wv.z + v[j].w * wv.w); }
            p[e] = a; if ((e & 3) == 3) __builtin_amdgcn_sched_barrier(0); }
        float q16[16], q8[8], q4[4], q2[2], q1;
        { const bool hi = lane & 32;
#pragma unroll
            for (int k = 0; k < 16; ++k) { const float send = hi ? p[k] : p[k + 16], keep = hi ? p[k + 16] : p[k]; q16[k] = keep + __shfl_xor(send, 32); } }
        { const bool hi = lane & 16;
#pragma unroll
            for (int k = 0; k < 8; ++k) { const float send = hi ? q16[k] : q16[k + 8], keep = hi ? q16[k + 8] : q16[k]; q8[k] = keep + __shfl_xor(send, 16); } }
        { const bool hi = lane & 8;
#pragma unroll
            for (int k = 0; k < 4; ++k) { const float send = hi ? q8[k] : q8[k + 4], keep = hi ? q8[k + 4] : q8[k]; q4[k] = keep + __shfl_xor(send, 8); } }
        { const bool hi = lane & 4;
#pragma unroll
            for (int k = 0; k < 2; ++k) { const float send = hi ? q4[k] : q4[k + 2], keep = hi ? q4[k + 2] : q4[k]; q2[k] = keep + __shfl_xor(send, 4); } }
        { const bool hi = lane & 2; const float send = hi ? q2[0] : q2[1], keep = hi ? q2[1] : q2[0]; q1 = keep + __shfl_xor(send, 2); }
        q1 += __shfl_xor(q1, 1);
        const float mylogit = q1 + brt;
        float lg[32];
#pragma unroll
        for (int e = 0; e < 32; ++e) lg[e] = __shfl(mylogit, 2 * e);
        unsigned used = 0u; int sel[4]; float val[4];
#pragma unroll
        for (int k = 0; k < 4; ++k) { float best = -3.0e38f; int bi = 0;
#pragma unroll
            for (int e = 0; e < 32; ++e) { const bool ok = (lg[e] > best) && !((used >> e) & 1u); best = ok ? lg[e] : best; bi = ok ? e : bi; }
            sel[k] = bi; val[k] = best; used |= 1u << bi; }
        const float e1 = __expf(val[1] - val[0]), e2 = __expf(val[2] - val[0]), e3 = __expf(val[3] - val[0]); const float inv = 1.f / (1.f + e1 + e2 + e3);
        if (lane < 4) { const int ek = lane == 0 ? sel[0] : (lane == 1 ? sel[1] : (lane == 2 ? sel[2] : sel[3])); const float gk = (lane == 0 ? 1.f : (lane == 1 ? e1 : (lane == 2 ? e2 : e3))) * inv;
            const int ls = __hip_atomic_fetch_add(lcnt + ek, 1, __ATOMIC_RELAXED, __HIP_MEMORY_SCOPE_WORKGROUP);
            te[tl * 4 + lane] = ek; ts[tl * 4 + lane] = ls; tg[tl * 4 + lane] = gk; }
    }
    __syncthreads();
    if (tid < 32) gbase[tid] = (int)atomicAdd(cnt + tid * 64, (unsigned)lcnt[tid]);
    __syncthreads();
    if (tid < 256) { const int t = blk * 64 + (tid >> 2), k = tid & 3, e = te[tid];
        WSP(int, WS_TOKE + roff)[t * 4 + k] = e; WSP(int, WS_TOKS + roff)[t * 4 + k] = gbase[e] + ts[tid]; WSP(float, WS_TOKG + roff)[t * 4 + k] = tg[tid]; }
    __syncthreads();
    }
}
__device__ __forceinline__ void moe_tables(Frame& F) {
    LAS int* tile_e = (LAS int*)(F.lds + TILEE_OFF); LAS int* baseL = (LAS int*)(F.lds + BASE_OFF);
    if (F.tid < 64) { const int e = F.lane & 31; const unsigned c = __hip_atomic_load((unsigned*)(F.ctl + CW_CNT) + e * 64, RLX_AGENT);
        const int nt = (int)((c + 255u) >> 8); int incl = nt;
#pragma unroll
        for (int off = 1; off < 32; off <<= 1) { const int v = __shfl_up(incl, off); if ((F.lane & 31) >= off) incl += v; }
        const int tb = incl - nt;
        if (F.lane < 32) { baseL[e] = tb * 256; for (int i = 0; i < nt; ++i) tile_e[tb + i] = e; if (e == 31) tile_e[319] = incl; } }
    __syncthreads();
}
__device__ __forceinline__ void scatter_phase(Frame& F) {
    moe_tables(F);
    LAS int* baseL = (LAS int*)(F.lds + BASE_OFF);
    const int gw = F.vcu * NWAVES + F.wave, NGW = F.G * NWAVES, lane = F.lane;
    for (int t = gw; t < T; t += NGW) {
        int pos = 0;
        if (lane < 4) { const int e = WSP(int, WS_TOKE)[t * 4 + lane], sl = WSP(int, WS_TOKS)[t * 4 + lane]; pos = baseL[e] + sl; WSP(int, WS_TOKP)[t * 4 + lane] = pos; WSP(float, WS_GPOS)[pos] = WSP(float, WS_TOKG)[t * 4 + lane]; }
        const v4u a = *((const GAS v4u*)(WSP(unsigned char, WS_XN) + (size_t)t * D) + lane);
#pragma unroll
        for (int k = 0; k < 4; ++k) { const int pk = __shfl(pos, k); *((GAS v4u*)(WSP(unsigned char, WS_XS) + (size_t)pk * D) + lane) = a; }
    }
}
__device__ __forceinline__ void combine_phase(Frame& F, int rep) {
    const int gw = F.vcu * NWAVES + F.wave, NGW = F.G * NWAVES, lane = F.lane;
    for (int t = gw; t < T; t += NGW) {
        GAS f32x4* xr = (GAS f32x4*)(F.out + (size_t)t * D) + lane;
        GAS f32x4* xw = rep ? (GAS f32x4*)(WSP(float, WS_PROJ) + (size_t)t * D) + lane : xr;
        const size_t xoff = (size_t)rep * (WS_PROJ + 64 * MiB - WS_XN), poff = (size_t)rep * (WS_PROJ + 100 * MiB - WS_PERSTD);
        f32x4 v[4];
#pragma unroll
        for (int j = 0; j < 4; ++j) v[j] = xr[64 * j];
#pragma unroll
        for (int k = 0; k < 4; ++k) { const int pk = WSP(int, WS_TOKP)[t * 4 + k]; const GAS u32x2* yr = (const GAS u32x2*)(WSP(bf16, WS_YS) + (size_t)pk * D) + lane;
#pragma unroll
            for (int j = 0; j < 4; ++j) { const u32x2 w = yr[64 * j]; v[j].x += bflo(w.x); v[j].y += bfhi(w.x); v[j].z += bflo(w.y); v[j].w += bfhi(w.y); } }
        float s = 0.f;
#pragma unroll
        for (int j = 0; j < 4; ++j) { xw[64 * j] = v[j]; s += (v[j].x * v[j].x + v[j].y * v[j].y) + (v[j].z * v[j].z + v[j].w * v[j].w); }
        const float rstd = 1.f / sqrtf(wave_sum(s) * (1.f / D) + EPS);
        const GAS f32x4* gr = (const GAS f32x4*)F.in[19] + lane; GAS u32x2* o8 = (GAS u32x2*)(WSP(bf16, WS_XN + xoff) + (size_t)t * D) + lane;
#pragma unroll
        for (int j = 0; j < 4; ++j) { const f32x4 gg = gr[64 * j]; f32x4 a = {v[j].x * rstd * gg.x, v[j].y * rstd * gg.y, v[j].z * rstd * gg.z, v[j].w * rstd * gg.w}; o8[64 * j] = pack4(a); }
        const GAS u32x2* pr = (const GAS u32x2*)(WSP(bf16, WS_PERAW) + (size_t)t * D) + lane; float ps = 0.f;
#pragma unroll
        for (int j = 0; j < 4; ++j) { const u32x2 w = pr[64 * j]; const float a = bflo(w.x), b = bfhi(w.x), c = bflo(w.y), d = bfhi(w.y); ps += (a * a + b * b) + (c * c + d * d); }
        ps = wave_sum(ps);
        if (lane == 0) WSP(float, WS_PERSTD + poff)[t] = 1.f / sqrtf(ps * (1.f / D) + EPS);
    }
}
__device__ __forceinline__ void final_phase(Frame& F, int rep) {
    const int gw = F.vcu * NWAVES + F.wave, NGW = F.G * NWAVES, lane = F.lane;
    for (int t = gw; t < T; t += NGW) {
        GAS f32x4* xr = (GAS f32x4*)(F.out + (size_t)t * D) + lane; const GAS f32x4* gr = (const GAS f32x4*)F.in[23] + lane;
        f32x4 v[4]; float s = 0.f;
#pragma unroll
        for (int j = 0; j < 4; ++j) { v[j] = xr[64 * j]; s += (v[j].x * v[j].x + v[j].y * v[j].y) + (v[j].z * v[j].z + v[j].w * v[j].w); }
        const float rstd = 1.f / sqrtf(wave_sum(s) * (1.f / D) + EPS);
        GAS f32x4* xw = rep ? (GAS f32x4*)(WSP(float, WS_PROJ) + (size_t)t * D) + lane : xr;
#pragma unroll
        for (int j = 0; j < 4; ++j) { const f32x4 gg = gr[64 * j]; xw[64 * j] = (f32x4){v[j].x * rstd * gg.x, v[j].y * rstd * gg.y, v[j].z * rstd * gg.z, v[j].w * rstd * gg.w}; }
    }
}

constexpr int NPH = 13;
struct Args { const float* in[24]; float* out; unsigned char* ws; int ph_lo, ph_hi; };
static_assert(sizeof(Args) == 24 * 8 + 8 + 8 + 8, "Args has no padding");
__global__ void __launch_bounds__(NWAVES * 64, 2) fwd_kernel(Args args) {
    extern __shared__ __attribute__((aligned(16))) unsigned char lds[];
    Frame F;
    F.lds = (LAS unsigned char*)lds;
    F.MISC = (volatile LAS unsigned*)(F.lds + MISC_OFF);
    F.tid = threadIdx.x; F.lane = F.tid & 63; F.wave = __builtin_amdgcn_readfirstlane(F.tid >> 6);
    F.G = gridDim.x; { const int bx = blockIdx.x; F.vcu = (F.G % 8 == 0) ? (bx % 8) * (F.G / 8) + bx / 8 : bx; }
    F.ws = args.ws; F.ctl = (gu32*)(args.ws + WS_CTL); F.out = args.out;
#pragma unroll
    for (int i = 0; i < 24; ++i) F.in[i] = args.in[i];
    for (int u = F.tid; u < (LDS_BYTES - LDSCTL_OFF) / 4; u += NWAVES * 64) ((LAS unsigned*)(F.lds + LDSCTL_OFF))[u] = 0u;
    __syncthreads();
    const int lo = args.ph_lo, hi = args.ph_hi;
    XcdBarrier bar; bar.bar = (unsigned*)(F.ctl + CW_BAR); bar.x = 0; bar.st = nullptr;
    bar = xcd_barrier_post((unsigned*)(F.ctl + CW_BAR), F.MISC + 8);
#define IN(k) (lo <= (k) && (k) < hi && !((MK_SKIP >> (k)) & 1))
#define SEAM(k) do { if ((lo <= (k)) && ((k) + 1 < hi)) xcd_barrier(bar); } while (0)

    if (IN(0)) { for (int rep_ = 0; rep_ <= ((MK_REP >> 0) & 1); ++rep_) { p0_prologue(F); } SEAM(0); }
    if (IN(1)) { for (int rep_ = 0; rep_ <= ((MK_REP >> 1) & 1); ++rep_) {
        { pg8::Gemm g{WSP(bf16, WS_XN), WSP(bf16, WS_WIN), T, LDP, D}; pg8::StaticOrder S; S.init(T, LDP, F.G, (int)blockIdx.x);
          pg8::EpiBf16P E{WSP(bf16, WS_PROJ), LDP};
          pg8::gemm_phase<pg8::EpiBf16P, pg8::StaticOrder, true, true>(F.lds + RING_OFF, g, S, E); }
        { pg8::Gemm g{WSP(bf16, WS_PB), WSP(bf16, WS_WPP), T, D, PLE}; pg8::StaticOrder S; S.init(T, D, F.G, (int)blockIdx.x);
          pg8::EpiBf16P E{WSP(bf16, WS_PERAW), D};
          pg8::gemm_phase<pg8::EpiBf16P, pg8::StaticOrder, true, true>(F.lds + RING_OFF, g, S, E); }
        }
        SEAM(1);
    }
    if (IN(2)) { for (int rep_ = 0; rep_ <= ((MK_REP >> 2) & 1); ++rep_) {
        for (int i = blockIdx.x; i < NCH * 8; i += F.G) { const int n = i >> 3, hh = (i + (i >> 8)) & 7;
            if (hh < 4) { if (!(MK_DBG & 1)) gla_prep_item(F, n, hh); } else gdn_prep_item(F, n, hh - 4); }
        }
        SEAM(2);
    }
    if (IN(3)) { for (int rep_ = 0; rep_ <= ((MK_REP >> 3) & 1); ++rep_) {
        for (int r3_ = 0; r3_ <= ((MK_REP >> 13) & 1); ++r3_) {
        for (int it = F.vcu; it < NGRP * 4; it += F.G) gdn_group_scan<0>(F, it >> 2, it & 3);
        for (int id = F.vcu * 8 + F.wave; id < NGRP * 128; id += F.G * 8) gla_scan_range<0>(F, id >> 7, (id & 127) * 64 + F.lane); }
        xcd_barrier(bar);
        for (int r3_ = 0; r3_ <= ((MK_REP >> 14) & 1); ++r3_) {
        if (F.vcu < 32) gdn_scan_groups(F, F.vcu >> 3, F.vcu & 7);
        else if (F.vcu < 160 && F.wave == 0) gla_scan_groups(F, (F.vcu - 32) * 64 + F.lane); }
        xcd_barrier(bar);
        for (int r3_ = 0; r3_ <= ((MK_REP >> 15) & 1); ++r3_) {
        for (int it = F.vcu; it < NGRP * 4; it += F.G) gdn_group_scan<1>(F, it >> 2, it & 3);
        for (int id = F.vcu * 8 + F.wave; id < NGRP * 128; id += F.G * 8) gla_scan_range<1>(F, id >> 7, (id & 127) * 64 + F.lane); }
        }
        SEAM(3);
    }
    if (IN(4)) { for (int rep_ = 0; rep_ <= ((MK_REP >> 4) & 1); ++rep_) {
        for (int i = blockIdx.x; i < NCH * 8; i += F.G) { const int n = i >> 3, hh = (i + (i >> 8)) & 7;
            if (hh < 4) gla_out_item(F, n, hh); else gdn_out_item(F, n, hh - 4); }
        }
        SEAM(4);
    }
    if (IN(5)) { for (int rep_ = 0; rep_ <= ((MK_REP >> 5) & 1); ++rep_) {
        pg8::Gemm g{WSP(bf16, WS_MIX), WSP(bf16, WS_WOUT), T, D, D}; pg8::StaticOrder S; S.init(T, D, F.G, (int)blockIdx.x);
        pg8::EpiResF32 E{F.in[0], F.out, D};
        pg8::gemm_phase<pg8::EpiResF32, pg8::StaticOrder, true, true>(F.lds + RING_OFF, g, S, E);
        }
        SEAM(5);
    }
    if (IN(6)) { for (int rep_ = 0; rep_ <= ((MK_REP >> 6) & 1); ++rep_) { route_phase(F, rep_); } SEAM(6); }
    if (IN(7)) { for (int rep_ = 0; rep_ <= ((MK_REP >> 7) & 1); ++rep_) { scatter_phase(F); } SEAM(7); }
    if (IN(8)) { for (int rep_ = 0; rep_ <= ((MK_REP >> 8) & 1); ++rep_) {
        moe_tables(F);
        const LAS int* tile_e = (const LAS int*)(F.lds + TILEE_OFF); const int ntiles = __builtin_amdgcn_readfirstlane(tile_e[319]);
        pg8::Gemm g{WSP(bf16, WS_XS), WSP(bf16, WS_W1), XS_ROWS, 2048, D / 2}; pg8::MoeOrder S{tile_e, ntiles, 8, F.G, (int)blockIdx.x};
        pg8::EpiMoeAct E{WSP(bf16, WS_HS), F.in[16]};
        pg8::gemm_phase<pg8::EpiMoeAct, pg8::MoeOrder, true, true, true>(F.lds + RING_OFF, g, S, E);
        }
        SEAM(8);
    }
    if (IN(9)) { for (int rep_ = 0; rep_ <= ((MK_REP >> 9) & 1); ++rep_) {
        moe_tables(F);
        const LAS int* tile_e = (const LAS int*)(F.lds + TILEE_OFF); const int ntiles = __builtin_amdgcn_readfirstlane(tile_e[319]);
        pg8::Gemm g{WSP(bf16, WS_HS), WSP(bf16, WS_W2), XS_ROWS, D, D / 2}; pg8::MoeOrder S{tile_e, ntiles, 4, F.G, (int)blockIdx.x};
        pg8::EpiMoeDown E{WSP(bf16, WS_YS), F.in[18], WSP(float, WS_GPOS)};
        pg8::gemm_phase<pg8::EpiMoeDown, pg8::MoeOrder, true, true, true>(F.lds + RING_OFF, g, S, E);
        }
        SEAM(9);
    }
    if (IN(10)) { for (int rep_ = 0; rep_ <= ((MK_REP >> 10) & 1); ++rep_) { combine_phase(F, rep_); } SEAM(10); }
    if (IN(11)) { for (int rep_ = 0; rep_ <= ((MK_REP >> 11) & 1); ++rep_) {
        pg8::Gemm g{WSP(bf16, WS_XN), WSP(bf16, WS_WPG), T, D, D}; pg8::StaticOrder S; S.init(T, D, F.G, (int)blockIdx.x);
        pg8::EpiPle E{F.out, WSP(bf16, WS_PERAW), WSP(float, WS_PERSTD), F.in[22]};
        pg8::gemm_phase<pg8::EpiPle, pg8::StaticOrder, true, true>(F.lds + RING_OFF, g, S, E);
        }
        SEAM(11);
    }
    if (IN(12)) { for (int rep_ = 0; rep_ <= ((MK_REP >> 12) & 1); ++rep_) { final_phase(F, rep_); } }
#undef IN
#undef SEAM
}

extern "C" void kernel_launch(void* const* d_in, const int* in_sizes, int n_in, void* d_out, int out_size, void* d_ws, size_t ws_size, hipStream_t stream) {
    static int grid = 0;
    if (grid == 0) {
        if (n_in != 24 || in_sizes[0] != T * D || out_size != T * D || ws_size < WS_END) { fprintf(stderr, "kernel_launch: unexpected shapes (n_in %d, in0 %d, out %d, ws %zu); nothing launched\n", n_in, n_in > 0 ? in_sizes[0] : -1, out_size, ws_size); grid = -1; return; }
        int dev = 0, cus = 0;
        if (hipGetDevice(&dev) != hipSuccess || hipDeviceGetAttribute(&cus, hipDeviceAttributeMultiprocessorCount, dev) != hipSuccess) { grid = -1; return; }
        if (hipFuncSetAttribute((const void*)fwd_kernel, hipFuncAttributeMaxDynamicSharedMemorySize, LDS_BYTES) != hipSuccess) { fprintf(stderr, "kernel_launch: hipFuncSetAttribute failed\n"); grid = -1; return; }
        int per_cu = 0;
        if (hipOccupancyMaxActiveBlocksPerMultiprocessor(&per_cu, (const void*)fwd_kernel, NWAVES * 64, LDS_BYTES) != hipSuccess || per_cu < 1) fprintf(stderr, "kernel_launch: occupancy query reports %d blocks per CU\n", per_cu);
        (void)hipGetLastError();
        grid = cus;
    }
    if (grid < 0) return;
    if (hipMemsetAsync((char*)d_ws + WS_CTL, 0, CTL_ZERO_BYTES, stream) != hipSuccess) return;
    Args a{};
    for (int i = 0; i < 24; ++i) a.in[i] = (const float*)d_in[i];
    a.out = (float*)d_out; a.ws = (unsigned char*)d_ws;
#if MK_ONE_LAUNCH
    a.ph_lo = 0; a.ph_hi = NPH;
    hipLaunchKernelGGL(fwd_kernel, dim3(grid), dim3(NWAVES * 64), LDS_BYTES, stream, a);
#else
    for (int p = 0; p < NPH; ++p) { a.ph_lo = p; a.ph_hi = p + 1; hipLaunchKernelGGL(fwd_kernel, dim3(grid), dim3(NWAVES * 64), LDS_BYTES, stream, a); }
#endif
}
```

```cpp
#include <hip/hip_runtime.h>
#include <cstdio>
#include <cstdint>
#ifndef MK_ONE_LAUNCH
#define MK_ONE_LAUNCH 1
#endif
#ifndef MK_SKIP
#define MK_SKIP 0
#endif
#ifndef MK_DBG
#define MK_DBG 0
#endif
#ifndef MK_REP
#define MK_REP 0
#endif
namespace pg8 {
#define PG8_LAS __attribute__((address_space(3)))
typedef unsigned short bf16_t;
typedef short bf16x8 __attribute__((ext_vector_type(8)));
typedef float f32x4 __attribute__((ext_vector_type(4)));
typedef unsigned u32x4 __attribute__((ext_vector_type(4)));
constexpr int BM = 256, BK = 64, HALF = 128, HTB = HALF * BK * 2  , STAGE_BYTES = 8 * HTB, NXCD = 8, WGM = 8;

__host__ __device__ __forceinline__ int lds_byte(int r, int c) { const int st = (r >> 4) * 2 + (c >> 5), rr = r & 15, cc = c & 31, ob = rr * 64 + cc * 2; return st * 1024 + (ob ^ (((ob >> 9) & 1) << 5)); }
__host__ __device__ __forceinline__ void stage_rc(int b, int& R, int& C) { const int st = b / 1024, sb = b % 1024, swz = sb ^ (((sb >> 9) & 1) << 5); R = (st >> 1) * 16 + swz / 64; C = (st & 1) * 32 + (swz % 64) / 2; }
__host__ __device__ __forceinline__ int perm32(int rho) { const int n = rho >> 4, i = rho & 15; return 8 * (i >> 2) + 4 * n + (i & 3); }

struct Unit { int pm, pn, pb, e; };
struct Gemm { const bf16_t* A; const bf16_t* Bt; int M, N, K; };

struct StaticOrder {
    int nM, nN, nwg, G, c;
    __host__ __device__ void init(int M, int N, int G_, int c_) { nM = M / BM; nN = N / BM; nwg = nM * nN; G = G_; c = c_; }
    __host__ __device__ bool next(int i, Unit& u) const {
        const long L = (long)i * G + c; if (L >= nwg) return false;
        int wgid = (int)L; { const int q = nwg / NXCD, r = nwg % NXCD, xcd = wgid % NXCD, off = wgid / NXCD; wgid = (xcd < r ? xcd * (q + 1) : r * (q + 1) + (xcd - r) * q) + off; }
        const int nig = WGM * nN, gid = wgid / nig, fm = gid * WGM, gsz = (nM - fm) < WGM ? (nM - fm) : WGM;
        u.pm = fm + ((wgid % nig) % gsz); u.pn = (wgid % nig) / gsz; u.pb = u.pn; u.e = 0; return true;
    }
    __device__ __forceinline__ void a_ready(const Unit&) const {}
    __device__ __forceinline__ void done(const Unit&) const {}
};

__device__ __forceinline__ unsigned cvt_pk_bf16(float lo, float hi) { unsigned r; asm volatile("v_cvt_pk_bf16_f32 %0, %1, %2" : "=v"(r) : "v"(lo), "v"(hi)); return r; }

typedef float f32x2 __attribute__((ext_vector_type(2)));
typedef unsigned u32x2 __attribute__((ext_vector_type(2)));
typedef __bf16 bf16x2v __attribute__((ext_vector_type(2)));
__device__ __forceinline__ unsigned cvtpk(float lo, float hi) { f32x2 v = {lo, hi}; bf16x2v b = __builtin_convertvector(v, bf16x2v); return __builtin_bit_cast(unsigned, b); }
typedef int v4i_t __attribute__((ext_vector_type(4)));
typedef int v8i_t __attribute__((ext_vector_type(8)));
__device__ __forceinline__ v8i_t cat16(bf16x8 lo, bf16x8 hi) { return __builtin_shufflevector(__builtin_bit_cast(v4i_t, lo), __builtin_bit_cast(v4i_t, hi), 0, 1, 2, 3, 4, 5, 6, 7); }
__device__ __forceinline__ unsigned cvt4_fp8(float a, float b, float c, float d) { int w = __builtin_amdgcn_cvt_pk_fp8_f32(a, b, 0, false); w = __builtin_amdgcn_cvt_pk_fp8_f32(c, d, w, true); return (unsigned)w; }
__device__ __forceinline__ float sigmoidf_(float x) { return __builtin_amdgcn_rcpf(1.0f + __expf(-x)); }

struct EpiBf16P {
    static constexpr bool PERM = true, AFTER_DRAIN = false;
    bf16_t* O; int ldc;
    __device__ __forceinline__ void operator()(const f32x4 (&acc)[2][2][4][2], const Unit& u, int wr, int wc, int fr, int fq) const {
        const int row0 = u.pm * BM + wr * 64 + fr, col0 = u.pn * BM + wc * 32 + 8 * fq;
#pragma unroll
        for (int ai = 0; ai < 2; ++ai)
#pragma unroll
            for (int m = 0; m < 4; ++m) { bf16_t* rowp = O + (size_t)(row0 + ai * HALF + m * 16) * ldc + col0;
#pragma unroll
                for (int bj = 0; bj < 2; ++bj) { const f32x4 v0 = acc[ai][bj][m][0], v1 = acc[ai][bj][m][1];
                    u32x4 w; w.x = cvtpk(v0[0], v0[1]); w.y = cvtpk(v0[2], v0[3]); w.z = cvtpk(v1[0], v1[1]); w.w = cvtpk(v1[2], v1[3]);
                    *(u32x4*)(rowp + bj * HALF) = w; } }
    }
};
struct EpiResF32 {
    static constexpr bool PERM = false, AFTER_DRAIN = false;
    const float* base; float* out; int ldc;
    __device__ __forceinline__ void operator()(const f32x4 (&acc)[2][2][4][2], const Unit& u, int wr, int wc, int fr, int fq) const {
        const int row0 = u.pm * BM + wr * 64 + fr, col0 = u.pn * BM + wc * 32 + 4 * fq;
#pragma unroll
        for (int ai = 0; ai < 2; ++ai)
#pragma unroll
            for (int m = 0; m < 4; ++m) { const size_t off = (size_t)(row0 + ai * HALF + m * 16) * ldc + col0;
#pragma unroll
                for (int bj = 0; bj < 2; ++bj)
#pragma unroll
                    for (int n = 0; n < 2; ++n) *(f32x4*)(out + off + bj * HALF + n * 16) = *(const f32x4*)(base + off + bj * HALF + n * 16) + acc[ai][bj][m][n]; }
    }
};
struct EpiMoeAct {
    static constexpr bool PERM = true, AFTER_DRAIN = false;
    bf16_t* O; const float* bgu;
    __device__ __forceinline__ void operator()(const f32x4 (&acc)[2][2][4][2], const Unit& u, int wr, int wc, int fr, int fq) const {
        const int row0 = u.pm * BM + wr * 64 + fr, ch0 = u.pn * HALF + wc * 32 + 8 * fq;
        const float* bb = bgu + (size_t)u.e * 2048 + ch0;
        f32x4 bg[2], bu[2];
#pragma unroll
        for (int n = 0; n < 2; ++n) { bg[n] = *(const f32x4*)(bb + 4 * n); bu[n] = *(const f32x4*)(bb + 1024 + 4 * n); }
#pragma unroll
        for (int ai = 0; ai < 2; ++ai)
#pragma unroll
            for (int m = 0; m < 4; ++m) {
                float a[8];
#pragma unroll
                for (int n = 0; n < 2; ++n)
#pragma unroll
                    for (int i = 0; i < 4; ++i) {
                        float g = acc[ai][0][m][n][i] + bg[n][i], up = acc[ai][1][m][n][i] + bu[n][i];
                        g = fminf(g, 7.0f); up = fminf(fmaxf(up, -7.0f), 7.0f);
                        a[n * 4 + i] = (up + 1.0f) * g * sigmoidf_(1.702f * g);
                    }
                u32x2 w; w.x = cvt4_fp8(a[0], a[1], a[2], a[3]); w.y = cvt4_fp8(a[4], a[5], a[6], a[7]);
                *(u32x2*)((unsigned char*)O + (size_t)(row0 + ai * HALF + m * 16) * 1024 + ch0) = w;
            }
    }
};
struct EpiMoeDown {
    static constexpr bool PERM = true, AFTER_DRAIN = false;
    bf16_t* O; const float* bd; const float* gpos;
    __device__ __forceinline__ void operator()(const f32x4 (&acc)[2][2][4][2], const Unit& u, int wr, int wc, int fr, int fq) const {
        const int row0 = u.pm * BM + wr * 64 + fr, col0 = u.pn * BM + wc * 32 + 8 * fq;
        const float* bb = bd + (size_t)u.e * 1024 + col0;
        f32x4 bv[2][2];
#pragma unroll
        for (int bj = 0; bj < 2; ++bj)
#pragma unroll
            for (int n = 0; n < 2; ++n) bv[bj][n] = *(const f32x4*)(bb + bj * HALF + 4 * n);
#pragma unroll
        for (int ai = 0; ai < 2; ++ai)
#pragma unroll
            for (int m = 0; m < 4; ++m) { const int r = row0 + ai * HALF + m * 16; const float gt = gpos[r];
#pragma unroll
                for (int bj = 0; bj < 2; ++bj) { const f32x4 v0 = (acc[ai][bj][m][0] + bv[bj][0]) * gt, v1 = (acc[ai][bj][m][1] + bv[bj][1]) * gt;
                    u32x4 w; w.x = cvtpk(v0[0], v0[1]); w.y = cvtpk(v0[2], v0[3]); w.z = cvtpk(v1[0], v1[1]); w.w = cvtpk(v1[2], v1[3]);
                    *(u32x4*)(O + (size_t)r * 1024 + col0 + bj * HALF) = w; } }
    }
};
struct EpiPle {
    static constexpr bool PERM = false, AFTER_DRAIN = false;
    float* out; const bf16_t* pe; const float* rstd; const float* gpost;
    __device__ __forceinline__ void operator()(const f32x4 (&acc)[2][2][4][2], const Unit& u, int wr, int wc, int fr, int fq) const {
        const int row0 = u.pm * BM + wr * 64 + fr, col0 = u.pn * BM + wc * 32 + 4 * fq;
        f32x4 gp[2][2];
#pragma unroll
        for (int bj = 0; bj < 2; ++bj)
#pragma unroll
            for (int n = 0; n < 2; ++n) gp[bj][n] = *(const f32x4*)(gpost + col0 + bj * HALF + n * 16);
#pragma unroll
        for (int ai = 0; ai < 2; ++ai)
#pragma unroll
            for (int m = 0; m < 4; ++m) { const int r = row0 + ai * HALF + m * 16; const float rs = rstd[r];
#pragma unroll
                for (int bj = 0; bj < 2; ++bj)
#pragma unroll
                    for (int n = 0; n < 2; ++n) { const size_t off = (size_t)r * 1024 + col0 + bj * HALF + n * 16;
                        const u32x2 pw = *(const u32x2*)(pe + off); const f32x4 a = acc[ai][bj][m][n];
                        f32x4 p4; p4[0] = __uint_as_float(pw.x << 16); p4[1] = __uint_as_float(pw.x & 0xffff0000u); p4[2] = __uint_as_float(pw.y << 16); p4[3] = __uint_as_float(pw.y & 0xffff0000u);
                        f32x4 o = *(const f32x4*)(out + off);
#pragma unroll
                        for (int i = 0; i < 4; ++i) o[i] += sigmoidf_(a[i]) * p4[i] * rs * gp[bj][n][i];
                        *(f32x4*)(out + off) = o; } }
    }
};
struct MoeOrder {
    const PG8_LAS int* tile_e; int ntiles, NT, G, c;
    __device__ __forceinline__ bool next(int i, Unit& u) const {
        const int L = (G % 8 == 0) ? i * G + (c & 7) * (G >> 3) + (c >> 3) : i * G + c;
        if (L >= ntiles * NT) return false;
        const int mt = L / NT, nt = L - mt * NT;
        const int e = __builtin_amdgcn_readfirstlane(tile_e[mt]);
        u.pm = mt; u.pn = nt; u.e = e; u.pb = e * NT + nt; return true;
    }
    __device__ __forceinline__ void a_ready(const Unit&) const {}
    __device__ __forceinline__ void done(const Unit&) const {}
};
template <class Epi, class Sched, bool ALIGN_EPI = false, bool SP2 = false, bool FP8 = false>
__device__ __forceinline__ void gemm_phase(PG8_LAS unsigned char* lds, const Gemm g, const Sched& S, const Epi& E) {
    const int tid = threadIdx.x, wid = __builtin_amdgcn_readfirstlane(tid >> 6), lane = tid & 63, wr = wid >> 2, wc = wid & 3, fr = lane & 15, fq = lane >> 4;
    const int K = g.K, nt = K / BK;
    unsigned voffA[2], voffB[2];
#pragma unroll
    for (int i = 0; i < 2; ++i) { int R, C; stage_rc(tid * 16 + i * 8192, R, C); const int Rb = Epi::PERM ? ((R & ~31) + perm32(R & 31)) : R;
        voffA[i] = (unsigned)(R * K + C) * 2u; voffB[i] = (unsigned)(Rb * K + C) * 2u; }
    const size_t kstep = (size_t)(BK * 2);
    const size_t hstep = (size_t)HALF * K * 2;
    const size_t tstep = 2 * hstep;
    const unsigned ldsw = (unsigned)wid * 1024u;
    const int aoff = lds_byte(wr * 64 + fr, fq * 8), boff = lds_byte(wc * 32 + fr, fq * 8);
#define PG8_SA(b, h) (((b) * 2 + (h)) * HTB)
#define PG8_SB(b, h) ((4 + (b) * 2 + (h)) * HTB)
#define PG8_STAGE(bufoff, gbase, voff) do { _Pragma("unroll") for (int _i = 0; _i < 2; ++_i) \
        __builtin_amdgcn_global_load_lds((const unsigned*)((const char*)(gbase) + (voff)[_i]), (PG8_LAS unsigned*)(lds + (bufoff) + ldsw + _i * 8192), 16, 0, 0); } while (0)
#define PG8_LD1(off) (*(const PG8_LAS bf16x8*)(lds + (off)))
#define PG8_LDA(dst, b, h) do { if constexpr (FP8) { _Pragma("unroll") for (int m = 0; m < 4; ++m) dst##8[m] = cat16(PG8_LD1(PG8_SA(b, h) + aoff + m * 2048), PG8_LD1(PG8_SA(b, h) + aoff + m * 2048 + 1024)); } \
        else { _Pragma("unroll") for (int m = 0; m < 4; ++m) _Pragma("unroll") for (int k = 0; k < 2; ++k) dst[m][k] = PG8_LD1(PG8_SA(b, h) + aoff + m * 2048 + k * 1024); } } while (0)
#define PG8_LDB(dst, b, h) do { if constexpr (FP8) { _Pragma("unroll") for (int n = 0; n < 2; ++n) dst##8[n] = cat16(PG8_LD1(PG8_SB(b, h) + boff + n * 2048), PG8_LD1(PG8_SB(b, h) + boff + n * 2048 + 1024)); } \
        else { _Pragma("unroll") for (int n = 0; n < 2; ++n) _Pragma("unroll") for (int k = 0; k < 2; ++k) dst[n][k] = PG8_LD1(PG8_SB(b, h) + boff + n * 2048 + k * 1024); } } while (0)
#define PG8_MMA(ai, bj, At, Bt) do { if constexpr (FP8) __builtin_amdgcn_sched_barrier(0); __builtin_amdgcn_s_setprio(1); _Pragma("unroll") for (int m = 0; m < 4; ++m) _Pragma("unroll") for (int n = 0; n < 2; ++n) { \
        if constexpr (FP8) { acc[ai][bj][m][n] = __builtin_amdgcn_mfma_scale_f32_16x16x128_f8f6f4(Bt##8[n], At##8[m], acc[ai][bj][m][n], 0, 0, 0, 0x79797979, 0, 0x7f7f7f7f); } \
        else { _Pragma("unroll") for (int k = 0; k < 2; ++k) acc[ai][bj][m][n] = __builtin_amdgcn_mfma_f32_16x16x32_bf16(Bt[n][k], At[m][k], acc[ai][bj][m][n], 0, 0, 0); } } \
        if constexpr (FP8) { _Pragma("unroll") for (int m = 0; m < 4; ++m) _Pragma("unroll") for (int n = 0; n < 2; ++n) asm volatile("" : "+v"(acc[ai][bj][m][n])); }     \
        __builtin_amdgcn_s_setprio(0); if constexpr (FP8) __builtin_amdgcn_sched_barrier(0); } while (0)
#define PG8_WAIT_V(n) asm volatile("s_waitcnt vmcnt(" #n ")" ::: "memory")
#define PG8_WAIT_L(n) asm volatile("s_waitcnt lgkmcnt(" #n ")" ::: "memory")
#define PG8_BAR __builtin_amdgcn_s_barrier()
#define PG8_SCHED __builtin_amdgcn_sched_barrier(0)
    Unit cur, nxt; int ui = 0;
    if (!S.next(0, cur)) return;
    f32x4 acc[2][2][4][2];
#pragma unroll
    for (int a = 0; a < 2; ++a)
#pragma unroll
        for (int b = 0; b < 2; ++b)
#pragma unroll
            for (int m = 0; m < 4; ++m)
#pragma unroll
                for (int n = 0; n < 2; ++n) acc[a][b][m][n] = (f32x4){0.f, 0.f, 0.f, 0.f};
    bf16x8 At[4][2], B0[2][2], B1[2][2]; v8i_t At8[4], B08[2], B18[2];
    const char* cA = (const char*)g.A + (size_t)cur.pm * tstep; const char* cB = (const char*)g.Bt + (size_t)cur.pb * tstep;
    S.a_ready(cur);
    if constexpr (SP2) {
        PG8_STAGE(PG8_SB(0, 0), cB, voffB); PG8_STAGE(PG8_SB(0, 1), cB + hstep, voffB); PG8_STAGE(PG8_SA(0, 0), cA, voffA); PG8_STAGE(PG8_SA(0, 1), cA + hstep, voffA);
        if (wr == 1) PG8_BAR;
        PG8_WAIT_V(2); PG8_BAR;
        PG8_STAGE(PG8_SB(1, 0), cB + kstep, voffB); PG8_STAGE(PG8_SA(1, 0), cA + kstep, voffA); PG8_STAGE(PG8_SB(1, 1), cB + hstep + kstep, voffB);
        PG8_WAIT_V(6); PG8_BAR;
    } else {
        PG8_STAGE(PG8_SB(0, 0), cB, voffB); PG8_STAGE(PG8_SA(0, 0), cA, voffA); PG8_STAGE(PG8_SB(0, 1), cB + hstep, voffB); PG8_STAGE(PG8_SA(0, 1), cA + hstep, voffA);
        if (wr == 1) PG8_BAR;
        PG8_WAIT_V(4); PG8_BAR;
        PG8_STAGE(PG8_SB(1, 0), cB + kstep, voffB); PG8_STAGE(PG8_SA(1, 0), cA + kstep, voffA); PG8_STAGE(PG8_SB(1, 1), cB + hstep + kstep, voffB);
        PG8_WAIT_V(6); PG8_BAR;
    }
    for (;;) {
        const bool has_next = S.next(ui + 1, nxt);
        const char* nA = has_next ? (const char*)g.A + (size_t)nxt.pm * tstep : cA; const char* nB = has_next ? (const char*)g.Bt + (size_t)nxt.pb * tstep : cB;
        for (int t = 0; t < nt; t += 2) {
            const bool last = (t == nt - 2);
            const char* a1 = cA + (size_t)(t + 1) * kstep;
            const char* a2 = last ? nA : cA + (size_t)(t + 2) * kstep; const char* b2 = last ? nB : cB + (size_t)(t + 2) * kstep;
            const char* a3 = a2 + kstep; const char* b3 = b2 + kstep;
            if (last && has_next) S.a_ready(nxt);
            if constexpr (SP2) {
            PG8_LDB(B0, 0, 0); PG8_LDB(B1, 0, 1); PG8_SCHED; PG8_LDA(At, 0, 0); PG8_STAGE(PG8_SA(1, 1), a1 + hstep, voffA);
            PG8_WAIT_V(8); PG8_WAIT_L(0); PG8_BAR; PG8_MMA(0, 0, At, B0); PG8_MMA(0, 1, At, B1); PG8_BAR; PG8_SCHED;
            PG8_LDA(At, 0, 1); PG8_STAGE(PG8_SB(0, 0), b2, voffB); PG8_STAGE(PG8_SB(0, 1), b2 + hstep, voffB); PG8_STAGE(PG8_SA(0, 0), a2, voffA);
            PG8_WAIT_V(8); PG8_WAIT_L(0); PG8_BAR; PG8_MMA(1, 0, At, B0); PG8_MMA(1, 1, At, B1); PG8_BAR; PG8_SCHED;
            PG8_LDB(B0, 1, 0); PG8_LDB(B1, 1, 1); PG8_SCHED; PG8_LDA(At, 1, 0); PG8_STAGE(PG8_SA(0, 1), a2 + hstep, voffA);
            PG8_WAIT_V(8); PG8_WAIT_L(0); PG8_BAR; PG8_MMA(0, 0, At, B0); PG8_MMA(0, 1, At, B1); PG8_BAR; PG8_SCHED;
            PG8_LDA(At, 1, 1); PG8_STAGE(PG8_SB(1, 0), b3, voffB); PG8_STAGE(PG8_SB(1, 1), b3 + hstep, voffB); PG8_STAGE(PG8_SA(1, 0), a3, voffA);
            PG8_WAIT_V(8); PG8_WAIT_L(0); PG8_BAR; PG8_MMA(1, 0, At, B0); PG8_MMA(1, 1, At, B1); PG8_BAR; PG8_SCHED;
            } else {
            PG8_LDB(B0, 0, 0); PG8_SCHED; PG8_LDA(At, 0, 0); PG8_STAGE(PG8_SA(1, 1), a1 + hstep, voffA);
            PG8_WAIT_L(8); PG8_BAR; PG8_WAIT_L(0); PG8_MMA(0, 0, At, B0); PG8_BAR; PG8_SCHED;
            PG8_LDB(B1, 0, 1); PG8_STAGE(PG8_SB(0, 0), b2, voffB);
            PG8_BAR; PG8_WAIT_L(0); PG8_MMA(0, 1, At, B1); PG8_BAR;
            PG8_LDA(At, 0, 1); PG8_STAGE(PG8_SA(0, 0), a2, voffA);
            PG8_BAR; PG8_WAIT_L(0); PG8_MMA(1, 0, At, B0); PG8_BAR; PG8_SCHED;
            PG8_STAGE(PG8_SB(0, 1), b2 + hstep, voffB);
            PG8_WAIT_V(6); PG8_BAR; PG8_MMA(1, 1, At, B1); PG8_BAR;
            PG8_LDB(B0, 1, 0); PG8_SCHED; PG8_LDA(At, 1, 0); PG8_STAGE(PG8_SA(0, 1), a2 + hstep, voffA);
            PG8_WAIT_L(8); PG8_BAR; PG8_WAIT_L(0); PG8_MMA(0, 0, At, B0); PG8_BAR; PG8_SCHED;
            PG8_LDB(B1, 1, 1); PG8_STAGE(PG8_SB(1, 0), b3, voffB);
            PG8_BAR; PG8_WAIT_L(0); PG8_MMA(0, 1, At, B1); PG8_BAR;
            PG8_LDA(At, 1, 1); PG8_STAGE(PG8_SA(1, 0), a3, voffA);
            PG8_BAR; PG8_WAIT_L(0); PG8_MMA(1, 0, At, B0); PG8_BAR; PG8_SCHED;
            PG8_STAGE(PG8_SB(1, 1), b3 + hstep, voffB);
            PG8_WAIT_V(6); PG8_BAR; PG8_MMA(1, 1, At, B1); PG8_BAR;
            }
        }
        if constexpr (ALIGN_EPI) { if (wr == 0) PG8_BAR; }
        if constexpr (!Epi::AFTER_DRAIN) { E(acc, cur, wr, wc, fr, fq); S.done(cur); }
        if (!has_next) break;
#pragma unroll
        for (int a = 0; a < 2; ++a)
#pragma unroll
            for (int b = 0; b < 2; ++b)
#pragma unroll
                for (int m = 0; m < 4; ++m)
#pragma unroll
                    for (int n = 0; n < 2; ++n) acc[a][b][m][n] = (f32x4){0.f, 0.f, 0.f, 0.f};
        cur = nxt; cA = nA; cB = nB; ++ui;
        if constexpr (ALIGN_EPI) { if (wr == 1) PG8_BAR; }
    }
    PG8_WAIT_V(0);
    if constexpr (!ALIGN_EPI) { if (wr == 0) PG8_BAR; }
    PG8_BAR;
    if constexpr (Epi::AFTER_DRAIN) { E.fused(acc, cur, wr, wc, fr, fq, lds, wid, lane); S.done(cur); }
#undef PG8_SA
#undef PG8_SB
#undef PG8_STAGE
#undef PG8_LD1
#undef PG8_LDA
#undef PG8_LDB
#undef PG8_MMA
#undef PG8_WAIT_V
#undef PG8_WAIT_L
#undef PG8_BAR
#undef PG8_SCHED
}
}

constexpr int NWAVES = 8;
constexpr int T = 16384, D = 1024, NCH = 256, LDP = 3840, DIN = 3608, PLE = 256, NE = 32;
constexpr int C_GQ = 0, C_GK = 256, C_GV = 512, C_GR = 1024, C_DQ = 1536, C_DZ = 3072, C_GLR = 3584, C_DA = 3600, C_DB = 3604;
constexpr float EPS = 1e-6f;
constexpr int XS_ROWS = 65536 + NE * 256;

constexpr size_t MiB = 1u << 20;
constexpr size_t WS_CTL = 0, CTL_ZERO_BYTES = 1 * MiB;
constexpr size_t WS_WIN = 2 * MiB, WS_WPP = 10 * MiB, WS_WOUT = 11 * MiB, WS_WPG = 13 * MiB, WS_W1 = 16 * MiB, WS_W2 = 80 * MiB;
constexpr size_t WS_XN = 112 * MiB, WS_PB = 144 * MiB, WS_PROJ = 152 * MiB, WS_PERAW = 272 * MiB;
constexpr size_t WS_KVT = 304 * MiB, WS_DVEC = 336 * MiB, WS_SGLA = 337 * MiB, WS_WF = 353 * MiB, WS_KDF = 369 * MiB, WS_UF = 385 * MiB, WS_CDEC = 417 * MiB;
constexpr size_t WS_QDEC = 418 * MiB, WS_AQK = 434 * MiB, WS_SGDN = 442 * MiB, WS_DELTA = 474 * MiB, WS_MIX = 490 * MiB;
constexpr size_t WS_TOKE = 522 * MiB, WS_TOKS = WS_TOKE + 256 * 1024, WS_TOKG = WS_TOKS + 256 * 1024, WS_TOKP = WS_TOKG + 256 * 1024;
constexpr size_t WS_GPOS = 523 * MiB, WS_PERSTD = 524 * MiB, WS_XS = 525 * MiB, WS_HS = 597 * MiB, WS_YS = 669 * MiB;
constexpr size_t WS_PEND = 813 * MiB, WS_SLE = 821 * MiB, WS_SST = 837 * MiB, WS_GSLE = 853 * MiB, WS_GPD = 861 * MiB, WS_GSST = 869 * MiB, WS_END = 877 * MiB;
static_assert(WS_XS + (size_t)XS_ROWS * 1024 <= WS_HS && WS_HS + (size_t)XS_ROWS * 1024 <= WS_YS && WS_YS + (size_t)XS_ROWS * 2048 <= WS_PEND, "d_ws map");
constexpr int GRP = 4, NGRP = NCH / GRP;
constexpr int CW_TMO = 0, CW_CODE = 1, CW_BAR = 4096, CW_CNT = 8192;

constexpr int RING_OFF = 0, RING_BYTES = 131072;
constexpr int LDSCTL_OFF = RING_BYTES, MISC_OFF = LDSCTL_OFF + 320;
constexpr int TILEE_OFF = MISC_OFF + 128;
constexpr int BASE_OFF = TILEE_OFF + 320 * 4;
constexpr int ROUTE_OFF = BASE_OFF + 128;
constexpr int LDS_BYTES = 147456;
static_assert(ROUTE_OFF + 256 + 3072 <= LDS_BYTES, "LDS map");

#define GAS __attribute__((address_space(1)))
#define LAS __attribute__((address_space(3)))
typedef unsigned short bf16;
typedef unsigned v4u __attribute__((ext_vector_type(4)));
typedef float f32x4 __attribute__((ext_vector_type(4)));
typedef short bf16x8 __attribute__((ext_vector_type(8)));
typedef GAS unsigned gu32;
typedef GAS unsigned long long gu64;
#define RLX_AGENT __ATOMIC_RELAXED, __HIP_MEMORY_SCOPE_AGENT
#define LDS_WAIT() asm volatile("s_waitcnt lgkmcnt(0)" ::: "memory")
#define VM_WAIT() asm volatile("s_waitcnt vmcnt(0)" ::: "memory")
__device__ __forceinline__ unsigned long long rt() { return __builtin_amdgcn_s_memrealtime(); }
__device__ __forceinline__ unsigned f2bf(float f) { unsigned u = __builtin_bit_cast(unsigned, f); return (u + 0x7fffu + ((u >> 16) & 1u)) >> 16; }
__device__ __forceinline__ unsigned pk2(float lo, float hi) { return f2bf(lo) | (f2bf(hi) << 16); }

#define XB_TMO      128
#define XB_XCNT(j)  (256  + 64 * (j))
#define XB_XSUB(j)  (1280 + 64 * (j))
#define XB_XGEN(j)  (2304 + 64 * (j))
#define XB_TOP      3328
#define XB_TOPGEN   3392
#define XCD_BAR_WORDS 3456
#define XB_SPIN_CAP (1u << 18)

__device__ __forceinline__ unsigned xb_ld(unsigned* p)              { return __hip_atomic_load(p, __ATOMIC_RELAXED, __HIP_MEMORY_SCOPE_AGENT); }
__device__ __forceinline__ unsigned xb_add(unsigned* p, unsigned v) { return __hip_atomic_fetch_add(p, v, __ATOMIC_RELAXED, __HIP_MEMORY_SCOPE_AGENT); }
__device__ __forceinline__ unsigned xb_xcc_id() { return (unsigned)__builtin_amdgcn_s_getreg((3 << 11) | 20) & 0xFu; }
#define XB_SPIN(cond, bar) do { unsigned _sp = 0; while (cond) { __builtin_amdgcn_s_sleep(1); \
    if ((++_sp & 255u) == 0u) { if (xb_ld(&(bar)[XB_TMO])) break; if (_sp > XB_SPIN_CAP) { atomicAdd(&(bar)[XB_TMO], 1u); break; } } } } while (0)

struct XcdBarrier {
    unsigned* bar; unsigned x;
    volatile LAS unsigned* st;
};

__device__ __forceinline__ XcdBarrier xcd_barrier_post(unsigned* bar, volatile LAS unsigned* st) {
    XcdBarrier b; b.bar = bar; b.x = xb_xcc_id(); b.st = st;
    if (threadIdx.x == 0) (void)xb_add(&bar[XB_XCNT(b.x)], 1u);
    return b;
}
__device__ __forceinline__ void xcd_barrier_complete(unsigned* bar, unsigned x, unsigned& nloc, unsigned& nx) {
    const unsigned G = gridDim.x * gridDim.y * gridDim.z;
    unsigned sum, cnt, mine, sp = 0u;
    for (;;) {
        sum = 0u; cnt = 0u; mine = 0u;
#pragma unroll
        for (unsigned j = 0; j < 16; ++j) { const unsigned c = xb_ld(&bar[XB_XCNT(j)]); sum += c; cnt += (c > 0u) ? 1u : 0u; mine = (j == x) ? c : mine; }
        if (sum == G) break;
        __builtin_amdgcn_s_sleep(1);
        if ((++sp & 255u) == 0u) { if (xb_ld(&bar[XB_TMO])) break; if (sp > XB_SPIN_CAP) { atomicAdd(&bar[XB_TMO], 1u); break; } }
    }
    nloc = mine > 0u ? mine : 1u; nx = cnt > 0u ? cnt : 1u;
}

__device__ __forceinline__ void xcd_barrier(const XcdBarrier& b) {
    asm volatile("s_waitcnt vmcnt(0)" ::: "memory");
    __syncthreads();
    if (threadIdx.x == 0) {
        unsigned* bar = b.bar;
        __builtin_amdgcn_s_waitcnt(0);
        unsigned nloc = b.st[0], nx = b.st[1];
        if (nloc == 0u) { xcd_barrier_complete(bar, b.x, nloc, nx); b.st[0] = nloc; b.st[1] = nx; }
        const unsigned old = xb_add(&bar[XB_XSUB(b.x)], 1u);
        const unsigned gen = old / nloc;
        if (old + 1u == (gen + 1u) * nloc) {
            __builtin_amdgcn_fence(__ATOMIC_RELEASE, "agent");
            asm volatile("s_waitcnt vmcnt(0)" ::: "memory");
            const unsigned og = xb_add(&bar[XB_TOP], 1u);
            const unsigned tg = og / nx;
            if (og + 1u == (tg + 1u) * nx) xb_add(&bar[XB_TOPGEN], 1u);
            else XB_SPIN(xb_ld(&bar[XB_TOPGEN]) == tg, bar);
            __builtin_amdgcn_fence(__ATOMIC_ACQUIRE, "agent");
            xb_add(&bar[XB_XGEN(b.x)], 1u);
            asm volatile("s_waitcnt vmcnt(0)" ::: "memory");
        } else {
            XB_SPIN(xb_ld(&bar[XB_XGEN(b.x)]) == gen, bar);
            __builtin_amdgcn_fence(__ATOMIC_ACQUIRE, "agent");
            asm volatile("s_waitcnt vmcnt(0)" ::: "memory");
        }
    }
    __syncthreads();
}


__device__ __forceinline__ float bflo(unsigned w) { return __uint_as_float(w << 16); }
__device__ __forceinline__ float bfhi(unsigned w) { return __uint_as_float(w & 0xffff0000u); }
__device__ __forceinline__ float bf2f(bf16 h) { return __uint_as_float((unsigned)h << 16); }
using pg8::cvtpk;
__device__ __forceinline__ bf16 f2bf1(float f) { return (bf16)(cvtpk(f, 0.f) & 0xffffu); }
__device__ __forceinline__ float wave_sum(float v) {
#pragma unroll
    for (int o = 1; o < 64; o <<= 1) v += __shfl_xor(v, o);
    return v;
}
__device__ __forceinline__ float sigm(float x) { return __builtin_amdgcn_rcpf(1.0f + __expf(-x)); }
__device__ __forceinline__ float siluf_(float x) { return x * sigm(x); }
__device__ __forceinline__ float softplusf_(float x) { return fmaxf(x, 0.f) + __logf(1.0f + __expf(-fabsf(x))); }
__device__ __forceinline__ float logsigf_(float x) { return fminf(x, 0.f) - __logf(1.0f + __expf(-fabsf(x))); }
#define MFMA16(a, b, c) __builtin_amdgcn_mfma_f32_16x16x32_bf16((a), (b), (c), 0, 0, 0)
typedef short bf16x4 __attribute__((ext_vector_type(4)));
typedef unsigned u32x2 __attribute__((ext_vector_type(2)));
__device__ __forceinline__ bf16x8 cat8(bf16x4 lo, bf16x4 hi) { return __builtin_shufflevector(lo, hi, 0, 1, 2, 3, 4, 5, 6, 7); }
__device__ __forceinline__ bf16x8 pack8(const f32x4& a, const f32x4& b) {
    v4u w; w.x = cvtpk(a[0], a[1]); w.y = cvtpk(a[2], a[3]); w.z = cvtpk(b[0], b[1]); w.w = cvtpk(b[2], b[3]); return __builtin_bit_cast(bf16x8, w);
}
__device__ __forceinline__ u32x2 pack4(const f32x4& a) { u32x2 w; w.x = cvtpk(a[0], a[1]); w.y = cvtpk(a[2], a[3]); return w; }

struct Frame {
    LAS unsigned char* lds;
    volatile LAS unsigned* MISC;
    gu32* ctl;
    int tid, lane, wave;
    int vcu, G;
    unsigned char* ws;
    const float* in[24];
    float* out;
};
#define WSP(T_, off) ((T_*)(F.ws + (off)))

template <class RowMap>
__device__ __forceinline__ void transpose_item(const float* W, int K, int N, bf16* WT, LAS float* scr, int item, int lane, RowMap rm) {
    const int nblk = (N + 31) >> 5, kb = item / nblk, nb = item - kb * nblk, k0 = 64 * kb, n0 = 32 * nb;
    const int cq = (lane & 7) * 4, rr = lane >> 3;
#pragma unroll
    for (int i = 0; i < 8; ++i) { const int kk = 8 * i + rr; f32x4 v = {0.f, 0.f, 0.f, 0.f};
        if (n0 + cq < N) v = *(const GAS f32x4*)(W + (size_t)(k0 + kk) * N + n0 + cq);
        LAS float* s = scr + kk * 33 + cq; s[0] = v[0]; s[1] = v[1]; s[2] = v[2]; s[3] = v[3]; }
    LDS_WAIT(); asm volatile("" ::: "memory");
    const int c = lane & 7;
#pragma unroll
    for (int j = 0; j < 4; ++j) { const int n = (lane >> 3) + 8 * j; const LAS float* s = scr + (8 * c) * 33 + n;
        v4u o; o.x = cvtpk(s[0 * 33], s[1 * 33]); o.y = cvtpk(s[2 * 33], s[3 * 33]); o.z = cvtpk(s[4 * 33], s[5 * 33]); o.w = cvtpk(s[6 * 33], s[7 * 33]);
        if (n0 + n < N) *(GAS v4u*)(WT + (size_t)rm(n0 + n) * K + k0 + 8 * c) = o; }
    LDS_WAIT(); asm volatile("" ::: "memory");
}
template <class RowMap>
__device__ __forceinline__ void transpose_item_fp8(const float* W, int K, int N, unsigned char* WT, LAS float* scr, int item, int lane, RowMap rm) {
    const int nblk = (N + 31) >> 5, kb = item / nblk, nb = item - kb * nblk, k0 = 64 * kb, n0 = 32 * nb;
    const int cq = (lane & 7) * 4, rr = lane >> 3;
#pragma unroll
    for (int i = 0; i < 8; ++i) { const int kk = 8 * i + rr; const f32x4 v = *(const GAS f32x4*)(W + (size_t)(k0 + kk) * N + n0 + cq);
        LAS float* s = scr + kk * 33 + cq; s[0] = v[0] * 64.f; s[1] = v[1] * 64.f; s[2] = v[2] * 64.f; s[3] = v[3] * 64.f; }
    LDS_WAIT(); asm volatile("" ::: "memory");
    const int c = lane & 7;
#pragma unroll
    for (int j = 0; j < 4; ++j) { const int n = (lane >> 3) + 8 * j; const LAS float* s = scr + (8 * c) * 33 + n;
        u32x2 o; o.x = pg8::cvt4_fp8(s[0 * 33], s[1 * 33], s[2 * 33], s[3 * 33]); o.y = pg8::cvt4_fp8(s[4 * 33], s[5 * 33], s[6 * 33], s[7 * 33]);
        *(GAS u32x2*)(WT + (size_t)rm(n0 + n) * K + k0 + 8 * c) = o; }
    LDS_WAIT(); asm volatile("" ::: "memory");
}
struct RmId { __device__ __forceinline__ int operator()(int n) const { return n; } };
struct RmWin { __device__ __forceinline__ int operator()(int c) const { return c < 1536 ? c : (c < 1552 ? c + 2048 : (c < 3600 ? c - 16 : c)); } };
struct RmW1 { __device__ __forceinline__ int operator()(int c) const { const int j = c & 1023, up = c >> 10; return (j >> 7) * 256 + up * 128 + (j & 127); } };

__device__ __forceinline__ void rms_row_to_bf16(const float* xrow, const float* g, bf16* orow, int lane) {
    const GAS f32x4* xr = (const GAS f32x4*)xrow + lane; const GAS f32x4* gr = (const GAS f32x4*)g + lane;
    f32x4 v[4]; float s = 0.f;
#pragma unroll
    for (int j = 0; j < 4; ++j) { v[j] = xr[64 * j]; s += (v[j].x * v[j].x + v[j].y * v[j].y) + (v[j].z * v[j].z + v[j].w * v[j].w); }
    const float rstd = 1.f / sqrtf(wave_sum(s) * (1.f / D) + EPS);
    GAS u32x2* o8 = (GAS u32x2*)orow + lane;
#pragma unroll
    for (int j = 0; j < 4; ++j) { const f32x4 gg = gr[64 * j]; u32x2 w; w.x = cvtpk(v[j].x * rstd * gg.x, v[j].y * rstd * gg.y); w.y = cvtpk(v[j].z * rstd * gg.z, v[j].w * rstd * gg.w); o8[64 * j] = w; }
}

__device__ __forceinline__ void p0_prologue(Frame& F) {
    LAS float* scr = (LAS float*)(F.lds + RING_OFF + F.wave * 16384);
    const int gw = F.vcu * NWAVES + F.wave, NGW = F.G * NWAVES, lane = F.lane;
    bf16* Win_t = WSP(bf16, WS_WIN);
    for (int it = gw; it < 16 * 113; it += NGW) transpose_item(F.in[3], 1024, DIN, Win_t, scr, it, lane, RmWin());
    for (int r = DIN + gw; r < LDP; r += NGW) { GAS v4u* o = (GAS v4u*)(Win_t + (size_t)r * 1024) + lane; o[0] = (v4u){0, 0, 0, 0}; o[64] = (v4u){0, 0, 0, 0}; }
    for (int it = gw; it < 4 * 32; it += NGW) transpose_item(F.in[21], PLE, D, WSP(bf16, WS_WPP), scr, it, lane, RmId());
    for (int it = gw; it < 512; it += NGW) transpose_item(F.in[11], D, D, WSP(bf16, WS_WOUT), scr, it, lane, RmId());
    for (int it = gw; it < 512; it += NGW) transpose_item(F.in[20], D, D, WSP(bf16, WS_WPG), scr, it, lane, RmId());
    for (int it = gw; it < NE * 1024; it += NGW) { const int e = it >> 10; transpose_item_fp8(F.in[15] + (size_t)e * 1024 * 2048, 1024, 2048, WSP(unsigned char, WS_W1) + (size_t)e * 2048 * 1024, scr, it & 1023, lane, RmW1()); }
    for (int it = gw; it < NE * 512; it += NGW) { const int e = it >> 9; transpose_item_fp8(F.in[17] + (size_t)e * 1024 * 1024, 1024, 1024, WSP(unsigned char, WS_W2) + (size_t)e * 1024 * 1024, scr, it & 511, lane, RmId()); }
    for (int m = gw; m < T; m += NGW) rms_row_to_bf16(F.in[0] + (size_t)m * D, F.in[2], WSP(bf16, WS_XN) + (size_t)m * D, lane);
    for (int m = gw; m < T; m += NGW) { const f32x4 v = *((const GAS f32x4*)(F.in[1] + (size_t)m * PLE) + lane); u32x2 w; w.x = cvtpk(v.x, v.y); w.y = cvtpk(v.z, v.w); *((GAS u32x2*)(WSP(bf16, WS_PB) + (size_t)m * PLE) + lane) = w; }
}

constexpr int GL_B = 0, GL_GLR = 16640, GL_T1 = 20992, GL_T2 = 30208, GL_VT = 39424, GL_RED = 57856;
__device__ __forceinline__ void gla_b(Frame& F, int n, int h) {
    LAS float* bL = (LAS float*)(F.lds + GL_B); LAS float* glrL = (LAS float*)(F.lds + GL_GLR);
    const bf16* PROJ = WSP(bf16, WS_PROJ); const int tid = F.tid, t0 = n * 64;
    { const int idx = tid * 2, t = idx >> 4, r = idx & 15; const unsigned w = *(const GAS unsigned*)(PROJ + (size_t)(t0 + t) * LDP + C_GLR + r); glrL[t * 17 + r] = bflo(w); glrL[t * 17 + r + 1] = bfhi(w); }
    const int d = tid & 63, tg = tid >> 6;
    float wg[16];
#pragma unroll
    for (int r = 0; r < 16; ++r) wg[r] = F.in[4][r * 256 + h * 64 + d];
    const float bias = F.in[5][h * 64 + d];
    __syncthreads();
#pragma unroll
    for (int tt = 0; tt < 8; ++tt) { const int t = tg * 8 + tt; float a = bias;
#pragma unroll
        for (int r = 0; r < 16; ++r) a += glrL[t * 17 + r] * wg[r];
        bL[t * 65 + d] = logsigf_(a) * 0.0625f; }
    __syncthreads();
    if (tid < 64) { float run = 0.f;
#pragma unroll 16
        for (int t = 0; t < 64; ++t) { run += bL[t * 65 + tid]; bL[t * 65 + tid] = run; } }
    __syncthreads();
}
__device__ __forceinline__ void gla_load_vT(Frame& F, int n, int h) {
    LAS bf16* vT = (LAS bf16*)(F.lds + GL_VT); const bf16* PROJ = WSP(bf16, WS_PROJ);
    const int t = F.tid >> 3, eg = F.tid & 7;
    const GAS v4u* src = (const GAS v4u*)(PROJ + (size_t)(n * 64 + t) * LDP + C_GV + h * 128 + eg * 16);
#pragma unroll
    for (int half = 0; half < 2; ++half) { const v4u w = src[half];
#pragma unroll
        for (int i = 0; i < 4; ++i) { const int e = eg * 16 + half * 8 + 2 * i; vT[e * 72 + t] = (bf16)(w[i] & 0xffffu); vT[(e + 1) * 72 + t] = (bf16)(w[i] >> 16); } }
}

__device__ __forceinline__ void gla_prep_item(Frame& F, int n, int h) {
    gla_b(F, n, h);
    LAS float* bL = (LAS float*)(F.lds + GL_B); LAS bf16* T1 = (LAS bf16*)(F.lds + GL_T1); LAS bf16* vT = (LAS bf16*)(F.lds + GL_VT);
    const bf16* PROJ = WSP(bf16, WS_PROJ); const int tid = F.tid, lane = F.lane, w = F.wave;
    { const int t = tid >> 3, dg = tid & 7; const v4u kw = *(const GAS v4u*)(PROJ + (size_t)(n * 64 + t) * LDP + C_GK + h * 64 + dg * 8);
#pragma unroll
        for (int i = 0; i < 4; ++i) { const int d0 = dg * 8 + 2 * i;
            T1[d0 * 72 + t] = f2bf1(bflo(kw[i]) * __expf(bL[63 * 65 + d0] - bL[t * 65 + d0]));
            T1[(d0 + 1) * 72 + t] = f2bf1(bfhi(kw[i]) * __expf(bL[63 * 65 + d0 + 1] - bL[t * 65 + d0 + 1])); } }
    gla_load_vT(F, n, h);
    __syncthreads();
    const int c = lane & 15, kq = lane >> 4;
    bf16x8 a[2];
#pragma unroll
    for (int ks = 0; ks < 2; ++ks) a[ks] = *(const LAS bf16x8*)(vT + (16 * w + c) * 72 + 32 * ks + 8 * kq);
    float* KVT = WSP(float, WS_KVT) + (size_t)(n * 4 + h) * 128 * 64;
#pragma unroll
    for (int dt = 0; dt < 4; ++dt) { f32x4 acc = {0.f, 0.f, 0.f, 0.f};
#pragma unroll
        for (int ks = 0; ks < 2; ++ks) { const bf16x8 b = *(const LAS bf16x8*)(T1 + (16 * dt + c) * 72 + 32 * ks + 8 * kq); acc = MFMA16(a[ks], b, acc); }
#pragma unroll
        for (int r = 0; r < 4; ++r) KVT[(16 * w + 4 * kq + r) * 64 + 16 * dt + c] = acc[r]; }
    if (tid < 64) WSP(float, WS_DVEC)[(n * 4 + h) * 64 + tid] = __expf(bL[63 * 65 + tid]);
    __syncthreads();
}

__device__ __forceinline__ void mix_epilogue(Frame& F, const f32x4 (&o)[4], int n, int it, int eh, const float* gain, int gate_col, int mix_col) {
    LAS float* red = (LAS float*)(F.lds + GL_RED);
    const int lane = F.lane, c = lane & 15, kq = lane >> 4, w = F.wave;
    float ss = 0.f;
#pragma unroll
    for (int q = 0; q < 4; ++q)
#pragma unroll
        for (int r = 0; r < 4; ++r) ss += o[q][r] * o[q][r];
    ss += __shfl_xor(ss, 16); ss += __shfl_xor(ss, 32);
    if (kq == 0) red[w * 64 + c] = ss;
    __syncthreads();
    const float tot = red[it * 64 + c] + red[(it + 4) * 64 + c];
    const float rstd = 1.f / sqrtf(tot * (1.f / 128.f) + EPS);
    const int t = n * 64 + 16 * it + c;
    const bf16* PROJ = WSP(bf16, WS_PROJ); bf16* MIX = WSP(bf16, WS_MIX);
#pragma unroll
    for (int q = 0; q < 4; ++q) { const int e = 16 * (4 * eh + q) + 4 * kq;
        const u32x2 gw = *(const GAS u32x2*)(PROJ + (size_t)t * LDP + gate_col + e); const f32x4 gn = *(const GAS f32x4*)(gain + e);
        f32x4 v; v[0] = o[q][0] * rstd * gn[0] * siluf_(bflo(gw.x)); v[1] = o[q][1] * rstd * gn[1] * siluf_(bfhi(gw.x)); v[2] = o[q][2] * rstd * gn[2] * siluf_(bflo(gw.y)); v[3] = o[q][3] * rstd * gn[3] * siluf_(bfhi(gw.y));
        *(GAS u32x2*)(MIX + (size_t)t * D + mix_col + e) = pack4(v); }
    __syncthreads();
}

__device__ __forceinline__ void gla_out_item(Frame& F, int n, int h) {
    const int c = F.lane & 15, kq = F.lane >> 4, it = F.wave & 3, eh = F.wave >> 2;
    const bf16* ST = WSP(bf16, WS_SGLA) + (size_t)(n * 4 + h) * 128 * 64;
    bf16x8 as[4][2];
#pragma unroll
    for (int q = 0; q < 4; ++q)
#pragma unroll
        for (int ks = 0; ks < 2; ++ks) as[q][ks] = *(const GAS bf16x8*)(ST + (16 * (4 * eh + q) + c) * 64 + 32 * ks + 8 * kq);
    __builtin_amdgcn_sched_barrier(0);
    gla_b(F, n, h);
    LAS float* bL = (LAS float*)(F.lds + GL_B); LAS bf16* T1 = (LAS bf16*)(F.lds + GL_T1); LAS bf16* T2 = (LAS bf16*)(F.lds + GL_T2); LAS bf16* vT = (LAS bf16*)(F.lds + GL_VT);
    const bf16* PROJ = WSP(bf16, WS_PROJ); const int tid = F.tid, lane = F.lane, w = F.wave;
    { const int t = tid >> 3, dg = tid & 7;
        const v4u qw = *(const GAS v4u*)(PROJ + (size_t)(n * 64 + t) * LDP + C_GQ + h * 64 + dg * 8); const v4u kw = *(const GAS v4u*)(PROJ + (size_t)(n * 64 + t) * LDP + C_GK + h * 64 + dg * 8);
        v4u qo, ko;
#pragma unroll
        for (int i = 0; i < 4; ++i) { const int d0 = dg * 8 + 2 * i; const float b0 = bL[t * 65 + d0], b1 = bL[t * 65 + d0 + 1];
            qo[i] = cvtpk(bflo(qw[i]) * 0.125f * __expf(b0), bfhi(qw[i]) * 0.125f * __expf(b1));
            ko[i] = cvtpk(bflo(kw[i]) * __expf(-b0), bfhi(kw[i]) * __expf(-b1)); }
        *(LAS v4u*)(T1 + t * 72 + dg * 8) = qo; *(LAS v4u*)(T2 + t * 72 + dg * 8) = ko; }
    gla_load_vT(F, n, h);
    __syncthreads();
    bf16x8 bq[2];
#pragma unroll
    for (int ks = 0; ks < 2; ++ks) bq[ks] = *(const LAS bf16x8*)(T1 + (16 * it + c) * 72 + 32 * ks + 8 * kq);
    f32x4 at[4];
#pragma unroll
    for (int jt = 0; jt < 4; ++jt) { f32x4 acc = {0.f, 0.f, 0.f, 0.f};
        if (jt <= it) {
#pragma unroll
            for (int ks = 0; ks < 2; ++ks) { const bf16x8 a = *(const LAS bf16x8*)(T2 + (16 * jt + c) * 72 + 32 * ks + 8 * kq); acc = MFMA16(a, bq[ks], acc); }
            if (jt == it) {
#pragma unroll
                for (int r = 0; r < 4; ++r) if (4 * kq + r > c) acc[r] = 0.f; }
        }
        at[jt] = acc; }
    bf16x8 pb[2]; pb[0] = pack8(at[0], at[1]); pb[1] = pack8(at[2], at[3]);
    f32x4 o[4];
#pragma unroll
    for (int q = 0; q < 4; ++q) { const int et = 4 * eh + q; f32x4 acc = {0.f, 0.f, 0.f, 0.f};
#pragma unroll
        for (int s = 0; s < 2; ++s) { const bf16x4 lo = *(const LAS bf16x4*)(vT + (16 * et + c) * 72 + 32 * s + 4 * kq), hi = *(const LAS bf16x4*)(vT + (16 * et + c) * 72 + 32 * s + 16 + 4 * kq);
            acc = MFMA16(cat8(lo, hi), pb[s], acc); }
#pragma unroll
        for (int ks = 0; ks < 2; ++ks) acc = MFMA16(as[q][ks], bq[ks], acc);
        o[q] = acc; }
    mix_epilogue(F, o, n, it, eh, F.in[6], C_GR + h * 128, h * 128);
}

__device__ __forceinline__ void gdn_out_item(Frame& F, int n, int h) {
    const int lane = F.lane, w = F.wave, c = lane & 15, kq = lane >> 4, it = w & 3, eh = w >> 2;
    const bf16* QD = WSP(bf16, WS_QDEC) + ((size_t)(n * 4 + h) * 64 + 16 * it + c) * 128; const bf16* AQ = WSP(bf16, WS_AQK) + ((size_t)(n * 4 + h) * 64 + 16 * it + c) * 64;
    bf16x8 bqd[4], baq[2];
#pragma unroll
    for (int ks = 0; ks < 4; ++ks) bqd[ks] = *(const GAS bf16x8*)(QD + 32 * ks + 8 * kq);
#pragma unroll
    for (int s = 0; s < 2; ++s) baq[s] = *(const GAS bf16x8*)(AQ + 32 * s + 8 * kq);
    const bf16* ST = WSP(bf16, WS_SGDN) + (size_t)(n * 4 + h) * 128 * 128; const bf16* DT = WSP(bf16, WS_DELTA) + (size_t)(n * 4 + h) * 128 * 64;
    bf16x8 as[4][4], ad[4][2];
#pragma unroll
    for (int q = 0; q < 4; ++q) { const int et = 4 * eh + q;
#pragma unroll
        for (int ks = 0; ks < 4; ++ks) as[q][ks] = *(const GAS bf16x8*)(ST + (16 * et + c) * 128 + 32 * ks + 8 * kq);
#pragma unroll
        for (int s = 0; s < 2; ++s) ad[q][s] = *(const GAS bf16x8*)(DT + (16 * et + c) * 64 + 32 * s + 8 * kq); }
    __builtin_amdgcn_sched_barrier(0);
    f32x4 o[4];
#pragma unroll
    for (int q = 0; q < 4; ++q) { f32x4 acc = {0.f, 0.f, 0.f, 0.f};
#pragma unroll
        for (int ks = 0; ks < 4; ++ks) acc = MFMA16(as[q][ks], bqd[ks], acc);
#pragma unroll
        for (int s = 0; s < 2; ++s) acc = MFMA16(ad[q][s], baq[s], acc);
        o[q] = acc; }
    mix_epilogue(F, o, n, it, eh, F.in[10], C_DZ + h * 128, 512 + h * 128);
}

constexpr int GD_QB = 0, GD_KB = 17408, GD_VB = 34816, GD_LS = 52224, GD_LB = 68608, GD_TB = 77824, GD_XT = 80896, GD_SC = 117760;
__device__ __forceinline__ void gdn_prep_item(Frame& F, int n, int h) {
    LAS bf16* qb = (LAS bf16*)(F.lds + GD_QB); LAS bf16* kb = (LAS bf16*)(F.lds + GD_KB); LAS bf16* vb = (LAS bf16*)(F.lds + GD_VB);
    LAS float* Ls = (LAS float*)(F.lds + GD_LS); LAS bf16* Lb = (LAS bf16*)(F.lds + GD_LB); LAS bf16* Tb = (LAS bf16*)(F.lds + GD_TB); LAS bf16* XT = (LAS bf16*)(F.lds + GD_XT);
    LAS float* bS = (LAS float*)(F.lds + GD_SC); LAS float* betaS = bS + 64; LAS float* ebS = bS + 128;
    const bf16* PROJ = WSP(bf16, WS_PROJ); const int tid = F.tid, lane = F.lane, w = F.wave, t0 = n * 64;
    const size_t nh = (size_t)(n * 4 + h);
    if (tid < 64) {
        const float da = bf2f(PROJ[(size_t)(t0 + tid) * LDP + C_DA + h]), db = bf2f(PROJ[(size_t)(t0 + tid) * LDP + C_DB + h]);
        float g = -__expf(F.in[8][h]) * softplusf_(da + F.in[9][h]);
#pragma unroll
        for (int off = 1; off < 64; off <<= 1) { const float v = __shfl_up(g, off); if (lane >= off) g += v; }
        bS[tid] = g; betaS[tid] = sigm(db); ebS[tid] = __expf(g);
    }
    if (!(MK_DBG & 2) && lane < 48) {
        const int grp = lane >> 4, c8 = (lane & 15) * 8;
        const int colP = C_DQ + grp * 512 + h * 128 + c8;
        f32x4 wc[4][2];
#pragma unroll
        for (int j = 0; j < 4; ++j) { const GAS f32x4* wp = (const GAS f32x4*)(F.in[7] + (size_t)j * 1536 + grp * 512 + h * 128 + c8); wc[j][0] = wp[0]; wc[j][1] = wp[1]; }
        v4u xin[11];
#pragma unroll
        for (int rr = 0; rr < 11; ++rr) { const int r = t0 + w * 8 - 3 + rr; xin[rr] = (v4u){0, 0, 0, 0}; if (r >= 0) xin[rr] = *(const GAS v4u*)(PROJ + (size_t)r * LDP + colP); }
#pragma unroll
        for (int tt = 0; tt < 8; ++tt) {
            float y[8];
#pragma unroll
            for (int i = 0; i < 8; ++i) y[i] = 0.f;
#pragma unroll
            for (int j = 0; j < 4; ++j)
#pragma unroll
                for (int i = 0; i < 4; ++i) { const unsigned xw = xin[tt + j][i]; y[2 * i] += wc[j][i >> 1][(2 * i) & 3] * bflo(xw); y[2 * i + 1] += wc[j][i >> 1][(2 * i + 1) & 3] * bfhi(xw); }
            float ss = 0.f;
#pragma unroll
            for (int i = 0; i < 8; ++i) { y[i] = siluf_(y[i]); ss += y[i] * y[i]; }
            ss += __shfl_xor(ss, 1); ss += __shfl_xor(ss, 2); ss += __shfl_xor(ss, 4); ss += __shfl_xor(ss, 8);
            const int row = w * 8 + tt;
            const float sc = grp == 2 ? 1.0f : (1.f / sqrtf(ss + EPS)) * (grp == 0 ? 0.08838834764831845f : 1.0f);
            v4u o; o.x = cvtpk(y[0] * sc, y[1] * sc); o.y = cvtpk(y[2] * sc, y[3] * sc); o.z = cvtpk(y[4] * sc, y[5] * sc); o.w = cvtpk(y[6] * sc, y[7] * sc);
            *(LAS v4u*)((grp == 0 ? qb : (grp == 1 ? kb : vb)) + row * 136 + c8) = o;
        }
    }
    __syncthreads();
    if (!(MK_DBG & 4)) {
        const int c = lane & 15, kq = lane >> 4;
        bf16* AQ = WSP(bf16, WS_AQK) + nh * 64 * 64;
        for (int job = w; job < 20; job += 8) {
            const int kind = job >= 10 ? 1 : 0, idx = job - 10 * kind;
            const int it = idx >= 6 ? 3 : (idx >= 3 ? 2 : (idx >= 1 ? 1 : 0)), jt = idx - (it * (it + 1)) / 2;
            const LAS bf16* Am = kind ? qb : kb;
            f32x4 acc = {0.f, 0.f, 0.f, 0.f};
#pragma unroll
            for (int ks = 0; ks < 4; ++ks) { const bf16x8 a = *(const LAS bf16x8*)(Am + (16 * it + c) * 136 + 32 * ks + 8 * kq), b = *(const LAS bf16x8*)(kb + (16 * jt + c) * 136 + 32 * ks + 8 * kq); acc = MFMA16(a, b, acc); }
            const int j = 16 * jt + c; const float bj = bS[j];
#pragma unroll
            for (int r = 0; r < 4; ++r) { const int i = 16 * it + 4 * kq + r; const float dec = __expf(fminf(bS[i] - bj, 0.f));
                if (kind == 0) Ls[i * 64 + j] = (j < i) ? betaS[i] * dec * acc[r] : 0.f;
                else { AQ[i * 64 + j] = (j <= i) ? f2bf1(dec * acc[r]) : (bf16)0; if (jt < it) AQ[(16 * jt + 4 * kq + r) * 64 + 16 * it + c] = (bf16)0; } }
        }
    }
    __syncthreads();
    { const int i = tid >> 3, c0 = (tid & 7) * 8; v4u o;
#pragma unroll
      for (int x = 0; x < 4; ++x) { const int col = c0 + 2 * x; const bool up = (col >> 4) > (i >> 4); o[x] = up ? 0u : cvtpk(-Ls[i * 64 + col], -Ls[i * 64 + col + 1]); }
      *(LAS v4u*)(Lb + i * 72 + c0) = o;
      for (int x = tid; x < 256 * 72 / 8; x += 512) *(LAS v4u*)(XT + x * 8) = (v4u){0u, 0u, 0u, 0u}; }
    if ((MK_DBG & 8) && tid < 64) {} else if (tid < 64) { const int b = tid >> 4, cc = tid & 15; float x[16];
#pragma unroll
        for (int i = 0; i < 16; ++i) { float a = (i == cc) ? 1.f : 0.f;
#pragma unroll
            for (int j = 0; j < i; ++j) a -= Ls[(16 * b + i) * 64 + 16 * b + j] * x[j];
            x[i] = a; Tb[(16 * b + i) * 24 + cc] = f2bf1(a); }
    } else if (!(MK_DBG & 16) && tid >= 256) {
        const int tt = tid - 256; const float bl = bS[63];
        bf16* QD = WSP(bf16, WS_QDEC) + nh * 64 * 128;
#pragma unroll 1
        for (int j = 0; j < 4; ++j) { const int id = tt + 256 * j, i = id >> 4, c8 = (id & 15) * 8; const v4u qw = *(const LAS v4u*)(qb + i * 136 + c8); const float e = ebS[i];
            v4u o; o.x = cvtpk(bflo(qw.x) * e, bfhi(qw.x) * e); o.y = cvtpk(bflo(qw.y) * e, bfhi(qw.y) * e); o.z = cvtpk(bflo(qw.z) * e, bfhi(qw.z) * e); o.w = cvtpk(bflo(qw.w) * e, bfhi(qw.w) * e);
            *(GAS v4u*)(QD + i * 128 + c8) = o; }
        bf16* KDF = WSP(bf16, WS_KDF) + nh * 16 * 512;
#pragma unroll 1
        for (int j = 0; j < 4; ++j) { const int id = tt + 256 * j, f = id >> 6, ln = id & 63, dt = f >> 1, ks2 = f & 1, q = ln >> 4, m = ln & 15, d = 16 * dt + m;
            float v[8];
#pragma unroll
            for (int x = 0; x < 8; ++x) { const int i = 32 * ks2 + (x < 4 ? 4 * q + x : 16 + 4 * q + (x - 4)); v[x] = bf2f(kb[i * 136 + d]) * __expf(bl - bS[i]); }
            v4u o; o.x = cvtpk(v[0], v[1]); o.y = cvtpk(v[2], v[3]); o.z = cvtpk(v[4], v[5]); o.w = cvtpk(v[6], v[7]);
            *(GAS v4u*)(KDF + ((size_t)f * 64 + ln) * 8) = o; }
        if (tt == 0) WSP(float, WS_CDEC)[nh] = __expf(bl);
    }
    __syncthreads();
    if (!(MK_DBG & 32)) { const int c = lane & 15, kq = lane >> 4;
      bf16* WF = WSP(bf16, WS_WF) + nh * 16 * 512; f32x4* UFp = (f32x4*)WSP(float, WS_UF) + nh * 8 * 4 * 64;
      const f32x4 z4 = {0.f, 0.f, 0.f, 0.f};
#pragma unroll
      for (int b = 0; b < 4; ++b) {
          const bf16x4 tlo = *(const LAS bf16x4*)(Tb + (16 * b + c) * 24 + 4 * kq); const bf16x8 ta = cat8(tlo, (bf16x4){0, 0, 0, 0});
#pragma unroll
          for (int t2 = 0; t2 < 2; ++t2) { const int ct = 2 * w + t2, col = 16 * ct + c; const bool isu = ct < 8;
              f32x4 acc;
#pragma unroll
              for (int r = 0; r < 4; ++r) { const int i = 16 * b + 4 * kq + r; acc[r] = isu ? betaS[i] * bf2f(vb[i * 136 + (col & 127)]) : betaS[i] * ebS[i] * bf2f(kb[i * 136 + (col & 127)]); }
#pragma unroll
              for (int ks = 0; ks < (b + 1) / 2; ++ks) acc = MFMA16(*(const LAS bf16x8*)(Lb + (16 * b + c) * 72 + 32 * ks + 8 * kq), *(const LAS bf16x8*)(XT + col * 72 + 32 * ks + 8 * kq), acc);
              const f32x4 x = MFMA16(ta, pack8(acc, z4), z4);
              *(LAS u32x2*)(XT + col * 72 + 16 * b + 4 * kq) = pack4(x);
              if (isu) UFp[(ct * 4 + b) * 64 + lane] = x;
              else { const int ctw = ct - 8;
#pragma unroll
                  for (int r = 0; r < 4; ++r) WF[((size_t)(b * 4 + (ctw >> 1)) * 64 + (c >> 2) * 16 + 4 * kq + r) * 8 + (c & 3) + 4 * (ctw & 1)] = f2bf1(-x[r]); }
          }
      }
    }
    __syncthreads();
}

template <int MODE>
__device__ __forceinline__ void gdn_group_scan(Frame& F, int grp, int h) {
    const int tid = F.tid, lane = F.lane, w = F.wave, c = lane & 15, kq = lane >> 4, n0 = grp * GRP;
    const v4u* WF = (const v4u*)WSP(bf16, WS_WF); const v4u* KDF = (const v4u*)WSP(bf16, WS_KDF); const f32x4* UF = (const f32x4*)WSP(float, WS_UF);
    const float* CDEC = WSP(float, WS_CDEC); bf16* SG = WSP(bf16, WS_SGDN); bf16* DL = WSP(bf16, WS_DELTA);
    {   v4u t[GRP][4];
#pragma unroll
        for (int i = 0; i < GRP; ++i) { const size_t nh = (size_t)((n0 + i) * 4 + h);
#pragma unroll
            for (int j = 0; j < 2; ++j) { t[i][j] = WF[nh * 1024 + tid + 512 * j]; t[i][2 + j] = KDF[nh * 1024 + tid + 512 * j]; } }
#pragma unroll
        for (int i = 0; i < GRP; ++i)
#pragma unroll
            for (int j = 0; j < 2; ++j) { *(LAS v4u*)(F.lds + i * 32768 + (tid + 512 * j) * 16) = t[i][j]; *(LAS v4u*)(F.lds + i * 32768 + 16384 + (tid + 512 * j) * 16) = t[i][2 + j]; } }
    f32x4 S[8], P[8];
    if (MODE == 1) { const f32x4* SST = (const f32x4*)WSP(float, WS_SST) + (size_t)(((grp * 4 + h) * 8 + w) * 8) * 64;
#pragma unroll
        for (int i = 0; i < 8; ++i) S[i] = SST[i * 64 + lane];
    } else {
#pragma unroll
        for (int i = 0; i < 8; ++i) { S[i] = (f32x4){0.f, 0.f, 0.f, 0.f};
#pragma unroll
            for (int r = 0; r < 4; ++r) P[i][r] = ((16 * i + 4 * kq + r) == 16 * w + c) ? 1.f : 0.f; }
    }
    f32x4 u[GRP][4]; float cd[GRP];
#pragma unroll
    for (int i = 0; i < GRP; ++i) { const size_t nh = (size_t)((n0 + i) * 4 + h); cd[i] = CDEC[nh];
#pragma unroll
        for (int mt = 0; mt < 4; ++mt) u[i][mt] = UF[((nh * 8 + w) * 4 + mt) * 64 + lane]; }
    __syncthreads();
#pragma unroll
    for (int i = 0; i < GRP; ++i) {
        const size_t nh = (size_t)((n0 + i) * 4 + h);
        const LAS unsigned char* wl = F.lds + i * 32768 + lane * 16; const LAS unsigned char* kl = wl + 16384;
        if (MODE == 1) { bf16* sg = SG + (nh * 128 + 16 * w + c) * 128 + 4 * kq;
#pragma unroll
            for (int dt = 0; dt < 8; ++dt) *(GAS u32x2*)(sg + 16 * dt) = pack4(S[dt]); }
        f32x4 dl[4], dp[4];
#pragma unroll
        for (int mt = 0; mt < 4; ++mt) { dl[mt] = u[i][mt]; dp[mt] = (f32x4){0.f, 0.f, 0.f, 0.f}; }
#pragma unroll
        for (int ks = 0; ks < 4; ++ks) { const bf16x8 sb = pack8(S[2 * ks], S[2 * ks + 1]); bf16x8 pb; if (MODE == 0) pb = pack8(P[2 * ks], P[2 * ks + 1]);
#pragma unroll
            for (int mt = 0; mt < 4; ++mt) { const bf16x8 a = *(const LAS bf16x8*)(wl + (mt * 4 + ks) * 1024); dl[mt] = MFMA16(a, sb, dl[mt]); if (MODE == 0) dp[mt] = MFMA16(a, pb, dp[mt]); } }
        if (MODE == 1) { bf16* dq = DL + (nh * 128 + 16 * w + c) * 64 + 4 * kq;
#pragma unroll
            for (int mt = 0; mt < 4; ++mt) *(GAS u32x2*)(dq + 16 * mt) = pack4(dl[mt]); }
#pragma unroll
        for (int dt = 0; dt < 8; ++dt) { S[dt] = S[dt] * cd[i]; if (MODE == 0) P[dt] = P[dt] * cd[i]; }
#pragma unroll
        for (int ks2 = 0; ks2 < 2; ++ks2) { const bf16x8 db = pack8(dl[2 * ks2], dl[2 * ks2 + 1]); bf16x8 qb; if (MODE == 0) qb = pack8(dp[2 * ks2], dp[2 * ks2 + 1]);
#pragma unroll
            for (int dt = 0; dt < 8; ++dt) { const bf16x8 a = *(const LAS bf16x8*)(kl + (dt * 2 + ks2) * 1024); S[dt] = MFMA16(a, db, S[dt]); if (MODE == 0) P[dt] = MFMA16(a, qb, P[dt]); } }
    }
    if (MODE == 0) {
        f32x4* SLE = (f32x4*)WSP(float, WS_SLE) + (size_t)(((grp * 4 + h) * 8 + w) * 8) * 64;
#pragma unroll
        for (int dt = 0; dt < 8; ++dt) SLE[dt * 64 + lane] = S[dt];
        bf16* PE = WSP(bf16, WS_PEND) + (size_t)(grp * 4 + h) * 32 * 512; const int ks = w >> 1, lq = (2 * (w & 1) + (c >> 3)) * 16 + 4 * kq, idx = c & 7;
#pragma unroll
        for (int dt = 0; dt < 8; ++dt)
#pragma unroll
            for (int r = 0; r < 4; ++r) PE[((size_t)(dt * 4 + ks) * 64 + lq + r) * 8 + idx] = f2bf1(P[dt][r]);
    }
    __syncthreads();
}
__device__ __forceinline__ void gdn_scan_groups(Frame& F, int h, int s) {
    const int lane = F.lane, w = F.wave, c = lane & 15, kq = lane >> 4;
    LAS bf16* STb = (LAS bf16*)F.lds;
    const bf16x8* PEND = (const bf16x8*)WSP(bf16, WS_PEND); const f32x4* SLE = (const f32x4*)WSP(float, WS_SLE); f32x4* SST = (f32x4*)WSP(float, WS_SST);
    f32x4 S = {0.f, 0.f, 0.f, 0.f};
    *(LAS u32x2*)(STb + c * 136 + 16 * w + 4 * kq) = (u32x2){0u, 0u};
    bf16x8 pe[4], pn[4]; f32x4 sle, sln;
#pragma unroll
    for (int ks = 0; ks < 4; ++ks) pe[ks] = PEND[((size_t)h * 32 + w * 4 + ks) * 64 + lane];
    sle = SLE[(((size_t)h * 8 + s) * 8 + w) * 64 + lane];
    __syncthreads();
    for (int g = 0; g < NGRP; ++g) {
        const size_t gh = (size_t)(g * 4 + h);
        SST[((gh * 8 + s) * 8 + w) * 64 + lane] = S;
        if (g + 1 == NGRP) break;
        { const size_t gh1 = (size_t)((g + 1) * 4 + h);
#pragma unroll
          for (int ks = 0; ks < 4; ++ks) pn[ks] = PEND[(gh1 * 32 + w * 4 + ks) * 64 + lane];
          sln = SLE[((gh1 * 8 + s) * 8 + w) * 64 + lane]; }
        const LAS bf16* st = STb + (g & 1) * 16 * 136 + c * 136 + 8 * kq;
        f32x4 acc = sle;
#pragma unroll
        for (int ks = 0; ks < 4; ++ks) acc = MFMA16(pe[ks], *(const LAS bf16x8*)(st + 32 * ks), acc);
        S = acc;
        *(LAS u32x2*)(STb + ((g + 1) & 1) * 16 * 136 + c * 136 + 16 * w + 4 * kq) = pack4(S);
#pragma unroll
        for (int ks = 0; ks < 4; ++ks) pe[ks] = pn[ks];
        sle = sln;
        __syncthreads();
    }
    __syncthreads();
}
template <int MODE>
__device__ __forceinline__ void gla_scan_range(Frame& F, int grp, int gid) {
    const int h = gid >> 11, rem = gid & 2047, e = rem >> 4, dg = rem & 15, n0 = grp * GRP;
    const float* KVT = WSP(float, WS_KVT); const float* DV = WSP(float, WS_DVEC); bf16* SG = WSP(bf16, WS_SGLA);
    f32x4 kv[GRP], dv[GRP];
#pragma unroll
    for (int i = 0; i < GRP; ++i) { const size_t nh = (size_t)((n0 + i) * 4 + h); kv[i] = *(const GAS f32x4*)(KVT + (nh * 128 + e) * 64 + 4 * dg); dv[i] = *(const GAS f32x4*)(DV + nh * 64 + 4 * dg); }
    f32x4 S = {0.f, 0.f, 0.f, 0.f}, P = {1.f, 1.f, 1.f, 1.f};
    if (MODE == 1) S = *((const GAS f32x4*)WSP(float, WS_GSST) + (size_t)grp * 8192 + gid);
#pragma unroll
    for (int i = 0; i < GRP; ++i) { const size_t nh = (size_t)((n0 + i) * 4 + h);
        if (MODE == 1) *(GAS u32x2*)(SG + (nh * 128 + e) * 64 + 4 * dg) = pack4(S);
        S = dv[i] * S + kv[i]; if (MODE == 0) P = P * dv[i]; }
    if (MODE == 0) { *((GAS f32x4*)WSP(float, WS_GSLE) + (size_t)grp * 8192 + gid) = S; *((GAS f32x4*)WSP(float, WS_GPD) + (size_t)grp * 8192 + gid) = P; }
}
__device__ __forceinline__ void gla_scan_groups(Frame& F, int gid) {
    f32x4 S = {0.f, 0.f, 0.f, 0.f};
    for (int g0 = 0; g0 < NGRP; g0 += 16) {
        f32x4 sl[16], pd[16];
#pragma unroll
        for (int g = 0; g < 16; ++g) { sl[g] = *((const GAS f32x4*)WSP(float, WS_GSLE) + (size_t)(g0 + g) * 8192 + gid); pd[g] = *((const GAS f32x4*)WSP(float, WS_GPD) + (size_t)(g0 + g) * 8192 + gid); }
#pragma unroll
        for (int g = 0; g < 16; ++g) { *((GAS f32x4*)WSP(float, WS_GSST) + (size_t)(g0 + g) * 8192 + gid) = S; S = pd[g] * S + sl[g]; }
    }
}

__device__ __forceinline__ void route_phase(Frame& F, int rep) {
    LAS float* WrT = (LAS float*)(F.lds + RING_OFF);
    const int tid = F.tid, lane = F.lane;
    for (int idx = tid; idx < 8192; idx += 512) { const int d = idx & 1023, e4 = (idx >> 10) * 4; const f32x4 v = *(const GAS f32x4*)(F.in[13] + (size_t)d * 32 + e4);
        WrT[(e4 + 0) * 1024 + d] = v[0]; WrT[(e4 + 1) * 1024 + d] = v[1]; WrT[(e4 + 2) * 1024 + d] = v[2]; WrT[(e4 + 3) * 1024 + d] = v[3]; }
    __syncthreads();
    const float brt = F.in[14][lane >> 1];
    unsigned* cnt = (unsigned*)(F.ctl + CW_CNT) + rep * 32;
    LAS int* lcnt = (LAS int*)(F.lds + ROUTE_OFF); LAS int* gbase = lcnt + 32; LAS int* te = lcnt + 64; LAS int* ts = te + 256; LAS float* tg = (LAS float*)(ts + 256);
    const size_t roff = (size_t)rep * (WS_PROJ - WS_TOKE), xoff = (size_t)rep * (WS_PROJ + 8 * MiB - WS_XN);
    for (int blk = F.vcu; blk < T / 64; blk += F.G) {
    if (tid < 32) lcnt[tid] = 0;
    __syncthreads();
    for (int ti = 0; ti < 8; ++ti) {
        const int tl = F.wave * 8 + ti, t = blk * 64 + tl;
        const GAS f32x4* xr = (const GAS f32x4*)(F.out + (size_t)t * D) + lane; const GAS f32x4* gr = (const GAS f32x4*)F.in[12] + lane;
        f32x4 v[4]; float s = 0.f;
#pragma unroll
        for (int j = 0; j < 4; ++j) { v[j] = xr[64 * j]; s += (v[j].x * v[j].x + v[j].y * v[j].y) + (v[j].z * v[j].z + v[j].w * v[j].w); }
        const float rstd = 1.f / sqrtf(wave_sum(s) * (1.f / D) + EPS);
        GAS unsigned* o8 = (GAS unsigned*)(WSP(unsigned char, WS_XN + xoff) + (size_t)t * D) + lane;
#pragma unroll
        for (int j = 0; j < 4; ++j) { const f32x4 gg = gr[64 * j]; v[j].x *= rstd * gg.x; v[j].y *= rstd * gg.y; v[j].z *= rstd * gg.z; v[j].w *= rstd * gg.w; o8[64 * j] = pg8::cvt4_fp8(v[j].x, v[j].y, v[j].z, v[j].w); }
        float p[32];
#pragma unroll
        for (int e = 0; e < 32; ++e) { float a = 0.f;
#pragma unroll
            for (int j = 0; j < 4; ++j) { const f32x4 wv = *(const LAS f32x4*)(WrT + e * 1024 + 4 * lane + 256 * j); a += (v[j].x * wv.x + v[j].y * wv.y) + (v[j].z * wv.z + v[j].w * wv.w); }
            p[e] = a; if ((e & 3) == 3) __builtin_amdgcn_sched_barrier(0); }
        float q16[16], q8[8], q4[4], q2[2], q1;
        { const bool hi = lane & 32;
#pragma unroll
            for (int k = 0; k < 16; ++k) { const float send = hi ? p[k] : p[k + 16], keep = hi ? p[k + 16] : p[k]; q16[k] = keep + __shfl_xor(send, 32); } }
        { const bool hi = lane & 16;
#pragma unroll
            for (int k = 0; k < 8; ++k) { const float send = hi ? q16[k] : q16[k + 8], keep = hi ? q16[k + 8] : q16[k]; q8[k] = keep + __shfl_xor(send, 16); } }
        { const bool hi = lane & 8;
#pragma unroll
            for (int k = 0; k < 4; ++k) { const float send = hi ? q8[k] : q8[k + 4], keep = hi ? q8[k + 4] : q8[k]; q4[k] = keep + __shfl_xor(send, 8); } }
        { const bool hi = lane & 4;
#pragma unroll
            for (int k = 0; k < 2; ++k) { const float send = hi ? q4[k] : q4[k + 2], keep = hi ? q4[k + 2] : q4[k]; q2[k] = keep + __shfl_xor(send, 4); } }
        { const bool hi = lane & 2; const float send = hi ? q2[0] : q2[1], keep = hi ? q2[1] : q2[0]; q1 = keep + __shfl_xor(send, 2); }
        q1 += __shfl_xor(q1, 1);
        const float mylogit = q1 + brt;
        float lg[32];
#pragma unroll
        for (int e = 0; e < 32; ++e) lg[e] = __shfl(mylogit, 2 * e);
        unsigned used = 0u; int sel[4]; float val[4];
#pragma unroll
        for (int k = 0; k < 4; ++k) { float best = -3.0e38f; int bi = 0;
#pragma unroll
            for (int e = 0; e < 32; ++e) { const bool ok = (lg[e] > best) && !((used >> e) & 1u); best = ok ? lg[e] : best; bi = ok ? e : bi; }
            sel[k] = bi; val[k] = best; used |= 1u << bi; }
        const float e1 = __expf(val[1] - val[0]), e2 = __expf(val[2] - val[0]), e3 = __expf(val[3] - val[0]); const float inv = 1.f / (1.f + e1 + e2 + e3);
        if (lane < 4) { const int ek = lane == 0 ? sel[0] : (lane == 1 ? sel[1] : (lane == 2 ? sel[2] : sel[3])); const float gk = (lane == 0 ? 1.f : (lane == 1 ? e1 : (lane == 2 ? e2 : e3))) * inv;
            const int ls = __hip_atomic_fetch_add(lcnt + ek, 1, __ATOMIC_RELAXED, __HIP_MEMORY_SCOPE_WORKGROUP);
            te[tl * 4 + lane] = ek; ts[tl * 4 + lane] = ls; tg[tl * 4 + lane] = gk; }
    }
    __syncthreads();
    if (tid < 32) gbase[tid] = (int)atomicAdd(cnt + tid * 64, (unsigned)lcnt[tid]);
    __syncthreads();
    if (tid < 256) { const int t = blk * 64 + (tid >> 2), k = tid & 3, e = te[tid];
        WSP(int, WS_TOKE + roff)[t * 4 + k] = e; WSP(int, WS_TOKS + roff)[t * 4 + k] = gbase[e] + ts[tid]; WSP(float, WS_TOKG + roff)[t * 4 + k] = tg[tid]; }
    __syncthreads();
    }
}
__device__ __forceinline__ void moe_tables(Frame& F) {
    LAS int* tile_e = (LAS int*)(F.lds + TILEE_OFF); LAS int* baseL = (LAS int*)(F.lds + BASE_OFF);
    if (F.tid < 64) { const int e = F.lane & 31; const unsigned c = __hip_atomic_load((unsigned*)(F.ctl + CW_CNT) + e * 64, RLX_AGENT);
        const int nt = (int)((c + 255u) >> 8); int incl = nt;
#pragma unroll
        for (int off = 1; off < 32; off <<= 1) { const int v = __shfl_up(incl, off); if ((F.lane & 31) >= off) incl += v; }
        const int tb = incl - nt;
        if (F.lane < 32) { baseL[e] = tb * 256; for (int i = 0; i < nt; ++i) tile_e[tb + i] = e; if (e == 31) tile_e[319] = incl; } }
    __syncthreads();
}
__device__ __forceinline__ void scatter_phase(Frame& F) {
    moe_tables(F);
    LAS int* baseL = (LAS int*)(F.lds + BASE_OFF);
    const int gw = F.vcu * NWAVES + F.wave, NGW = F.G * NWAVES, lane = F.lane;
    for (int t = gw; t < T; t += NGW) {
        int pos = 0;
        if (lane < 4) { const int e = WSP(int, WS_TOKE)[t * 4 + lane], sl = WSP(int, WS_TOKS)[t * 4 + lane]; pos = baseL[e] + sl; WSP(int, WS_TOKP)[t * 4 + lane] = pos; WSP(float, WS_GPOS)[pos] = WSP(float, WS_TOKG)[t * 4 + lane]; }
        const v4u a = *((const GAS v4u*)(WSP(unsigned char, WS_XN) + (size_t)t * D) + lane);
#pragma unroll
        for (int k = 0; k < 4; ++k) { const int pk = __shfl(pos, k); *((GAS v4u*)(WSP(unsigned char, WS_XS) + (size_t)pk * D) + lane) = a; }
    }
}
__device__ __forceinline__ void combine_phase(Frame& F, int rep) {
    const int gw = F.vcu * NWAVES + F.wave, NGW = F.G * NWAVES, lane = F.lane;
    for (int t = gw; t < T; t += NGW) {
        GAS f32x4* xr = (GAS f32x4*)(F.out + (size_t)t * D) + lane;
        GAS f32x4* xw = rep ? (GAS f32x4*)(WSP(float, WS_PROJ) + (size_t)t * D) + lane : xr;
        const size_t xoff = (size_t)rep * (WS_PROJ + 64 * MiB - WS_XN), poff = (size_t)rep * (WS_PROJ + 100 * MiB - WS_PERSTD);
        f32x4 v[4];
#pragma unroll
        for (int j = 0; j < 4; ++j) v[j] = xr[64 * j];
#pragma unroll
        for (int k = 0; k < 4; ++k) { const int pk = WSP(int, WS_TOKP)[t * 4 + k]; const GAS u32x2* yr = (const GAS u32x2*)(WSP(bf16, WS_YS) + (size_t)pk * D) + lane;
#pragma unroll
            for (int j = 0; j < 4; ++j) { const u32x2 w = yr[64 * j]; v[j].x += bflo(w.x); v[j].y += bfhi(w.x); v[j].z += bflo(w.y); v[j].w += bfhi(w.y); } }
        float s = 0.f;
#pragma unroll
        for (int j = 0; j < 4; ++j) { xw[64 * j] = v[j]; s += (v[j].x * v[j].x + v[j].y * v[j].y) + (v[j].z * v[j].z + v[j].w * v[j].w); }
        const float rstd = 1.f / sqrtf(wave_sum(s) * (1.f / D) + EPS);
        const GAS f32x4* gr = (const GAS f32x4*)F.in[19] + lane; GAS u32x2* o8 = (GAS u32x2*)(WSP(bf16, WS_XN + xoff) + (size_t)t * D) + lane;
#pragma unroll
        for (int j = 0; j < 4; ++j) { const f32x4 gg = gr[64 * j]; f32x4 a = {v[j].x * rstd * gg.x, v[j].y * rstd * gg.y, v[j].z * rstd * gg.z, v[j].w * rstd * gg.w}; o8[64 * j] = pack4(a); }
        const GAS u32x2* pr = (const GAS u32x2*)(WSP(bf16, WS_PERAW) + (size_t)t * D) + lane; float ps = 0.f;
#pragma unroll
        for (int j = 0; j < 4; ++j) { const u32x2 w = pr[64 * j]; const float a = bflo(w.x), b = bfhi(w.x), c = bflo(w.y), d = bfhi(w.y); ps += (a * a + b * b) + (c * c + d * d); }
        ps = wave_sum(ps);
        if (lane == 0) WSP(float, WS_PERSTD + poff)[t] = 1.f / sqrtf(ps * (1.f / D) + EPS);
    }
}
__device__ __forceinline__ void final_phase(Frame& F, int rep) {
    const int gw = F.vcu * NWAVES + F.wave, NGW = F.G * NWAVES, lane = F.lane;
    for (int t = gw; t < T; t += NGW) {
        GAS f32x4* xr = (GAS f32x4*)(F.out + (size_t)t * D) + lane; const GAS f32x4* gr = (const GAS f32x4*)F.in[23] + lane;
        f32x4 v[4]; float s = 0.f;
#pragma unroll
        for (int j = 0; j < 4; ++j) { v[j] = xr[64 * j]; s += (v[j].x * v[j].x + v[j].y * v[j].y) + (v[j].z * v[j].z + v[j].w * v[j].w); }
        const float rstd = 1.f / sqrtf(wave_sum(s) * (1.f / D) + EPS);
        GAS f32x4* xw = rep ? (GAS f32x4*)(WSP(float, WS_PROJ) + (size_t)t * D) + lane : xr;
#pragma unroll
        for (int j = 0; j < 4; ++j) { const f32x4 gg = gr[64 * j]; xw[64 * j] = (f32x4){v[j].x * rstd * gg.x, v[j].y * rstd * gg.y, v[j].z * rstd * gg.z, v[j].w * rstd * gg.w}; }
    }
}

constexpr int NPH = 13;
struct Args { const float* in[24]; float* out; unsigned char* ws; int ph_lo, ph_hi; };
static_assert(sizeof(Args) == 24 * 8 + 8 + 8 + 8, "Args has no padding");
__global__ void __launch_bounds__(NWAVES * 64, 2) fwd_kernel(Args args) {
    extern __shared__ __attribute__((aligned(16))) unsigned char lds[];
    Frame F;
    F.lds = (LAS unsigned char*)lds;
    F.MISC = (volatile LAS unsigned*)(F.lds + MISC_OFF);
    F.tid = threadIdx.x; F.lane = F.tid & 63; F.wave = __builtin_amdgcn_readfirstlane(F.tid >> 6);
    F.G = gridDim.x; { const int bx = blockIdx.x; F.vcu = (F.G % 8 == 0) ? (bx % 8) * (F.G / 8) + bx / 8 : bx; }
    F.ws = args.ws; F.ctl = (gu32*)(args.ws + WS_CTL); F.out = args.out;
#pragma unroll
    for (int i = 0; i < 24; ++i) F.in[i] = args.in[i];
    for (int u = F.tid; u < (LDS_BYTES - LDSCTL_OFF) / 4; u += NWAVES * 64) ((LAS unsigned*)(F.lds + LDSCTL_OFF))[u] = 0u;
    __syncthreads();
    const int lo = args.ph_lo, hi = args.ph_hi;
    XcdBarrier bar; bar.bar = (unsigned*)(F.ctl + CW_BAR); bar.x = 0; bar.st = nullptr;
    bar = xcd_barrier_post((unsigned*)(F.ctl + CW_BAR), F.MISC + 8);
#define IN(k) (lo <= (k) && (k) < hi && !((MK_SKIP >> (k)) & 1))
#define SEAM(k) do { if ((lo <= (k)) && ((k) + 1 < hi)) xcd_barrier(bar); } while (0)

    if (IN(0)) { for (int rep_ = 0; rep_ <= ((MK_REP >> 0) & 1); ++rep_) { p0_prologue(F); } SEAM(0); }
    if (IN(1)) { for (int rep_ = 0; rep_ <= ((MK_REP >> 1) & 1); ++rep_) {
        { pg8::Gemm g{WSP(bf16, WS_XN), WSP(bf16, WS_WIN), T, LDP, D}; pg8::StaticOrder S; S.init(T, LDP, F.G, (int)blockIdx.x);
          pg8::EpiBf16P E{WSP(bf16, WS_PROJ), LDP};
          pg8::gemm_phase<pg8::EpiBf16P, pg8::StaticOrder, true, true>(F.lds + RING_OFF, g, S, E); }
        { pg8::Gemm g{WSP(bf16, WS_PB), WSP(bf16, WS_WPP), T, D, PLE}; pg8::StaticOrder S; S.init(T, D, F.G, (int)blockIdx.x);
          pg8::EpiBf16P E{WSP(bf16, WS_PERAW), D};
          pg8::gemm_phase<pg8::EpiBf16P, pg8::StaticOrder, true, true>(F.lds + RING_OFF, g, S, E); }
        }
        SEAM(1);
    }
    if (IN(2)) { for (int rep_ = 0; rep_ <= ((MK_REP >> 2) & 1); ++rep_) {
        for (int i = blockIdx.x; i < NCH * 8; i += F.G) { const int n = i >> 3, hh = (i + (i >> 8)) & 7;
            if (hh < 4) { if (!(MK_DBG & 1)) gla_prep_item(F, n, hh); } else gdn_prep_item(F, n, hh - 4); }
        }
        SEAM(2);
    }
    if (IN(3)) { for (int rep_ = 0; rep_ <= ((MK_REP >> 3) & 1); ++rep_) {
        for (int r3_ = 0; r3_ <= ((MK_REP >> 13) & 1); ++r3_) {
        for (int it = F.vcu; it < NGRP * 4; it += F.G) gdn_group_scan<0>(F, it >> 2, it & 3);
        for (int id = F.vcu * 8 + F.wave; id < NGRP * 128; id += F.G * 8) gla_scan_range<0>(F, id >> 7, (id & 127) * 64 + F.lane); }
        xcd_barrier(bar);
        for (int r3_ = 0; r3_ <= ((MK_REP >> 14) & 1); ++r3_) {
        if (F.vcu < 32) gdn_scan_groups(F, F.vcu >> 3, F.vcu & 7);
        else if (F.vcu < 160 && F.wave == 0) gla_scan_groups(F, (F.vcu - 32) * 64 + F.lane); }
        xcd_barrier(bar);
        for (int r3_ = 0; r3_ <= ((MK_REP >> 15) & 1); ++r3_) {
        for (int it = F.vcu; it < NGRP * 4; it += F.G) gdn_group_scan<1>(F, it >> 2, it & 3);
        for (int id = F.vcu * 8 + F.wave; id < NGRP * 128; id += F.G * 8) gla_scan_range<1>(F, id >> 7, (id & 127) * 64 + F.lane); }
        }
        SEAM(3);
    }
    if (IN(4)) { for (int rep_ = 0; rep_ <= ((MK_REP >> 4) & 1); ++rep_) {
        for (int i = blockIdx.x; i < NCH * 8; i += F.G) { const int n = i >> 3, hh = (i + (i >> 8)) & 7;
            if (hh < 4) gla_out_item(F, n, hh); else gdn_out_item(F, n, hh - 4); }
        }
        SEAM(4);
    }
    if (IN(5)) { for (int rep_ = 0; rep_ <= ((MK_REP >> 5) & 1); ++rep_) {
        pg8::Gemm g{WSP(bf16, WS_MIX), WSP(bf16, WS_WOUT), T, D, D}; pg8::StaticOrder S; S.init(T, D, F.G, (int)blockIdx.x);
        pg8::EpiResF32 E{F.in[0], F.out, D};
        pg8::gemm_phase<pg8::EpiResF32, pg8::StaticOrder, true, true>(F.lds + RING_OFF, g, S, E);
        }
        SEAM(5);
    }
    if (IN(6)) { for (int rep_ = 0; rep_ <= ((MK_REP >> 6) & 1); ++rep_) { route_phase(F, rep_); } SEAM(6); }
    if (IN(7)) { for (int rep_ = 0; rep_ <= ((MK_REP >> 7) & 1); ++rep_) { scatter_phase(F); } SEAM(7); }
    if (IN(8)) { for (int rep_ = 0; rep_ <= ((MK_REP >> 8) & 1); ++rep_) {
        moe_tables(F);
        const LAS int* tile_e = (const LAS int*)(F.lds + TILEE_OFF); const int ntiles = __builtin_amdgcn_readfirstlane(tile_e[319]);
        pg8::Gemm g{WSP(bf16, WS_XS), WSP(bf16, WS_W1), XS_ROWS, 2048, D / 2}; pg8::MoeOrder S{tile_e, ntiles, 8, F.G, (int)blockIdx.x};
        pg8::EpiMoeAct E{WSP(bf16, WS_HS), F.in[16]};
        pg8::gemm_phase<pg8::EpiMoeAct, pg8::MoeOrder, true, true, true>(F.lds + RING_OFF, g, S, E);
        }
        SEAM(8);
    }
    if (IN(9)) { for (int rep_ = 0; rep_ <= ((MK_REP >> 9) & 1); ++rep_) {
        moe_tables(F);
        const LAS int* tile_e = (const LAS int*)(F.lds + TILEE_OFF); const int ntiles = __builtin_amdgcn_readfirstlane(tile_e[319]);
        pg8::Gemm g{WSP(bf16, WS_HS), WSP(bf16, WS_W2), XS_ROWS, D, D / 2}; pg8::MoeOrder S{tile_e, ntiles, 4, F.G, (int)blockIdx.x};
        pg8::EpiMoeDown E{WSP(bf16, WS_YS), F.in[18], WSP(float, WS_GPOS)};
        pg8::gemm_phase<pg8::EpiMoeDown, pg8::MoeOrder, true, true, true>(F.lds + RING_OFF, g, S, E);
        }
        SEAM(9);
    }
    if (IN(10)) { for (int rep_ = 0; rep_ <= ((MK_REP >> 10) & 1); ++rep_) { combine_phase(F, rep_); } SEAM(10); }
    if (IN(11)) { for (int rep_ = 0; rep_ <= ((MK_REP >> 11) & 1); ++rep_) {
        pg8::Gemm g{WSP(bf16, WS_XN), WSP(bf16, WS_WPG), T, D, D}; pg8::StaticOrder S; S.init(T, D, F.G, (int)blockIdx.x);
        pg8::EpiPle E{F.out, WSP(bf16, WS_PERAW), WSP(float, WS_PERSTD), F.in[22]};
        pg8::gemm_phase<pg8::EpiPle, pg8::StaticOrder, true, true>(F.lds + RING_OFF, g, S, E);
        }
        SEAM(11);
    }
    if (IN(12)) { for (int rep_ = 0; rep_ <= ((MK_REP >> 12) & 1); ++rep_) { final_phase(F, rep_); } }
#undef IN
#undef SEAM
}

extern "C" void kernel_launch(void* const* d_in, const int* in_sizes, int n_in, void* d_out, int out_size, void* d_ws, size_t ws_size, hipStream_t stream) {
    static int grid = 0;
    if (grid == 0) {
        if (n_in != 24 || in_sizes[0] != T * D || out_size != T * D || ws_size < WS_END) { fprintf(stderr, "kernel_launch: unexpected shapes (n_in %d, in0 %d, out %d, ws %zu); nothing launched\n", n_in, n_in > 0 ? in_sizes[0] : -1, out_size, ws_size); grid = -1; return; }
        int dev = 0, cus = 0;
        if (hipGetDevice(&dev) != hipSuccess || hipDeviceGetAttribute(&cus, hipDeviceAttributeMultiprocessorCount, dev) != hipSuccess) { grid = -1; return; }
        if (hipFuncSetAttribute((const void*)fwd_kernel, hipFuncAttributeMaxDynamicSharedMemorySize, LDS_BYTES) != hipSuccess) { fprintf(stderr, "kernel_launch: hipFuncSetAttribute failed\n"); grid = -1; return; }
        int per_cu = 0;
        if (hipOccupancyMaxActiveBlocksPerMultiprocessor(&per_cu, (const void*)fwd_kernel, NWAVES * 64, LDS_BYTES) != hipSuccess || per_cu < 1) fprintf(stderr, "kernel_launch: occupancy query reports %d blocks per CU\n", per_cu);
        (void)hipGetLastError();
        grid = cus;
    }
    if (grid < 0) return;
    if (hipMemsetAsync((char*)d_ws + WS_CTL, 0, CTL_ZERO_BYTES, stream) != hipSuccess) return;
    Args a{};
    for (int i = 0; i < 24; ++i) a.in[i] = (const float*)d_in[i];
    a.out = (float*)d_out; a.ws = (unsigned char*)d_ws;
#if MK_ONE_LAUNCH
    a.ph_lo = 0; a.ph_hi = NPH;
    hipLaunchKernelGGL(fwd_kernel, dim3(grid), dim3(NWAVES * 64), LDS_BYTES, stream, a);
#else
    for (int p = 0; p < NPH; ++p) { a.ph_lo = p; a.ph_hi = p + 1; hipLaunchKernelGGL(fwd_kernel, dim3(grid), dim3(NWAVES * 64), LDS_BYTES, stream, a); }
#endif
}
```

```cpp
#include <hip/hip_runtime.h>
#include <cstdio>
#include <cstdint>
#ifndef MK_ONE_LAUNCH
#define MK_ONE_LAUNCH 1
#endif
#ifndef MK_SKIP
#define MK_SKIP 0
#endif
#ifndef MK_DBG
#define MK_DBG 0
#endif
#ifndef MK_REP
#define MK_REP 0
#endif
namespace pg8 {
#define PG8_LAS __attribute__((address_space(3)))
typedef unsigned short bf16_t;
typedef short bf16x8 __attribute__((ext_vector_type(8)));
typedef float f32x4 __attribute__((ext_vector_type(4)));
typedef unsigned u32x4 __attribute__((ext_vector_type(4)));
constexpr int BM = 256, BK = 64, HALF = 128, HTB = HALF * BK * 2  , STAGE_BYTES = 8 * HTB, NXCD = 8, WGM = 8;

__host__ __device__ __forceinline__ int lds_byte(int r, int c) { const int st = (r >> 4) * 2 + (c >> 5), rr = r & 15, cc = c & 31, ob = rr * 64 + cc * 2; return st * 1024 + (ob ^ (((ob >> 9) & 1) << 5)); }
__host__ __device__ __forceinline__ void stage_rc(int b, int& R, int& C) { const int st = b / 1024, sb = b % 1024, swz = sb ^ (((sb >> 9) & 1) << 5); R = (st >> 1) * 16 + swz / 64; C = (st & 1) * 32 + (swz % 64) / 2; }
__host__ __device__ __forceinline__ int perm32(int rho) { const int n = rho >> 4, i = rho & 15; return 8 * (i >> 2) + 4 * n + (i & 3); }

struct Unit { int pm, pn, pb, e; };
struct Gemm { const bf16_t* A; const bf16_t* Bt; int M, N, K; };

struct StaticOrder {
    int nM, nN, nwg, G, c;
    __host__ __device__ void init(int M, int N, int G_, int c_) { nM = M / BM; nN = N / BM; nwg = nM * nN; G = G_; c = c_; }
    __host__ __device__ bool next(int i, Unit& u) const {
        const long L = (long)i * G + c; if (L >= nwg) return false;
        int wgid = (int)L; { const int q = nwg / NXCD, r = nwg % NXCD, xcd = wgid % NXCD, off = wgid / NXCD; wgid = (xcd < r ? xcd * (q + 1) : r * (q + 1) + (xcd - r) * q) + off; }
        const int nig = WGM * nN, gid = wgid / nig, fm = gid * WGM, gsz = (nM - fm) < WGM ? (nM - fm) : WGM;
        u.pm = fm + ((wgid % nig) % gsz); u.pn = (wgid % nig) / gsz; u.pb = u.pn; u.e = 0; return true;
    }
    __device__ __forceinline__ void a_ready(const Unit&) const {}
    __device__ __forceinline__ void done(const Unit&) const {}
};

__device__ __forceinline__ unsigned cvt_pk_bf16(float lo, float hi) { unsigned r; asm volatile("v_cvt_pk_bf16_f32 %0, %1, %2" : "=v"(r) : "v"(lo), "v"(hi)); return r; }

typedef float f32x2 __attribute__((ext_vector_type(2)));
typedef unsigned u32x2 __attribute__((ext_vector_type(2)));
typedef __bf16 bf16x2v __attribute__((ext_vector_type(2)));
__device__ __forceinline__ unsigned cvtpk(float lo, float hi) { f32x2 v = {lo, hi}; bf16x2v b = __builtin_convertvector(v, bf16x2v); return __builtin_bit_cast(unsigned, b); }
typedef int v4i_t __attribute__((ext_vector_type(4)));
typedef int v8i_t __attribute__((ext_vector_type(8)));
__device__ __forceinline__ v8i_t cat16(bf16x8 lo, bf16x8 hi) { return __builtin_shufflevector(__builtin_bit_cast(v4i_t, lo), __builtin_bit_cast(v4i_t, hi), 0, 1, 2, 3, 4, 5, 6, 7); }
__device__ __forceinline__ unsigned cvt4_fp8(float a, float b, float c, float d) { int w = __builtin_amdgcn_cvt_pk_fp8_f32(a, b, 0, false); w = __builtin_amdgcn_cvt_pk_fp8_f32(c, d, w, true); return (unsigned)w; }
__device__ __forceinline__ float sigmoidf_(float x) { return __builtin_amdgcn_rcpf(1.0f + __expf(-x)); }

struct EpiBf16P {
    static constexpr bool PERM = true, AFTER_DRAIN = false;
    bf16_t* O; int ldc;
    __device__ __forceinline__ void operator()(const f32x4 (&acc)[2][2][4][2], const Unit& u, int wr, int wc, int fr, int fq) const {
        const int row0 = u.pm * BM + wr * 64 + fr, col0 = u.pn * BM + wc * 32 + 8 * fq;
#pragma unroll
        for (int ai = 0; ai < 2; ++ai)
#pragma unroll
            for (int m = 0; m < 4; ++m) { bf16_t* rowp = O + (size_t)(row0 + ai * HALF + m * 16) * ldc + col0;
#pragma unroll
                for (int bj = 0; bj < 2; ++bj) { const f32x4 v0 = acc[ai][bj][m][0], v1 = acc[ai][bj][m][1];
                    u32x4 w; w.x = cvtpk(v0[0], v0[1]); w.y = cvtpk(v0[2], v0[3]); w.z = cvtpk(v1[0], v1[1]); w.w = cvtpk(v1[2], v1[3]);
                    *(u32x4*)(rowp + bj * HALF) = w; } }
    }
};
struct EpiResF32 {
    static constexpr bool PERM = false, AFTER_DRAIN = false;
    const float* base; float* out; int ldc;
    __device__ __forceinline__ void operator()(const f32x4 (&acc)[2][2][4][2], const Unit& u, int wr, int wc, int fr, int fq) const {
        const int row0 = u.pm * BM + wr * 64 + fr, col0 = u.pn * BM + wc * 32 + 4 * fq;
#pragma unroll
        for (int ai = 0; ai < 2; ++ai)
#pragma unroll
            for (int m = 0; m < 4; ++m) { const size_t off = (size_t)(row0 + ai * HALF + m * 16) * ldc + col0;
#pragma unroll
                for (int bj = 0; bj < 2; ++bj)
#pragma unroll
                    for (int n = 0; n < 2; ++n) *(f32x4*)(out + off + bj * HALF + n * 16) = *(const f32x4*)(base + off + bj * HALF + n * 16) + acc[ai][bj][m][n]; }
    }
};
struct EpiMoeAct {
    static constexpr bool PERM = true, AFTER_DRAIN = false;
    bf16_t* O; const float* bgu;
    __device__ __forceinline__ void operator()(const f32x4 (&acc)[2][2][4][2], const Unit& u, int wr, int wc, int fr, int fq) const {
        const int row0 = u.pm * BM + wr * 64 + fr, ch0 = u.pn * HALF + wc * 32 + 8 * fq;
        const float* bb = bgu + (size_t)u.e * 2048 + ch0;
        f32x4 bg[2], bu[2];
#pragma unroll
        for (int n = 0; n < 2; ++n) { bg[n] = *(const f32x4*)(bb + 4 * n); bu[n] = *(const f32x4*)(bb + 1024 + 4 * n); }
#pragma unroll
        for (int ai = 0; ai < 2; ++ai)
#pragma unroll
            for (int m = 0; m < 4; ++m) {
                float a[8];
#pragma unroll
                for (int n = 0; n < 2; ++n)
#pragma unroll
                    for (int i = 0; i < 4; ++i) {
                        float g = acc[ai][0][m][n][i] + bg[n][i], up = acc[ai][1][m][n][i] + bu[n][i];
                        g = fminf(g, 7.0f); up = fminf(fmaxf(up, -7.0f), 7.0f);
                        a[n * 4 + i] = (up + 1.0f) * g * sigmoidf_(1.702f * g);
                    }
                u32x2 w; w.x = cvt4_fp8(a[0], a[1], a[2], a[3]); w.y = cvt4_fp8(a[4], a[5], a[6], a[7]);
                *(u32x2*)((unsigned char*)O + (size_t)(row0 + ai * HALF + m * 16) * 1024 + ch0) = w;
            }
    }
};
struct EpiMoeDown {
    static constexpr bool PERM = true, AFTER_DRAIN = false;
    bf16_t* O; const float* bd; const float* gpos;
    __device__ __forceinline__ void operator()(const f32x4 (&acc)[2][2][4][2], const Unit& u, int wr, int wc, int fr, int fq) const {
        const int row0 = u.pm * BM + wr * 64 + fr, col0 = u.pn * BM + wc * 32 + 8 * fq;
        const float* bb = bd + (size_t)u.e * 1024 + col0;
        f32x4 bv[2][2];
#pragma unroll
        for (int bj = 0; bj < 2; ++bj)
#pragma unroll
            for (int n = 0; n < 2; ++n) bv[bj][n] = *(const f32x4*)(bb + bj * HALF + 4 * n);
#pragma unroll
        for (int ai = 0; ai < 2; ++ai)
#pragma unroll
            for (int m = 0; m < 4; ++m) { const int r = row0 + ai * HALF + m * 16; const float gt = gpos[r];
#pragma unroll
                for (int bj = 0; bj < 2; ++bj) { const f32x4 v0 = (acc[ai][bj][m][0] + bv[bj][0]) * gt, v1 = (acc[ai][bj][m][1] + bv[bj][1]) * gt;
                    u32x4 w; w.x = cvtpk(v0[0], v0[1]); w.y = cvtpk(v0[2], v0[3]); w.z = cvtpk(v1[0], v1[1]); w.w = cvtpk(v1[2], v1[3]);
                    *(u32x4*)(O + (size_t)r * 1024 + col0 + bj * HALF) = w; } }
    }
};
struct EpiPle {
    static constexpr bool PERM = false, AFTER_DRAIN = false;
    float* out; const bf16_t* pe; const float* rstd; const float* gpost;
    __device__ __forceinline__ void operator()(const f32x4 (&acc)[2][2][4][2], const Unit& u, int wr, int wc, int fr, int fq) const {
        const int row0 = u.pm * BM + wr * 64 + fr, col0 = u.pn * BM + wc * 32 + 4 * fq;
        f32x4 gp[2][2];
#pragma unroll
        for (int bj = 0; bj < 2; ++bj)
#pragma unroll
            for (int n = 0; n < 2; ++n) gp[bj][n] = *(const f32x4*)(gpost + col0 + bj * HALF + n * 16);
#pragma unroll
        for (int ai = 0; ai < 2; ++ai)
#pragma unroll
            for (int m = 0; m < 4; ++m) { const int r = row0 + ai * HALF + m * 16; const float rs = rstd[r];
#pragma unroll
                for (int bj = 0; bj < 2; ++bj)
#pragma unroll
                    for (int n = 0; n < 2; ++n) { const size_t off = (size_t)r * 1024 + col0 + bj * HALF + n * 16;
                        const u32x2 pw = *(const u32x2*)(pe + off); const f32x4 a = acc[ai][bj][m][n];
                        f32x4 p4; p4[0] = __uint_as_float(pw.x << 16); p4[1] = __uint_as_float(pw.x & 0xffff0000u); p4[2] = __uint_as_float(pw.y << 16); p4[3] = __uint_as_float(pw.y & 0xffff0000u);
                        f32x4 o = *(const f32x4*)(out + off);
#pragma unroll
                        for (int i = 0; i < 4; ++i) o[i] += sigmoidf_(a[i]) * p4[i] * rs * gp[bj][n][i];
                        *(f32x4*)(out + off) = o; } }
    }
};
struct MoeOrder {
    const PG8_LAS int* tile_e; int ntiles, NT, G, c;
    __device__ __forceinline__ bool next(int i, Unit& u) const {
        const int L = (G % 8 == 0) ? i * G + (c & 7) * (G >> 3) + (c >> 3) : i * G + c;
        if (L >= ntiles * NT) return false;
        const int mt = L / NT, nt = L - mt * NT;
        const int e = __builtin_amdgcn_readfirstlane(tile_e[mt]);
        u.pm = mt; u.pn = nt; u.e = e; u.pb = e * NT + nt; return true;
    }
    __device__ __forceinline__ void a_ready(const Unit&) const {}
    __device__ __forceinline__ void done(const Unit&) const {}
};
template <class Epi, class Sched, bool ALIGN_EPI = false, bool SP2 = false, bool FP8 = false>
__device__ __forceinline__ void gemm_phase(PG8_LAS unsigned char* lds, const Gemm g, const Sched& S, const Epi& E) {
    const int tid = threadIdx.x, wid = __builtin_amdgcn_readfirstlane(tid >> 6), lane = tid & 63, wr = wid >> 2, wc = wid & 3, fr = lane & 15, fq = lane >> 4;
    const int K = g.K, nt = K / BK;
    unsigned voffA[2], voffB[2];
#pragma unroll
    for (int i = 0; i < 2; ++i) { int R, C; stage_rc(tid * 16 + i * 8192, R, C); const int Rb = Epi::PERM ? ((R & ~31) + perm32(R & 31)) : R;
        voffA[i] = (unsigned)(R * K + C) * 2u; voffB[i] = (unsigned)(Rb * K + C) * 2u; }
    const size_t kstep = (size_t)(BK * 2);
    const size_t hstep = (size_t)HALF * K * 2;
    const size_t tstep = 2 * hstep;
    const unsigned ldsw = (unsigned)wid * 1024u;
    const int aoff = lds_byte(wr * 64 + fr, fq * 8), boff = lds_byte(wc * 32 + fr, fq * 8);
#define PG8_SA(b, h) (((b) * 2 + (h)) * HTB)
#define PG8_SB(b, h) ((4 + (b) * 2 + (h)) * HTB)
#define PG8_STAGE(bufoff, gbase, voff) do { _Pragma("unroll") for (int _i = 0; _i < 2; ++_i) \
        __builtin_amdgcn_global_load_lds((const unsigned*)((const char*)(gbase) + (voff)[_i]), (PG8_LAS unsigned*)(lds + (bufoff) + ldsw + _i * 8192), 16, 0, 0); } while (0)
#define PG8_LD1(off) (*(const PG8_LAS bf16x8*)(lds + (off)))
#define PG8_LDA(dst, b, h) do { if constexpr (FP8) { _Pragma("unroll") for (int m = 0; m < 4; ++m) dst##8[m] = cat16(PG8_LD1(PG8_SA(b, h) + aoff + m * 2048), PG8_LD1(PG8_SA(b, h) + aoff + m * 2048 + 1024)); } \
        else { _Pragma("unroll") for (int m = 0; m < 4; ++m) _Pragma("unroll") for (int k = 0; k < 2; ++k) dst[m][k] = PG8_LD1(PG8_SA(b, h) + aoff + m * 2048 + k * 1024); } } while (0)
#define PG8_LDB(dst, b, h) do { if constexpr (FP8) { _Pragma("unroll") for (int n = 0; n < 2; ++n) dst##8[n] = cat16(PG8_LD1(PG8_SB(b, h) + boff + n * 2048), PG8_LD1(PG8_SB(b, h) + boff + n * 2048 + 1024)); } \
        else { _Pragma("unroll") for (int n = 0; n < 2; ++n) _Pragma("unroll") for (int k = 0; k < 2; ++k) dst[n][k] = PG8_LD1(PG8_SB(b, h) + boff + n * 2048 + k * 1024); } } while (0)
#define PG8_MMA(ai, bj, At, Bt) do { if constexpr (FP8) __builtin_amdgcn_sched_barrier(0); __builtin_amdgcn_s_setprio(1); _Pragma("unroll") for (int m = 0; m < 4; ++m) _Pragma("unroll") for (int n = 0; n < 2; ++n) { \
        if constexpr (FP8) { acc[ai][bj][m][n] = __builtin_amdgcn_mfma_scale_f32_16x16x128_f8f6f4(Bt##8[n], At##8[m], acc[ai][bj][m][n], 0, 0, 0, 0x79797979, 0, 0x7f7f7f7f); } \
        else { _Pragma("unroll") for (int k = 0; k < 2; ++k) acc[ai][bj][m][n] = __builtin_amdgcn_mfma_f32_16x16x32_bf16(Bt[n][k], At[m][k], acc[ai][bj][m][n], 0, 0, 0); } } \
        if constexpr (FP8) { _Pragma("unroll") for (int m = 0; m < 4; ++m) _Pragma("unroll") for (int n = 0; n < 2; ++n) asm volatile("" : "+v"(acc[ai][bj][m][n])); }     \
        __builtin_amdgcn_s_setprio(0); if constexpr (FP8) __builtin_amdgcn_sched_barrier(0); } while (0)
#define PG8_WAIT_V(n) asm volatile("s_waitcnt vmcnt(" #n ")" ::: "memory")
#define PG8_WAIT_L(n) asm volatile("s_waitcnt lgkmcnt(" #n ")" ::: "memory")
#define PG8_BAR __builtin_amdgcn_s_barrier()
#define PG8_SCHED __builtin_amdgcn_sched_barrier(0)
    Unit cur, nxt; int ui = 0;
    if (!S.next(0, cur)) return;
    f32x4 acc[2][2][4][2];
#pragma unroll
    for (int a = 0; a < 2; ++a)
#pragma unroll
        for (int b = 0; b < 2; ++b)
#pragma unroll
            for (int m = 0; m < 4; ++m)
#pragma unroll
                for (int n = 0; n < 2; ++n) acc[a][b][m][n] = (f32x4){0.f, 0.f, 0.f, 0.f};
    bf16x8 At[4][2], B0[2][2], B1[2][2]; v8i_t At8[4], B08[2], B18[2];
    const char* cA = (const char*)g.A + (size_t)cur.pm * tstep; const char* cB = (const char*)g.Bt + (size_t)cur.pb * tstep;
    S.a_ready(cur);
    if constexpr (SP2) {
        PG8_STAGE(PG8_SB(0, 0), cB, voffB); PG8_STAGE(PG8_SB(0, 1), cB + hstep, voffB); PG8_STAGE(PG8_SA(0, 0), cA, voffA); PG8_STAGE(PG8_SA(0, 1), cA + hstep, voffA);
        if (wr == 1) PG8_BAR;
        PG8_WAIT_V(2); PG8_BAR;
        PG8_STAGE(PG8_SB(1, 0), cB + kstep, voffB); PG8_STAGE(PG8_SA(1, 0), cA + kstep, voffA); PG8_STAGE(PG8_SB(1, 1), cB + hstep + kstep, voffB);
        PG8_WAIT_V(6); PG8_BAR;
    } else {
        PG8_STAGE(PG8_SB(0, 0), cB, voffB); PG8_STAGE(PG8_SA(0, 0), cA, voffA); PG8_STAGE(PG8_SB(0, 1), cB + hstep, voffB); PG8_STAGE(PG8_SA(0, 1), cA + hstep, voffA);
        if (wr == 1) PG8_BAR;
        PG8_WAIT_V(4); PG8_BAR;
        PG8_STAGE(PG8_SB(1, 0), cB + kstep, voffB); PG8_STAGE(PG8_SA(1, 0), cA + kstep, voffA); PG8_STAGE(PG8_SB(1, 1), cB + hstep + kstep, voffB);
        PG8_WAIT_V(6); PG8_BAR;
    }
    for (;;) {
        const bool has_next = S.next(ui + 1, nxt);
        const char* nA = has_next ? (const char*)g.A + (size_t)nxt.pm * tstep : cA; const char* nB = has_next ? (const char*)g.Bt + (size_t)nxt.pb * tstep : cB;
        for (int t = 0; t < nt; t += 2) {
            const bool last = (t == nt - 2);
            const char* a1 = cA + (size_t)(t + 1) * kstep;
            const char* a2 = last ? nA : cA + (size_t)(t + 2) * kstep; const char* b2 = last ? nB : cB + (size_t)(t + 2) * kstep;
            const char* a3 = a2 + kstep; const char* b3 = b2 + kstep;
            if (last && has_next) S.a_ready(nxt);
            if constexpr (SP2) {
            PG8_LDB(B0, 0, 0); PG8_LDB(B1, 0, 1); PG8_SCHED; PG8_LDA(At, 0, 0); PG8_STAGE(PG8_SA(1, 1), a1 + hstep, voffA);
            PG8_WAIT_V(8); PG8_WAIT_L(0); PG8_BAR; PG8_MMA(0, 0, At, B0); PG8_MMA(0, 1, At, B1); PG8_BAR; PG8_SCHED;
            PG8_LDA(At, 0, 1); PG8_STAGE(PG8_SB(0, 0), b2, voffB); PG8_STAGE(PG8_SB(0, 1), b2 + hstep, voffB); PG8_STAGE(PG8_SA(0, 0), a2, voffA);
            PG8_WAIT_V(8); PG8_WAIT_L(0); PG8_BAR; PG8_MMA(1, 0, At, B0); PG8_MMA(1, 1, At, B1); PG8_BAR; PG8_SCHED;
            PG8_LDB(B0, 1, 0); PG8_LDB(B1, 1, 1); PG8_SCHED; PG8_LDA(At, 1, 0); PG8_STAGE(PG8_SA(0, 1), a2 + hstep, voffA);
            PG8_WAIT_V(8); PG8_WAIT_L(0); PG8_BAR; PG8_MMA(0, 0, At, B0); PG8_MMA(0, 1, At, B1); PG8_BAR; PG8_SCHED;
            PG8_LDA(At, 1, 1); PG8_STAGE(PG8_SB(1, 0), b3, voffB); PG8_STAGE(PG8_SB(1, 1), b3 + hstep, voffB); PG8_STAGE(PG8_SA(1, 0), a3, voffA);
            PG8_WAIT_V(8); PG8_WAIT_L(0); PG8_BAR; PG8_MMA(1, 0, At, B0); PG8_MMA(1, 1, At, B1); PG8_BAR; PG8_SCHED;
            } else {
            PG8_LDB(B0, 0, 0); PG8_SCHED; PG8_LDA(At, 0, 0); PG8_STAGE(PG8_SA(1, 1), a1 + hstep, voffA);
            PG8_WAIT_L(8); PG8_BAR; PG8_WAIT_L(0); PG8_MMA(0, 0, At, B0); PG8_BAR; PG8_SCHED;
            PG8_LDB(B1, 0, 1); PG8_STAGE(PG8_SB(0, 0), b2, voffB);
            PG8_BAR; PG8_WAIT_L(0); PG8_MMA(0, 1, At, B1); PG8_BAR;
            PG8_LDA(At, 0, 1); PG8_STAGE(PG8_SA(0, 0), a2, voffA);
            PG8_BAR; PG8_WAIT_L(0); PG8_MMA(1, 0, At, B0); PG8_BAR; PG8_SCHED;
            PG8_STAGE(PG8_SB(0, 1), b2 + hstep, voffB);
            PG8_WAIT_V(6); PG8_BAR; PG8_MMA(1, 1, At, B1); PG8_BAR;
            PG8_LDB(B0, 1, 0); PG8_SCHED; PG8_LDA(At, 1, 0); PG8_STAGE(PG8_SA(0, 1), a2 + hstep, voffA);
            PG8_WAIT_L(8); PG8_BAR; PG8_WAIT_L(0); PG8_MMA(0, 0, At, B0); PG8_BAR; PG8_SCHED;
            PG8_LDB(B1, 1, 1); PG8_STAGE(PG8_SB(1, 0), b3, voffB);
            PG8_BAR; PG8_WAIT_L(0); PG8_MMA(0, 1, At, B1); PG8_BAR;
            PG8_LDA(At, 1, 1); PG8_STAGE(PG8_SA(1, 0), a3, voffA);
            PG8_BAR; PG8_WAIT_L(0); PG8_MMA(1, 0, At, B0); PG8_BAR; PG8_SCHED;
            PG8_STAGE(PG8_SB(1, 1), b3 + hstep, voffB);
            PG8_WAIT_V(6); PG8_BAR; PG8_MMA(1, 1, At, B1); PG8_BAR;
            }
        }
        if constexpr (ALIGN_EPI) { if (wr == 0) PG8_BAR; }
        if constexpr (!Epi::AFTER_DRAIN) { E(acc, cur, wr, wc, fr, fq); S.done(cur); }
        if (!has_next) break;
#pragma unroll
        for (int a = 0; a < 2; ++a)
#pragma unroll
            for (int b = 0; b < 2; ++b)
#pragma unroll
                for (int m = 0; m < 4; ++m)
#pragma unroll
                    for (int n = 0; n < 2; ++n) acc[a][b][m][n] = (f32x4){0.f, 0.f, 0.f, 0.f};
        cur = nxt; cA = nA; cB = nB; ++ui;
        if constexpr (ALIGN_EPI) { if (wr == 1) PG8_BAR; }
    }
    PG8_WAIT_V(0);
    if constexpr (!ALIGN_EPI) { if (wr == 0) PG8_BAR; }
    PG8_BAR;
    if constexpr (Epi::AFTER_DRAIN) { E.fused(acc, cur, wr, wc, fr, fq, lds, wid, lane); S.done(cur); }
#undef PG8_SA
#undef PG8_SB
#undef PG8_STAGE
#undef PG8_LD1
#undef PG8_LDA
#undef PG8_LDB
#undef PG8_MMA
#undef PG8_WAIT_V
#undef PG8_WAIT_L
#undef PG8_BAR
#undef PG8_SCHED
}
}

constexpr int NWAVES = 8;
constexpr int T = 16384, D = 1024, NCH = 256, LDP = 3840, DIN = 3608, PLE = 256, NE = 32;
constexpr int C_GQ = 0, C_GK = 256, C_GV = 512, C_GR = 1024, C_DQ = 1536, C_DZ = 3072, C_GLR = 3584, C_DA = 3600, C_DB = 3604;
constexpr float EPS = 1e-6f;
constexpr int XS_ROWS = 65536 + NE * 256;

constexpr size_t MiB = 1u << 20;
constexpr size_t WS_CTL = 0, CTL_ZERO_BYTES = 1 * MiB;
constexpr size_t WS_WIN = 2 * MiB, WS_WPP = 10 * MiB, WS_WOUT = 11 * MiB, WS_WPG = 13 * MiB, WS_W1 = 16 * MiB, WS_W2 = 80 * MiB;
constexpr size_t WS_XN = 112 * MiB, WS_PB = 144 * MiB, WS_PROJ = 152 * MiB, WS_PERAW = 272 * MiB;
constexpr size_t WS_KVT = 304 * MiB, WS_DVEC = 336 * MiB, WS_SGLA = 337 * MiB, WS_WF = 353 * MiB, WS_KDF = 369 * MiB, WS_UF = 385 * MiB, WS_CDEC = 417 * MiB;
constexpr size_t WS_QDEC = 418 * MiB, WS_AQK = 434 * MiB, WS_SGDN = 442 * MiB, WS_DELTA = 474 * MiB, WS_MIX = 490 * MiB;
constexpr size_t WS_TOKE = 522 * MiB, WS_TOKS = WS_TOKE + 256 * 1024, WS_TOKG = WS_TOKS + 256 * 1024, WS_TOKP = WS_TOKG + 256 * 1024;
constexpr size_t WS_GPOS = 523 * MiB, WS_PERSTD = 524 * MiB, WS_XS = 525 * MiB, WS_HS = 597 * MiB, WS_YS = 669 * MiB;
constexpr size_t WS_PEND = 813 * MiB, WS_SLE = 821 * MiB, WS_SST = 837 * MiB, WS_GSLE = 853 * MiB, WS_GPD = 861 * MiB, WS_GSST = 869 * MiB, WS_END = 877 * MiB;
static_assert(WS_XS + (size_t)XS_ROWS * 1024 <= WS_HS && WS_HS + (size_t)XS_ROWS * 1024 <= WS_YS && WS_YS + (size_t)XS_ROWS * 2048 <= WS_PEND, "d_ws map");
constexpr int GRP = 4, NGRP = NCH / GRP;
constexpr int CW_TMO = 0, CW_CODE = 1, CW_BAR = 4096, CW_CNT = 8192;

constexpr int RING_OFF = 0, RING_BYTES = 131072;
constexpr int LDSCTL_OFF = RING_BYTES, MISC_OFF = LDSCTL_OFF + 320;
constexpr int TILEE_OFF = MISC_OFF + 128;
constexpr int BASE_OFF = TILEE_OFF + 320 * 4;
constexpr int ROUTE_OFF = BASE_OFF + 128;
constexpr int LDS_BYTES = 147456;
static_assert(ROUTE_OFF + 256 + 3072 <= LDS_BYTES, "LDS map");

#define GAS __attribute__((address_space(1)))
#define LAS __attribute__((address_space(3)))
typedef unsigned short bf16;
typedef unsigned v4u __attribute__((ext_vector_type(4)));
typedef float f32x4 __attribute__((ext_vector_type(4)));
typedef short bf16x8 __attribute__((ext_vector_type(8)));
typedef GAS unsigned gu32;
typedef GAS unsigned long long gu64;
#define RLX_AGENT __ATOMIC_RELAXED, __HIP_MEMORY_SCOPE_AGENT
#define LDS_WAIT() asm volatile("s_waitcnt lgkmcnt(0)" ::: "memory")
#define VM_WAIT() asm volatile("s_waitcnt vmcnt(0)" ::: "memory")
__device__ __forceinline__ unsigned long long rt() { return __builtin_amdgcn_s_memrealtime(); }
__device__ __forceinline__ unsigned f2bf(float f) { unsigned u = __builtin_bit_cast(unsigned, f); return (u + 0x7fffu + ((u >> 16) & 1u)) >> 16; }
__device__ __forceinline__ unsigned pk2(float lo, float hi) { return f2bf(lo) | (f2bf(hi) << 16); }

#define XB_TMO      128
#define XB_XCNT(j)  (256  + 64 * (j))
#define XB_XSUB(j)  (1280 + 64 * (j))
#define XB_XGEN(j)  (2304 + 64 * (j))
#define XB_TOP      3328
#define XB_TOPGEN   3392
#define XCD_BAR_WORDS 3456
#define XB_SPIN_CAP (1u << 18)

__device__ __forceinline__ unsigned xb_ld(unsigned* p)              { return __hip_atomic_load(p, __ATOMIC_RELAXED, __HIP_MEMORY_SCOPE_AGENT); }
__device__ __forceinline__ unsigned xb_add(unsigned* p, unsigned v) { return __hip_atomic_fetch_add(p, v, __ATOMIC_RELAXED, __HIP_MEMORY_SCOPE_AGENT); }
__device__ __forceinline__ unsigned xb_xcc_id() { return (unsigned)__builtin_amdgcn_s_getreg((3 << 11) | 20) & 0xFu; }
#define XB_SPIN(cond, bar) do { unsigned _sp = 0; while (cond) { __builtin_amdgcn_s_sleep(1); \
    if ((++_sp & 255u) == 0u) { if (xb_ld(&(bar)[XB_TMO])) break; if (_sp > XB_SPIN_CAP) { atomicAdd(&(bar)[XB_TMO], 1u); break; } } } } while (0)

struct XcdBarrier {
    unsigned* bar; unsigned x;
    volatile LAS unsigned* st;
};

__device__ __forceinline__ XcdBarrier xcd_barrier_post(unsigned* bar, volatile LAS unsigned* st) {
    XcdBarrier b; b.bar = bar; b.x = xb_xcc_id(); b.st = st;
    if (threadIdx.x == 0) (void)xb_add(&bar[XB_XCNT(b.x)], 1u);
    return b;
}
__device__ __forceinline__ void xcd_barrier_complete(unsigned* bar, unsigned x, unsigned& nloc, unsigned& nx) {
    const unsigned G = gridDim.x * gridDim.y * gridDim.z;
    unsigned sum, cnt, mine, sp = 0u;
    for (;;) {
        sum = 0u; cnt = 0u; mine = 0u;
#pragma unroll
        for (unsigned j = 0; j < 16; ++j) { const unsigned c = xb_ld(&bar[XB_XCNT(j)]); sum += c; cnt += (c > 0u) ? 1u : 0u; mine = (j == x) ? c : mine; }
        if (sum == G) break;
        __builtin_amdgcn_s_sleep(1);
        if ((++sp & 255u) == 0u) { if (xb_ld(&bar[XB_TMO])) break; if (sp > XB_SPIN_CAP) { atomicAdd(&bar[XB_TMO], 1u); break; } }
    }
    nloc = mine > 0u ? mine : 1u; nx = cnt > 0u ? cnt : 1u;
}

__device__ __forceinline__ void xcd_barrier(const XcdBarrier& b) {
    asm volatile("s_waitcnt vmcnt(0)" ::: "memory");
    __syncthreads();
    if (threadIdx.x == 0) {
        unsigned* bar = b.bar;
        __builtin_amdgcn_s_waitcnt(0);
        unsigned nloc = b.st[0], nx = b.st[1];
        if (nloc == 0u) { xcd_barrier_complete(bar, b.x, nloc, nx); b.st[0] = nloc; b.st[1] = nx; }
        const unsigned old = xb_add(&bar[XB_XSUB(b.x)], 1u);
        const unsigned gen = old / nloc;
        if (old + 1u == (gen + 1u) * nloc) {
            __builtin_amdgcn_fence(__ATOMIC_RELEASE, "agent");
            asm volatile("s_waitcnt vmcnt(0)" ::: "memory");
            const unsigned og = xb_add(&bar[XB_TOP], 1u);
            const unsigned tg = og / nx;
            if (og + 1u == (tg + 1u) * nx) xb_add(&bar[XB_TOPGEN], 1u);
            else XB_SPIN(xb_ld(&bar[XB_TOPGEN]) == tg, bar);
            __builtin_amdgcn_fence(__ATOMIC_ACQUIRE, "agent");
            xb_add(&bar[XB_XGEN(b.x)], 1u);
            asm volatile("s_waitcnt vmcnt(0)" ::: "memory");
        } else {
            XB_SPIN(xb_ld(&bar[XB_XGEN(b.x)]) == gen, bar);
            __builtin_amdgcn_fence(__ATOMIC_ACQUIRE, "agent");
            asm volatile("s_waitcnt vmcnt(0)" ::: "memory");
        }
    }
    __syncthreads();
}


__device__ __forceinline__ float bflo(unsigned w) { return __uint_as_float(w << 16); }
__device__ __forceinline__ float bfhi(unsigned w) { return __uint_as_float(w & 0xffff0000u); }
__device__ __forceinline__ float bf2f(bf16 h) { return __uint_as_float((unsigned)h << 16); }
using pg8::cvtpk;
__device__ __forceinline__ bf16 f2bf1(float f) { return (bf16)(cvtpk(f, 0.f) & 0xffffu); }
__device__ __forceinline__ float wave_sum(float v) {
#pragma unroll
    for (int o = 1; o < 64; o <<= 1) v += __shfl_xor(v, o);
    return v;
}
__device__ __forceinline__ float sigm(float x) { return __builtin_amdgcn_rcpf(1.0f + __expf(-x)); }
__device__ __forceinline__ float siluf_(float x) { return x * sigm(x); }
__device__ __forceinline__ float softplusf_(float x) { return fmaxf(x, 0.f) + __logf(1.0f + __expf(-fabsf(x))); }
__device__ __forceinline__ float logsigf_(float x) { return fminf(x, 0.f) - __logf(1.0f + __expf(-fabsf(x))); }
#define MFMA16(a, b, c) __builtin_amdgcn_mfma_f32_16x16x32_bf16((a), (b), (c), 0, 0, 0)
typedef short bf16x4 __attribute__((ext_vector_type(4)));
typedef unsigned u32x2 __attribute__((ext_vector_type(2)));
__device__ __forceinline__ bf16x8 cat8(bf16x4 lo, bf16x4 hi) { return __builtin_shufflevector(lo, hi, 0, 1, 2, 3, 4, 5, 6, 7); }
__device__ __forceinline__ bf16x8 pack8(const f32x4& a, const f32x4& b) {
    v4u w; w.x = cvtpk(a[0], a[1]); w.y = cvtpk(a[2], a[3]); w.z = cvtpk(b[0], b[1]); w.w = cvtpk(b[2], b[3]); return __builtin_bit_cast(bf16x8, w);
}
__device__ __forceinline__ u32x2 pack4(const f32x4& a) { u32x2 w; w.x = cvtpk(a[0], a[1]); w.y = cvtpk(a[2], a[3]); return w; }

struct Frame {
    LAS unsigned char* lds;
    volatile LAS unsigned* MISC;
    gu32* ctl;
    int tid, lane, wave;
    int vcu, G;
    unsigned char* ws;
    const float* in[24];
    float* out;
};
#define WSP(T_, off) ((T_*)(F.ws + (off)))

__device__ __forceinline__ void titem_load(const float* W0, size_t wstride, int K, int N, int nblk, int ipm, int it, int lane, f32x4 (&v)[8]) {
    const int m = it / ipm, li = it - m * ipm, kb = li / nblk, nb = li - kb * nblk, k0 = 64 * kb, n0 = 32 * nb, cq = (lane & 7) * 4, rr = lane >> 3;
    const float* W = W0 + (size_t)m * wstride;
#pragma unroll
    for (int i = 0; i < 8; ++i) { v[i] = (f32x4){0.f, 0.f, 0.f, 0.f}; if (n0 + cq < N) v[i] = *(const GAS f32x4*)(W + (size_t)(k0 + 8 * i + rr) * N + n0 + cq); }
}
template <bool FP8, class RowMap>
__device__ __forceinline__ void transpose_set(const float* W0, size_t wstride, unsigned char* WT0, size_t wtstride, int K, int N, int nmat, LAS float* scr, int gw, int NGW, int lane, RowMap rm) {
    const int nblk = (N + 31) >> 5, ipm = (K >> 6) * nblk, total = nmat * ipm;
    int it = gw; if (it >= total) return;
    f32x4 cur[8], nxt[8];
    titem_load(W0, wstride, K, N, nblk, ipm, it, lane, cur);
    for (; it < total; it += NGW) {
        const bool more = it + NGW < total;
        if (more) titem_load(W0, wstride, K, N, nblk, ipm, it + NGW, lane, nxt);
        const int m = it / ipm, li = it - m * ipm, kb = li / nblk, nb = li - kb * nblk, k0 = 64 * kb, n0 = 32 * nb, cq = (lane & 7) * 4, rr = lane >> 3, c = lane & 7;
        const float sc = FP8 ? 64.f : 1.f;
#pragma unroll
        for (int i = 0; i < 8; ++i) { LAS float* s = scr + (8 * i + rr) * 33 + cq; s[0] = cur[i][0] * sc; s[1] = cur[i][1] * sc; s[2] = cur[i][2] * sc; s[3] = cur[i][3] * sc; }
        LDS_WAIT(); asm volatile("" ::: "memory");
        unsigned char* WT = WT0 + (size_t)m * wtstride;
#pragma unroll
        for (int j = 0; j < 4; ++j) { const int n = (lane >> 3) + 8 * j; const LAS float* s = scr + (8 * c) * 33 + n;
            if (n0 + n < N) {
                if (FP8) { u32x2 o; o.x = pg8::cvt4_fp8(s[0 * 33], s[1 * 33], s[2 * 33], s[3 * 33]); o.y = pg8::cvt4_fp8(s[4 * 33], s[5 * 33], s[6 * 33], s[7 * 33]);
                    *(GAS u32x2*)(WT + (size_t)rm(n0 + n) * K + k0 + 8 * c) = o; }
                else { v4u o; o.x = cvtpk(s[0 * 33], s[1 * 33]); o.y = cvtpk(s[2 * 33], s[3 * 33]); o.z = cvtpk(s[4 * 33], s[5 * 33]); o.w = cvtpk(s[6 * 33], s[7 * 33]);
                    *(GAS v4u*)((bf16*)WT + (size_t)rm(n0 + n) * K + k0 + 8 * c) = o; } } }
        LDS_WAIT(); asm volatile("" ::: "memory");
        if (more) {
#pragma unroll
            for (int i = 0; i < 8; ++i) cur[i] = nxt[i]; }
    }
}
__device__ __forceinline__ void titem_load_w(const float* W0, size_t wstride, int N, int nblk, int ipm, int it, int lane, f32x4 (&v)[16]) {
    const int m = it / ipm, li = it - m * ipm, kb = li / nblk, nb = li - kb * nblk, k0 = 64 * kb, n0 = 64 * nb, cq = (lane & 7) * 4, rr = lane >> 3;
    const float* W = W0 + (size_t)m * wstride;
#pragma unroll
    for (int i = 0; i < 8; ++i) { const GAS f32x4* p = (const GAS f32x4*)(W + (size_t)(k0 + 8 * i + rr) * N + n0 + cq); v[2 * i] = p[0]; v[2 * i + 1] = p[8]; }
}
template <class RowMap>
__device__ __forceinline__ void transpose_set_w(const float* W0, size_t wstride, unsigned char* WT0, size_t wtstride, int K, int N, int nmat, LAS float* scr, int gw, int NGW, int lane, RowMap rm) {
    const int nblk = N >> 6, ipm = (K >> 6) * nblk, total = nmat * ipm;
    int it = gw; if (it >= total) return;
    f32x4 cur[16], nxt[16];
    titem_load_w(W0, wstride, N, nblk, ipm, it, lane, cur);
    for (; it < total; it += NGW) {
        const bool more = it + NGW < total;
        if (more) titem_load_w(W0, wstride, N, nblk, ipm, it + NGW, lane, nxt);
        const int m = it / ipm, li = it - m * ipm, kb = li / nblk, nb = li - kb * nblk, k0 = 64 * kb, n0 = 64 * nb, cq = (lane & 7) * 4, rr = lane >> 3, c = lane & 7;
        unsigned char* WT = WT0 + (size_t)m * wtstride;
#pragma unroll
        for (int hf = 0; hf < 2; ++hf) {
#pragma unroll
            for (int i = 0; i < 8; ++i) { LAS float* s = scr + (8 * i + rr) * 33 + cq; const f32x4 x = cur[2 * i + hf]; s[0] = x[0] * 64.f; s[1] = x[1] * 64.f; s[2] = x[2] * 64.f; s[3] = x[3] * 64.f; }
            LDS_WAIT(); asm volatile("" ::: "memory");
#pragma unroll
            for (int j = 0; j < 4; ++j) { const int n = (lane >> 3) + 8 * j; const LAS float* s = scr + (8 * c) * 33 + n;
                u32x2 o; o.x = pg8::cvt4_fp8(s[0 * 33], s[1 * 33], s[2 * 33], s[3 * 33]); o.y = pg8::cvt4_fp8(s[4 * 33], s[5 * 33], s[6 * 33], s[7 * 33]);
                *(GAS u32x2*)(WT + (size_t)rm(n0 + 32 * hf + n) * K + k0 + 8 * c) = o; }
            LDS_WAIT(); asm volatile("" ::: "memory");
        }
        if (more) {
#pragma unroll
            for (int i = 0; i < 16; ++i) cur[i] = nxt[i]; }
    }
}
struct RmId { __device__ __forceinline__ int operator()(int n) const { return n; } };
struct RmWin { __device__ __forceinline__ int operator()(int c) const { return c < 1536 ? c : (c < 1552 ? c + 2048 : (c < 3600 ? c - 16 : c)); } };
struct RmW1 { __device__ __forceinline__ int operator()(int c) const { const int j = c & 1023, up = c >> 10; return (j >> 7) * 256 + up * 128 + (j & 127); } };

__device__ __forceinline__ void rms_row_to_bf16(const float* xrow, const float* g, bf16* orow, int lane) {
    const GAS f32x4* xr = (const GAS f32x4*)xrow + lane; const GAS f32x4* gr = (const GAS f32x4*)g + lane;
    f32x4 v[4]; float s = 0.f;
#pragma unroll
    for (int j = 0; j < 4; ++j) { v[j] = xr[64 * j]; s += (v[j].x * v[j].x + v[j].y * v[j].y) + (v[j].z * v[j].z + v[j].w * v[j].w); }
    const float rstd = 1.f / sqrtf(wave_sum(s) * (1.f / D) + EPS);
    GAS u32x2* o8 = (GAS u32x2*)orow + lane;
#pragma unroll
    for (int j = 0; j < 4; ++j) { const f32x4 gg = gr[64 * j]; u32x2 w; w.x = cvtpk(v[j].x * rstd * gg.x, v[j].y * rstd * gg.y); w.y = cvtpk(v[j].z * rstd * gg.z, v[j].w * rstd * gg.w); o8[64 * j] = w; }
}

__device__ __forceinline__ void p0_prologue(Frame& F) {
    LAS float* scr = (LAS float*)(F.lds + RING_OFF + F.wave * 16384);
    const int gw = F.vcu * NWAVES + F.wave, NGW = F.G * NWAVES, lane = F.lane;
    bf16* Win_t = WSP(bf16, WS_WIN);
    transpose_set<false>(F.in[3], 0, (unsigned char*)Win_t, 0, 1024, DIN, 1, scr, gw, NGW, lane, RmWin());
    for (int r = DIN + gw; r < LDP; r += NGW) { GAS v4u* o = (GAS v4u*)(Win_t + (size_t)r * 1024) + lane; o[0] = (v4u){0, 0, 0, 0}; o[64] = (v4u){0, 0, 0, 0}; }
    transpose_set<false>(F.in[21], 0, WSP(unsigned char, WS_WPP), 0, PLE, D, 1, scr, gw, NGW, lane, RmId());
    transpose_set<false>(F.in[11], 0, WSP(unsigned char, WS_WOUT), 0, D, D, 1, scr, gw, NGW, lane, RmId());
    transpose_set<false>(F.in[20], 0, WSP(unsigned char, WS_WPG), 0, D, D, 1, scr, gw, NGW, lane, RmId());
    transpose_set_w(F.in[15], (size_t)1024 * 2048, WSP(unsigned char, WS_W1), (size_t)2048 * 1024, 1024, 2048, NE, scr, gw, NGW, lane, RmW1());
    transpose_set_w(F.in[17], (size_t)1024 * 1024, WSP(unsigned char, WS_W2), (size_t)1024 * 1024, 1024, 1024, NE, scr, gw, NGW, lane, RmId());
    for (int m0 = gw; m0 < T; m0 += 4 * NGW) {
        f32x4 v[4][4];
#pragma unroll
        for (int q = 0; q < 4; ++q) { const int m = m0 + q * NGW; const GAS f32x4* xr = (const GAS f32x4*)(F.in[0] + (size_t)(m < T ? m : 0) * D) + lane;
#pragma unroll
            for (int j = 0; j < 4; ++j) v[q][j] = xr[64 * j]; }
#pragma unroll
        for (int q = 0; q < 4; ++q) { const int m = m0 + q * NGW; if (m >= T) break;
            float s2 = 0.f;
#pragma unroll
            for (int j = 0; j < 4; ++j) s2 += (v[q][j].x * v[q][j].x + v[q][j].y * v[q][j].y) + (v[q][j].z * v[q][j].z + v[q][j].w * v[q][j].w);
            const float rstd = 1.f / sqrtf(wave_sum(s2) * (1.f / D) + EPS);
            const GAS f32x4* gr = (const GAS f32x4*)F.in[2] + lane; GAS u32x2* o8 = (GAS u32x2*)(WSP(bf16, WS_XN) + (size_t)m * D) + lane;
#pragma unroll
            for (int j = 0; j < 4; ++j) { const f32x4 gg = gr[64 * j]; u32x2 w; w.x = cvtpk(v[q][j].x * rstd * gg.x, v[q][j].y * rstd * gg.y); w.y = cvtpk(v[q][j].z * rstd * gg.z, v[q][j].w * rstd * gg.w); o8[64 * j] = w; } }
    }
    for (int m0 = gw; m0 < T; m0 += 8 * NGW) {
        f32x4 v[8];
#pragma unroll
        for (int q = 0; q < 8; ++q) { const int m = m0 + q * NGW; v[q] = *((const GAS f32x4*)(F.in[1] + (size_t)(m < T ? m : 0) * PLE) + lane); }
#pragma unroll
        for (int q = 0; q < 8; ++q) { const int m = m0 + q * NGW; if (m >= T) break; u32x2 w; w.x = cvtpk(v[q].x, v[q].y); w.y = cvtpk(v[q].z, v[q].w); *((GAS u32x2*)(WSP(bf16, WS_PB) + (size_t)m * PLE) + lane) = w; }
    }
}

constexpr int GL_B = 0, GL_GLR = 16640, GL_T1 = 20992, GL_T2 = 30208, GL_VT = 39424, GL_RED = 57856;
__device__ __forceinline__ void gla_b(Frame& F, int n, int h) {
    LAS float* bL = (LAS float*)(F.lds + GL_B); LAS float* glrL = (LAS float*)(F.lds + GL_GLR);
    const bf16* PROJ = WSP(bf16, WS_PROJ); const int tid = F.tid, t0 = n * 64;
    { const int idx = tid * 2, t = idx >> 4, r = idx & 15; const unsigned w = *(const GAS unsigned*)(PROJ + (size_t)(t0 + t) * LDP + C_GLR + r); glrL[t * 17 + r] = bflo(w); glrL[t * 17 + r + 1] = bfhi(w); }
    const int d = tid & 63, tg = tid >> 6;
    float wg[16];
#pragma unroll
    for (int r = 0; r < 16; ++r) wg[r] = F.in[4][r * 256 + h * 64 + d];
    const float bias = F.in[5][h * 64 + d];
    __syncthreads();
#pragma unroll
    for (int tt = 0; tt < 8; ++tt) { const int t = tg * 8 + tt; float a = bias;
#pragma unroll
        for (int r = 0; r < 16; ++r) a += glrL[t * 17 + r] * wg[r];
        bL[t * 65 + d] = logsigf_(a) * 0.0625f; }
    __syncthreads();
    if (tid < 64) { float run = 0.f;
#pragma unroll 16
        for (int t = 0; t < 64; ++t) { run += bL[t * 65 + tid]; bL[t * 65 + tid] = run; } }
    __syncthreads();
}
__device__ __forceinline__ void gla_load_vT(Frame& F, int n, int h) {
    LAS bf16* vT = (LAS bf16*)(F.lds + GL_VT); const bf16* PROJ = WSP(bf16, WS_PROJ);
    const int t = F.tid >> 3, eg = F.tid & 7;
    const GAS v4u* src = (const GAS v4u*)(PROJ + (size_t)(n * 64 + t) * LDP + C_GV + h * 128 + eg * 16);
#pragma unroll
    for (int half = 0; half < 2; ++half) { const v4u w = src[half];
#pragma unroll
        for (int i = 0; i < 4; ++i) { const int e = eg * 16 + half * 8 + 2 * i; vT[e * 72 + t] = (bf16)(w[i] & 0xffffu); vT[(e + 1) * 72 + t] = (bf16)(w[i] >> 16); } }
}

__device__ __forceinline__ void gla_prep_item(Frame& F, int n, int h) {
    gla_b(F, n, h);
    LAS float* bL = (LAS float*)(F.lds + GL_B); LAS bf16* T1 = (LAS bf16*)(F.lds + GL_T1); LAS bf16* vT = (LAS bf16*)(F.lds + GL_VT);
    const bf16* PROJ = WSP(bf16, WS_PROJ); const int tid = F.tid, lane = F.lane, w = F.wave;
    { const int t = tid >> 3, dg = tid & 7; const v4u kw = *(const GAS v4u*)(PROJ + (size_t)(n * 64 + t) * LDP + C_GK + h * 64 + dg * 8);
#pragma unroll
        for (int i = 0; i < 4; ++i) { const int d0 = dg * 8 + 2 * i;
            T1[d0 * 72 + t] = f2bf1(bflo(kw[i]) * __expf(bL[63 * 65 + d0] - bL[t * 65 + d0]));
            T1[(d0 + 1) * 72 + t] = f2bf1(bfhi(kw[i]) * __expf(bL[63 * 65 + d0 + 1] - bL[t * 65 + d0 + 1])); } }
    gla_load_vT(F, n, h);
    __syncthreads();
    const int c = lane & 15, kq = lane >> 4;
    bf16x8 a[2];
#pragma unroll
    for (int ks = 0; ks < 2; ++ks) a[ks] = *(const LAS bf16x8*)(vT + (16 * w + c) * 72 + 32 * ks + 8 * kq);
    float* KVT = WSP(float, WS_KVT) + (size_t)(n * 4 + h) * 128 * 64;
#pragma unroll
    for (int dt = 0; dt < 4; ++dt) { f32x4 acc = {0.f, 0.f, 0.f, 0.f};
#pragma unroll
        for (int ks = 0; ks < 2; ++ks) { const bf16x8 b = *(const LAS bf16x8*)(T1 + (16 * dt + c) * 72 + 32 * ks + 8 * kq); acc = MFMA16(a[ks], b, acc); }
#pragma unroll
        for (int r = 0; r < 4; ++r) KVT[(16 * w + 4 * kq + r) * 64 + 16 * dt + c] = acc[r]; }
    if (tid < 64) WSP(float, WS_DVEC)[(n * 4 + h) * 64 + tid] = __expf(bL[63 * 65 + tid]);
    __syncthreads();
}

__device__ __forceinline__ void mix_epilogue(Frame& F, const f32x4 (&o)[4], int n, int it, int eh, const float* gain, int gate_col, int mix_col) {
    LAS float* red = (LAS float*)(F.lds + GL_RED);
    const int lane = F.lane, c = lane & 15, kq = lane >> 4, w = F.wave;
    float ss = 0.f;
#pragma unroll
    for (int q = 0; q < 4; ++q)
#pragma unroll
        for (int r = 0; r < 4; ++r) ss += o[q][r] * o[q][r];
    ss += __shfl_xor(ss, 16); ss += __shfl_xor(ss, 32);
    if (kq == 0) red[w * 64 + c] = ss;
    __syncthreads();
    const float tot = red[it * 64 + c] + red[(it + 4) * 64 + c];
    const float rstd = 1.f / sqrtf(tot * (1.f / 128.f) + EPS);
    const int t = n * 64 + 16 * it + c;
    const bf16* PROJ = WSP(bf16, WS_PROJ); bf16* MIX = WSP(bf16, WS_MIX);
#pragma unroll
    for (int q = 0; q < 4; ++q) { const int e = 16 * (4 * eh + q) + 4 * kq;
        const u32x2 gw = *(const GAS u32x2*)(PROJ + (size_t)t * LDP + gate_col + e); const f32x4 gn = *(const GAS f32x4*)(gain + e);
        f32x4 v; v[0] = o[q][0] * rstd * gn[0] * siluf_(bflo(gw.x)); v[1] = o[q][1] * rstd * gn[1] * siluf_(bfhi(gw.x)); v[2] = o[q][2] * rstd * gn[2] * siluf_(bflo(gw.y)); v[3] = o[q][3] * rstd * gn[3] * siluf_(bfhi(gw.y));
        *(GAS u32x2*)(MIX + (size_t)t * D + mix_col + e) = pack4(v); }
    __syncthreads();
}

__device__ __forceinline__ void gla_out_item(Frame& F, int n, int h) {
    const int c = F.lane & 15, kq = F.lane >> 4, it = F.wave & 3, eh = F.wave >> 2;
    const bf16* ST = WSP(bf16, WS_SGLA) + (size_t)(n * 4 + h) * 128 * 64;
    bf16x8 as[4][2];
#pragma unroll
    for (int q = 0; q < 4; ++q)
#pragma unroll
        for (int ks = 0; ks < 2; ++ks) as[q][ks] = *(const GAS bf16x8*)(ST + (16 * (4 * eh + q) + c) * 64 + 32 * ks + 8 * kq);
    __builtin_amdgcn_sched_barrier(0);
    gla_b(F, n, h);
    LAS float* bL = (LAS float*)(F.lds + GL_B); LAS bf16* T1 = (LAS bf16*)(F.lds + GL_T1); LAS bf16* T2 = (LAS bf16*)(F.lds + GL_T2); LAS bf16* vT = (LAS bf16*)(F.lds + GL_VT);
    const bf16* PROJ = WSP(bf16, WS_PROJ); const int tid = F.tid, lane = F.lane, w = F.wave;
    { const int t = tid >> 3, dg = tid & 7;
        const v4u qw = *(const GAS v4u*)(PROJ + (size_t)(n * 64 + t) * LDP + C_GQ + h * 64 + dg * 8); const v4u kw = *(const GAS v4u*)(PROJ + (size_t)(n * 64 + t) * LDP + C_GK + h * 64 + dg * 8);
        v4u qo, ko;
#pragma unroll
        for (int i = 0; i < 4; ++i) { const int d0 = dg * 8 + 2 * i; const float b0 = bL[t * 65 + d0], b1 = bL[t * 65 + d0 + 1];
            qo[i] = cvtpk(bflo(qw[i]) * 0.125f * __expf(b0), bfhi(qw[i]) * 0.125f * __expf(b1));
            ko[i] = cvtpk(bflo(kw[i]) * __expf(-b0), bfhi(kw[i]) * __expf(-b1)); }
        *(LAS v4u*)(T1 + t * 72 + dg * 8) = qo; *(LAS v4u*)(T2 + t * 72 + dg * 8) = ko; }
    gla_load_vT(F, n, h);
    __syncthreads();
    bf16x8 bq[2];
#pragma unroll
    for (int ks = 0; ks < 2; ++ks) bq[ks] = *(const LAS bf16x8*)(T1 + (16 * it + c) * 72 + 32 * ks + 8 * kq);
    f32x4 at[4];
#pragma unroll
    for (int jt = 0; jt < 4; ++jt) { f32x4 acc = {0.f, 0.f, 0.f, 0.f};
        if (jt <= it) {
#pragma unroll
            for (int ks = 0; ks < 2; ++ks) { const bf16x8 a = *(const LAS bf16x8*)(T2 + (16 * jt + c) * 72 + 32 * ks + 8 * kq); acc = MFMA16(a, bq[ks], acc); }
            if (jt == it) {
#pragma unroll
                for (int r = 0; r < 4; ++r) if (4 * kq + r > c) acc[r] = 0.f; }
        }
        at[jt] = acc; }
    bf16x8 pb[2]; pb[0] = pack8(at[0], at[1]); pb[1] = pack8(at[2], at[3]);
    f32x4 o[4];
#pragma unroll
    for (int q = 0; q < 4; ++q) { const int et = 4 * eh + q; f32x4 acc = {0.f, 0.f, 0.f, 0.f};
#pragma unroll
        for (int s = 0; s < 2; ++s) { const bf16x4 lo = *(const LAS bf16x4*)(vT + (16 * et + c) * 72 + 32 * s + 4 * kq), hi = *(const LAS bf16x4*)(vT + (16 * et + c) * 72 + 32 * s + 16 + 4 * kq);
            acc = MFMA16(cat8(lo, hi), pb[s], acc); }
#pragma unroll
        for (int ks = 0; ks < 2; ++ks) acc = MFMA16(as[q][ks], bq[ks], acc);
        o[q] = acc; }
    mix_epilogue(F, o, n, it, eh, F.in[6], C_GR + h * 128, h * 128);
}

__device__ __forceinline__ void gdn_out_item(Frame& F, int n, int h) {
    const int lane = F.lane, w = F.wave, c = lane & 15, kq = lane >> 4, it = w & 3, eh = w >> 2;
    const bf16* QD = WSP(bf16, WS_QDEC) + ((size_t)(n * 4 + h) * 64 + 16 * it + c) * 128; const bf16* AQ = WSP(bf16, WS_AQK) + ((size_t)(n * 4 + h) * 64 + 16 * it + c) * 64;
    bf16x8 bqd[4], baq[2];
#pragma unroll
    for (int ks = 0; ks < 4; ++ks) bqd[ks] = *(const GAS bf16x8*)(QD + 32 * ks + 8 * kq);
#pragma unroll
    for (int s = 0; s < 2; ++s) baq[s] = *(const GAS bf16x8*)(AQ + 32 * s + 8 * kq);
    const bf16* ST = WSP(bf16, WS_SGDN) + (size_t)(n * 4 + h) * 128 * 128; const bf16* DT = WSP(bf16, WS_DELTA) + (size_t)(n * 4 + h) * 128 * 64;
    bf16x8 as[4][4], ad[4][2];
#pragma unroll
    for (int q = 0; q < 4; ++q) { const int et = 4 * eh + q;
#pragma unroll
        for (int ks = 0; ks < 4; ++ks) as[q][ks] = *(const GAS bf16x8*)(ST + (16 * et + c) * 128 + 32 * ks + 8 * kq);
#pragma unroll
        for (int s = 0; s < 2; ++s) ad[q][s] = *(const GAS bf16x8*)(DT + (16 * et + c) * 64 + 32 * s + 8 * kq); }
    __builtin_amdgcn_sched_barrier(0);
    f32x4 o[4];
#pragma unroll
    for (int q = 0; q < 4; ++q) { f32x4 acc = {0.f, 0.f, 0.f, 0.f};
#pragma unroll
        for (int ks = 0; ks < 4; ++ks) acc = MFMA16(as[q][ks], bqd[ks], acc);
#pragma unroll
        for (int s = 0; s < 2; ++s) acc = MFMA16(ad[q][s], baq[s], acc);
        o[q] = acc; }
    mix_epilogue(F, o, n, it, eh, F.in[10], C_DZ + h * 128, 512 + h * 128);
}

constexpr int GD_QB = 0, GD_KB = 17408, GD_VB = 34816, GD_LS = 52224, GD_LB = 68608, GD_TB = 77824, GD_XT = 80896, GD_SC = 117760;
__device__ __forceinline__ void gdn_prep_item(Frame& F, int n, int h) {
    LAS bf16* qb = (LAS bf16*)(F.lds + GD_QB); LAS bf16* kb = (LAS bf16*)(F.lds + GD_KB); LAS bf16* vb = (LAS bf16*)(F.lds + GD_VB);
    LAS float* Ls = (LAS float*)(F.lds + GD_LS); LAS bf16* Lb = (LAS bf16*)(F.lds + GD_LB); LAS bf16* Tb = (LAS bf16*)(F.lds + GD_TB); LAS bf16* XT = (LAS bf16*)(F.lds + GD_XT);
    LAS float* bS = (LAS float*)(F.lds + GD_SC); LAS float* betaS = bS + 64; LAS float* ebS = bS + 128;
    const bf16* PROJ = WSP(bf16, WS_PROJ); const int tid = F.tid, lane = F.lane, w = F.wave, t0 = n * 64;
    const size_t nh = (size_t)(n * 4 + h);
    if (tid < 64) {
        const float da = bf2f(PROJ[(size_t)(t0 + tid) * LDP + C_DA + h]), db = bf2f(PROJ[(size_t)(t0 + tid) * LDP + C_DB + h]);
        float g = -__expf(F.in[8][h]) * softplusf_(da + F.in[9][h]);
#pragma unroll
        for (int off = 1; off < 64; off <<= 1) { const float v = __shfl_up(g, off); if (lane >= off) g += v; }
        bS[tid] = g; betaS[tid] = sigm(db); ebS[tid] = __expf(g);
    }
    if (!(MK_DBG & 2) && lane < 48) {
        const int grp = lane >> 4, c8 = (lane & 15) * 8;
        const int colP = C_DQ + grp * 512 + h * 128 + c8;
        f32x4 wc[4][2];
#pragma unroll
        for (int j = 0; j < 4; ++j) { const GAS f32x4* wp = (const GAS f32x4*)(F.in[7] + (size_t)j * 1536 + grp * 512 + h * 128 + c8); wc[j][0] = wp[0]; wc[j][1] = wp[1]; }
        v4u xin[11];
#pragma unroll
        for (int rr = 0; rr < 11; ++rr) { const int r = t0 + w * 8 - 3 + rr; xin[rr] = (v4u){0, 0, 0, 0}; if (r >= 0) xin[rr] = *(const GAS v4u*)(PROJ + (size_t)r * LDP + colP); }
#pragma unroll
        for (int tt = 0; tt < 8; ++tt) {
            float y[8];
#pragma unroll
            for (int i = 0; i < 8; ++i) y[i] = 0.f;
#pragma unroll
            for (int j = 0; j < 4; ++j)
#pragma unroll
                for (int i = 0; i < 4; ++i) { const unsigned xw = xin[tt + j][i]; y[2 * i] += wc[j][i >> 1][(2 * i) & 3] * bflo(xw); y[2 * i + 1] += wc[j][i >> 1][(2 * i + 1) & 3] * bfhi(xw); }
            float ss = 0.f;
#pragma unroll
            for (int i = 0; i < 8; ++i) { y[i] = siluf_(y[i]); ss += y[i] * y[i]; }
            ss += __shfl_xor(ss, 1); ss += __shfl_xor(ss, 2); ss += __shfl_xor(ss, 4); ss += __shfl_xor(ss, 8);
            const int row = w * 8 + tt;
            const float sc = grp == 2 ? 1.0f : (1.f / sqrtf(ss + EPS)) * (grp == 0 ? 0.08838834764831845f : 1.0f);
            v4u o; o.x = cvtpk(y[0] * sc, y[1] * sc); o.y = cvtpk(y[2] * sc, y[3] * sc); o.z = cvtpk(y[4] * sc, y[5] * sc); o.w = cvtpk(y[6] * sc, y[7] * sc);
            *(LAS v4u*)((grp == 0 ? qb : (grp == 1 ? kb : vb)) + row * 136 + c8) = o;
        }
    }
    __syncthreads();
    if (!(MK_DBG & 4)) {
        const int c = lane & 15, kq = lane >> 4;
        bf16* AQ = WSP(bf16, WS_AQK) + nh * 64 * 64;
        for (int job = w; job < 20; job += 8) {
            const int kind = job >= 10 ? 1 : 0, idx = job - 10 * kind;
            const int it = idx >= 6 ? 3 : (idx >= 3 ? 2 : (idx >= 1 ? 1 : 0)), jt = idx - (it * (it + 1)) / 2;
            const LAS bf16* Am = kind ? qb : kb;
            f32x4 acc = {0.f, 0.f, 0.f, 0.f};
#pragma unroll
            for (int ks = 0; ks < 4; ++ks) { const bf16x8 a = *(const LAS bf16x8*)(Am + (16 * it + c) * 136 + 32 * ks + 8 * kq), b = *(const LAS bf16x8*)(kb + (16 * jt + c) * 136 + 32 * ks + 8 * kq); acc = MFMA16(a, b, acc); }
            const int j = 16 * jt + c; const float bj = bS[j];
#pragma unroll
            for (int r = 0; r < 4; ++r) { const int i = 16 * it + 4 * kq + r; const float dec = __expf(fminf(bS[i] - bj, 0.f));
                if (kind == 0) Ls[i * 64 + j] = (j < i) ? betaS[i] * dec * acc[r] : 0.f;
                else { AQ[i * 64 + j] = (j <= i) ? f2bf1(dec * acc[r]) : (bf16)0; if (jt < it) AQ[(16 * jt + 4 * kq + r) * 64 + 16 * it + c] = (bf16)0; } }
        }
    }
    __syncthreads();
    { const int i = tid >> 3, c0 = (tid & 7) * 8; v4u o;
#pragma unroll
      for (int x = 0; x < 4; ++x) { const int col = c0 + 2 * x; const bool up = (col >> 4) > (i >> 4); o[x] = up ? 0u : cvtpk(-Ls[i * 64 + col], -Ls[i * 64 + col + 1]); }
      *(LAS v4u*)(Lb + i * 72 + c0) = o;
      for (int x = tid; x < 256 * 72 / 8; x += 512) *(LAS v4u*)(XT + x * 8) = (v4u){0u, 0u, 0u, 0u}; }
    if ((MK_DBG & 8) && tid < 64) {} else if (tid < 64) { const int b = tid >> 4, cc = tid & 15; float x[16];
#pragma unroll
        for (int i = 0; i < 16; ++i) { float a = (i == cc) ? 1.f : 0.f;
#pragma unroll
            for (int j = 0; j < i; ++j) a -= Ls[(16 * b + i) * 64 + 16 * b + j] * x[j];
            x[i] = a; Tb[(16 * b + i) * 24 + cc] = f2bf1(a); }
    } else if (!(MK_DBG & 16) && tid >= 256) {
        const int tt = tid - 256; const float bl = bS[63];
        bf16* QD = WSP(bf16, WS_QDEC) + nh * 64 * 128;
#pragma unroll 1
        for (int j = 0; j < 4; ++j) { const int id = tt + 256 * j, i = id >> 4, c8 = (id & 15) * 8; const v4u qw = *(const LAS v4u*)(qb + i * 136 + c8); const float e = ebS[i];
            v4u o; o.x = cvtpk(bflo(qw.x) * e, bfhi(qw.x) * e); o.y = cvtpk(bflo(qw.y) * e, bfhi(qw.y) * e); o.z = cvtpk(bflo(qw.z) * e, bfhi(qw.z) * e); o.w = cvtpk(bflo(qw.w) * e, bfhi(qw.w) * e);
            *(GAS v4u*)(QD + i * 128 + c8) = o; }
        bf16* KDF = WSP(bf16, WS_KDF) + nh * 16 * 512;
#pragma unroll 1
        for (int j = 0; j < 4; ++j) { const int id = tt + 256 * j, f = id >> 6, ln = id & 63, dt = f >> 1, ks2 = f & 1, q = ln >> 4, m = ln & 15, d = 16 * dt + m;
            float v[8];
#pragma unroll
            for (int x = 0; x < 8; ++x) { const int i = 32 * ks2 + (x < 4 ? 4 * q + x : 16 + 4 * q + (x - 4)); v[x] = bf2f(kb[i * 136 + d]) * __expf(bl - bS[i]); }
            v4u o; o.x = cvtpk(v[0], v[1]); o.y = cvtpk(v[2], v[3]); o.z = cvtpk(v[4], v[5]); o.w = cvtpk(v[6], v[7]);
            *(GAS v4u*)(KDF + ((size_t)f * 64 + ln) * 8) = o; }
        if (tt == 0) WSP(float, WS_CDEC)[nh] = __expf(bl);
    }
    __syncthreads();
    if (!(MK_DBG & 32)) { const int c = lane & 15, kq = lane >> 4;
      bf16* WF = WSP(bf16, WS_WF) + nh * 16 * 512; f32x4* UFp = (f32x4*)WSP(float, WS_UF) + nh * 8 * 4 * 64;
      const f32x4 z4 = {0.f, 0.f, 0.f, 0.f};
#pragma unroll
      for (int b = 0; b < 4; ++b) {
          const bf16x4 tlo = *(const LAS bf16x4*)(Tb + (16 * b + c) * 24 + 4 * kq); const bf16x8 ta = cat8(tlo, (bf16x4){0, 0, 0, 0});
#pragma unroll
          for (int t2 = 0; t2 < 2; ++t2) { const int ct = 2 * w + t2, col = 16 * ct + c; const bool isu = ct < 8;
              f32x4 acc;
#pragma unroll
              for (int r = 0; r < 4; ++r) { const int i = 16 * b + 4 * kq + r; acc[r] = isu ? betaS[i] * bf2f(vb[i * 136 + (col & 127)]) : betaS[i] * ebS[i] * bf2f(kb[i * 136 + (col & 127)]); }
#pragma unroll
              for (int ks = 0; ks < (b + 1) / 2; ++ks) acc = MFMA16(*(const LAS bf16x8*)(Lb + (16 * b + c) * 72 + 32 * ks + 8 * kq), *(const LAS bf16x8*)(XT + col * 72 + 32 * ks + 8 * kq), acc);
              const f32x4 x = MFMA16(ta, pack8(acc, z4), z4);
              *(LAS u32x2*)(XT + col * 72 + 16 * b + 4 * kq) = pack4(x);
              if (isu) UFp[(ct * 4 + b) * 64 + lane] = x;
              else { const int ctw = ct - 8;
#pragma unroll
                  for (int r = 0; r < 4; ++r) WF[((size_t)(b * 4 + (ctw >> 1)) * 64 + (c >> 2) * 16 + 4 * kq + r) * 8 + (c & 3) + 4 * (ctw & 1)] = f2bf1(-x[r]); }
          }
      }
    }
    __syncthreads();
}

template <int MODE>
__device__ __forceinline__ void gdn_group_scan(Frame& F, int grp, int h) {
    const int tid = F.tid, lane = F.lane, w = F.wave, c = lane & 15, kq = lane >> 4, n0 = grp * GRP;
    const v4u* WF = (const v4u*)WSP(bf16, WS_WF); const v4u* KDF = (const v4u*)WSP(bf16, WS_KDF); const f32x4* UF = (const f32x4*)WSP(float, WS_UF);
    const float* CDEC = WSP(float, WS_CDEC); bf16* SG = WSP(bf16, WS_SGDN); bf16* DL = WSP(bf16, WS_DELTA);
    {   v4u t[GRP][4];
#pragma unroll
        for (int i = 0; i < GRP; ++i) { const size_t nh = (size_t)((n0 + i) * 4 + h);
#pragma unroll
            for (int j = 0; j < 2; ++j) { t[i][j] = WF[nh * 1024 + tid + 512 * j]; t[i][2 + j] = KDF[nh * 1024 + tid + 512 * j]; } }
#pragma unroll
        for (int i = 0; i < GRP; ++i)
#pragma unroll
            for (int j = 0; j < 2; ++j) { *(LAS v4u*)(F.lds + i * 32768 + (tid + 512 * j) * 16) = t[i][j]; *(LAS v4u*)(F.lds + i * 32768 + 16384 + (tid + 512 * j) * 16) = t[i][2 + j]; } }
    f32x4 S[8], P[8];
    if (MODE == 1) { const f32x4* SST = (const f32x4*)WSP(float, WS_SST) + (size_t)(((grp * 4 + h) * 8 + w) * 8) * 64;
#pragma unroll
        for (int i = 0; i < 8; ++i) S[i] = SST[i * 64 + lane];
    } else {
#pragma unroll
        for (int i = 0; i < 8; ++i) { S[i] = (f32x4){0.f, 0.f, 0.f, 0.f};
#pragma unroll
            for (int r = 0; r < 4; ++r) P[i][r] = ((16 * i + 4 * kq + r) == 16 * w + c) ? 1.f : 0.f; }
    }
    f32x4 u[GRP][4]; float cd[GRP];
#pragma unroll
    for (int i = 0; i < GRP; ++i) { const size_t nh = (size_t)((n0 + i) * 4 + h); cd[i] = CDEC[nh];
#pragma unroll
        for (int mt = 0; mt < 4; ++mt) u[i][mt] = UF[((nh * 8 + w) * 4 + mt) * 64 + lane]; }
    __syncthreads();
#pragma unroll
    for (int i = 0; i < GRP; ++i) {
        const size_t nh = (size_t)((n0 + i) * 4 + h);
        const LAS unsigned char* wl = F.lds + i * 32768 + lane * 16; const LAS unsigned char* kl = wl + 16384;
        if (MODE == 1) { bf16* sg = SG + (nh * 128 + 16 * w + c) * 128 + 4 * kq;
#pragma unroll
            for (int dt = 0; dt < 8; ++dt) *(GAS u32x2*)(sg + 16 * dt) = pack4(S[dt]); }
        f32x4 dl[4], dp[4];
#pragma unroll
        for (int mt = 0; mt < 4; ++mt) { dl[mt] = u[i][mt]; dp[mt] = (f32x4){0.f, 0.f, 0.f, 0.f}; }
#pragma unroll
        for (int ks = 0; ks < 4; ++ks) { const bf16x8 sb = pack8(S[2 * ks], S[2 * ks + 1]); bf16x8 pb; if (MODE == 0) pb = pack8(P[2 * ks], P[2 * ks + 1]);
#pragma unroll
            for (int mt = 0; mt < 4; ++mt) { const bf16x8 a = *(const LAS bf16x8*)(wl + (mt * 4 + ks) * 1024); dl[mt] = MFMA16(a, sb, dl[mt]); if (MODE == 0) dp[mt] = MFMA16(a, pb, dp[mt]); } }
        if (MODE == 1) { bf16* dq = DL + (nh * 128 + 16 * w + c) * 64 + 4 * kq;
#pragma unroll
            for (int mt = 0; mt < 4; ++mt) *(GAS u32x2*)(dq + 16 * mt) = pack4(dl[mt]); }
#pragma unroll
        for (int dt = 0; dt < 8; ++dt) { S[dt] = S[dt] * cd[i]; if (MODE == 0) P[dt] = P[dt] * cd[i]; }
#pragma unroll
        for (int ks2 = 0; ks2 < 2; ++ks2) { const bf16x8 db = pack8(dl[2 * ks2], dl[2 * ks2 + 1]); bf16x8 qb; if (MODE == 0) qb = pack8(dp[2 * ks2], dp[2 * ks2 + 1]);
#pragma unroll
            for (int dt = 0; dt < 8; ++dt) { const bf16x8 a = *(const LAS bf16x8*)(kl + (dt * 2 + ks2) * 1024); S[dt] = MFMA16(a, db, S[dt]); if (MODE == 0) P[dt] = MFMA16(a, qb, P[dt]); } }
    }
    if (MODE == 0) {
        f32x4* SLE = (f32x4*)WSP(float, WS_SLE) + (size_t)(((grp * 4 + h) * 8 + w) * 8) * 64;
#pragma unroll
        for (int dt = 0; dt < 8; ++dt) SLE[dt * 64 + lane] = S[dt];
        bf16* PE = WSP(bf16, WS_PEND) + (size_t)(grp * 4 + h) * 32 * 512; const int ks = w >> 1, lq = (2 * (w & 1) + (c >> 3)) * 16 + 4 * kq, idx = c & 7;
#pragma unroll
        for (int dt = 0; dt < 8; ++dt)
#pragma unroll
            for (int r = 0; r < 4; ++r) PE[((size_t)(dt * 4 + ks) * 64 + lq + r) * 8 + idx] = f2bf1(P[dt][r]);
    }
    __syncthreads();
}
__device__ __forceinline__ void gdn_scan_groups(Frame& F, int h, int s) {
    const int lane = F.lane, w = F.wave, c = lane & 15, kq = lane >> 4;
    LAS bf16* STb = (LAS bf16*)F.lds;
    const bf16x8* PEND = (const bf16x8*)WSP(bf16, WS_PEND); const f32x4* SLE = (const f32x4*)WSP(float, WS_SLE); f32x4* SST = (f32x4*)WSP(float, WS_SST);
    f32x4 S = {0.f, 0.f, 0.f, 0.f};
    *(LAS u32x2*)(STb + c * 136 + 16 * w + 4 * kq) = (u32x2){0u, 0u};
    bf16x8 pe[4], pn[4]; f32x4 sle, sln;
#pragma unroll
    for (int ks = 0; ks < 4; ++ks) pe[ks] = PEND[((size_t)h * 32 + w * 4 + ks) * 64 + lane];
    sle = SLE[(((size_t)h * 8 + s) * 8 + w) * 64 + lane];
    __syncthreads();
    for (int g = 0; g < NGRP; ++g) {
        const size_t gh = (size_t)(g * 4 + h);
        SST[((gh * 8 + s) * 8 + w) * 64 + lane] = S;
        if (g + 1 == NGRP) break;
        { const size_t gh1 = (size_t)((g + 1) * 4 + h);
#pragma unroll
          for (int ks = 0; ks < 4; ++ks) pn[ks] = PEND[(gh1 * 32 + w * 4 + ks) * 64 + lane];
          sln = SLE[((gh1 * 8 + s) * 8 + w) * 64 + lane]; }
        const LAS bf16* st = STb + (g & 1) * 16 * 136 + c * 136 + 8 * kq;
        f32x4 acc = sle;
#pragma unroll
        for (int ks = 0; ks < 4; ++ks) acc = MFMA16(pe[ks], *(const LAS bf16x8*)(st + 32 * ks), acc);
        S = acc;
        *(LAS u32x2*)(STb + ((g + 1) & 1) * 16 * 136 + c * 136 + 16 * w + 4 * kq) = pack4(S);
#pragma unroll
        for (int ks = 0; ks < 4; ++ks) pe[ks] = pn[ks];
        sle = sln;
        __syncthreads();
    }
    __syncthreads();
}
template <int MODE>
__device__ __forceinline__ void gla_scan_range(Frame& F, int grp, int gid) {
    const int h = gid >> 11, rem = gid & 2047, e = rem >> 4, dg = rem & 15, n0 = grp * GRP;
    const float* KVT = WSP(float, WS_KVT); const float* DV = WSP(float, WS_DVEC); bf16* SG = WSP(bf16, WS_SGLA);
    f32x4 kv[GRP], dv[GRP];
#pragma unroll
    for (int i = 0; i < GRP; ++i) { const size_t nh = (size_t)((n0 + i) * 4 + h); kv[i] = *(const GAS f32x4*)(KVT + (nh * 128 + e) * 64 + 4 * dg); dv[i] = *(const GAS f32x4*)(DV + nh * 64 + 4 * dg); }
    f32x4 S = {0.f, 0.f, 0.f, 0.f}, P = {1.f, 1.f, 1.f, 1.f};
    if (MODE == 1) S = *((const GAS f32x4*)WSP(float, WS_GSST) + (size_t)grp * 8192 + gid);
#pragma unroll
    for (int i = 0; i < GRP; ++i) { const size_t nh = (size_t)((n0 + i) * 4 + h);
        if (MODE == 1) *(GAS u32x2*)(SG + (nh * 128 + e) * 64 + 4 * dg) = pack4(S);
        S = dv[i] * S + kv[i]; if (MODE == 0) P = P * dv[i]; }
    if (MODE == 0) { *((GAS f32x4*)WSP(float, WS_GSLE) + (size_t)grp * 8192 + gid) = S; *((GAS f32x4*)WSP(float, WS_GPD) + (size_t)grp * 8192 + gid) = P; }
}
__device__ __forceinline__ void gla_scan_groups(Frame& F, int gid) {
    f32x4 S = {0.f, 0.f, 0.f, 0.f};
    for (int g0 = 0; g0 < NGRP; g0 += 16) {
        f32x4 sl[16], pd[16];
#pragma unroll
        for (int g = 0; g < 16; ++g) { sl[g] = *((const GAS f32x4*)WSP(float, WS_GSLE) + (size_t)(g0 + g) * 8192 + gid); pd[g] = *((const GAS f32x4*)WSP(float, WS_GPD) + (size_t)(g0 + g) * 8192 + gid); }
#pragma unroll
        for (int g = 0; g < 16; ++g) { *((GAS f32x4*)WSP(float, WS_GSST) + (size_t)(g0 + g) * 8192 + gid) = S; S = pd[g] * S + sl[g]; }
    }
}

__device__ __forceinline__ void route_phase(Frame& F, int rep) {
    LAS float* WrT = (LAS float*)(F.lds + RING_OFF);
    const int tid = F.tid, lane = F.lane;
    for (int idx = tid; idx < 8192; idx += 512) { const int d = idx & 1023, e4 = (idx >> 10) * 4; const f32x4 v = *(const GAS f32x4*)(F.in[13] + (size_t)d * 32 + e4);
        WrT[(e4 + 0) * 1024 + d] = v[0]; WrT[(e4 + 1) * 1024 + d] = v[1]; WrT[(e4 + 2) * 1024 + d] = v[2]; WrT[(e4 + 3) * 1024 + d] = v[3]; }
    __syncthreads();
    const float brt = F.in[14][lane >> 1];
    unsigned* cnt = (unsigned*)(F.ctl + CW_CNT) + rep * 32;
    LAS int* lcnt = (LAS int*)(F.lds + ROUTE_OFF); LAS int* gbase = lcnt + 32; LAS int* te = lcnt + 64; LAS int* ts = te + 256; LAS float* tg = (LAS float*)(ts + 256);
    const size_t roff = (size_t)rep * (WS_PROJ - WS_TOKE), xoff = (size_t)rep * (WS_PROJ + 8 * MiB - WS_XN);
    for (int blk = F.vcu; blk < T / 64; blk += F.G) {
    if (tid < 32) lcnt[tid] = 0;
    __syncthreads();
    for (int ti = 0; ti < 8; ++ti) {
        const int tl = F.wave * 8 + ti, t = blk * 64 + tl;
        const GAS f32x4* xr = (const GAS f32x4*)(F.out + (size_t)t * D) + lane; const GAS f32x4* gr = (const GAS f32x4*)F.in[12] + lane;
        f32x4 v[4]; float s = 0.f;
#pragma unroll
        for (int j = 0; j < 4; ++j) { v[j] = xr[64 * j]; s += (v[j].x * v[j].x + v[j].y * v[j].y) + (v[j].z * v[j].z + v[j].w * v[j].w); }
        const float rstd = 1.f / sqrtf(wave_sum(s) * (1.f / D) + EPS);
        GAS unsigned* o8 = (GAS unsigned*)(WSP(unsigned char, WS_XN + xoff) + (size_t)t * D) + lane;
#pragma unroll
        for (int j = 0; j < 4; ++j) { const f32x4 gg = gr[64 * j]; v[j].x *= rstd * gg.x; v[j].y *= rstd * gg.y; v[j].z *= rstd * gg.z; v[j].w *= rstd * gg.w; o8[64 * j] = pg8::cvt4_fp8(v[j].x, v[j].y, v[j].z, v[j].w); }
        float p[32];
#pragma unroll
        for (int e = 0; e < 32; ++e) { float a = 0.f;
#pragma unroll
            for (int j = 0; j < 4; ++j) { const f32x4 wv = *(const LAS f32x4*)(WrT + e * 1024 + 4 * lane + 256 * j); a += (v[j].x * wv.x + v[j].y * wv.y) + (v[j].z * wv.z + v[j].w * wv.w); }
            p[e] = a; if ((e & 3) == 3) __builtin_amdgcn_sched_barrier(0); }
        float q16[16], q8[8], q4[4], q2[2], q1;
        { const bool hi = lane & 32;
#pragma unroll
            for (int k = 0; k < 16; ++k) { const float send = hi ? p[k] : p[k + 16], keep = hi ? p[k + 16] : p[k]; q16[k] = keep + __shfl_xor(send, 32); } }
        { const bool hi = lane & 16;
#pragma unroll
            for (int k = 0; k < 8; ++k) { const float send = hi ? q16[k] : q16[k + 8], keep = hi ? q16[k + 8] : q16[k]; q8[k] = keep + __shfl_xor(send, 16); } }
        { const bool hi = lane & 8;
#pragma unroll
            for (int k = 0; k < 4; ++k) { const float send = hi ? q8[k] : q8[k + 4], keep = hi ? q8[k + 4] : q8[k]; q4[k] = keep + __shfl_xor(send, 8); } }
        { const bool hi = lane & 4;
#pragma unroll
            for (int k = 0; k < 2; ++k) { const float send = hi ? q4[k] : q4[k + 2], keep = hi ? q4[k + 2] : q4[k]; q2[k] = keep + __shfl_xor(send, 4); } }
        { const bool hi = lane & 2; const float send = hi ? q2[0] : q2[1], keep = hi ? q2[1] : q2[0]; q1 = keep + __shfl_xor(send, 2); }
        q1 += __shfl_xor(q1, 1);
        const float mylogit = q1 + brt;
        float lg[32];
#pragma unroll
        for (int e = 0; e < 32; ++e) lg[e] = __shfl(mylogit, 2 * e);
        unsigned used = 0u; int sel[4]; float val[4];
#pragma unroll
        for (int k = 0; k < 4; ++k) { float best = -3.0e38f; int bi = 0;
#pragma unroll
            for (int e = 0; e < 32; ++e) { const bool ok = (lg[e] > best) && !((used >> e) & 1u); best = ok ? lg[e] : best; bi = ok ? e : bi; }
            sel[k] = bi; val[k] = best; used |= 1u << bi; }
        const float e1 = __expf(val[1] - val[0]), e2 = __expf(val[2] - val[0]), e3 = __expf(val[3] - val[0]); const float inv = 1.f / (1.f + e1 + e2 + e3);
        if (lane < 4) { const int ek = lane == 0 ? sel[0] : (lane == 1 ? sel[1] : (lane == 2 ? sel[2] : sel[3])); const float gk = (lane == 0 ? 1.f : (lane == 1 ? e1 : (lane == 2 ? e2 : e3))) * inv;
            const int ls = __hip_atomic_fetch_add(lcnt + ek, 1, __ATOMIC_RELAXED, __HIP_MEMORY_SCOPE_WORKGROUP);
            te[tl * 4 + lane] = ek; ts[tl * 4 + lane] = ls; tg[tl * 4 + lane] = gk; }
    }
    __syncthreads();
    if (tid < 32) gbase[tid] = (int)atomicAdd(cnt + tid * 64, (unsigned)lcnt[tid]);
    __syncthreads();
    if (tid < 256) { const int t = blk * 64 + (tid >> 2), k = tid & 3, e = te[tid];
        WSP(int, WS_TOKE + roff)[t * 4 + k] = e; WSP(int, WS_TOKS + roff)[t * 4 + k] = gbase[e] + ts[tid]; WSP(float, WS_TOKG + roff)[t * 4 + k] = tg[tid]; }
    __syncthreads();
    }
}
__device__ __forceinline__ void moe_tables(Frame& F) {
    LAS int* tile_e = (LAS int*)(F.lds + TILEE_OFF); LAS int* baseL = (LAS int*)(F.lds + BASE_OFF);
    if (F.tid < 64) { const int e = F.lane & 31; const unsigned c = __hip_atomic_load((unsigned*)(F.ctl + CW_CNT) + e * 64, RLX_AGENT);
        const int nt = (int)((c + 255u) >> 8); int incl = nt;
#pragma unroll
        for (int off = 1; off < 32; off <<= 1) { const int v = __shfl_up(incl, off); if ((F.lane & 31) >= off) incl += v; }
        const int tb = incl - nt;
        if (F.lane < 32) { baseL[e] = tb * 256; for (int i = 0; i < nt; ++i) tile_e[tb + i] = e; if (e == 31) tile_e[319] = incl; } }
    __syncthreads();
}
__device__ __forceinline__ void scatter_phase(Frame& F) {
    moe_tables(F);
    LAS int* baseL = (LAS int*)(F.lds + BASE_OFF);
    const int gw = F.vcu * NWAVES + F.wave, NGW = F.G * NWAVES, lane = F.lane;
    for (int t0 = gw; t0 < T; t0 += 8 * NGW) {
        int e[8], sl[8]; float gt[8]; v4u a[8];
#pragma unroll
        for (int q = 0; q < 8; ++q) { const int t = (t0 + q * NGW < T) ? t0 + q * NGW : 0; e[q] = 0; sl[q] = 0; gt[q] = 0.f;
            if (lane < 4) { e[q] = WSP(int, WS_TOKE)[t * 4 + lane]; sl[q] = WSP(int, WS_TOKS)[t * 4 + lane]; gt[q] = WSP(float, WS_TOKG)[t * 4 + lane]; }
            a[q] = *((const GAS v4u*)(WSP(unsigned char, WS_XN) + (size_t)t * D) + lane); }
#pragma unroll
        for (int q = 0; q < 8; ++q) { const int t = t0 + q * NGW; if (t >= T) break;
            int pos = 0;
            if (lane < 4) { pos = baseL[e[q]] + sl[q]; WSP(int, WS_TOKP)[t * 4 + lane] = pos; WSP(float, WS_GPOS)[pos] = gt[q]; }
#pragma unroll
            for (int k = 0; k < 4; ++k) { const int pk = __shfl(pos, k); *((GAS v4u*)(WSP(unsigned char, WS_XS) + (size_t)pk * D) + lane) = a[q]; } }
    }
}
__device__ __forceinline__ void combine_phase(Frame& F, int rep) {
    const int gw = F.vcu * NWAVES + F.wave, NGW = F.G * NWAVES, lane = F.lane;
    const size_t xoff = (size_t)rep * (WS_PROJ + 64 * MiB - WS_XN), poff = (size_t)rep * (WS_PROJ + 100 * MiB - WS_PERSTD);
    for (int t0 = gw; t0 < T; t0 += 2 * NGW) {
        int pk[2][4]; f32x4 v[2][4]; u32x2 y[2][4][4], pr[2][4];
#pragma unroll
        for (int q = 0; q < 2; ++q) { const int t = (t0 + q * NGW < T) ? t0 + q * NGW : 0;
#pragma unroll
            for (int k = 0; k < 4; ++k) pk[q][k] = WSP(int, WS_TOKP)[t * 4 + k];
            const GAS f32x4* xr = (const GAS f32x4*)(F.out + (size_t)t * D) + lane; const GAS u32x2* pp = (const GAS u32x2*)(WSP(bf16, WS_PERAW) + (size_t)t * D) + lane;
#pragma unroll
            for (int j = 0; j < 4; ++j) { v[q][j] = xr[64 * j]; pr[q][j] = pp[64 * j]; } }
#pragma unroll
        for (int q = 0; q < 2; ++q)
#pragma unroll
            for (int k = 0; k < 4; ++k) { const GAS u32x2* yr = (const GAS u32x2*)(WSP(bf16, WS_YS) + (size_t)pk[q][k] * D) + lane;
#pragma unroll
                for (int j = 0; j < 4; ++j) y[q][k][j] = yr[64 * j]; }
#pragma unroll
        for (int q = 0; q < 2; ++q) { const int t = t0 + q * NGW; if (t >= T) break;
            GAS f32x4* xw = rep ? (GAS f32x4*)(WSP(float, WS_PROJ) + (size_t)t * D) + lane : (GAS f32x4*)(F.out + (size_t)t * D) + lane;
            float s = 0.f, ps = 0.f;
#pragma unroll
            for (int j = 0; j < 4; ++j) {
#pragma unroll
                for (int k = 0; k < 4; ++k) { const u32x2 w = y[q][k][j]; v[q][j].x += bflo(w.x); v[q][j].y += bfhi(w.x); v[q][j].z += bflo(w.y); v[q][j].w += bfhi(w.y); }
                xw[64 * j] = v[q][j]; s += (v[q][j].x * v[q][j].x + v[q][j].y * v[q][j].y) + (v[q][j].z * v[q][j].z + v[q][j].w * v[q][j].w);
                const u32x2 w = pr[q][j]; const float a = bflo(w.x), b = bfhi(w.x), c = bflo(w.y), d = bfhi(w.y); ps += (a * a + b * b) + (c * c + d * d); }
            const float rstd = 1.f / sqrtf(wave_sum(s) * (1.f / D) + EPS);
            const GAS f32x4* gr = (const GAS f32x4*)F.in[19] + lane; GAS u32x2* o8 = (GAS u32x2*)(WSP(bf16, WS_XN + xoff) + (size_t)t * D) + lane;
#pragma unroll
            for (int j = 0; j < 4; ++j) { const f32x4 gg = gr[64 * j]; f32x4 a = {v[q][j].x * rstd * gg.x, v[q][j].y * rstd * gg.y, v[q][j].z * rstd * gg.z, v[q][j].w * rstd * gg.w}; o8[64 * j] = pack4(a); }
            ps = wave_sum(ps);
            if (lane == 0) WSP(float, WS_PERSTD + poff)[t] = 1.f / sqrtf(ps * (1.f / D) + EPS); }
    }
}
__device__ __forceinline__ void final_phase(Frame& F, int rep) {
    const int gw = F.vcu * NWAVES + F.wave, NGW = F.G * NWAVES, lane = F.lane;
    for (int t0 = gw; t0 < T; t0 += 4 * NGW) {
        f32x4 v[4][4];
#pragma unroll
        for (int q = 0; q < 4; ++q) { const int t = (t0 + q * NGW < T) ? t0 + q * NGW : 0; const GAS f32x4* xr = (const GAS f32x4*)(F.out + (size_t)t * D) + lane;
#pragma unroll
            for (int j = 0; j < 4; ++j) v[q][j] = xr[64 * j]; }
#pragma unroll
        for (int q = 0; q < 4; ++q) { const int t = t0 + q * NGW; if (t >= T) break;
            float s = 0.f;
#pragma unroll
            for (int j = 0; j < 4; ++j) s += (v[q][j].x * v[q][j].x + v[q][j].y * v[q][j].y) + (v[q][j].z * v[q][j].z + v[q][j].w * v[q][j].w);
            const float rstd = 1.f / sqrtf(wave_sum(s) * (1.f / D) + EPS);
            const GAS f32x4* gr = (const GAS f32x4*)F.in[23] + lane;
            GAS f32x4* xw = rep ? (GAS f32x4*)(WSP(float, WS_PROJ) + (size_t)t * D) + lane : (GAS f32x4*)(F.out + (size_t)t * D) + lane;
#pragma unroll
            for (int j = 0; j < 4; ++j) { const f32x4 gg = gr[64 * j]; xw[64 * j] = (f32x4){v[q][j].x * rstd * gg.x, v[q][j].y * rstd * gg.y, v[q][j].z * rstd * gg.z, v[q][j].w * rstd * gg.w}; } }
    }
}

constexpr int NPH = 13;
struct Args { const float* in[24]; float* out; unsigned char* ws; int ph_lo, ph_hi; };
static_assert(sizeof(Args) == 24 * 8 + 8 + 8 + 8, "Args has no padding");
__global__ void __launch_bounds__(NWAVES * 64, 2) fwd_kernel(Args args) {
    extern __shared__ __attribute__((aligned(16))) unsigned char lds[];
    Frame F;
    F.lds = (LAS unsigned char*)lds;
    F.MISC = (volatile LAS unsigned*)(F.lds + MISC_OFF);
    F.tid = threadIdx.x; F.lane = F.tid & 63; F.wave = __builtin_amdgcn_readfirstlane(F.tid >> 6);
    F.G = gridDim.x; { const int bx = blockIdx.x; F.vcu = (F.G % 8 == 0) ? (bx % 8) * (F.G / 8) + bx / 8 : bx; }
    F.ws = args.ws; F.ctl = (gu32*)(args.ws + WS_CTL); F.out = args.out;
#pragma unroll
    for (int i = 0; i < 24; ++i) F.in[i] = args.in[i];
    for (int u = F.tid; u < (LDS_BYTES - LDSCTL_OFF) / 4; u += NWAVES * 64) ((LAS unsigned*)(F.lds + LDSCTL_OFF))[u] = 0u;
    __syncthreads();
    const int lo = args.ph_lo, hi = args.ph_hi;
    XcdBarrier bar; bar.bar = (unsigned*)(F.ctl + CW_BAR); bar.x = 0; bar.st = nullptr;
    bar = xcd_barrier_post((unsigned*)(F.ctl + CW_BAR), F.MISC + 8);
#define IN(k) (lo <= (k) && (k) < hi && !((MK_SKIP >> (k)) & 1))
#define SEAM(k) do { if ((lo <= (k)) && ((k) + 1 < hi)) xcd_barrier(bar); } while (0)

    if (IN(0)) { for (int rep_ = 0; rep_ <= ((MK_REP >> 0) & 1); ++rep_) { p0_prologue(F); } SEAM(0); }
    if (IN(1)) { for (int rep_ = 0; rep_ <= ((MK_REP >> 1) & 1); ++rep_) {
        { pg8::Gemm g{WSP(bf16, WS_XN), WSP(bf16, WS_WIN), T, LDP, D}; pg8::StaticOrder S; S.init(T, LDP, F.G, (int)blockIdx.x);
          pg8::EpiBf16P E{WSP(bf16, WS_PROJ), LDP};
          pg8::gemm_phase<pg8::EpiBf16P, pg8::StaticOrder, true, true>(F.lds + RING_OFF, g, S, E); }
        { pg8::Gemm g{WSP(bf16, WS_PB), WSP(bf16, WS_WPP), T, D, PLE}; pg8::StaticOrder S; S.init(T, D, F.G, (int)blockIdx.x);
          pg8::EpiBf16P E{WSP(bf16, WS_PERAW), D};
          pg8::gemm_phase<pg8::EpiBf16P, pg8::StaticOrder, true, true>(F.lds + RING_OFF, g, S, E); }
        }
        SEAM(1);
    }
    if (IN(2)) { for (int rep_ = 0; rep_ <= ((MK_REP >> 2) & 1); ++rep_) {
        for (int i = blockIdx.x; i < NCH * 8; i += F.G) { const int n = i >> 3, hh = (i + (i >> 8)) & 7;
            if (hh < 4) { if (!(MK_DBG & 1)) gla_prep_item(F, n, hh); } else gdn_prep_item(F, n, hh - 4); }
        }
        SEAM(2);
    }
    if (IN(3)) { for (int rep_ = 0; rep_ <= ((MK_REP >> 3) & 1); ++rep_) {
        for (int r3_ = 0; r3_ <= ((MK_REP >> 13) & 1); ++r3_) {
        for (int it = F.vcu; it < NGRP * 4; it += F.G) gdn_group_scan<0>(F, it >> 2, it & 3);
        for (int id = F.vcu * 8 + F.wave; id < NGRP * 128; id += F.G * 8) gla_scan_range<0>(F, id >> 7, (id & 127) * 64 + F.lane); }
        xcd_barrier(bar);
        for (int r3_ = 0; r3_ <= ((MK_REP >> 14) & 1); ++r3_) {
        if (F.vcu < 32) gdn_scan_groups(F, F.vcu >> 3, F.vcu & 7);
        else if (F.vcu < 160 && F.wave == 0) gla_scan_groups(F, (F.vcu - 32) * 64 + F.lane); }
        xcd_barrier(bar);
        for (int r3_ = 0; r3_ <= ((MK_REP >> 15) & 1); ++r3_) {
        for (int it = F.vcu; it < NGRP * 4; it += F.G) gdn_group_scan<1>(F, it >> 2, it & 3);
        for (int id = F.vcu * 8 + F.wave; id < NGRP * 128; id += F.G * 8) gla_scan_range<1>(F, id >> 7, (id & 127) * 64 + F.lane); }
        }
        SEAM(3);
    }
    if (IN(4)) { for (int rep_ = 0; rep_ <= ((MK_REP >> 4) & 1); ++rep_) {
        for (int i = blockIdx.x; i < NCH * 8; i += F.G) { const int n = i >> 3, hh = (i + (i >> 8)) & 7;
            if (hh < 4) gla_out_item(F, n, hh); else gdn_out_item(F, n, hh - 4); }
        }
        SEAM(4);
    }
    if (IN(5)) { for (int rep_ = 0; rep_ <= ((MK_REP >> 5) & 1); ++rep_) {
        pg8::Gemm g{WSP(bf16, WS_MIX), WSP(bf16, WS_WOUT), T, D, D}; pg8::StaticOrder S; S.init(T, D, F.G, (int)blockIdx.x);
        pg8::EpiResF32 E{F.in[0], F.out, D};
        pg8::gemm_phase<pg8::EpiResF32, pg8::StaticOrder, true, true>(F.lds + RING_OFF, g, S, E);
        }
        SEAM(5);
    }
    if (IN(6)) { for (int rep_ = 0; rep_ <= ((MK_REP >> 6) & 1); ++rep_) { route_phase(F, rep_); } SEAM(6); }
    if (IN(7)) { for (int rep_ = 0; rep_ <= ((MK_REP >> 7) & 1); ++rep_) { scatter_phase(F); } SEAM(7); }
    if (IN(8)) { for (int rep_ = 0; rep_ <= ((MK_REP >> 8) & 1); ++rep_) {
        moe_tables(F);
        const LAS int* tile_e = (const LAS int*)(F.lds + TILEE_OFF); const int ntiles = __builtin_amdgcn_readfirstlane(tile_e[319]);
        pg8::Gemm g{WSP(bf16, WS_XS), WSP(bf16, WS_W1), XS_ROWS, 2048, D / 2}; pg8::MoeOrder S{tile_e, ntiles, 8, F.G, (int)blockIdx.x};
        pg8::EpiMoeAct E{WSP(bf16, WS_HS), F.in[16]};
        pg8::gemm_phase<pg8::EpiMoeAct, pg8::MoeOrder, true, true, true>(F.lds + RING_OFF, g, S, E);
        }
        SEAM(8);
    }
    if (IN(9)) { for (int rep_ = 0; rep_ <= ((MK_REP >> 9) & 1); ++rep_) {
        moe_tables(F);
        const LAS int* tile_e = (const LAS int*)(F.lds + TILEE_OFF); const int ntiles = __builtin_amdgcn_readfirstlane(tile_e[319]);
        pg8::Gemm g{WSP(bf16, WS_HS), WSP(bf16, WS_W2), XS_ROWS, D, D / 2}; pg8::MoeOrder S{tile_e, ntiles, 4, F.G, (int)blockIdx.x};
        pg8::EpiMoeDown E{WSP(bf16, WS_YS), F.in[18], WSP(float, WS_GPOS)};
        pg8::gemm_phase<pg8::EpiMoeDown, pg8::MoeOrder, true, true, true>(F.lds + RING_OFF, g, S, E);
        }
        SEAM(9);
    }
    if (IN(10)) { for (int rep_ = 0; rep_ <= ((MK_REP >> 10) & 1); ++rep_) { combine_phase(F, rep_); } SEAM(10); }
    if (IN(11)) { for (int rep_ = 0; rep_ <= ((MK_REP >> 11) & 1); ++rep_) {
        pg8::Gemm g{WSP(bf16, WS_XN), WSP(bf16, WS_WPG), T, D, D}; pg8::StaticOrder S; S.init(T, D, F.G, (int)blockIdx.x);
        pg8::EpiPle E{F.out, WSP(bf16, WS_PERAW), WSP(float, WS_PERSTD), F.in[22]};
        pg8::gemm_phase<pg8::EpiPle, pg8::StaticOrder, true, true>(F.lds + RING_OFF, g, S, E);
        }
        SEAM(11);
    }
    if (IN(12)) { for (int rep_ = 0; rep_ <= ((MK_REP >> 12) & 1); ++rep_) { final_phase(F, rep_); } }
#undef IN
#undef SEAM
}

extern "C" void kernel_launch(void* const* d_in, const int* in_sizes, int n_in, void* d_out, int out_size, void* d_ws, size_t ws_size, hipStream_t stream) {
    static int grid = 0;
    if (grid == 0) {
        if (n_in != 24 || in_sizes[0] != T * D || out_size != T * D || ws_size < WS_END) { fprintf(stderr, "kernel_launch: unexpected shapes (n_in %d, in0 %d, out %d, ws %zu); nothing launched\n", n_in, n_in > 0 ? in_sizes[0] : -1, out_size, ws_size); grid = -1; return; }
        int dev = 0, cus = 0;
        if (hipGetDevice(&dev) != hipSuccess || hipDeviceGetAttribute(&cus, hipDeviceAttributeMultiprocessorCount, dev) != hipSuccess) { grid = -1; return; }
        if (hipFuncSetAttribute((const void*)fwd_kernel, hipFuncAttributeMaxDynamicSharedMemorySize, LDS_BYTES) != hipSuccess) { fprintf(stderr, "kernel_launch: hipFuncSetAttribute failed\n"); grid = -1; return; }
        int per_cu = 0;
        if (hipOccupancyMaxActiveBlocksPerMultiprocessor(&per_cu, (const void*)fwd_kernel, NWAVES * 64, LDS_BYTES) != hipSuccess || per_cu < 1) fprintf(stderr, "kernel_launch: occupancy query reports %d blocks per CU\n", per_cu);
        (void)hipGetLastError();
        grid = cus;
    }
    if (grid < 0) return;
    if (hipMemsetAsync((char*)d_ws + WS_CTL, 0, CTL_ZERO_BYTES, stream) != hipSuccess) return;
    Args a{};
    for (int i = 0; i < 24; ++i) a.in[i] = (const float*)d_in[i];
    a.out = (float*)d_out; a.ws = (unsigned char*)d_ws;
#if MK_ONE_LAUNCH
    a.ph_lo = 0; a.ph_hi = NPH;
    hipLaunchKernelGGL(fwd_kernel, dim3(grid), dim3(NWAVES * 64), LDS_BYTES, stream, a);
#else
    for (int p = 0; p < NPH; ++p) { a.ph_lo = p; a.ph_hi = p + 1; hipLaunchKernelGGL(fwd_kernel, dim3(grid), dim3(NWAVES * 64), LDS_BYTES, stream, a); }
#endif
}
```

```cpp
#include <hip/hip_runtime.h>
#include <cstdio>
#include <cstdint>
#ifndef MK_ONE_LAUNCH
#define MK_ONE_LAUNCH 1
#endif
#ifndef MK_SKIP
#define MK_SKIP 0
#endif
#ifndef MK_DBG
#define MK_DBG 0
#endif
#ifndef MK_REP
#define MK_REP 0
#endif
namespace pg8 {
#define PG8_LAS __attribute__((address_space(3)))
typedef unsigned short bf16_t;
typedef short bf16x8 __attribute__((ext_vector_type(8)));
typedef float f32x4 __attribute__((ext_vector_type(4)));
typedef unsigned u32x4 __attribute__((ext_vector_type(4)));
constexpr int BM = 256, BK = 64, HALF = 128, HTB = HALF * BK * 2  , STAGE_BYTES = 8 * HTB, NXCD = 8, WGM = 8;

__host__ __device__ __forceinline__ int lds_byte(int r, int c) { const int st = (r >> 4) * 2 + (c >> 5), rr = r & 15, cc = c & 31, ob = rr * 64 + cc * 2; return st * 1024 + (ob ^ (((ob >> 9) & 1) << 5)); }
__host__ __device__ __forceinline__ void stage_rc(int b, int& R, int& C) { const int st = b / 1024, sb = b % 1024, swz = sb ^ (((sb >> 9) & 1) << 5); R = (st >> 1) * 16 + swz / 64; C = (st & 1) * 32 + (swz % 64) / 2; }
__host__ __device__ __forceinline__ int perm32(int rho) { const int n = rho >> 4, i = rho & 15; return 8 * (i >> 2) + 4 * n + (i & 3); }

struct Unit { int pm, pn, pb, e; };
struct Gemm { const bf16_t* A; const bf16_t* Bt; int M, N, K; const int* rowmap; };

struct StaticOrder {
    int nM, nN, nwg, G, c;
    __host__ __device__ void init(int M, int N, int G_, int c_) { nM = M / BM; nN = N / BM; nwg = nM * nN; G = G_; c = c_; }
    __host__ __device__ bool next(int i, Unit& u) const {
        const long L = (long)i * G + c; if (L >= nwg) return false;
        int wgid = (int)L; { const int q = nwg / NXCD, r = nwg % NXCD, xcd = wgid % NXCD, off = wgid / NXCD; wgid = (xcd < r ? xcd * (q + 1) : r * (q + 1) + (xcd - r) * q) + off; }
        const int nig = WGM * nN, gid = wgid / nig, fm = gid * WGM, gsz = (nM - fm) < WGM ? (nM - fm) : WGM;
        u.pm = fm + ((wgid % nig) % gsz); u.pn = (wgid % nig) / gsz; u.pb = u.pn; u.e = 0; return true;
    }
    __device__ __forceinline__ void a_ready(const Unit&) const {}
    __device__ __forceinline__ void done(const Unit&) const {}
};

__device__ __forceinline__ unsigned cvt_pk_bf16(float lo, float hi) { unsigned r; asm volatile("v_cvt_pk_bf16_f32 %0, %1, %2" : "=v"(r) : "v"(lo), "v"(hi)); return r; }

typedef float f32x2 __attribute__((ext_vector_type(2)));
typedef unsigned u32x2 __attribute__((ext_vector_type(2)));
typedef __bf16 bf16x2v __attribute__((ext_vector_type(2)));
__device__ __forceinline__ unsigned cvtpk(float lo, float hi) { f32x2 v = {lo, hi}; bf16x2v b = __builtin_convertvector(v, bf16x2v); return __builtin_bit_cast(unsigned, b); }
typedef int v4i_t __attribute__((ext_vector_type(4)));
typedef int v8i_t __attribute__((ext_vector_type(8)));
__device__ __forceinline__ v8i_t cat16(bf16x8 lo, bf16x8 hi) { return __builtin_shufflevector(__builtin_bit_cast(v4i_t, lo), __builtin_bit_cast(v4i_t, hi), 0, 1, 2, 3, 4, 5, 6, 7); }
__device__ __forceinline__ unsigned cvt4_fp8(float a, float b, float c, float d) { int w = __builtin_amdgcn_cvt_pk_fp8_f32(a, b, 0, false); w = __builtin_amdgcn_cvt_pk_fp8_f32(c, d, w, true); return (unsigned)w; }
__device__ __forceinline__ float sigmoidf_(float x) { return __builtin_amdgcn_rcpf(1.0f + __expf(-x)); }

struct EpiBf16P {
    static constexpr bool PERM = true, AFTER_DRAIN = false;
    bf16_t* O; int ldc;
    __device__ __forceinline__ void operator()(const f32x4 (&acc)[2][2][4][2], const Unit& u, int wr, int wc, int fr, int fq) const {
        const int row0 = u.pm * BM + wr * 64 + fr, col0 = u.pn * BM + wc * 32 + 8 * fq;
#pragma unroll
        for (int ai = 0; ai < 2; ++ai)
#pragma unroll
            for (int m = 0; m < 4; ++m) { bf16_t* rowp = O + (size_t)(row0 + ai * HALF + m * 16) * ldc + col0;
#pragma unroll
                for (int bj = 0; bj < 2; ++bj) { const f32x4 v0 = acc[ai][bj][m][0], v1 = acc[ai][bj][m][1];
                    u32x4 w; w.x = cvtpk(v0[0], v0[1]); w.y = cvtpk(v0[2], v0[3]); w.z = cvtpk(v1[0], v1[1]); w.w = cvtpk(v1[2], v1[3]);
                    *(u32x4*)(rowp + bj * HALF) = w; } }
    }
};
struct EpiResF32 {
    static constexpr bool PERM = false, AFTER_DRAIN = false;
    const float* base; float* out; int ldc;
    __device__ __forceinline__ void operator()(const f32x4 (&acc)[2][2][4][2], const Unit& u, int wr, int wc, int fr, int fq) const {
        const int row0 = u.pm * BM + wr * 64 + fr, col0 = u.pn * BM + wc * 32 + 4 * fq;
#pragma unroll
        for (int ai = 0; ai < 2; ++ai)
#pragma unroll
            for (int m = 0; m < 4; ++m) { const size_t off = (size_t)(row0 + ai * HALF + m * 16) * ldc + col0;
#pragma unroll
                for (int bj = 0; bj < 2; ++bj)
#pragma unroll
                    for (int n = 0; n < 2; ++n) *(f32x4*)(out + off + bj * HALF + n * 16) = *(const f32x4*)(base + off + bj * HALF + n * 16) + acc[ai][bj][m][n]; }
    }
};
struct EpiMoeAct {
    static constexpr bool PERM = true, AFTER_DRAIN = false;
    bf16_t* O; const float* bgu; const float* rpos;
    __device__ __forceinline__ void operator()(const f32x4 (&acc)[2][2][4][2], const Unit& u, int wr, int wc, int fr, int fq) const {
        const int row0 = u.pm * BM + wr * 64 + fr, ch0 = u.pn * HALF + wc * 32 + 8 * fq;
        const float* bb = bgu + (size_t)u.e * 2048 + ch0;
        f32x4 bg[2], bu[2];
#pragma unroll
        for (int n = 0; n < 2; ++n) { bg[n] = *(const f32x4*)(bb + 4 * n); bu[n] = *(const f32x4*)(bb + 1024 + 4 * n); }
#pragma unroll
        for (int ai = 0; ai < 2; ++ai)
#pragma unroll
            for (int m = 0; m < 4; ++m) { const float rs = rpos[row0 + ai * HALF + m * 16];
                float a[8];
#pragma unroll
                for (int n = 0; n < 2; ++n)
#pragma unroll
                    for (int i = 0; i < 4; ++i) {
                        float g = acc[ai][0][m][n][i] * rs + bg[n][i], up = acc[ai][1][m][n][i] * rs + bu[n][i];
                        g = fminf(g, 7.0f); up = fminf(fmaxf(up, -7.0f), 7.0f);
                        a[n * 4 + i] = (up + 1.0f) * g * sigmoidf_(1.702f * g);
                    }
                u32x2 w; w.x = cvt4_fp8(a[0], a[1], a[2], a[3]); w.y = cvt4_fp8(a[4], a[5], a[6], a[7]);
                *(u32x2*)((unsigned char*)O + (size_t)(row0 + ai * HALF + m * 16) * 1024 + ch0) = w;
            }
    }
};
struct EpiMoeDown {
    static constexpr bool PERM = true, AFTER_DRAIN = false;
    bf16_t* O; const float* bd; const float* gpos;
    __device__ __forceinline__ void operator()(const f32x4 (&acc)[2][2][4][2], const Unit& u, int wr, int wc, int fr, int fq) const {
        const int row0 = u.pm * BM + wr * 64 + fr, col0 = u.pn * BM + wc * 32 + 8 * fq;
        const float* bb = bd + (size_t)u.e * 1024 + col0;
        f32x4 bv[2][2];
#pragma unroll
        for (int bj = 0; bj < 2; ++bj)
#pragma unroll
            for (int n = 0; n < 2; ++n) bv[bj][n] = *(const f32x4*)(bb + bj * HALF + 4 * n);
#pragma unroll
        for (int ai = 0; ai < 2; ++ai)
#pragma unroll
            for (int m = 0; m < 4; ++m) { const int r = row0 + ai * HALF + m * 16; const float gt = gpos[r];
#pragma unroll
                for (int bj = 0; bj < 2; ++bj) { const f32x4 v0 = (acc[ai][bj][m][0] + bv[bj][0]) * gt, v1 = (acc[ai][bj][m][1] + bv[bj][1]) * gt;
                    u32x4 w; w.x = cvtpk(v0[0], v0[1]); w.y = cvtpk(v0[2], v0[3]); w.z = cvtpk(v1[0], v1[1]); w.w = cvtpk(v1[2], v1[3]);
                    *(u32x4*)(O + (size_t)r * 1024 + col0 + bj * HALF) = w; } }
    }
};
struct EpiPle {
    static constexpr bool PERM = false, AFTER_DRAIN = false;
    float* out; const bf16_t* pe; const float* rstd; const float* gpost;
    __device__ __forceinline__ void operator()(const f32x4 (&acc)[2][2][4][2], const Unit& u, int wr, int wc, int fr, int fq) const {
        const int row0 = u.pm * BM + wr * 64 + fr, col0 = u.pn * BM + wc * 32 + 4 * fq;
        f32x4 gp[2][2];
#pragma unroll
        for (int bj = 0; bj < 2; ++bj)
#pragma unroll
            for (int n = 0; n < 2; ++n) gp[bj][n] = *(const f32x4*)(gpost + col0 + bj * HALF + n * 16);
#pragma unroll
        for (int ai = 0; ai < 2; ++ai)
#pragma unroll
            for (int m = 0; m < 4; ++m) { const int r = row0 + ai * HALF + m * 16; const float rs = rstd[r];
#pragma unroll
                for (int bj = 0; bj < 2; ++bj)
#pragma unroll
                    for (int n = 0; n < 2; ++n) { const size_t off = (size_t)r * 1024 + col0 + bj * HALF + n * 16;
                        const u32x2 pw = *(const u32x2*)(pe + off); const f32x4 a = acc[ai][bj][m][n];
                        f32x4 p4; p4[0] = __uint_as_float(pw.x << 16); p4[1] = __uint_as_float(pw.x & 0xffff0000u); p4[2] = __uint_as_float(pw.y << 16); p4[3] = __uint_as_float(pw.y & 0xffff0000u);
                        f32x4 o = *(const f32x4*)(out + off);
#pragma unroll
                        for (int i = 0; i < 4; ++i) o[i] += sigmoidf_(a[i]) * p4[i] * rs * gp[bj][n][i];
                        *(f32x4*)(out + off) = o; } }
    }
};
struct MoeOrder {
    const PG8_LAS int* tile_e; int ntiles, NT, G, c;
    __device__ __forceinline__ bool next(int i, Unit& u) const {
        const int L = (G % 8 == 0) ? i * G + (c & 7) * (G >> 3) + (c >> 3) : i * G + c;
        if (L >= ntiles * NT) return false;
        const int mt = L / NT, nt = L - mt * NT;
        const int e = __builtin_amdgcn_readfirstlane(tile_e[mt]);
        u.pm = mt; u.pn = nt; u.e = e; u.pb = e * NT + nt; return true;
    }
    __device__ __forceinline__ void a_ready(const Unit&) const {}
    __device__ __forceinline__ void done(const Unit&) const {}
};
template <class Epi, class Sched, bool ALIGN_EPI = false, bool SP2 = false, bool FP8 = false, bool GATHER = false>
__device__ __forceinline__ void gemm_phase(PG8_LAS unsigned char* lds, const Gemm g, const Sched& S, const Epi& E) {
    const int tid = threadIdx.x, wid = __builtin_amdgcn_readfirstlane(tid >> 6), lane = tid & 63, wr = wid >> 2, wc = wid & 3, fr = lane & 15, fq = lane >> 4;
    const int K = g.K, nt = K / BK;
    unsigned voffA[2], voffB[2]; int Rr[2]; unsigned cb2[2];
#pragma unroll
    for (int i = 0; i < 2; ++i) { int R, C; stage_rc(tid * 16 + i * 8192, R, C); const int Rb = Epi::PERM ? ((R & ~31) + perm32(R & 31)) : R;
        voffA[i] = (unsigned)(R * K + C) * 2u; voffB[i] = (unsigned)(Rb * K + C) * 2u; Rr[i] = R; cb2[i] = (unsigned)C * 2u; }
    const size_t kstep = (size_t)(BK * 2);
    const size_t hstep = (size_t)HALF * K * 2;
    const size_t tstep = 2 * hstep;
    const unsigned ldsw = (unsigned)wid * 1024u;
    const int aoff = lds_byte(wr * 64 + fr, fq * 8), boff = lds_byte(wc * 32 + fr, fq * 8);
#define PG8_SA(b, h) (((b) * 2 + (h)) * HTB)
#define PG8_SB(b, h) ((4 + (b) * 2 + (h)) * HTB)
#define PG8_STAGE(bufoff, gbase, voff) do { _Pragma("unroll") for (int _i = 0; _i < 2; ++_i) \
        __builtin_amdgcn_global_load_lds((const unsigned*)((const char*)(gbase) + (voff)[_i]), (PG8_LAS unsigned*)(lds + (bufoff) + ldsw + _i * 8192), 16, 0, 0); } while (0)
#define PG8_GOFF(dst, pm_) do { _Pragma("unroll") for (int _h = 0; _h < 2; ++_h) _Pragma("unroll") for (int _i = 0; _i < 2; ++_i) dst[_h][_i] = (unsigned)g.rowmap[(pm_) * BM + _h * HALF + Rr[_i]] * (unsigned)(K * 2) + cb2[_i]; } while (0)
#define PG8_STAGE_A(bufoff, ptr, half, nsel) do { if constexpr (GATHER) { unsigned _v[2]; _v[0] = (nsel) ? nvA[half][0] : vA[half][0]; _v[1] = (nsel) ? nvA[half][1] : vA[half][1]; PG8_STAGE(bufoff, ptr, _v); } \
        else { PG8_STAGE(bufoff, (ptr) + ((half) ? hstep : 0), voffA); } } while (0)
#define PG8_LD1(off) (*(const PG8_LAS bf16x8*)(lds + (off)))
#define PG8_LDA(dst, b, h) do { if constexpr (FP8) { _Pragma("unroll") for (int m = 0; m < 4; ++m) dst##8[m] = cat16(PG8_LD1(PG8_SA(b, h) + aoff + m * 2048), PG8_LD1(PG8_SA(b, h) + aoff + m * 2048 + 1024)); } \
        else { _Pragma("unroll") for (int m = 0; m < 4; ++m) _Pragma("unroll") for (int k = 0; k < 2; ++k) dst[m][k] = PG8_LD1(PG8_SA(b, h) + aoff + m * 2048 + k * 1024); } } while (0)
#define PG8_LDB(dst, b, h) do { if constexpr (FP8) { _Pragma("unroll") for (int n = 0; n < 2; ++n) dst##8[n] = cat16(PG8_LD1(PG8_SB(b, h) + boff + n * 2048), PG8_LD1(PG8_SB(b, h) + boff + n * 2048 + 1024)); } \
        else { _Pragma("unroll") for (int n = 0; n < 2; ++n) _Pragma("unroll") for (int k = 0; k < 2; ++k) dst[n][k] = PG8_LD1(PG8_SB(b, h) + boff + n * 2048 + k * 1024); } } while (0)
#define PG8_MMA(ai, bj, At, Bt) do { if constexpr (FP8) __builtin_amdgcn_sched_barrier(0); __builtin_amdgcn_s_setprio(1); _Pragma("unroll") for (int m = 0; m < 4; ++m) _Pragma("unroll") for (int n = 0; n < 2; ++n) { \
        if constexpr (FP8) { acc[ai][bj][m][n] = __builtin_amdgcn_mfma_scale_f32_16x16x128_f8f6f4(Bt##8[n], At##8[m], acc[ai][bj][m][n], 0, 0, 0, 0x79797979, 0, 0x7f7f7f7f); } \
        else { _Pragma("unroll") for (int k = 0; k < 2; ++k) acc[ai][bj][m][n] = __builtin_amdgcn_mfma_f32_16x16x32_bf16(Bt[n][k], At[m][k], acc[ai][bj][m][n], 0, 0, 0); } } \
        if constexpr (FP8) { _Pragma("unroll") for (int m = 0; m < 4; ++m) _Pragma("unroll") for (int n = 0; n < 2; ++n) asm volatile("" : "+v"(acc[ai][bj][m][n])); }     \
        __builtin_amdgcn_s_setprio(0); if constexpr (FP8) __builtin_amdgcn_sched_barrier(0); } while (0)
#define PG8_WAIT_V(n) asm volatile("s_waitcnt vmcnt(" #n ")" ::: "memory")
#define PG8_WAIT_L(n) asm volatile("s_waitcnt lgkmcnt(" #n ")" ::: "memory")
#define PG8_BAR __builtin_amdgcn_s_barrier()
#define PG8_SCHED __builtin_amdgcn_sched_barrier(0)
    Unit cur, nxt; int ui = 0;
    if (!S.next(0, cur)) return;
    f32x4 acc[2][2][4][2];
#pragma unroll
    for (int a = 0; a < 2; ++a)
#pragma unroll
        for (int b = 0; b < 2; ++b)
#pragma unroll
            for (int m = 0; m < 4; ++m)
#pragma unroll
                for (int n = 0; n < 2; ++n) acc[a][b][m][n] = (f32x4){0.f, 0.f, 0.f, 0.f};
    bf16x8 At[4][2], B0[2][2], B1[2][2]; v8i_t At8[4], B08[2], B18[2];
    unsigned vA[2][2], nvA[2][2];
    if constexpr (GATHER) { PG8_GOFF(vA, cur.pm); }
    const char* cA = (const char*)g.A + (GATHER ? (size_t)0 : (size_t)cur.pm * tstep); const char* cB = (const char*)g.Bt + (size_t)cur.pb * tstep;
    S.a_ready(cur);
    if constexpr (SP2) {
        PG8_STAGE(PG8_SB(0, 0), cB, voffB); PG8_STAGE(PG8_SB(0, 1), cB + hstep, voffB); PG8_STAGE_A(PG8_SA(0, 0), cA, 0, false); PG8_STAGE_A(PG8_SA(0, 1), cA, 1, false);
        if (wr == 1) PG8_BAR;
        PG8_WAIT_V(2); PG8_BAR;
        PG8_STAGE(PG8_SB(1, 0), cB + kstep, voffB); PG8_STAGE_A(PG8_SA(1, 0), cA + kstep, 0, false); PG8_STAGE(PG8_SB(1, 1), cB + hstep + kstep, voffB);
        PG8_WAIT_V(6); PG8_BAR;
    } else {
        PG8_STAGE(PG8_SB(0, 0), cB, voffB); PG8_STAGE_A(PG8_SA(0, 0), cA, 0, false); PG8_STAGE(PG8_SB(0, 1), cB + hstep, voffB); PG8_STAGE_A(PG8_SA(0, 1), cA, 1, false);
        if (wr == 1) PG8_BAR;
        PG8_WAIT_V(4); PG8_BAR;
        PG8_STAGE(PG8_SB(1, 0), cB + kstep, voffB); PG8_STAGE_A(PG8_SA(1, 0), cA + kstep, 0, false); PG8_STAGE(PG8_SB(1, 1), cB + hstep + kstep, voffB);
        PG8_WAIT_V(6); PG8_BAR;
    }
    for (;;) {
        const bool has_next = S.next(ui + 1, nxt);
        if constexpr (GATHER) { if (has_next) { PG8_GOFF(nvA, nxt.pm); } else { _Pragma("unroll") for (int _h = 0; _h < 2; ++_h) _Pragma("unroll") for (int _i = 0; _i < 2; ++_i) nvA[_h][_i] = vA[_h][_i]; } }
        const char* nA = (has_next && !GATHER) ? (const char*)g.A + (size_t)nxt.pm * tstep : cA; const char* nB = has_next ? (const char*)g.Bt + (size_t)nxt.pb * tstep : cB;
        for (int t = 0; t < nt; t += 2) {
            const bool last = (t == nt - 2);
            const char* a1 = cA + (size_t)(t + 1) * kstep;
            const char* a2 = last ? nA : cA + (size_t)(t + 2) * kstep; const char* b2 = last ? nB : cB + (size_t)(t + 2) * kstep;
            const char* a3 = a2 + kstep; const char* b3 = b2 + kstep;
            if (last && has_next) S.a_ready(nxt);
            if constexpr (SP2) {
            PG8_LDB(B0, 0, 0); PG8_LDB(B1, 0, 1); PG8_SCHED; PG8_LDA(At, 0, 0); PG8_STAGE_A(PG8_SA(1, 1), a1, 1, false);
            PG8_WAIT_V(8); PG8_WAIT_L(0); PG8_BAR; PG8_MMA(0, 0, At, B0); PG8_MMA(0, 1, At, B1); PG8_BAR; PG8_SCHED;
            PG8_LDA(At, 0, 1); PG8_STAGE(PG8_SB(0, 0), b2, voffB); PG8_STAGE(PG8_SB(0, 1), b2 + hstep, voffB); PG8_STAGE_A(PG8_SA(0, 0), a2, 0, last);
            PG8_WAIT_V(8); PG8_WAIT_L(0); PG8_BAR; PG8_MMA(1, 0, At, B0); PG8_MMA(1, 1, At, B1); PG8_BAR; PG8_SCHED;
            PG8_LDB(B0, 1, 0); PG8_LDB(B1, 1, 1); PG8_SCHED; PG8_LDA(At, 1, 0); PG8_STAGE_A(PG8_SA(0, 1), a2, 1, last);
            PG8_WAIT_V(8); PG8_WAIT_L(0); PG8_BAR; PG8_MMA(0, 0, At, B0); PG8_MMA(0, 1, At, B1); PG8_BAR; PG8_SCHED;
            PG8_LDA(At, 1, 1); PG8_STAGE(PG8_SB(1, 0), b3, voffB); PG8_STAGE(PG8_SB(1, 1), b3 + hstep, voffB); PG8_STAGE_A(PG8_SA(1, 0), a3, 0, last);
            PG8_WAIT_V(8); PG8_WAIT_L(0); PG8_BAR; PG8_MMA(1, 0, At, B0); PG8_MMA(1, 1, At, B1); PG8_BAR; PG8_SCHED;
            } else {
            PG8_LDB(B0, 0, 0); PG8_SCHED; PG8_LDA(At, 0, 0); PG8_STAGE_A(PG8_SA(1, 1), a1, 1, false);
            PG8_WAIT_L(8); PG8_BAR; PG8_WAIT_L(0); PG8_MMA(0, 0, At, B0); PG8_BAR; PG8_SCHED;
            PG8_LDB(B1, 0, 1); PG8_STAGE(PG8_SB(0, 0), b2, voffB);
            PG8_BAR; PG8_WAIT_L(0); PG8_MMA(0, 1, At, B1); PG8_BAR;
            PG8_LDA(At, 0, 1); PG8_STAGE_A(PG8_SA(0, 0), a2, 0, last);
            PG8_BAR; PG8_WAIT_L(0); PG8_MMA(1, 0, At, B0); PG8_BAR; PG8_SCHED;
            PG8_STAGE(PG8_SB(0, 1), b2 + hstep, voffB);
            PG8_WAIT_V(6); PG8_BAR; PG8_MMA(1, 1, At, B1); PG8_BAR;
            PG8_LDB(B0, 1, 0); PG8_SCHED; PG8_LDA(At, 1, 0); PG8_STAGE_A(PG8_SA(0, 1), a2, 1, last);
            PG8_WAIT_L(8); PG8_BAR; PG8_WAIT_L(0); PG8_MMA(0, 0, At, B0); PG8_BAR; PG8_SCHED;
            PG8_LDB(B1, 1, 1); PG8_STAGE(PG8_SB(1, 0), b3, voffB);
            PG8_BAR; PG8_WAIT_L(0); PG8_MMA(0, 1, At, B1); PG8_BAR;
            PG8_LDA(At, 1, 1); PG8_STAGE_A(PG8_SA(1, 0), a3, 0, last);
            PG8_BAR; PG8_WAIT_L(0); PG8_MMA(1, 0, At, B0); PG8_BAR; PG8_SCHED;
            PG8_STAGE(PG8_SB(1, 1), b3 + hstep, voffB);
            PG8_WAIT_V(6); PG8_BAR; PG8_MMA(1, 1, At, B1); PG8_BAR;
            }
        }
        if constexpr (ALIGN_EPI) { if (wr == 0) PG8_BAR; }
        if constexpr (!Epi::AFTER_DRAIN) { E(acc, cur, wr, wc, fr, fq); S.done(cur); }
        if (!has_next) break;
#pragma unroll
        for (int a = 0; a < 2; ++a)
#pragma unroll
            for (int b = 0; b < 2; ++b)
#pragma unroll
                for (int m = 0; m < 4; ++m)
#pragma unroll
                    for (int n = 0; n < 2; ++n) acc[a][b][m][n] = (f32x4){0.f, 0.f, 0.f, 0.f};
        cur = nxt; cA = nA; cB = nB; ++ui;
        if constexpr (GATHER) { _Pragma("unroll") for (int _h = 0; _h < 2; ++_h) _Pragma("unroll") for (int _i = 0; _i < 2; ++_i) vA[_h][_i] = nvA[_h][_i]; }
        if constexpr (ALIGN_EPI) { if (wr == 1) PG8_BAR; }
    }
    PG8_WAIT_V(0);
    if constexpr (!ALIGN_EPI) { if (wr == 0) PG8_BAR; }
    PG8_BAR;
    if constexpr (Epi::AFTER_DRAIN) { E.fused(acc, cur, wr, wc, fr, fq, lds, wid, lane); S.done(cur); }
#undef PG8_SA
#undef PG8_SB
#undef PG8_STAGE
#undef PG8_GOFF
#undef PG8_STAGE_A
#undef PG8_LD1
#undef PG8_LDA
#undef PG8_LDB
#undef PG8_MMA
#undef PG8_WAIT_V
#undef PG8_WAIT_L
#undef PG8_BAR
#undef PG8_SCHED
}
}

constexpr int NWAVES = 8;
constexpr int T = 16384, D = 1024, NCH = 256, LDP = 3840, DIN = 3608, PLE = 256, NE = 32;
constexpr int C_GQ = 0, C_GK = 256, C_GV = 512, C_GR = 1024, C_DQ = 1536, C_DZ = 3072, C_GLR = 3584, C_DA = 3600, C_DB = 3604;
constexpr float EPS = 1e-6f;
constexpr int XS_ROWS = 65536 + NE * 256;

constexpr size_t MiB = 1u << 20;
constexpr size_t WS_CTL = 0, CTL_ZERO_BYTES = 1 * MiB;
constexpr size_t WS_WIN = 2 * MiB, WS_WPP = 10 * MiB, WS_WOUT = 11 * MiB, WS_WPG = 13 * MiB, WS_W1 = 16 * MiB, WS_W2 = 80 * MiB;
constexpr size_t WS_XN = 112 * MiB, WS_PB = 144 * MiB, WS_PROJ = 152 * MiB, WS_PERAW = 272 * MiB;
constexpr size_t WS_KVT = 304 * MiB, WS_DVEC = 336 * MiB, WS_SGLA = 337 * MiB, WS_WF = 353 * MiB, WS_KDF = 369 * MiB, WS_UF = 385 * MiB, WS_CDEC = 417 * MiB;
constexpr size_t WS_QDEC = 418 * MiB, WS_AQK = 434 * MiB, WS_SGDN = 442 * MiB, WS_DELTA = 474 * MiB, WS_MIX = 490 * MiB;
constexpr size_t WS_TOKE = 522 * MiB, WS_TOKS = WS_TOKE + 256 * 1024, WS_TOKG = WS_TOKS + 256 * 1024, WS_TOKP = WS_TOKG + 256 * 1024;
constexpr size_t WS_GPOS = 523 * MiB, WS_PERSTD = 524 * MiB, WS_XS = 525 * MiB, WS_TOKQ = WS_XS  , WS_HS = 597 * MiB, WS_YS = 669 * MiB;
constexpr size_t WS_PEND = 813 * MiB, WS_SLE = 821 * MiB, WS_SST = 837 * MiB, WS_GSLE = 853 * MiB, WS_GPD = 861 * MiB, WS_GSST = 869 * MiB, WS_QT = 877 * MiB, WS_OI = 885 * MiB, WS_WRF = 901 * MiB, WS_RSTD = 902 * MiB, WS_RPOS = 903 * MiB, WS_END = 904 * MiB;
static_assert(WS_XS + (size_t)XS_ROWS * 1024 <= WS_HS && WS_HS + (size_t)XS_ROWS * 1024 <= WS_YS && WS_YS + (size_t)XS_ROWS * 2048 <= WS_PEND, "d_ws map");
constexpr int GRP = 4, NGRP = NCH / GRP;
constexpr int CW_TMO = 0, CW_CODE = 1, CW_BAR = 4096, CW_CNT = 8192;

constexpr int RING_OFF = 0, RING_BYTES = 131072;
constexpr int LDSCTL_OFF = RING_BYTES, MISC_OFF = LDSCTL_OFF + 320;
constexpr int TILEE_OFF = MISC_OFF + 128;
constexpr int BASE_OFF = TILEE_OFF + 320 * 4;
constexpr int ROUTE_OFF = BASE_OFF + 128;
constexpr int LDS_BYTES = 147456;
static_assert(ROUTE_OFF + 256 + 3072 <= LDS_BYTES, "LDS map");

#define GAS __attribute__((address_space(1)))
#define LAS __attribute__((address_space(3)))
typedef unsigned short bf16;
typedef unsigned v4u __attribute__((ext_vector_type(4)));
typedef float f32x4 __attribute__((ext_vector_type(4)));
typedef short bf16x8 __attribute__((ext_vector_type(8)));
typedef GAS unsigned gu32;
typedef GAS unsigned long long gu64;
#define RLX_AGENT __ATOMIC_RELAXED, __HIP_MEMORY_SCOPE_AGENT
#define LDS_WAIT() asm volatile("s_waitcnt lgkmcnt(0)" ::: "memory")
#define VM_WAIT() asm volatile("s_waitcnt vmcnt(0)" ::: "memory")
__device__ __forceinline__ unsigned long long rt() { return __builtin_amdgcn_s_memrealtime(); }
__device__ __forceinline__ unsigned f2bf(float f) { unsigned u = __builtin_bit_cast(unsigned, f); return (u + 0x7fffu + ((u >> 16) & 1u)) >> 16; }
__device__ __forceinline__ unsigned pk2(float lo, float hi) { return f2bf(lo) | (f2bf(hi) << 16); }

#define XB_TMO      128
#define XB_XCNT(j)  (256  + 64 * (j))
#define XB_XSUB(j)  (1280 + 64 * (j))
#define XB_XGEN(j)  (2304 + 64 * (j))
#define XB_TOP      3328
#define XB_TOPGEN   3392
#define XCD_BAR_WORDS 3456
#define XB_SPIN_CAP (1u << 18)

__device__ __forceinline__ unsigned xb_ld(unsigned* p)              { return __hip_atomic_load(p, __ATOMIC_RELAXED, __HIP_MEMORY_SCOPE_AGENT); }
__device__ __forceinline__ unsigned xb_add(unsigned* p, unsigned v) { return __hip_atomic_fetch_add(p, v, __ATOMIC_RELAXED, __HIP_MEMORY_SCOPE_AGENT); }
__device__ __forceinline__ unsigned xb_xcc_id() { return (unsigned)__builtin_amdgcn_s_getreg((3 << 11) | 20) & 0xFu; }
#define XB_SPIN(cond, bar) do { unsigned _sp = 0; while (cond) { __builtin_amdgcn_s_sleep(1); \
    if ((++_sp & 255u) == 0u) { if (xb_ld(&(bar)[XB_TMO])) break; if (_sp > XB_SPIN_CAP) { atomicAdd(&(bar)[XB_TMO], 1u); break; } } } } while (0)

struct XcdBarrier {
    unsigned* bar; unsigned x;
    volatile LAS unsigned* st;
};

__device__ __forceinline__ XcdBarrier xcd_barrier_post(unsigned* bar, volatile LAS unsigned* st) {
    XcdBarrier b; b.bar = bar; b.x = xb_xcc_id(); b.st = st;
    if (threadIdx.x == 0) (void)xb_add(&bar[XB_XCNT(b.x)], 1u);
    return b;
}
__device__ __forceinline__ void xcd_barrier_complete(unsigned* bar, unsigned x, unsigned& nloc, unsigned& nx) {
    const unsigned G = gridDim.x * gridDim.y * gridDim.z;
    unsigned sum, cnt, mine, sp = 0u;
    for (;;) {
        sum = 0u; cnt = 0u; mine = 0u;
#pragma unroll
        for (unsigned j = 0; j < 16; ++j) { const unsigned c = xb_ld(&bar[XB_XCNT(j)]); sum += c; cnt += (c > 0u) ? 1u : 0u; mine = (j == x) ? c : mine; }
        if (sum == G) break;
        __builtin_amdgcn_s_sleep(1);
        if ((++sp & 255u) == 0u) { if (xb_ld(&bar[XB_TMO])) break; if (sp > XB_SPIN_CAP) { atomicAdd(&bar[XB_TMO], 1u); break; } }
    }
    nloc = mine > 0u ? mine : 1u; nx = cnt > 0u ? cnt : 1u;
}

__device__ __forceinline__ void xcd_barrier(const XcdBarrier& b) {
    asm volatile("s_waitcnt vmcnt(0)" ::: "memory");
    __syncthreads();
    if (threadIdx.x == 0) {
        unsigned* bar = b.bar;
        __builtin_amdgcn_s_waitcnt(0);
        unsigned nloc = b.st[0], nx = b.st[1];
        if (nloc == 0u) { xcd_barrier_complete(bar, b.x, nloc, nx); b.st[0] = nloc; b.st[1] = nx; }
        const unsigned old = xb_add(&bar[XB_XSUB(b.x)], 1u);
        const unsigned gen = old / nloc;
        if (old + 1u == (gen + 1u) * nloc) {
            __builtin_amdgcn_fence(__ATOMIC_RELEASE, "agent");
            asm volatile("s_waitcnt vmcnt(0)" ::: "memory");
            const unsigned og = xb_add(&bar[XB_TOP], 1u);
            const unsigned tg = og / nx;
            if (og + 1u == (tg + 1u) * nx) xb_add(&bar[XB_TOPGEN], 1u);
            else XB_SPIN(xb_ld(&bar[XB_TOPGEN]) == tg, bar);
            __builtin_amdgcn_fence(__ATOMIC_ACQUIRE, "agent");
            xb_add(&bar[XB_XGEN(b.x)], 1u);
            asm volatile("s_waitcnt vmcnt(0)" ::: "memory");
        } else {
            XB_SPIN(xb_ld(&bar[XB_XGEN(b.x)]) == gen, bar);
            __builtin_amdgcn_fence(__ATOMIC_ACQUIRE, "agent");
            asm volatile("s_waitcnt vmcnt(0)" ::: "memory");
        }
    }
    __syncthreads();
}


__device__ __forceinline__ float bflo(unsigned w) { return __uint_as_float(w << 16); }
__device__ __forceinline__ float bfhi(unsigned w) { return __uint_as_float(w & 0xffff0000u); }
__device__ __forceinline__ float bf2f(bf16 h) { return __uint_as_float((unsigned)h << 16); }
using pg8::cvtpk;
__device__ __forceinline__ bf16 f2bf1(float f) { return (bf16)(cvtpk(f, 0.f) & 0xffffu); }
__device__ __forceinline__ float wave_sum(float v) {
#pragma unroll
    for (int o = 1; o < 64; o <<= 1) v += __shfl_xor(v, o);
    return v;
}
__device__ __forceinline__ float sigm(float x) { return __builtin_amdgcn_rcpf(1.0f + __expf(-x)); }
__device__ __forceinline__ float siluf_(float x) { return x * sigm(x); }
__device__ __forceinline__ float softplusf_(float x) { return fmaxf(x, 0.f) + __logf(1.0f + __expf(-fabsf(x))); }
__device__ __forceinline__ float logsigf_(float x) { return fminf(x, 0.f) - __logf(1.0f + __expf(-fabsf(x))); }
#define MFMA16(a, b, c) __builtin_amdgcn_mfma_f32_16x16x32_bf16((a), (b), (c), 0, 0, 0)
typedef short bf16x4 __attribute__((ext_vector_type(4)));
typedef unsigned u32x2 __attribute__((ext_vector_type(2)));
__device__ __forceinline__ bf16x8 cat8(bf16x4 lo, bf16x4 hi) { return __builtin_shufflevector(lo, hi, 0, 1, 2, 3, 4, 5, 6, 7); }
__device__ __forceinline__ bf16x8 pack8(const f32x4& a, const f32x4& b) {
    v4u w; w.x = cvtpk(a[0], a[1]); w.y = cvtpk(a[2], a[3]); w.z = cvtpk(b[0], b[1]); w.w = cvtpk(b[2], b[3]); return __builtin_bit_cast(bf16x8, w);
}
__device__ __forceinline__ u32x2 pack4(const f32x4& a) { u32x2 w; w.x = cvtpk(a[0], a[1]); w.y = cvtpk(a[2], a[3]); return w; }

struct Frame {
    LAS unsigned char* lds;
    volatile LAS unsigned* MISC;
    gu32* ctl;
    int tid, lane, wave;
    int vcu, G;
    unsigned char* ws;
    const float* in[24];
    float* out;
};
#define WSP(T_, off) ((T_*)(F.ws + (off)))

__device__ __forceinline__ void titem_load(const float* W0, size_t wstride, int K, int N, int nblk, int ipm, int it, int lane, f32x4 (&v)[8]) {
    const int m = it / ipm, li = it - m * ipm, kb = li / nblk, nb = li - kb * nblk, k0 = 64 * kb, n0 = 32 * nb, cq = (lane & 7) * 4, rr = lane >> 3;
    const float* W = W0 + (size_t)m * wstride;
#pragma unroll
    for (int i = 0; i < 8; ++i) { v[i] = (f32x4){0.f, 0.f, 0.f, 0.f}; if (n0 + cq < N) v[i] = *(const GAS f32x4*)(W + (size_t)(k0 + 8 * i + rr) * N + n0 + cq); }
}
template <bool FP8, class RowMap>
__device__ __forceinline__ void transpose_set(const float* W0, size_t wstride, unsigned char* WT0, size_t wtstride, int K, int N, int nmat, LAS float* scr, int gw, int NGW, int lane, RowMap rm) {
    const int nblk = (N + 31) >> 5, ipm = (K >> 6) * nblk, total = nmat * ipm;
    int it = gw; if (it >= total) return;
    f32x4 cur[8], nxt[8];
    titem_load(W0, wstride, K, N, nblk, ipm, it, lane, cur);
    for (; it < total; it += NGW) {
        const bool more = it + NGW < total;
        if (more) titem_load(W0, wstride, K, N, nblk, ipm, it + NGW, lane, nxt);
        const int m = it / ipm, li = it - m * ipm, kb = li / nblk, nb = li - kb * nblk, k0 = 64 * kb, n0 = 32 * nb, cq = (lane & 7) * 4, rr = lane >> 3, c = lane & 7;
        const float sc = FP8 ? 64.f : 1.f;
#pragma unroll
        for (int i = 0; i < 8; ++i) { LAS float* s = scr + (8 * i + rr) * 33 + cq; s[0] = cur[i][0] * sc; s[1] = cur[i][1] * sc; s[2] = cur[i][2] * sc; s[3] = cur[i][3] * sc; }
        LDS_WAIT(); asm volatile("" ::: "memory");
        unsigned char* WT = WT0 + (size_t)m * wtstride;
#pragma unroll
        for (int j = 0; j < 4; ++j) { const int n = (lane >> 3) + 8 * j; const LAS float* s = scr + (8 * c) * 33 + n;
            if (n0 + n < N) {
                if (FP8) { u32x2 o; o.x = pg8::cvt4_fp8(s[0 * 33], s[1 * 33], s[2 * 33], s[3 * 33]); o.y = pg8::cvt4_fp8(s[4 * 33], s[5 * 33], s[6 * 33], s[7 * 33]);
                    *(GAS u32x2*)(WT + (size_t)rm(n0 + n) * K + k0 + 8 * c) = o; }
                else { v4u o; o.x = cvtpk(s[0 * 33], s[1 * 33]); o.y = cvtpk(s[2 * 33], s[3 * 33]); o.z = cvtpk(s[4 * 33], s[5 * 33]); o.w = cvtpk(s[6 * 33], s[7 * 33]);
                    *(GAS v4u*)((bf16*)WT + (size_t)rm(n0 + n) * K + k0 + 8 * c) = o; } } }
        LDS_WAIT(); asm volatile("" ::: "memory");
        if (more) {
#pragma unroll
            for (int i = 0; i < 8; ++i) cur[i] = nxt[i]; }
    }
}
__device__ __forceinline__ void titem_load_w(const float* W0, size_t wstride, int N, int nblk, int ipm, int it, int lane, f32x4 (&v)[16]) {
    const int m = it / ipm, li = it - m * ipm, kb = li / nblk, nb = li - kb * nblk, k0 = 64 * kb, n0 = 64 * nb, cq = (lane & 7) * 4, rr = lane >> 3;
    const float* W = W0 + (size_t)m * wstride;
#pragma unroll
    for (int i = 0; i < 8; ++i) { const GAS f32x4* p = (const GAS f32x4*)(W + (size_t)(k0 + 8 * i + rr) * N + n0 + cq); v[2 * i] = p[0]; v[2 * i + 1] = p[8]; }
}
template <class RowMap>
__device__ __forceinline__ void transpose_set_w(const float* W0, size_t wstride, unsigned char* WT0, size_t wtstride, int K, int N, int nmat, LAS float* scr, int gw, int NGW, int lane, RowMap rm) {
    const int nblk = N >> 6, ipm = (K >> 6) * nblk, total = nmat * ipm;
    int it = gw; if (it >= total) return;
    f32x4 cur[16], nxt[16];
    titem_load_w(W0, wstride, N, nblk, ipm, it, lane, cur);
    for (; it < total; it += NGW) {
        const bool more = it + NGW < total;
        if (more) titem_load_w(W0, wstride, N, nblk, ipm, it + NGW, lane, nxt);
        const int m = it / ipm, li = it - m * ipm, kb = li / nblk, nb = li - kb * nblk, k0 = 64 * kb, n0 = 64 * nb, cq = (lane & 7) * 4, rr = lane >> 3, c = lane & 7;
        unsigned char* WT = WT0 + (size_t)m * wtstride;
#pragma unroll
        for (int hf = 0; hf < 2; ++hf) {
#pragma unroll
            for (int i = 0; i < 8; ++i) { LAS float* s = scr + (8 * i + rr) * 33 + cq; const f32x4 x = cur[2 * i + hf]; s[0] = x[0] * 64.f; s[1] = x[1] * 64.f; s[2] = x[2] * 64.f; s[3] = x[3] * 64.f; }
            LDS_WAIT(); asm volatile("" ::: "memory");
#pragma unroll
            for (int j = 0; j < 4; ++j) { const int n = (lane >> 3) + 8 * j; const LAS float* s = scr + (8 * c) * 33 + n;
                u32x2 o; o.x = pg8::cvt4_fp8(s[0 * 33], s[1 * 33], s[2 * 33], s[3 * 33]); o.y = pg8::cvt4_fp8(s[4 * 33], s[5 * 33], s[6 * 33], s[7 * 33]);
                *(GAS u32x2*)(WT + (size_t)rm(n0 + 32 * hf + n) * K + k0 + 8 * c) = o; }
            LDS_WAIT(); asm volatile("" ::: "memory");
        }
        if (more) {
#pragma unroll
            for (int i = 0; i < 16; ++i) cur[i] = nxt[i]; }
    }
}
struct RmId { __device__ __forceinline__ int operator()(int n) const { return n; } };
struct RmWin { __device__ __forceinline__ int operator()(int c) const { return c < 1536 ? c : (c < 1552 ? c + 2048 : (c < 3600 ? c - 16 : c)); } };
struct RmW1 { __device__ __forceinline__ int operator()(int c) const { const int j = c & 1023, up = c >> 10; return (j >> 7) * 256 + up * 128 + (j & 127); } };

__device__ __forceinline__ void rms_row_to_bf16(const float* xrow, const float* g, bf16* orow, int lane) {
    const GAS f32x4* xr = (const GAS f32x4*)xrow + lane; const GAS f32x4* gr = (const GAS f32x4*)g + lane;
    f32x4 v[4]; float s = 0.f;
#pragma unroll
    for (int j = 0; j < 4; ++j) { v[j] = xr[64 * j]; s += (v[j].x * v[j].x + v[j].y * v[j].y) + (v[j].z * v[j].z + v[j].w * v[j].w); }
    const float rstd = 1.f / sqrtf(wave_sum(s) * (1.f / D) + EPS);
    GAS u32x2* o8 = (GAS u32x2*)orow + lane;
#pragma unroll
    for (int j = 0; j < 4; ++j) { const f32x4 gg = gr[64 * j]; u32x2 w; w.x = cvtpk(v[j].x * rstd * gg.x, v[j].y * rstd * gg.y); w.y = cvtpk(v[j].z * rstd * gg.z, v[j].w * rstd * gg.w); o8[64 * j] = w; }
}

__device__ __forceinline__ void p0_prologue(Frame& F) {
    LAS float* scr = (LAS float*)(F.lds + RING_OFF + F.wave * 16384);
    const int gw = F.vcu * NWAVES + F.wave, NGW = F.G * NWAVES, lane = F.lane;
    bf16* Win_t = WSP(bf16, WS_WIN);
    transpose_set<false>(F.in[3], 0, (unsigned char*)Win_t, 0, 1024, DIN, 1, scr, gw, NGW, lane, RmWin());
    for (int r = DIN + gw; r < LDP; r += NGW) { GAS v4u* o = (GAS v4u*)(Win_t + (size_t)r * 1024) + lane; o[0] = (v4u){0, 0, 0, 0}; o[64] = (v4u){0, 0, 0, 0}; }
    transpose_set<false>(F.in[21], 0, WSP(unsigned char, WS_WPP), 0, PLE, D, 1, scr, gw, NGW, lane, RmId());
    transpose_set<false>(F.in[11], 0, WSP(unsigned char, WS_WOUT), 0, D, D, 1, scr, gw, NGW, lane, RmId());
    transpose_set<false>(F.in[20], 0, WSP(unsigned char, WS_WPG), 0, D, D, 1, scr, gw, NGW, lane, RmId());
    transpose_set_w(F.in[15], (size_t)1024 * 2048, WSP(unsigned char, WS_W1), (size_t)2048 * 1024, 1024, 2048, NE, scr, gw, NGW, lane, RmW1());
    transpose_set_w(F.in[17], (size_t)1024 * 1024, WSP(unsigned char, WS_W2), (size_t)1024 * 1024, 1024, 1024, NE, scr, gw, NGW, lane, RmId());
    for (int id = F.vcu * NWAVES * 64 + F.tid; id < 32 * 2 * 64; id += F.G * NWAVES * 64) { const int ln = id & 63, nt = (id >> 6) & 1, ks = id >> 7, n = ln & 15, kq = ln >> 4;
        float hi[8], lo[8];
#pragma unroll
        for (int j = 0; j < 8; ++j) { const int d = 32 * ks + 8 * kq + j; const float v = F.in[12][d] * F.in[13][(size_t)d * 32 + 16 * nt + n]; hi[j] = bf2f(f2bf1(v)); lo[j] = v - hi[j]; }
        v4u oh, ol;
#pragma unroll
        for (int j = 0; j < 4; ++j) { oh[j] = cvtpk(hi[2 * j], hi[2 * j + 1]); ol[j] = cvtpk(lo[2 * j], lo[2 * j + 1]); }
        GAS v4u* W = (GAS v4u*)WSP(bf16, WS_WRF) + (size_t)((ks * 2 + nt) * 2) * 64 + ln; W[0] = oh; W[64] = ol; }
    for (int m0 = gw; m0 < T; m0 += 4 * NGW) {
        f32x4 v[4][4];
#pragma unroll
        for (int q = 0; q < 4; ++q) { const int m = m0 + q * NGW; const GAS f32x4* xr = (const GAS f32x4*)(F.in[0] + (size_t)(m < T ? m : 0) * D) + lane;
#pragma unroll
            for (int j = 0; j < 4; ++j) v[q][j] = xr[64 * j]; }
#pragma unroll
        for (int q = 0; q < 4; ++q) { const int m = m0 + q * NGW; if (m >= T) break;
            float s2 = 0.f;
#pragma unroll
            for (int j = 0; j < 4; ++j) s2 += (v[q][j].x * v[q][j].x + v[q][j].y * v[q][j].y) + (v[q][j].z * v[q][j].z + v[q][j].w * v[q][j].w);
            const float rstd = 1.f / sqrtf(wave_sum(s2) * (1.f / D) + EPS);
            const GAS f32x4* gr = (const GAS f32x4*)F.in[2] + lane; GAS u32x2* o8 = (GAS u32x2*)(WSP(bf16, WS_XN) + (size_t)m * D) + lane;
#pragma unroll
            for (int j = 0; j < 4; ++j) { const f32x4 gg = gr[64 * j]; u32x2 w; w.x = cvtpk(v[q][j].x * rstd * gg.x, v[q][j].y * rstd * gg.y); w.y = cvtpk(v[q][j].z * rstd * gg.z, v[q][j].w * rstd * gg.w); o8[64 * j] = w; } }
    }
    for (int m0 = gw; m0 < T; m0 += 8 * NGW) {
        f32x4 v[8];
#pragma unroll
        for (int q = 0; q < 8; ++q) { const int m = m0 + q * NGW; v[q] = *((const GAS f32x4*)(F.in[1] + (size_t)(m < T ? m : 0) * PLE) + lane); }
#pragma unroll
        for (int q = 0; q < 8; ++q) { const int m = m0 + q * NGW; if (m >= T) break; u32x2 w; w.x = cvtpk(v[q].x, v[q].y); w.y = cvtpk(v[q].z, v[q].w); *((GAS u32x2*)(WSP(bf16, WS_PB) + (size_t)m * PLE) + lane) = w; }
    }
}

constexpr int GL_B = 0, GL_GLR = 16640, GL_T1 = 20992, GL_T2 = 30208, GL_T3 = 39424, GL_VT = 48640;
__device__ __forceinline__ void gla_b(Frame& F, int n, int h) {
    LAS float* bL = (LAS float*)(F.lds + GL_B); LAS float* glrL = (LAS float*)(F.lds + GL_GLR);
    const bf16* PROJ = WSP(bf16, WS_PROJ); const int tid = F.tid, t0 = n * 64;
    { const int idx = tid * 2, t = idx >> 4, r = idx & 15; const unsigned w = *(const GAS unsigned*)(PROJ + (size_t)(t0 + t) * LDP + C_GLR + r); glrL[t * 17 + r] = bflo(w); glrL[t * 17 + r + 1] = bfhi(w); }
    const int d = tid & 63, tg = tid >> 6;
    float wg[16];
#pragma unroll
    for (int r = 0; r < 16; ++r) wg[r] = F.in[4][r * 256 + h * 64 + d];
    const float bias = F.in[5][h * 64 + d];
    __syncthreads();
#pragma unroll
    for (int tt = 0; tt < 8; ++tt) { const int t = tg * 8 + tt; float a = bias;
#pragma unroll
        for (int r = 0; r < 16; ++r) a += glrL[t * 17 + r] * wg[r];
        bL[t * 65 + d] = logsigf_(a) * 0.0625f; }
    __syncthreads();
    if (tid < 64) { float run = 0.f;
#pragma unroll 16
        for (int t = 0; t < 64; ++t) { run += bL[t * 65 + tid]; bL[t * 65 + tid] = run; } }
    __syncthreads();
}
__device__ __forceinline__ void gla_load_vT(Frame& F, int n, int h) {
    LAS bf16* vT = (LAS bf16*)(F.lds + GL_VT); const bf16* PROJ = WSP(bf16, WS_PROJ);
    const int t = F.tid >> 3, eg = F.tid & 7;
    const GAS v4u* src = (const GAS v4u*)(PROJ + (size_t)(n * 64 + t) * LDP + C_GV + h * 128 + eg * 16);
#pragma unroll
    for (int half = 0; half < 2; ++half) { const v4u w = src[half];
#pragma unroll
        for (int i = 0; i < 4; ++i) { const int e = eg * 16 + half * 8 + 2 * i; vT[e * 72 + t] = (bf16)(w[i] & 0xffffu); vT[(e + 1) * 72 + t] = (bf16)(w[i] >> 16); } }
}

__device__ __forceinline__ void gla_prep_item(Frame& F, int n, int h) {
    gla_b(F, n, h);
    LAS float* bL = (LAS float*)(F.lds + GL_B); LAS bf16* T1 = (LAS bf16*)(F.lds + GL_T1); LAS bf16* T2 = (LAS bf16*)(F.lds + GL_T2); LAS bf16* T3 = (LAS bf16*)(F.lds + GL_T3); LAS bf16* vT = (LAS bf16*)(F.lds + GL_VT);
    const bf16* PROJ = WSP(bf16, WS_PROJ); const int tid = F.tid, lane = F.lane, w = F.wave;
    const size_t nh = (size_t)(n * 4 + h);
    { const int t = tid >> 3, dg = tid & 7;
        const v4u qw = *(const GAS v4u*)(PROJ + (size_t)(n * 64 + t) * LDP + C_GQ + h * 64 + dg * 8); const v4u kw = *(const GAS v4u*)(PROJ + (size_t)(n * 64 + t) * LDP + C_GK + h * 64 + dg * 8);
        v4u qo, ko;
#pragma unroll
        for (int i = 0; i < 4; ++i) { const int d0 = dg * 8 + 2 * i; const float b0 = bL[t * 65 + d0], b1 = bL[t * 65 + d0 + 1], l0 = bL[63 * 65 + d0], l1 = bL[63 * 65 + d0 + 1];
            qo[i] = cvtpk(bflo(qw[i]) * 0.125f * __expf(b0), bfhi(qw[i]) * 0.125f * __expf(b1));
            ko[i] = cvtpk(bflo(kw[i]) * __expf(-b0), bfhi(kw[i]) * __expf(-b1));
            T3[d0 * 72 + t] = f2bf1(bflo(kw[i]) * __expf(l0 - b0)); T3[(d0 + 1) * 72 + t] = f2bf1(bfhi(kw[i]) * __expf(l1 - b1)); }
        *(LAS v4u*)(T1 + t * 72 + dg * 8) = qo; *(LAS v4u*)(T2 + t * 72 + dg * 8) = ko;
        *(GAS v4u*)(WSP(bf16, WS_QT) + (nh * 64 + t) * 64 + dg * 8) = qo; }
    gla_load_vT(F, n, h);
    __syncthreads();
    const int c = lane & 15, kq = lane >> 4;
    {
        bf16x8 a[2];
#pragma unroll
        for (int ks = 0; ks < 2; ++ks) a[ks] = *(const LAS bf16x8*)(vT + (16 * w + c) * 72 + 32 * ks + 8 * kq);
        float* KVT = WSP(float, WS_KVT) + nh * 128 * 64;
#pragma unroll
        for (int dt = 0; dt < 4; ++dt) { f32x4 acc = {0.f, 0.f, 0.f, 0.f};
#pragma unroll
            for (int ks = 0; ks < 2; ++ks) { const bf16x8 b = *(const LAS bf16x8*)(T3 + (16 * dt + c) * 72 + 32 * ks + 8 * kq); acc = MFMA16(a[ks], b, acc); }
#pragma unroll
            for (int r = 0; r < 4; ++r) KVT[(16 * w + 4 * kq + r) * 64 + 16 * dt + c] = acc[r]; }
        if (tid < 64) WSP(float, WS_DVEC)[nh * 64 + tid] = __expf(bL[63 * 65 + tid]);
    }
    {
        const int it = w & 3, eh = w >> 2;
        bf16x8 bq[2];
#pragma unroll
        for (int ks = 0; ks < 2; ++ks) bq[ks] = *(const LAS bf16x8*)(T1 + (16 * it + c) * 72 + 32 * ks + 8 * kq);
        f32x4 at[4];
#pragma unroll
        for (int jt = 0; jt < 4; ++jt) { f32x4 acc = {0.f, 0.f, 0.f, 0.f};
            if (jt <= it) {
#pragma unroll
                for (int ks = 0; ks < 2; ++ks) { const bf16x8 a = *(const LAS bf16x8*)(T2 + (16 * jt + c) * 72 + 32 * ks + 8 * kq); acc = MFMA16(a, bq[ks], acc); }
                if (jt == it) {
#pragma unroll
                    for (int r = 0; r < 4; ++r) if (4 * kq + r > c) acc[r] = 0.f; }
            }
            at[jt] = acc; }
        bf16x8 pb[2]; pb[0] = pack8(at[0], at[1]); pb[1] = pack8(at[2], at[3]);
        u32x2* OI = (u32x2*)WSP(bf16, WS_OI) + nh * 32 * 64;
#pragma unroll
        for (int q = 0; q < 4; ++q) { const int et = 4 * eh + q; f32x4 acc = {0.f, 0.f, 0.f, 0.f};
#pragma unroll
            for (int s2 = 0; s2 < 2; ++s2) { const bf16x4 lo = *(const LAS bf16x4*)(vT + (16 * et + c) * 72 + 32 * s2 + 4 * kq), hi = *(const LAS bf16x4*)(vT + (16 * et + c) * 72 + 32 * s2 + 16 + 4 * kq);
                acc = MFMA16(cat8(lo, hi), pb[s2], acc); }
            *(GAS u32x2*)(OI + (et * 4 + it) * 64 + lane) = pack4(acc); }
    }
    __syncthreads();
}

__device__ __forceinline__ void mix_epilogue_w(Frame& F, const f32x4 (&o)[8], int n, int it, const float* gain, int gate_col, int mix_col) {
    const int lane = F.lane, c = lane & 15, kq = lane >> 4;
    float ss = 0.f;
#pragma unroll
    for (int q = 0; q < 8; ++q)
#pragma unroll
        for (int r = 0; r < 4; ++r) ss += o[q][r] * o[q][r];
    ss += __shfl_xor(ss, 16); ss += __shfl_xor(ss, 32);
    const float rstd = 1.f / sqrtf(ss * (1.f / 128.f) + EPS);
    const int t = n * 64 + 16 * it + c;
    const bf16* PROJ = WSP(bf16, WS_PROJ); bf16* MIX = WSP(bf16, WS_MIX);
    u32x2 gw[8];
#pragma unroll
    for (int q = 0; q < 8; ++q) gw[q] = *(const GAS u32x2*)(PROJ + (size_t)t * LDP + gate_col + 16 * q + 4 * kq);
#pragma unroll
    for (int q = 0; q < 8; ++q) { const int e = 16 * q + 4 * kq; const f32x4 gn = *(const GAS f32x4*)(gain + e);
        f32x4 v; v[0] = o[q][0] * rstd * gn[0] * siluf_(bflo(gw[q].x)); v[1] = o[q][1] * rstd * gn[1] * siluf_(bfhi(gw[q].x)); v[2] = o[q][2] * rstd * gn[2] * siluf_(bflo(gw[q].y)); v[3] = o[q][3] * rstd * gn[3] * siluf_(bfhi(gw[q].y));
        *(GAS u32x2*)(MIX + (size_t)t * D + mix_col + e) = pack4(v); }
}
__device__ __forceinline__ void gla_out_wave(Frame& F, int n, int h, int it) {
    const int lane = F.lane, c = lane & 15, kq = lane >> 4; const size_t nh = (size_t)(n * 4 + h);
    const bf16* QT = WSP(bf16, WS_QT) + (nh * 64 + 16 * it + c) * 64; const bf16* ST = WSP(bf16, WS_SGLA) + nh * 128 * 64; const u32x2* OI = (const u32x2*)WSP(bf16, WS_OI) + nh * 32 * 64;
    bf16x8 bq[2], as[8][2]; u32x2 oi[8];
#pragma unroll
    for (int ks = 0; ks < 2; ++ks) bq[ks] = *(const GAS bf16x8*)(QT + 32 * ks + 8 * kq);
#pragma unroll
    for (int q = 0; q < 8; ++q) { oi[q] = *(const GAS u32x2*)(OI + (q * 4 + it) * 64 + lane);
#pragma unroll
        for (int ks = 0; ks < 2; ++ks) as[q][ks] = *(const GAS bf16x8*)(ST + (16 * q + c) * 64 + 32 * ks + 8 * kq); }
    __builtin_amdgcn_sched_barrier(0);
    f32x4 o[8];
#pragma unroll
    for (int q = 0; q < 8; ++q) { f32x4 acc = {bflo(oi[q].x), bfhi(oi[q].x), bflo(oi[q].y), bfhi(oi[q].y)};
#pragma unroll
        for (int ks = 0; ks < 2; ++ks) acc = MFMA16(as[q][ks], bq[ks], acc);
        o[q] = acc; }
    mix_epilogue_w(F, o, n, it, F.in[6], C_GR + h * 128, h * 128);
}
__device__ __forceinline__ void gdn_out_wave(Frame& F, int n, int h, int it) {
    const int lane = F.lane, c = lane & 15, kq = lane >> 4; const size_t nh = (size_t)(n * 4 + h);
    const bf16* QD = WSP(bf16, WS_QDEC) + (nh * 64 + 16 * it + c) * 128; const bf16* AQ = WSP(bf16, WS_AQK) + (nh * 64 + 16 * it + c) * 64;
    const bf16* ST = WSP(bf16, WS_SGDN) + nh * 128 * 128; const bf16* DT = WSP(bf16, WS_DELTA) + nh * 128 * 64;
    bf16x8 bqd[4], baq[2];
#pragma unroll
    for (int ks = 0; ks < 4; ++ks) bqd[ks] = *(const GAS bf16x8*)(QD + 32 * ks + 8 * kq);
#pragma unroll
    for (int s2 = 0; s2 < 2; ++s2) baq[s2] = *(const GAS bf16x8*)(AQ + 32 * s2 + 8 * kq);
    f32x4 o[8];
#pragma unroll
    for (int hf = 0; hf < 2; ++hf) {
        bf16x8 as[4][4], ad[4][2];
#pragma unroll
        for (int q = 0; q < 4; ++q) { const int et = 4 * hf + q;
#pragma unroll
            for (int ks = 0; ks < 4; ++ks) as[q][ks] = *(const GAS bf16x8*)(ST + (16 * et + c) * 128 + 32 * ks + 8 * kq);
#pragma unroll
            for (int s2 = 0; s2 < 2; ++s2) ad[q][s2] = *(const GAS bf16x8*)(DT + (16 * et + c) * 64 + 32 * s2 + 8 * kq); }
        __builtin_amdgcn_sched_barrier(0);
#pragma unroll
        for (int q = 0; q < 4; ++q) { f32x4 acc = {0.f, 0.f, 0.f, 0.f};
#pragma unroll
            for (int ks = 0; ks < 4; ++ks) acc = MFMA16(as[q][ks], bqd[ks], acc);
#pragma unroll
            for (int s2 = 0; s2 < 2; ++s2) acc = MFMA16(ad[q][s2], baq[s2], acc);
            o[4 * hf + q] = acc; }
        __builtin_amdgcn_sched_barrier(0);
    }
    mix_epilogue_w(F, o, n, it, F.in[10], C_DZ + h * 128, 512 + h * 128);
}

constexpr int GD_QB = 0, GD_KB = 17408, GD_VB = 34816, GD_LS = 52224, GD_LB = 68608, GD_TB = 77824, GD_XT = 80896, GD_SC = 117760;
__device__ __forceinline__ void gdn_prep_item(Frame& F, int n, int h) {
    LAS bf16* qb = (LAS bf16*)(F.lds + GD_QB); LAS bf16* kb = (LAS bf16*)(F.lds + GD_KB); LAS bf16* vb = (LAS bf16*)(F.lds + GD_VB);
    LAS float* Ls = (LAS float*)(F.lds + GD_LS); LAS bf16* Lb = (LAS bf16*)(F.lds + GD_LB); LAS bf16* Tb = (LAS bf16*)(F.lds + GD_TB); LAS bf16* XT = (LAS bf16*)(F.lds + GD_XT);
    LAS float* bS = (LAS float*)(F.lds + GD_SC); LAS float* betaS = bS + 64; LAS float* ebS = bS + 128;
    const bf16* PROJ = WSP(bf16, WS_PROJ); const int tid = F.tid, lane = F.lane, w = F.wave, t0 = n * 64;
    const size_t nh = (size_t)(n * 4 + h);
    if (tid < 64) {
        const float da = bf2f(PROJ[(size_t)(t0 + tid) * LDP + C_DA + h]), db = bf2f(PROJ[(size_t)(t0 + tid) * LDP + C_DB + h]);
        float g = -__expf(F.in[8][h]) * softplusf_(da + F.in[9][h]);
#pragma unroll
        for (int off = 1; off < 64; off <<= 1) { const float v = __shfl_up(g, off); if (lane >= off) g += v; }
        bS[tid] = g; betaS[tid] = sigm(db); ebS[tid] = __expf(g);
    }
    if (!(MK_DBG & 2) && lane < 48) {
        const int grp = lane >> 4, c8 = (lane & 15) * 8;
        const int colP = C_DQ + grp * 512 + h * 128 + c8;
        f32x4 wc[4][2];
#pragma unroll
        for (int j = 0; j < 4; ++j) { const GAS f32x4* wp = (const GAS f32x4*)(F.in[7] + (size_t)j * 1536 + grp * 512 + h * 128 + c8); wc[j][0] = wp[0]; wc[j][1] = wp[1]; }
        v4u xin[11];
#pragma unroll
        for (int rr = 0; rr < 11; ++rr) { const int r = t0 + w * 8 - 3 + rr; xin[rr] = (v4u){0, 0, 0, 0}; if (r >= 0) xin[rr] = *(const GAS v4u*)(PROJ + (size_t)r * LDP + colP); }
#pragma unroll
        for (int tt = 0; tt < 8; ++tt) {
            float y[8];
#pragma unroll
            for (int i = 0; i < 8; ++i) y[i] = 0.f;
#pragma unroll
            for (int j = 0; j < 4; ++j)
#pragma unroll
                for (int i = 0; i < 4; ++i) { const unsigned xw = xin[tt + j][i]; y[2 * i] += wc[j][i >> 1][(2 * i) & 3] * bflo(xw); y[2 * i + 1] += wc[j][i >> 1][(2 * i + 1) & 3] * bfhi(xw); }
            float ss = 0.f;
#pragma unroll
            for (int i = 0; i < 8; ++i) { y[i] = siluf_(y[i]); ss += y[i] * y[i]; }
            ss += __shfl_xor(ss, 1); ss += __shfl_xor(ss, 2); ss += __shfl_xor(ss, 4); ss += __shfl_xor(ss, 8);
            const int row = w * 8 + tt;
            const float sc = grp == 2 ? 1.0f : (1.f / sqrtf(ss + EPS)) * (grp == 0 ? 0.08838834764831845f : 1.0f);
            v4u o; o.x = cvtpk(y[0] * sc, y[1] * sc); o.y = cvtpk(y[2] * sc, y[3] * sc); o.z = cvtpk(y[4] * sc, y[5] * sc); o.w = cvtpk(y[6] * sc, y[7] * sc);
            *(LAS v4u*)((grp == 0 ? qb : (grp == 1 ? kb : vb)) + row * 136 + c8) = o;
        }
    }
    __syncthreads();
    if (!(MK_DBG & 4)) {
        const int c = lane & 15, kq = lane >> 4;
        bf16* AQ = WSP(bf16, WS_AQK) + nh * 64 * 64;
        for (int job = w; job < 20; job += 8) {
            const int kind = job >= 10 ? 1 : 0, idx = job - 10 * kind;
            const int it = idx >= 6 ? 3 : (idx >= 3 ? 2 : (idx >= 1 ? 1 : 0)), jt = idx - (it * (it + 1)) / 2;
            const LAS bf16* Am = kind ? qb : kb;
            f32x4 acc = {0.f, 0.f, 0.f, 0.f};
#pragma unroll
            for (int ks = 0; ks < 4; ++ks) { const bf16x8 a = *(const LAS bf16x8*)(Am + (16 * it + c) * 136 + 32 * ks + 8 * kq), b = *(const LAS bf16x8*)(kb + (16 * jt + c) * 136 + 32 * ks + 8 * kq); acc = MFMA16(a, b, acc); }
            const int j = 16 * jt + c; const float bj = bS[j];
#pragma unroll
            for (int r = 0; r < 4; ++r) { const int i = 16 * it + 4 * kq + r; const float dec = __expf(fminf(bS[i] - bj, 0.f));
                if (kind == 0) Ls[i * 64 + j] = (j < i) ? betaS[i] * dec * acc[r] : 0.f;
                else { AQ[i * 64 + j] = (j <= i) ? f2bf1(dec * acc[r]) : (bf16)0; if (jt < it) AQ[(16 * jt + 4 * kq + r) * 64 + 16 * it + c] = (bf16)0; } }
        }
    }
    __syncthreads();
    { const int i = tid >> 3, c0 = (tid & 7) * 8; v4u o;
#pragma unroll
      for (int x = 0; x < 4; ++x) { const int col = c0 + 2 * x; const bool up = (col >> 4) > (i >> 4); o[x] = up ? 0u : cvtpk(-Ls[i * 64 + col], -Ls[i * 64 + col + 1]); }
      *(LAS v4u*)(Lb + i * 72 + c0) = o;
      for (int x = tid; x < 256 * 72 / 8; x += 512) *(LAS v4u*)(XT + x * 8) = (v4u){0u, 0u, 0u, 0u}; }
    if ((MK_DBG & 8) && tid < 64) {} else if (tid < 64) { const int b = tid >> 4, cc = tid & 15; float x[16];
#pragma unroll
        for (int i = 0; i < 16; ++i) { float a = (i == cc) ? 1.f : 0.f;
#pragma unroll
            for (int j = 0; j < i; ++j) a -= Ls[(16 * b + i) * 64 + 16 * b + j] * x[j];
            x[i] = a; Tb[(16 * b + i) * 24 + cc] = f2bf1(a); }
    } else if (!(MK_DBG & 16) && tid >= 256) {
        const int tt = tid - 256; const float bl = bS[63];
        bf16* QD = WSP(bf16, WS_QDEC) + nh * 64 * 128;
#pragma unroll 1
        for (int j = 0; j < 4; ++j) { const int id = tt + 256 * j, i = id >> 4, c8 = (id & 15) * 8; const v4u qw = *(const LAS v4u*)(qb + i * 136 + c8); const float e = ebS[i];
            v4u o; o.x = cvtpk(bflo(qw.x) * e, bfhi(qw.x) * e); o.y = cvtpk(bflo(qw.y) * e, bfhi(qw.y) * e); o.z = cvtpk(bflo(qw.z) * e, bfhi(qw.z) * e); o.w = cvtpk(bflo(qw.w) * e, bfhi(qw.w) * e);
            *(GAS v4u*)(QD + i * 128 + c8) = o; }
        bf16* KDF = WSP(bf16, WS_KDF) + nh * 16 * 512;
#pragma unroll 1
        for (int j = 0; j < 4; ++j) { const int id = tt + 256 * j, f = id >> 6, ln = id & 63, dt = f >> 1, ks2 = f & 1, q = ln >> 4, m = ln & 15, d = 16 * dt + m;
            float v[8];
#pragma unroll
            for (int x = 0; x < 8; ++x) { const int i = 32 * ks2 + (x < 4 ? 4 * q + x : 16 + 4 * q + (x - 4)); v[x] = bf2f(kb[i * 136 + d]) * __expf(bl - bS[i]); }
            v4u o; o.x = cvtpk(v[0], v[1]); o.y = cvtpk(v[2], v[3]); o.z = cvtpk(v[4], v[5]); o.w = cvtpk(v[6], v[7]);
            *(GAS v4u*)(KDF + ((size_t)f * 64 + ln) * 8) = o; }
        if (tt == 0) WSP(float, WS_CDEC)[nh] = __expf(bl);
    }
    __syncthreads();
    if (!(MK_DBG & 32)) { const int c = lane & 15, kq = lane >> 4;
      bf16* WF = WSP(bf16, WS_WF) + nh * 16 * 512; f32x4* UFp = (f32x4*)WSP(float, WS_UF) + nh * 8 * 4 * 64;
      const f32x4 z4 = {0.f, 0.f, 0.f, 0.f};
#pragma unroll
      for (int b = 0; b < 4; ++b) {
          const bf16x4 tlo = *(const LAS bf16x4*)(Tb + (16 * b + c) * 24 + 4 * kq); const bf16x8 ta = cat8(tlo, (bf16x4){0, 0, 0, 0});
#pragma unroll
          for (int t2 = 0; t2 < 2; ++t2) { const int ct = 2 * w + t2, col = 16 * ct + c; const bool isu = ct < 8;
              f32x4 acc;
#pragma unroll
              for (int r = 0; r < 4; ++r) { const int i = 16 * b + 4 * kq + r; acc[r] = isu ? betaS[i] * bf2f(vb[i * 136 + (col & 127)]) : betaS[i] * ebS[i] * bf2f(kb[i * 136 + (col & 127)]); }
#pragma unroll
              for (int ks = 0; ks < (b + 1) / 2; ++ks) acc = MFMA16(*(const LAS bf16x8*)(Lb + (16 * b + c) * 72 + 32 * ks + 8 * kq), *(const LAS bf16x8*)(XT + col * 72 + 32 * ks + 8 * kq), acc);
              const f32x4 x = MFMA16(ta, pack8(acc, z4), z4);
              *(LAS u32x2*)(XT + col * 72 + 16 * b + 4 * kq) = pack4(x);
              if (isu) UFp[(ct * 4 + b) * 64 + lane] = x;
              else { const int ctw = ct - 8;
#pragma unroll
                  for (int r = 0; r < 4; ++r) WF[((size_t)(b * 4 + (ctw >> 1)) * 64 + (c >> 2) * 16 + 4 * kq + r) * 8 + (c & 3) + 4 * (ctw & 1)] = f2bf1(-x[r]); }
          }
      }
    }
    __syncthreads();
}

template <int MODE>
__device__ __forceinline__ void gdn_group_scan(Frame& F, int grp, int h) {
    const int tid = F.tid, lane = F.lane, w = F.wave, c = lane & 15, kq = lane >> 4, n0 = grp * GRP;
    const v4u* WF = (const v4u*)WSP(bf16, WS_WF); const v4u* KDF = (const v4u*)WSP(bf16, WS_KDF); const f32x4* UF = (const f32x4*)WSP(float, WS_UF);
    const float* CDEC = WSP(float, WS_CDEC); bf16* SG = WSP(bf16, WS_SGDN); bf16* DL = WSP(bf16, WS_DELTA);
    {   v4u t[GRP][4];
#pragma unroll
        for (int i = 0; i < GRP; ++i) { const size_t nh = (size_t)((n0 + i) * 4 + h);
#pragma unroll
            for (int j = 0; j < 2; ++j) { t[i][j] = WF[nh * 1024 + tid + 512 * j]; t[i][2 + j] = KDF[nh * 1024 + tid + 512 * j]; } }
#pragma unroll
        for (int i = 0; i < GRP; ++i)
#pragma unroll
            for (int j = 0; j < 2; ++j) { *(LAS v4u*)(F.lds + i * 32768 + (tid + 512 * j) * 16) = t[i][j]; *(LAS v4u*)(F.lds + i * 32768 + 16384 + (tid + 512 * j) * 16) = t[i][2 + j]; } }
    f32x4 S[8], P[8];
    if (MODE == 1) { const f32x4* SST = (const f32x4*)WSP(float, WS_SST) + (size_t)(((grp * 4 + h) * 8 + w) * 8) * 64;
#pragma unroll
        for (int i = 0; i < 8; ++i) S[i] = SST[i * 64 + lane];
    } else {
#pragma unroll
        for (int i = 0; i < 8; ++i) { S[i] = (f32x4){0.f, 0.f, 0.f, 0.f};
#pragma unroll
            for (int r = 0; r < 4; ++r) P[i][r] = ((16 * i + 4 * kq + r) == 16 * w + c) ? 1.f : 0.f; }
    }
    f32x4 u[GRP][4]; float cd[GRP];
#pragma unroll
    for (int i = 0; i < GRP; ++i) { const size_t nh = (size_t)((n0 + i) * 4 + h); cd[i] = CDEC[nh];
#pragma unroll
        for (int mt = 0; mt < 4; ++mt) u[i][mt] = UF[((nh * 8 + w) * 4 + mt) * 64 + lane]; }
    __syncthreads();
#pragma unroll
    for (int i = 0; i < GRP; ++i) {
        const size_t nh = (size_t)((n0 + i) * 4 + h);
        const LAS unsigned char* wl = F.lds + i * 32768 + lane * 16; const LAS unsigned char* kl = wl + 16384;
        if (MODE == 1) { bf16* sg = SG + (nh * 128 + 16 * w + c) * 128 + 4 * kq;
#pragma unroll
            for (int dt = 0; dt < 8; ++dt) *(GAS u32x2*)(sg + 16 * dt) = pack4(S[dt]); }
        f32x4 dl[4], dp[4];
#pragma unroll
        for (int mt = 0; mt < 4; ++mt) { dl[mt] = u[i][mt]; dp[mt] = (f32x4){0.f, 0.f, 0.f, 0.f}; }
#pragma unroll
        for (int ks = 0; ks < 4; ++ks) { const bf16x8 sb = pack8(S[2 * ks], S[2 * ks + 1]); bf16x8 pb; if (MODE == 0) pb = pack8(P[2 * ks], P[2 * ks + 1]);
#pragma unroll
            for (int mt = 0; mt < 4; ++mt) { const bf16x8 a = *(const LAS bf16x8*)(wl + (mt * 4 + ks) * 1024); dl[mt] = MFMA16(a, sb, dl[mt]); if (MODE == 0) dp[mt] = MFMA16(a, pb, dp[mt]); } }
        if (MODE == 1) { bf16* dq = DL + (nh * 128 + 16 * w + c) * 64 + 4 * kq;
#pragma unroll
            for (int mt = 0; mt < 4; ++mt) *(GAS u32x2*)(dq + 16 * mt) = pack4(dl[mt]); }
#pragma unroll
        for (int dt = 0; dt < 8; ++dt) { S[dt] = S[dt] * cd[i]; if (MODE == 0) P[dt] = P[dt] * cd[i]; }
#pragma unroll
        for (int ks2 = 0; ks2 < 2; ++ks2) { const bf16x8 db = pack8(dl[2 * ks2], dl[2 * ks2 + 1]); bf16x8 qb; if (MODE == 0) qb = pack8(dp[2 * ks2], dp[2 * ks2 + 1]);
#pragma unroll
            for (int dt = 0; dt < 8; ++dt) { const bf16x8 a = *(const LAS bf16x8*)(kl + (dt * 2 + ks2) * 1024); S[dt] = MFMA16(a, db, S[dt]); if (MODE == 0) P[dt] = MFMA16(a, qb, P[dt]); } }
    }
    if (MODE == 0) {
        f32x4* SLE = (f32x4*)WSP(float, WS_SLE) + (size_t)(((grp * 4 + h) * 8 + w) * 8) * 64;
#pragma unroll
        for (int dt = 0; dt < 8; ++dt) SLE[dt * 64 + lane] = S[dt];
        bf16* PE = WSP(bf16, WS_PEND) + (size_t)(grp * 4 + h) * 32 * 512; const int ks = w >> 1, lq = (2 * (w & 1) + (c >> 3)) * 16 + 4 * kq, idx = c & 7;
#pragma unroll
        for (int dt = 0; dt < 8; ++dt)
#pragma unroll
            for (int r = 0; r < 4; ++r) PE[((size_t)(dt * 4 + ks) * 64 + lq + r) * 8 + idx] = f2bf1(P[dt][r]);
    }
    __syncthreads();
}
__device__ __forceinline__ void gdn_scan_groups(Frame& F, int h, int s) {
    const int lane = F.lane, w = F.wave, c = lane & 15, kq = lane >> 4;
    LAS bf16* STb = (LAS bf16*)F.lds;
    const bf16x8* PEND = (const bf16x8*)WSP(bf16, WS_PEND); const f32x4* SLE = (const f32x4*)WSP(float, WS_SLE); f32x4* SST = (f32x4*)WSP(float, WS_SST);
    f32x4 S = {0.f, 0.f, 0.f, 0.f};
    *(LAS u32x2*)(STb + c * 136 + 16 * w + 4 * kq) = (u32x2){0u, 0u};
    bf16x8 pe[4], pn[4]; f32x4 sle, sln;
#pragma unroll
    for (int ks = 0; ks < 4; ++ks) pe[ks] = PEND[((size_t)h * 32 + w * 4 + ks) * 64 + lane];
    sle = SLE[(((size_t)h * 8 + s) * 8 + w) * 64 + lane];
    __syncthreads();
    for (int g = 0; g < NGRP; ++g) {
        const size_t gh = (size_t)(g * 4 + h);
        SST[((gh * 8 + s) * 8 + w) * 64 + lane] = S;
        if (g + 1 == NGRP) break;
        { const size_t gh1 = (size_t)((g + 1) * 4 + h);
#pragma unroll
          for (int ks = 0; ks < 4; ++ks) pn[ks] = PEND[(gh1 * 32 + w * 4 + ks) * 64 + lane];
          sln = SLE[((gh1 * 8 + s) * 8 + w) * 64 + lane]; }
        const LAS bf16* st = STb + (g & 1) * 16 * 136 + c * 136 + 8 * kq;
        f32x4 acc = sle;
#pragma unroll
        for (int ks = 0; ks < 4; ++ks) acc = MFMA16(pe[ks], *(const LAS bf16x8*)(st + 32 * ks), acc);
        S = acc;
        *(LAS u32x2*)(STb + ((g + 1) & 1) * 16 * 136 + c * 136 + 16 * w + 4 * kq) = pack4(S);
#pragma unroll
        for (int ks = 0; ks < 4; ++ks) pe[ks] = pn[ks];
        sle = sln;
        __syncthreads();
    }
    __syncthreads();
}
template <int MODE>
__device__ __forceinline__ void gla_scan_range(Frame& F, int grp, int gid) {
    const int h = gid >> 11, rem = gid & 2047, e = rem >> 4, dg = rem & 15, n0 = grp * GRP;
    const float* KVT = WSP(float, WS_KVT); const float* DV = WSP(float, WS_DVEC); bf16* SG = WSP(bf16, WS_SGLA);
    f32x4 kv[GRP], dv[GRP];
#pragma unroll
    for (int i = 0; i < GRP; ++i) { const size_t nh = (size_t)((n0 + i) * 4 + h); kv[i] = *(const GAS f32x4*)(KVT + (nh * 128 + e) * 64 + 4 * dg); dv[i] = *(const GAS f32x4*)(DV + nh * 64 + 4 * dg); }
    f32x4 S = {0.f, 0.f, 0.f, 0.f}, P = {1.f, 1.f, 1.f, 1.f};
    if (MODE == 1) S = *((const GAS f32x4*)WSP(float, WS_GSST) + (size_t)grp * 8192 + gid);
#pragma unroll
    for (int i = 0; i < GRP; ++i) { const size_t nh = (size_t)((n0 + i) * 4 + h);
        if (MODE == 1) *(GAS u32x2*)(SG + (nh * 128 + e) * 64 + 4 * dg) = pack4(S);
        S = dv[i] * S + kv[i]; if (MODE == 0) P = P * dv[i]; }
    if (MODE == 0) { *((GAS f32x4*)WSP(float, WS_GSLE) + (size_t)grp * 8192 + gid) = S; *((GAS f32x4*)WSP(float, WS_GPD) + (size_t)grp * 8192 + gid) = P; }
}
__device__ __forceinline__ void gla_scan_groups(Frame& F, int gid) {
    f32x4 S = {0.f, 0.f, 0.f, 0.f};
    for (int g0 = 0; g0 < NGRP; g0 += 16) {
        f32x4 sl[16], pd[16];
#pragma unroll
        for (int g = 0; g < 16; ++g) { sl[g] = *((const GAS f32x4*)WSP(float, WS_GSLE) + (size_t)(g0 + g) * 8192 + gid); pd[g] = *((const GAS f32x4*)WSP(float, WS_GPD) + (size_t)(g0 + g) * 8192 + gid); }
#pragma unroll
        for (int g = 0; g < 16; ++g) { *((GAS f32x4*)WSP(float, WS_GSST) + (size_t)(g0 + g) * 8192 + gid) = S; S = pd[g] * S + sl[g]; }
    }
}

__device__ __forceinline__ void route_phase(Frame& F, int rep) {
    const int tid = F.tid, lane = F.lane, w = F.wave, c = lane & 15, kq = lane >> 4, tile = w & 3, kh = w >> 2;
    unsigned* cnt = (unsigned*)(F.ctl + CW_CNT) + rep * 32;
    LAS int* lcnt = (LAS int*)(F.lds + ROUTE_OFF); LAS int* gbase = lcnt + 32; LAS int* te = lcnt + 64; LAS int* ts = te + 256; LAS float* tg = (LAS float*)(ts + 256);
    LAS float* part = (LAS float*)(F.lds + RING_OFF);
    const size_t roff = (size_t)rep * (WS_PROJ - WS_TOKE), xoff = (size_t)rep * (WS_PROJ + 8 * MiB - WS_XN), soff = (size_t)rep * (WS_PROJ + 40 * MiB - WS_RSTD);
    const v4u* WRF = (const v4u*)WSP(bf16, WS_WRF);
    for (int blk = F.vcu; blk < T / 64; blk += F.G) {
        if (tid < 32) lcnt[tid] = 0;
        const int t = blk * 64 + tile * 16 + c;
        const GAS f32x4* xr = (const GAS f32x4*)(F.out + (size_t)t * D) + 2 * kq; const GAS f32x4* gr = (const GAS f32x4*)F.in[12] + 2 * kq;
        GAS u32x2* xq = (GAS u32x2*)(WSP(unsigned char, WS_XN + xoff) + (size_t)t * D) + kq;
        f32x4 acc0 = {0.f, 0.f, 0.f, 0.f}, acc1 = {0.f, 0.f, 0.f, 0.f}; float ss = 0.f;
#pragma unroll 4
        for (int ks = kh * 16; ks < kh * 16 + 16; ++ks) {
            const f32x4 x0 = xr[8 * ks], x1 = xr[8 * ks + 1], g0 = gr[8 * ks], g1 = gr[8 * ks + 1];
            const v4u bh0 = WRF[(size_t)((ks * 2 + 0) * 2 + 0) * 64 + lane], bl0 = WRF[(size_t)((ks * 2 + 0) * 2 + 1) * 64 + lane], bh1 = WRF[(size_t)((ks * 2 + 1) * 2 + 0) * 64 + lane], bl1 = WRF[(size_t)((ks * 2 + 1) * 2 + 1) * 64 + lane];
            ss += (x0[0] * x0[0] + x0[1] * x0[1]) + (x0[2] * x0[2] + x0[3] * x0[3]) + (x1[0] * x1[0] + x1[1] * x1[1]) + (x1[2] * x1[2] + x1[3] * x1[3]);
            v4u hi; hi[0] = cvtpk(x0[0], x0[1]); hi[1] = cvtpk(x0[2], x0[3]); hi[2] = cvtpk(x1[0], x1[1]); hi[3] = cvtpk(x1[2], x1[3]);
            v4u lo; lo[0] = cvtpk(x0[0] - bflo(hi[0]), x0[1] - bfhi(hi[0])); lo[1] = cvtpk(x0[2] - bflo(hi[1]), x0[3] - bfhi(hi[1])); lo[2] = cvtpk(x1[0] - bflo(hi[2]), x1[1] - bfhi(hi[2])); lo[3] = cvtpk(x1[2] - bflo(hi[3]), x1[3] - bfhi(hi[3]));
            u32x2 q8; q8.x = pg8::cvt4_fp8(x0[0] * g0[0], x0[1] * g0[1], x0[2] * g0[2], x0[3] * g0[3]); q8.y = pg8::cvt4_fp8(x1[0] * g1[0], x1[1] * g1[1], x1[2] * g1[2], x1[3] * g1[3]);
            xq[4 * ks] = q8;
            const bf16x8 ah = __builtin_bit_cast(bf16x8, hi), al = __builtin_bit_cast(bf16x8, lo);
            acc0 = MFMA16(ah, __builtin_bit_cast(bf16x8, bh0), acc0); acc0 = MFMA16(ah, __builtin_bit_cast(bf16x8, bl0), acc0); acc0 = MFMA16(al, __builtin_bit_cast(bf16x8, bh0), acc0);
            acc1 = MFMA16(ah, __builtin_bit_cast(bf16x8, bh1), acc1); acc1 = MFMA16(ah, __builtin_bit_cast(bf16x8, bl1), acc1); acc1 = MFMA16(al, __builtin_bit_cast(bf16x8, bh1), acc1);
        }
        ss += __shfl_xor(ss, 16); ss += __shfl_xor(ss, 32);
        if (kh == 1) { LAS float* p = part + (tile * 64 + lane) * 12; *(LAS f32x4*)p = acc0; *(LAS f32x4*)(p + 4) = acc1; p[8] = ss; }
        __syncthreads();
        if (kh == 0) {
            const LAS float* p = part + (tile * 64 + lane) * 12; acc0 = acc0 + *(const LAS f32x4*)p; acc1 = acc1 + *(const LAS f32x4*)(p + 4); ss += p[8];
            const float rstd = 1.f / sqrtf(ss * (1.f / D) + EPS);
            if (kq == 0) WSP(float, WS_RSTD + soff)[t] = rstd;
            const float b0 = F.in[14][c], b1 = F.in[14][16 + c];
#pragma unroll
            for (int r = 0; r < 4; ++r) {
                const int tr = 4 * kq + r, tl = tile * 16 + tr;
                const float rs = __shfl(rstd, tr);
                const float l0 = acc0[r] * rs + b0, l1 = acc1[r] * rs + b1;
                unsigned k0, k1; { const unsigned u0 = __float_as_uint(l0), u1 = __float_as_uint(l1);
                    k0 = (((u0 & 0x80000000u) ? ~u0 : (u0 | 0x80000000u)) & ~31u) | (unsigned)(31 - c); k1 = (((u1 & 0x80000000u) ? ~u1 : (u1 | 0x80000000u)) & ~31u) | (unsigned)(15 - c); }
                int sel[4]; float val[4];
#pragma unroll
                for (int k = 0; k < 4; ++k) { unsigned m = k0 > k1 ? k0 : k1;
#pragma unroll
                    for (int o = 1; o < 16; o <<= 1) { const unsigned other = (unsigned)__shfl_xor((int)m, o); m = other > m ? other : m; }
                    const int bi = 31 - (int)(m & 31u); sel[k] = bi;
                    const float v0 = __shfl(l0, (lane & 48) + (bi & 15)), v1 = __shfl(l1, (lane & 48) + (bi & 15)); val[k] = bi < 16 ? v0 : v1;
                    if (c == (bi & 15)) { if (bi < 16) k0 = 0u; else k1 = 0u; } }
                const float e1 = __expf(val[1] - val[0]), e2 = __expf(val[2] - val[0]), e3 = __expf(val[3] - val[0]); const float inv = 1.f / (1.f + e1 + e2 + e3);
                if (c < 4) { const int ek = c == 0 ? sel[0] : (c == 1 ? sel[1] : (c == 2 ? sel[2] : sel[3])); const float gk = (c == 0 ? 1.f : (c == 1 ? e1 : (c == 2 ? e2 : e3))) * inv;
                    const int ls = __hip_atomic_fetch_add(lcnt + ek, 1, __ATOMIC_RELAXED, __HIP_MEMORY_SCOPE_WORKGROUP);
                    te[tl * 4 + c] = ek; ts[tl * 4 + c] = ls; tg[tl * 4 + c] = gk; }
            }
        }
        __syncthreads();
        if (tid < 32) gbase[tid] = (int)atomicAdd(cnt + tid * 64, (unsigned)lcnt[tid]);
        __syncthreads();
        if (tid < 256) { const int tt = blk * 64 + (tid >> 2), k = tid & 3, e = te[tid];
            WSP(int, WS_TOKE + roff)[tt * 4 + k] = e; WSP(int, WS_TOKS + roff)[tt * 4 + k] = gbase[e] + ts[tid]; WSP(float, WS_TOKG + roff)[tt * 4 + k] = tg[tid]; }
        __syncthreads();
    }
}
__device__ __forceinline__ void moe_tables(Frame& F) {
    LAS int* tile_e = (LAS int*)(F.lds + TILEE_OFF); LAS int* baseL = (LAS int*)(F.lds + BASE_OFF);
    if (F.tid < 64) { const int e = F.lane & 31; const unsigned c = __hip_atomic_load((unsigned*)(F.ctl + CW_CNT) + e * 64, RLX_AGENT);
        const int nt = (int)((c + 255u) >> 8); int incl = nt;
#pragma unroll
        for (int off = 1; off < 32; off <<= 1) { const int v = __shfl_up(incl, off); if ((F.lane & 31) >= off) incl += v; }
        const int tb = incl - nt;
        if (F.lane < 32) { baseL[e] = tb * 256; for (int i = 0; i < nt; ++i) tile_e[tb + i] = e; if (e == 31) tile_e[319] = incl; } }
    __syncthreads();
}
__device__ __forceinline__ void scatter_phase(Frame& F) {
    moe_tables(F);
    LAS int* baseL = (LAS int*)(F.lds + BASE_OFF);
    const int gt = F.vcu * NWAVES * 64 + F.tid, NGT = F.G * NWAVES * 64;
    for (int i = gt; i < T * 4; i += NGT) { const int e = WSP(int, WS_TOKE)[i], pos = baseL[e] + WSP(int, WS_TOKS)[i];
        WSP(int, WS_TOKP)[i] = pos; WSP(float, WS_GPOS)[pos] = WSP(float, WS_TOKG)[i]; WSP(int, WS_TOKQ)[pos] = i >> 2; WSP(float, WS_RPOS)[pos] = WSP(float, WS_RSTD)[i >> 2]; }
    if (F.vcu < NE) { const int e = F.vcu; const unsigned c = __hip_atomic_load((unsigned*)(F.ctl + CW_CNT) + e * 64, RLX_AGENT); const int lo = baseL[e] + (int)c, hi = baseL[e] + (int)((c + 255u) & ~255u);
        for (int p = lo + F.tid; p < hi; p += NWAVES * 64) WSP(int, WS_TOKQ)[p] = 0; }
}
__device__ __forceinline__ void combine_phase(Frame& F, int rep) {
    const int gw = F.vcu * NWAVES + F.wave, NGW = F.G * NWAVES, lane = F.lane;
    const size_t xoff = (size_t)rep * (WS_PROJ + 64 * MiB - WS_XN), poff = (size_t)rep * (WS_PROJ + 100 * MiB - WS_PERSTD);
    for (int t0 = gw; t0 < T; t0 += 2 * NGW) {
        int pk[2][4]; f32x4 v[2][4]; u32x2 y[2][4][4], pr[2][4];
#pragma unroll
        for (int q = 0; q < 2; ++q) { const int t = (t0 + q * NGW < T) ? t0 + q * NGW : 0;
#pragma unroll
            for (int k = 0; k < 4; ++k) pk[q][k] = WSP(int, WS_TOKP)[t * 4 + k];
            const GAS f32x4* xr = (const GAS f32x4*)(F.out + (size_t)t * D) + lane; const GAS u32x2* pp = (const GAS u32x2*)(WSP(bf16, WS_PERAW) + (size_t)t * D) + lane;
#pragma unroll
            for (int j = 0; j < 4; ++j) { v[q][j] = xr[64 * j]; pr[q][j] = pp[64 * j]; } }
#pragma unroll
        for (int q = 0; q < 2; ++q)
#pragma unroll
            for (int k = 0; k < 4; ++k) { const GAS u32x2* yr = (const GAS u32x2*)(WSP(bf16, WS_YS) + (size_t)pk[q][k] * D) + lane;
#pragma unroll
                for (int j = 0; j < 4; ++j) y[q][k][j] = yr[64 * j]; }
#pragma unroll
        for (int q = 0; q < 2; ++q) { const int t = t0 + q * NGW; if (t >= T) break;
            GAS f32x4* xw = rep ? (GAS f32x4*)(WSP(float, WS_PROJ) + (size_t)t * D) + lane : (GAS f32x4*)(F.out + (size_t)t * D) + lane;
            float s = 0.f, ps = 0.f;
#pragma unroll
            for (int j = 0; j < 4; ++j) {
#pragma unroll
                for (int k = 0; k < 4; ++k) { const u32x2 w = y[q][k][j]; v[q][j].x += bflo(w.x); v[q][j].y += bfhi(w.x); v[q][j].z += bflo(w.y); v[q][j].w += bfhi(w.y); }
                xw[64 * j] = v[q][j]; s += (v[q][j].x * v[q][j].x + v[q][j].y * v[q][j].y) + (v[q][j].z * v[q][j].z + v[q][j].w * v[q][j].w);
                const u32x2 w = pr[q][j]; const float a = bflo(w.x), b = bfhi(w.x), c = bflo(w.y), d = bfhi(w.y); ps += (a * a + b * b) + (c * c + d * d); }
            const float rstd = 1.f / sqrtf(wave_sum(s) * (1.f / D) + EPS);
            const GAS f32x4* gr = (const GAS f32x4*)F.in[19] + lane; GAS u32x2* o8 = (GAS u32x2*)(WSP(bf16, WS_XN + xoff) + (size_t)t * D) + lane;
#pragma unroll
            for (int j = 0; j < 4; ++j) { const f32x4 gg = gr[64 * j]; f32x4 a = {v[q][j].x * rstd * gg.x, v[q][j].y * rstd * gg.y, v[q][j].z * rstd * gg.z, v[q][j].w * rstd * gg.w}; o8[64 * j] = pack4(a); }
            ps = wave_sum(ps);
            if (lane == 0) WSP(float, WS_PERSTD + poff)[t] = 1.f / sqrtf(ps * (1.f / D) + EPS); }
    }
}
__device__ __forceinline__ void final_phase(Frame& F, int rep) {
    const int gw = F.vcu * NWAVES + F.wave, NGW = F.G * NWAVES, lane = F.lane;
    for (int t0 = gw; t0 < T; t0 += 4 * NGW) {
        f32x4 v[4][4];
#pragma unroll
        for (int q = 0; q < 4; ++q) { const int t = (t0 + q * NGW < T) ? t0 + q * NGW : 0; const GAS f32x4* xr = (const GAS f32x4*)(F.out + (size_t)t * D) + lane;
#pragma unroll
            for (int j = 0; j < 4; ++j) v[q][j] = xr[64 * j]; }
#pragma unroll
        for (int q = 0; q < 4; ++q) { const int t = t0 + q * NGW; if (t >= T) break;
            float s = 0.f;
#pragma unroll
            for (int j = 0; j < 4; ++j) s += (v[q][j].x * v[q][j].x + v[q][j].y * v[q][j].y) + (v[q][j].z * v[q][j].z + v[q][j].w * v[q][j].w);
            const float rstd = 1.f / sqrtf(wave_sum(s) * (1.f / D) + EPS);
            const GAS f32x4* gr = (const GAS f32x4*)F.in[23] + lane;
            GAS f32x4* xw = rep ? (GAS f32x4*)(WSP(float, WS_PROJ) + (size_t)t * D) + lane : (GAS f32x4*)(F.out + (size_t)t * D) + lane;
#pragma unroll
            for (int j = 0; j < 4; ++j) { const f32x4 gg = gr[64 * j]; xw[64 * j] = (f32x4){v[q][j].x * rstd * gg.x, v[q][j].y * rstd * gg.y, v[q][j].z * rstd * gg.z, v[q][j].w * rstd * gg.w}; } }
    }
}

constexpr int NPH = 13;
struct Args { const float* in[24]; float* out; unsigned char* ws; int ph_lo, ph_hi; };
static_assert(sizeof(Args) == 24 * 8 + 8 + 8 + 8, "Args has no padding");
__global__ void __launch_bounds__(NWAVES * 64, 2) fwd_kernel(Args args) {
    extern __shared__ __attribute__((aligned(16))) unsigned char lds[];
    Frame F;
    F.lds = (LAS unsigned char*)lds;
    F.MISC = (volatile LAS unsigned*)(F.lds + MISC_OFF);
    F.tid = threadIdx.x; F.lane = F.tid & 63; F.wave = __builtin_amdgcn_readfirstlane(F.tid >> 6);
    F.G = gridDim.x; { const int bx = blockIdx.x; F.vcu = (F.G % 8 == 0) ? (bx % 8) * (F.G / 8) + bx / 8 : bx; }
    F.ws = args.ws; F.ctl = (gu32*)(args.ws + WS_CTL); F.out = args.out;
#pragma unroll
    for (int i = 0; i < 24; ++i) F.in[i] = args.in[i];
    for (int u = F.tid; u < (LDS_BYTES - LDSCTL_OFF) / 4; u += NWAVES * 64) ((LAS unsigned*)(F.lds + LDSCTL_OFF))[u] = 0u;
    __syncthreads();
    const int lo = args.ph_lo, hi = args.ph_hi;
    XcdBarrier bar; bar.bar = (unsigned*)(F.ctl + CW_BAR); bar.x = 0; bar.st = nullptr;
    bar = xcd_barrier_post((unsigned*)(F.ctl + CW_BAR), F.MISC + 8);
#define IN(k) (lo <= (k) && (k) < hi && !((MK_SKIP >> (k)) & 1))
#define SEAM(k) do { if ((lo <= (k)) && ((k) + 1 < hi)) xcd_barrier(bar); } while (0)

    if (IN(0)) { for (int rep_ = 0; rep_ <= ((MK_REP >> 0) & 1); ++rep_) { p0_prologue(F); } SEAM(0); }
    if (IN(1)) {
#if (MK_REP >> 1) & 1
        {
        { pg8::Gemm g{WSP(bf16, WS_XN), WSP(bf16, WS_WIN), T, LDP, D, nullptr}; pg8::StaticOrder S; S.init(T, LDP, F.G, (int)blockIdx.x);
          pg8::EpiBf16P E{WSP(bf16, WS_PROJ), LDP};
          pg8::gemm_phase<pg8::EpiBf16P, pg8::StaticOrder, true, true>(F.lds + RING_OFF, g, S, E); }
        { pg8::Gemm g{WSP(bf16, WS_PB), WSP(bf16, WS_WPP), T, D, PLE, nullptr}; pg8::StaticOrder S; S.init(T, D, F.G, (int)blockIdx.x);
          pg8::EpiBf16P E{WSP(bf16, WS_PERAW), D};
          pg8::gemm_phase<pg8::EpiBf16P, pg8::StaticOrder, true, true>(F.lds + RING_OFF, g, S, E); }
        }
#endif
        {
        { pg8::Gemm g{WSP(bf16, WS_XN), WSP(bf16, WS_WIN), T, LDP, D, nullptr}; pg8::StaticOrder S; S.init(T, LDP, F.G, (int)blockIdx.x);
          pg8::EpiBf16P E{WSP(bf16, WS_PROJ), LDP};
          pg8::gemm_phase<pg8::EpiBf16P, pg8::StaticOrder, true, true>(F.lds + RING_OFF, g, S, E); }
        { pg8::Gemm g{WSP(bf16, WS_PB), WSP(bf16, WS_WPP), T, D, PLE, nullptr}; pg8::StaticOrder S; S.init(T, D, F.G, (int)blockIdx.x);
          pg8::EpiBf16P E{WSP(bf16, WS_PERAW), D};
          pg8::gemm_phase<pg8::EpiBf16P, pg8::StaticOrder, true, true>(F.lds + RING_OFF, g, S, E); }
        }
        SEAM(1);
    }
    if (IN(2)) { for (int rep_ = 0; rep_ <= ((MK_REP >> 2) & 1); ++rep_) {
        for (int i = blockIdx.x; i < NCH * 8; i += F.G) { const int n = i >> 3, hh = (i + (i >> 8)) & 7;
            if (hh < 4) { if (!(MK_DBG & 1)) gla_prep_item(F, n, hh); } else gdn_prep_item(F, n, hh - 4); }
        }
        SEAM(2);
    }
    if (IN(3)) { for (int rep_ = 0; rep_ <= ((MK_REP >> 3) & 1); ++rep_) {
        for (int r3_ = 0; r3_ <= ((MK_REP >> 13) & 1); ++r3_) {
        for (int it = F.vcu; it < NGRP * 4; it += F.G) gdn_group_scan<0>(F, it >> 2, it & 3);
        for (int id = F.vcu * 8 + F.wave; id < NGRP * 128; id += F.G * 8) gla_scan_range<0>(F, id >> 7, (id & 127) * 64 + F.lane); }
        xcd_barrier(bar);
        for (int r3_ = 0; r3_ <= ((MK_REP >> 14) & 1); ++r3_) {
        if (F.vcu < 32) gdn_scan_groups(F, F.vcu >> 3, F.vcu & 7);
        else if (F.vcu < 160 && F.wave == 0) gla_scan_groups(F, (F.vcu - 32) * 64 + F.lane); }
        xcd_barrier(bar);
        for (int r3_ = 0; r3_ <= ((MK_REP >> 15) & 1); ++r3_) {
        for (int it = F.vcu; it < NGRP * 4; it += F.G) gdn_group_scan<1>(F, it >> 2, it & 3);
        for (int id = F.vcu * 8 + F.wave; id < NGRP * 128; id += F.G * 8) gla_scan_range<1>(F, id >> 7, (id & 127) * 64 + F.lane); }
        }
        SEAM(3);
    }
    if (IN(4)) { for (int rep_ = 0; rep_ <= ((MK_REP >> 4) & 1); ++rep_) {
        for (int id = (int)blockIdx.x * 8 + F.wave; id < NCH * 32; id += F.G * 8) { const int item = id >> 2, it = id & 3, n = item >> 3, hh = (item + (item >> 8)) & 7;
            if (hh < 4) gla_out_wave(F, n, hh, it); else gdn_out_wave(F, n, hh - 4, it); }
        }
        SEAM(4);
    }
    if (IN(5)) {
#if (MK_REP >> 5) & 1
        {
        pg8::Gemm g{WSP(bf16, WS_MIX), WSP(bf16, WS_WOUT), T, D, D, nullptr}; pg8::StaticOrder S; S.init(T, D, F.G, (int)blockIdx.x);
        pg8::EpiResF32 E{F.in[0], F.out, D};
        pg8::gemm_phase<pg8::EpiResF32, pg8::StaticOrder, true, true>(F.lds + RING_OFF, g, S, E);
        }
#endif
        {
        pg8::Gemm g{WSP(bf16, WS_MIX), WSP(bf16, WS_WOUT), T, D, D, nullptr}; pg8::StaticOrder S; S.init(T, D, F.G, (int)blockIdx.x);
        pg8::EpiResF32 E{F.in[0], F.out, D};
        pg8::gemm_phase<pg8::EpiResF32, pg8::StaticOrder, true, true>(F.lds + RING_OFF, g, S, E);
        }
        SEAM(5);
    }
    if (IN(6)) { for (int rep_ = 0; rep_ <= ((MK_REP >> 6) & 1); ++rep_) { route_phase(F, rep_); } SEAM(6); }
    if (IN(7)) { for (int rep_ = 0; rep_ <= ((MK_REP >> 7) & 1); ++rep_) { scatter_phase(F); } SEAM(7); }
    if (IN(8)) {
#if (MK_REP >> 8) & 1
        {
        moe_tables(F);
        const LAS int* tile_e = (const LAS int*)(F.lds + TILEE_OFF); const int ntiles = __builtin_amdgcn_readfirstlane(tile_e[319]);
        pg8::Gemm g{WSP(bf16, WS_XN), WSP(bf16, WS_W1), XS_ROWS, 2048, D / 2, WSP(int, WS_TOKQ)}; pg8::MoeOrder S{tile_e, ntiles, 8, F.G, (int)blockIdx.x};
        pg8::EpiMoeAct E{WSP(bf16, WS_HS), F.in[16], WSP(float, WS_RPOS)};
        pg8::gemm_phase<pg8::EpiMoeAct, pg8::MoeOrder, true, true, true, true>(F.lds + RING_OFF, g, S, E);
        }
#endif
        {
        moe_tables(F);
        const LAS int* tile_e = (const LAS int*)(F.lds + TILEE_OFF); const int ntiles = __builtin_amdgcn_readfirstlane(tile_e[319]);
        pg8::Gemm g{WSP(bf16, WS_XN), WSP(bf16, WS_W1), XS_ROWS, 2048, D / 2, WSP(int, WS_TOKQ)}; pg8::MoeOrder S{tile_e, ntiles, 8, F.G, (int)blockIdx.x};
        pg8::EpiMoeAct E{WSP(bf16, WS_HS), F.in[16], WSP(float, WS_RPOS)};
        pg8::gemm_phase<pg8::EpiMoeAct, pg8::MoeOrder, true, true, true, true>(F.lds + RING_OFF, g, S, E);
        }
        SEAM(8);
    }
    if (IN(9)) {
#if (MK_REP >> 9) & 1
        {
        moe_tables(F);
        const LAS int* tile_e = (const LAS int*)(F.lds + TILEE_OFF); const int ntiles = __builtin_amdgcn_readfirstlane(tile_e[319]);
        pg8::Gemm g{WSP(bf16, WS_HS), WSP(bf16, WS_W2), XS_ROWS, D, D / 2, nullptr}; pg8::MoeOrder S{tile_e, ntiles, 4, F.G, (int)blockIdx.x};
        pg8::EpiMoeDown E{WSP(bf16, WS_YS), F.in[18], WSP(float, WS_GPOS)};
        pg8::gemm_phase<pg8::EpiMoeDown, pg8::MoeOrder, true, true, true>(F.lds + RING_OFF, g, S, E);
        }
#endif
        {
        moe_tables(F);
        const LAS int* tile_e = (const LAS int*)(F.lds + TILEE_OFF); const int ntiles = __builtin_amdgcn_readfirstlane(tile_e[319]);
        pg8::Gemm g{WSP(bf16, WS_HS), WSP(bf16, WS_W2), XS_ROWS, D, D / 2, nullptr}; pg8::MoeOrder S{tile_e, ntiles, 4, F.G, (int)blockIdx.x};
        pg8::EpiMoeDown E{WSP(bf16, WS_YS), F.in[18], WSP(float, WS_GPOS)};
        pg8::gemm_phase<pg8::EpiMoeDown, pg8::MoeOrder, true, true, true>(F.lds + RING_OFF, g, S, E);
        }
        SEAM(9);
    }
    if (IN(10)) { for (int rep_ = 0; rep_ <= ((MK_REP >> 10) & 1); ++rep_) { combine_phase(F, rep_); } SEAM(10); }
    if (IN(11)) {
#if (MK_REP >> 11) & 1
        {
        pg8::Gemm g{WSP(bf16, WS_XN), WSP(bf16, WS_WPG), T, D, D, nullptr}; pg8::StaticOrder S; S.init(T, D, F.G, (int)blockIdx.x);
        pg8::EpiPle E{F.out, WSP(bf16, WS_PERAW), WSP(float, WS_PERSTD), F.in[22]};
        pg8::gemm_phase<pg8::EpiPle, pg8::StaticOrder, true, true>(F.lds + RING_OFF, g, S, E);
        }
#endif
        {
        pg8::Gemm g{WSP(bf16, WS_XN), WSP(bf16, WS_WPG), T, D, D, nullptr}; pg8::StaticOrder S; S.init(T, D, F.G, (int)blockIdx.x);
        pg8::EpiPle E{F.out, WSP(bf16, WS_PERAW), WSP(float, WS_PERSTD), F.in[22]};
        pg8::gemm_phase<pg8::EpiPle, pg8::StaticOrder, true, true>(F.lds + RING_OFF, g, S, E);
        }
        SEAM(11);
    }
    if (IN(12)) { for (int rep_ = 0; rep_ <= ((MK_REP >> 12) & 1); ++rep_) { final_phase(F, rep_); } }
#undef IN
#undef SEAM
}

extern "C" void kernel_launch(void* const* d_in, const int* in_sizes, int n_in, void* d_out, int out_size, void* d_ws, size_t ws_size, hipStream_t stream) {
    static int grid = 0;
    if (grid == 0) {
        if (n_in != 24 || in_sizes[0] != T * D || out_size != T * D || ws_size < WS_END) { fprintf(stderr, "kernel_launch: unexpected shapes (n_in %d, in0 %d, out %d, ws %zu); nothing launched\n", n_in, n_in > 0 ? in_sizes[0] : -1, out_size, ws_size); grid = -1; return; }
        int dev = 0, cus = 0;
        if (hipGetDevice(&dev) != hipSuccess || hipDeviceGetAttribute(&cus, hipDeviceAttributeMultiprocessorCount, dev) != hipSuccess) { grid = -1; return; }
        if (hipFuncSetAttribute((const void*)fwd_kernel, hipFuncAttributeMaxDynamicSharedMemorySize, LDS_BYTES) != hipSuccess) { fprintf(stderr, "kernel_launch: hipFuncSetAttribute failed\n"); grid = -1; return; }
        int per_cu = 0;
        if (hipOccupancyMaxActiveBlocksPerMultiprocessor(&per_cu, (const void*)fwd_kernel, NWAVES * 64, LDS_BYTES) != hipSuccess || per_cu < 1) fprintf(stderr, "kernel_launch: occupancy query reports %d blocks per CU\n", per_cu);
        (void)hipGetLastError();
        grid = cus;
    }
    if (grid < 0) return;
    if (hipMemsetAsync((char*)d_ws + WS_CTL, 0, CTL_ZERO_BYTES, stream) != hipSuccess) return;
    Args a{};
    for (int i = 0; i < 24; ++i) a.in[i] = (const float*)d_in[i];
    a.out = (float*)d_out; a.ws = (unsigned char*)d_ws;
#if MK_ONE_LAUNCH
    a.ph_lo = 0; a.ph_hi = NPH;
    hipLaunchKernelGGL(fwd_kernel, dim3(grid), dim3(NWAVES * 64), LDS_BYTES, stream, a);
#else
    for (int p = 0; p < NPH; ++p) { a.ph_lo = p; a.ph_hi = p + 1; hipLaunchKernelGGL(fwd_kernel, dim3(grid), dim3(NWAVES * 64), LDS_BYTES, stream, a); }
#endif
}
```

```cpp
#include <hip/hip_runtime.h>
#include <cstdio>
#include <cstdint>
#ifndef MK_ONE_LAUNCH
#define MK_ONE_LAUNCH 1
#endif
#ifndef MK_SKIP
#define MK_SKIP 0
#endif
#ifndef MK_DBG
#define MK_DBG 0
#endif
#ifndef MK_REP
#define MK_REP 0
#endif
namespace pg8 {
#define PG8_LAS __attribute__((address_space(3)))
typedef unsigned short bf16_t;
typedef short bf16x8 __attribute__((ext_vector_type(8)));
typedef float f32x4 __attribute__((ext_vector_type(4)));
typedef unsigned u32x4 __attribute__((ext_vector_type(4)));
constexpr int BM = 256, BK = 64, HALF = 128, HTB = HALF * BK * 2  , STAGE_BYTES = 8 * HTB, NXCD = 8, WGM = 8;

__host__ __device__ __forceinline__ int lds_byte(int r, int c) { const int st = (r >> 4) * 2 + (c >> 5), rr = r & 15, cc = c & 31, ob = rr * 64 + cc * 2; return st * 1024 + (ob ^ (((ob >> 9) & 1) << 5)); }
__host__ __device__ __forceinline__ void stage_rc(int b, int& R, int& C) { const int st = b / 1024, sb = b % 1024, swz = sb ^ (((sb >> 9) & 1) << 5); R = (st >> 1) * 16 + swz / 64; C = (st & 1) * 32 + (swz % 64) / 2; }
__host__ __device__ __forceinline__ int perm32(int rho) { const int n = rho >> 4, i = rho & 15; return 8 * (i >> 2) + 4 * n + (i & 3); }

struct Unit { int pm, pn, pb, e; };
struct Gemm { const bf16_t* A; const bf16_t* Bt; int M, N, K; const int* rowmap; };

struct StaticOrder {
    int nM, nN, nwg, G, c;
    __host__ __device__ void init(int M, int N, int G_, int c_) { nM = M / BM; nN = N / BM; nwg = nM * nN; G = G_; c = c_; }
    __host__ __device__ bool next(int i, Unit& u) const {
        const long L = (long)i * G + c; if (L >= nwg) return false;
        int wgid = (int)L; { const int q = nwg / NXCD, r = nwg % NXCD, xcd = wgid % NXCD, off = wgid / NXCD; wgid = (xcd < r ? xcd * (q + 1) : r * (q + 1) + (xcd - r) * q) + off; }
        const int nig = WGM * nN, gid = wgid / nig, fm = gid * WGM, gsz = (nM - fm) < WGM ? (nM - fm) : WGM;
        u.pm = fm + ((wgid % nig) % gsz); u.pn = (wgid % nig) / gsz; u.pb = u.pn; u.e = 0; return true;
    }
    __device__ __forceinline__ void a_ready(const Unit&) const {}
    __device__ __forceinline__ void done(const Unit&) const {}
};

__device__ __forceinline__ unsigned cvt_pk_bf16(float lo, float hi) { unsigned r; asm volatile("v_cvt_pk_bf16_f32 %0, %1, %2" : "=v"(r) : "v"(lo), "v"(hi)); return r; }

typedef float f32x2 __attribute__((ext_vector_type(2)));
typedef unsigned u32x2 __attribute__((ext_vector_type(2)));
typedef __bf16 bf16x2v __attribute__((ext_vector_type(2)));
__device__ __forceinline__ unsigned cvtpk(float lo, float hi) { f32x2 v = {lo, hi}; bf16x2v b = __builtin_convertvector(v, bf16x2v); return __builtin_bit_cast(unsigned, b); }
typedef int v4i_t __attribute__((ext_vector_type(4)));
typedef int v8i_t __attribute__((ext_vector_type(8)));
__device__ __forceinline__ v8i_t cat16(bf16x8 lo, bf16x8 hi) { return __builtin_shufflevector(__builtin_bit_cast(v4i_t, lo), __builtin_bit_cast(v4i_t, hi), 0, 1, 2, 3, 4, 5, 6, 7); }
__device__ __forceinline__ unsigned cvt4_fp8(float a, float b, float c, float d) { int w = __builtin_amdgcn_cvt_pk_fp8_f32(a, b, 0, false); w = __builtin_amdgcn_cvt_pk_fp8_f32(c, d, w, true); return (unsigned)w; }
__device__ __forceinline__ float sigmoidf_(float x) { return __builtin_amdgcn_rcpf(1.0f + __expf(-x)); }

struct EpiBf16P {
    static constexpr bool PERM = true, AFTER_DRAIN = false;
    bf16_t* O; int ldc;
    __device__ __forceinline__ void operator()(const f32x4 (&acc)[2][2][4][2], const Unit& u, int wr, int wc, int fr, int fq) const {
        const int row0 = u.pm * BM + wr * 64 + fr, col0 = u.pn * BM + wc * 32 + 8 * fq;
#pragma unroll
        for (int ai = 0; ai < 2; ++ai)
#pragma unroll
            for (int m = 0; m < 4; ++m) { bf16_t* rowp = O + (size_t)(row0 + ai * HALF + m * 16) * ldc + col0;
#pragma unroll
                for (int bj = 0; bj < 2; ++bj) { const f32x4 v0 = acc[ai][bj][m][0], v1 = acc[ai][bj][m][1];
                    u32x4 w; w.x = cvtpk(v0[0], v0[1]); w.y = cvtpk(v0[2], v0[3]); w.z = cvtpk(v1[0], v1[1]); w.w = cvtpk(v1[2], v1[3]);
                    *(u32x4*)(rowp + bj * HALF) = w; } }
    }
};
struct EpiResF32 {
    static constexpr bool PERM = false, AFTER_DRAIN = false;
    const float* base; float* out; int ldc;
    __device__ __forceinline__ void operator()(const f32x4 (&acc)[2][2][4][2], const Unit& u, int wr, int wc, int fr, int fq) const {
        const int row0 = u.pm * BM + wr * 64 + fr, col0 = u.pn * BM + wc * 32 + 4 * fq;
#pragma unroll
        for (int ai = 0; ai < 2; ++ai)
#pragma unroll
            for (int m = 0; m < 4; ++m) { const size_t off = (size_t)(row0 + ai * HALF + m * 16) * ldc + col0;
#pragma unroll
                for (int bj = 0; bj < 2; ++bj)
#pragma unroll
                    for (int n = 0; n < 2; ++n) *(f32x4*)(out + off + bj * HALF + n * 16) = *(const f32x4*)(base + off + bj * HALF + n * 16) + acc[ai][bj][m][n]; }
    }
};
struct EpiMoeAct {
    static constexpr bool PERM = true, AFTER_DRAIN = false;
    bf16_t* O; const float* bgu; const float* rpos;
    __device__ __forceinline__ void operator()(const f32x4 (&acc)[2][2][4][2], const Unit& u, int wr, int wc, int fr, int fq) const {
        const int row0 = u.pm * BM + wr * 64 + fr, ch0 = u.pn * HALF + wc * 32 + 8 * fq;
        const float* bb = bgu + (size_t)u.e * 2048 + ch0;
        f32x4 bg[2], bu[2];
#pragma unroll
        for (int n = 0; n < 2; ++n) { bg[n] = *(const f32x4*)(bb + 4 * n); bu[n] = *(const f32x4*)(bb + 1024 + 4 * n); }
#pragma unroll
        for (int ai = 0; ai < 2; ++ai)
#pragma unroll
            for (int m = 0; m < 4; ++m) { const float rs = rpos[row0 + ai * HALF + m * 16];
                float a[8];
#pragma unroll
                for (int n = 0; n < 2; ++n)
#pragma unroll
                    for (int i = 0; i < 4; ++i) {
                        float g = acc[ai][0][m][n][i] * rs + bg[n][i], up = acc[ai][1][m][n][i] * rs + bu[n][i];
                        g = fminf(g, 7.0f); up = fminf(fmaxf(up, -7.0f), 7.0f);
                        a[n * 4 + i] = (up + 1.0f) * g * sigmoidf_(1.702f * g);
                    }
                u32x2 w; w.x = cvt4_fp8(a[0], a[1], a[2], a[3]); w.y = cvt4_fp8(a[4], a[5], a[6], a[7]);
                *(u32x2*)((unsigned char*)O + (size_t)(row0 + ai * HALF + m * 16) * 1024 + ch0) = w;
            }
    }
};
struct EpiMoeDown {
    static constexpr bool PERM = true, AFTER_DRAIN = false;
    bf16_t* O; const float* bd; const float* gpos;
    __device__ __forceinline__ void operator()(const f32x4 (&acc)[2][2][4][2], const Unit& u, int wr, int wc, int fr, int fq) const {
        const int row0 = u.pm * BM + wr * 64 + fr, col0 = u.pn * BM + wc * 32 + 8 * fq;
        const float* bb = bd + (size_t)u.e * 1024 + col0;
        f32x4 bv[2][2];
#pragma unroll
        for (int bj = 0; bj < 2; ++bj)
#pragma unroll
            for (int n = 0; n < 2; ++n) bv[bj][n] = *(const f32x4*)(bb + bj * HALF + 4 * n);
#pragma unroll
        for (int ai = 0; ai < 2; ++ai)
#pragma unroll
            for (int m = 0; m < 4; ++m) { const int r = row0 + ai * HALF + m * 16; const float gt = gpos[r];
#pragma unroll
                for (int bj = 0; bj < 2; ++bj) { const f32x4 v0 = (acc[ai][bj][m][0] + bv[bj][0]) * gt, v1 = (acc[ai][bj][m][1] + bv[bj][1]) * gt;
                    u32x4 w; w.x = cvtpk(v0[0], v0[1]); w.y = cvtpk(v0[2], v0[3]); w.z = cvtpk(v1[0], v1[1]); w.w = cvtpk(v1[2], v1[3]);
                    *(u32x4*)(O + (size_t)r * 1024 + col0 + bj * HALF) = w; } }
    }
};
struct EpiPle {
    static constexpr bool PERM = false, AFTER_DRAIN = false;
    float* out; const bf16_t* pe; const float* rstd; const float* gpost;
    __device__ __forceinline__ void operator()(const f32x4 (&acc)[2][2][4][2], const Unit& u, int wr, int wc, int fr, int fq) const {
        const int row0 = u.pm * BM + wr * 64 + fr, col0 = u.pn * BM + wc * 32 + 4 * fq;
        f32x4 gp[2][2];
#pragma unroll
        for (int bj = 0; bj < 2; ++bj)
#pragma unroll
            for (int n = 0; n < 2; ++n) gp[bj][n] = *(const f32x4*)(gpost + col0 + bj * HALF + n * 16);
#pragma unroll
        for (int ai = 0; ai < 2; ++ai)
#pragma unroll
            for (int m = 0; m < 4; ++m) { const int r = row0 + ai * HALF + m * 16; const float rs = rstd[r];
#pragma unroll
                for (int bj = 0; bj < 2; ++bj)
#pragma unroll
                    for (int n = 0; n < 2; ++n) { const size_t off = (size_t)r * 1024 + col0 + bj * HALF + n * 16;
                        const u32x2 pw = *(const u32x2*)(pe + off); const f32x4 a = acc[ai][bj][m][n];
                        f32x4 p4; p4[0] = __uint_as_float(pw.x << 16); p4[1] = __uint_as_float(pw.x & 0xffff0000u); p4[2] = __uint_as_float(pw.y << 16); p4[3] = __uint_as_float(pw.y & 0xffff0000u);
                        f32x4 o = *(const f32x4*)(out + off);
#pragma unroll
                        for (int i = 0; i < 4; ++i) o[i] += sigmoidf_(a[i]) * p4[i] * rs * gp[bj][n][i];
                        *(f32x4*)(out + off) = o; } }
    }
};
struct MoeOrder {
    const PG8_LAS int* tile_e; int ntiles, NT, G, c;
    __device__ __forceinline__ bool next(int i, Unit& u) const {
        const int L = (G % 8 == 0) ? i * G + (c & 7) * (G >> 3) + (c >> 3) : i * G + c;
        if (L >= ntiles * NT) return false;
        const int mt = L / NT, nt = L - mt * NT;
        const int e = __builtin_amdgcn_readfirstlane(tile_e[mt]);
        u.pm = mt; u.pn = nt; u.e = e; u.pb = e * NT + nt; return true;
    }
    __device__ __forceinline__ void a_ready(const Unit&) const {}
    __device__ __forceinline__ void done(const Unit&) const {}
};
template <class Epi, class Sched, bool ALIGN_EPI = false, bool SP2 = false, bool FP8 = false, bool GATHER = false>
__device__ __forceinline__ void gemm_phase(PG8_LAS unsigned char* lds, const Gemm g, const Sched& S, const Epi& E) {
    const int tid = threadIdx.x, wid = __builtin_amdgcn_readfirstlane(tid >> 6), lane = tid & 63, wr = wid >> 2, wc = wid & 3, fr = lane & 15, fq = lane >> 4;
    const int K = g.K, nt = K / BK;
    unsigned voffA[2], voffB[2]; int Rr[2]; unsigned cb2[2];
#pragma unroll
    for (int i = 0; i < 2; ++i) { int R, C; stage_rc(tid * 16 + i * 8192, R, C); const int Rb = Epi::PERM ? ((R & ~31) + perm32(R & 31)) : R;
        voffA[i] = (unsigned)(R * K + C) * 2u; voffB[i] = (unsigned)(Rb * K + C) * 2u; Rr[i] = R; cb2[i] = (unsigned)C * 2u; }
    const size_t kstep = (size_t)(BK * 2);
    const size_t hstep = (size_t)HALF * K * 2;
    const size_t tstep = 2 * hstep;
    const unsigned ldsw = (unsigned)wid * 1024u;
    const int aoff = lds_byte(wr * 64 + fr, fq * 8), boff = lds_byte(wc * 32 + fr, fq * 8);
#define PG8_SA(b, h) (((b) * 2 + (h)) * HTB)
#define PG8_SB(b, h) ((4 + (b) * 2 + (h)) * HTB)
#define PG8_STAGE(bufoff, gbase, voff) do { _Pragma("unroll") for (int _i = 0; _i < 2; ++_i) \
        __builtin_amdgcn_global_load_lds((const unsigned*)((const char*)(gbase) + (voff)[_i]), (PG8_LAS unsigned*)(lds + (bufoff) + ldsw + _i * 8192), 16, 0, 0); } while (0)
#define PG8_GOFF(dst, pm_) do { _Pragma("unroll") for (int _h = 0; _h < 2; ++_h) _Pragma("unroll") for (int _i = 0; _i < 2; ++_i) dst[_h][_i] = (unsigned)g.rowmap[(pm_) * BM + _h * HALF + Rr[_i]] * (unsigned)(K * 2) + cb2[_i]; } while (0)
#define PG8_STAGE_A(bufoff, ptr, half, nsel) do { if constexpr (GATHER) { unsigned _v[2]; _v[0] = (nsel) ? nvA[half][0] : vA[half][0]; _v[1] = (nsel) ? nvA[half][1] : vA[half][1]; PG8_STAGE(bufoff, ptr, _v); } \
        else { PG8_STAGE(bufoff, (ptr) + ((half) ? hstep : 0), voffA); } } while (0)
#define PG8_LD1(off) (*(const PG8_LAS bf16x8*)(lds + (off)))
#define PG8_LDA(dst, b, h) do { if constexpr (FP8) { _Pragma("unroll") for (int m = 0; m < 4; ++m) dst##8[m] = cat16(PG8_LD1(PG8_SA(b, h) + aoff + m * 2048), PG8_LD1(PG8_SA(b, h) + aoff + m * 2048 + 1024)); } \
        else { _Pragma("unroll") for (int m = 0; m < 4; ++m) _Pragma("unroll") for (int k = 0; k < 2; ++k) dst[m][k] = PG8_LD1(PG8_SA(b, h) + aoff + m * 2048 + k * 1024); } } while (0)
#define PG8_LDB(dst, b, h) do { if constexpr (FP8) { _Pragma("unroll") for (int n = 0; n < 2; ++n) dst##8[n] = cat16(PG8_LD1(PG8_SB(b, h) + boff + n * 2048), PG8_LD1(PG8_SB(b, h) + boff + n * 2048 + 1024)); } \
        else { _Pragma("unroll") for (int n = 0; n < 2; ++n) _Pragma("unroll") for (int k = 0; k < 2; ++k) dst[n][k] = PG8_LD1(PG8_SB(b, h) + boff + n * 2048 + k * 1024); } } while (0)
#define PG8_MMA(ai, bj, At, Bt) do { if constexpr (FP8) __builtin_amdgcn_sched_barrier(0); __builtin_amdgcn_s_setprio(1); _Pragma("unroll") for (int m = 0; m < 4; ++m) _Pragma("unroll") for (int n = 0; n < 2; ++n) { \
        if constexpr (FP8) { acc[ai][bj][m][n] = __builtin_amdgcn_mfma_scale_f32_16x16x128_f8f6f4(Bt##8[n], At##8[m], acc[ai][bj][m][n], 0, 0, 0, 0x79797979, 0, 0x7f7f7f7f); } \
        else { _Pragma("unroll") for (int k = 0; k < 2; ++k) acc[ai][bj][m][n] = __builtin_amdgcn_mfma_f32_16x16x32_bf16(Bt[n][k], At[m][k], acc[ai][bj][m][n], 0, 0, 0); } } \
        if constexpr (FP8) { _Pragma("unroll") for (int m = 0; m < 4; ++m) _Pragma("unroll") for (int n = 0; n < 2; ++n) asm volatile("" : "+v"(acc[ai][bj][m][n])); }     \
        __builtin_amdgcn_s_setprio(0); if constexpr (FP8) __builtin_amdgcn_sched_barrier(0); } while (0)
#define PG8_WAIT_V(n) asm volatile("s_waitcnt vmcnt(" #n ")" ::: "memory")
#define PG8_WAIT_L(n) asm volatile("s_waitcnt lgkmcnt(" #n ")" ::: "memory")
#define PG8_BAR __builtin_amdgcn_s_barrier()
#define PG8_SCHED __builtin_amdgcn_sched_barrier(0)
    Unit cur, nxt; int ui = 0;
    if (!S.next(0, cur)) return;
    f32x4 acc[2][2][4][2];
#pragma unroll
    for (int a = 0; a < 2; ++a)
#pragma unroll
        for (int b = 0; b < 2; ++b)
#pragma unroll
            for (int m = 0; m < 4; ++m)
#pragma unroll
                for (int n = 0; n < 2; ++n) acc[a][b][m][n] = (f32x4){0.f, 0.f, 0.f, 0.f};
    bf16x8 At[4][2], B0[2][2], B1[2][2]; v8i_t At8[4], B08[2], B18[2];
    unsigned vA[2][2], nvA[2][2];
    if constexpr (GATHER) { PG8_GOFF(vA, cur.pm); }
    const char* cA = (const char*)g.A + (GATHER ? (size_t)0 : (size_t)cur.pm * tstep); const char* cB = (const char*)g.Bt + (size_t)cur.pb * tstep;
    S.a_ready(cur);
    if constexpr (SP2) {
        PG8_STAGE(PG8_SB(0, 0), cB, voffB); PG8_STAGE(PG8_SB(0, 1), cB + hstep, voffB); PG8_STAGE_A(PG8_SA(0, 0), cA, 0, false); PG8_STAGE_A(PG8_SA(0, 1), cA, 1, false);
        if (wr == 1) PG8_BAR;
        PG8_WAIT_V(2); PG8_BAR;
        PG8_STAGE(PG8_SB(1, 0), cB + kstep, voffB); PG8_STAGE_A(PG8_SA(1, 0), cA + kstep, 0, false); PG8_STAGE(PG8_SB(1, 1), cB + hstep + kstep, voffB);
        PG8_WAIT_V(6); PG8_BAR;
    } else {
        PG8_STAGE(PG8_SB(0, 0), cB, voffB); PG8_STAGE_A(PG8_SA(0, 0), cA, 0, false); PG8_STAGE(PG8_SB(0, 1), cB + hstep, voffB); PG8_STAGE_A(PG8_SA(0, 1), cA, 1, false);
        if (wr == 1) PG8_BAR;
        PG8_WAIT_V(4); PG8_BAR;
        PG8_STAGE(PG8_SB(1, 0), cB + kstep, voffB); PG8_STAGE_A(PG8_SA(1, 0), cA + kstep, 0, false); PG8_STAGE(PG8_SB(1, 1), cB + hstep + kstep, voffB);
        PG8_WAIT_V(6); PG8_BAR;
    }
    for (;;) {
        const bool has_next = S.next(ui + 1, nxt);
        if constexpr (GATHER) { if (has_next) { PG8_GOFF(nvA, nxt.pm); } else { _Pragma("unroll") for (int _h = 0; _h < 2; ++_h) _Pragma("unroll") for (int _i = 0; _i < 2; ++_i) nvA[_h][_i] = vA[_h][_i]; } }
        const char* nA = (has_next && !GATHER) ? (const char*)g.A + (size_t)nxt.pm * tstep : cA; const char* nB = has_next ? (const char*)g.Bt + (size_t)nxt.pb * tstep : cB;
        for (int t = 0; t < nt; t += 2) {
            const bool last = (t == nt - 2);
            const char* a1 = cA + (size_t)(t + 1) * kstep;
            const char* a2 = last ? nA : cA + (size_t)(t + 2) * kstep; const char* b2 = last ? nB : cB + (size_t)(t + 2) * kstep;
            const char* a3 = a2 + kstep; const char* b3 = b2 + kstep;
            if (last && has_next) S.a_ready(nxt);
            if constexpr (SP2) {
            PG8_LDB(B0, 0, 0); PG8_LDB(B1, 0, 1); PG8_SCHED; PG8_LDA(At, 0, 0); PG8_STAGE_A(PG8_SA(1, 1), a1, 1, false);
            PG8_WAIT_V(8); PG8_WAIT_L(0); PG8_BAR; PG8_MMA(0, 0, At, B0); PG8_MMA(0, 1, At, B1); PG8_BAR; PG8_SCHED;
            PG8_LDA(At, 0, 1); PG8_STAGE(PG8_SB(0, 0), b2, voffB); PG8_STAGE(PG8_SB(0, 1), b2 + hstep, voffB); PG8_STAGE_A(PG8_SA(0, 0), a2, 0, last);
            PG8_WAIT_V(8); PG8_WAIT_L(0); PG8_BAR; PG8_MMA(1, 0, At, B0); PG8_MMA(1, 1, At, B1); PG8_BAR; PG8_SCHED;
            PG8_LDB(B0, 1, 0); PG8_LDB(B1, 1, 1); PG8_SCHED; PG8_LDA(At, 1, 0); PG8_STAGE_A(PG8_SA(0, 1), a2, 1, last);
            PG8_WAIT_V(8); PG8_WAIT_L(0); PG8_BAR; PG8_MMA(0, 0, At, B0); PG8_MMA(0, 1, At, B1); PG8_BAR; PG8_SCHED;
            PG8_LDA(At, 1, 1); PG8_STAGE(PG8_SB(1, 0), b3, voffB); PG8_STAGE(PG8_SB(1, 1), b3 + hstep, voffB); PG8_STAGE_A(PG8_SA(1, 0), a3, 0, last);
            PG8_WAIT_V(8); PG8_WAIT_L(0); PG8_BAR; PG8_MMA(1, 0, At, B0); PG8_MMA(1, 1, At, B1); PG8_BAR; PG8_SCHED;
            } else {
            PG8_LDB(B0, 0, 0); PG8_SCHED; PG8_LDA(At, 0, 0); PG8_STAGE_A(PG8_SA(1, 1), a1, 1, false);
            PG8_WAIT_L(8); PG8_BAR; PG8_WAIT_L(0); PG8_MMA(0, 0, At, B0); PG8_BAR; PG8_SCHED;
            PG8_LDB(B1, 0, 1); PG8_STAGE(PG8_SB(0, 0), b2, voffB);
            PG8_BAR; PG8_WAIT_L(0); PG8_MMA(0, 1, At, B1); PG8_BAR;
            PG8_LDA(At, 0, 1); PG8_STAGE_A(PG8_SA(0, 0), a2, 0, last);
            PG8_BAR; PG8_WAIT_L(0); PG8_MMA(1, 0, At, B0); PG8_BAR; PG8_SCHED;
            PG8_STAGE(PG8_SB(0, 1), b2 + hstep, voffB);
            PG8_WAIT_V(6); PG8_BAR; PG8_MMA(1, 1, At, B1); PG8_BAR;
            PG8_LDB(B0, 1, 0); PG8_SCHED; PG8_LDA(At, 1, 0); PG8_STAGE_A(PG8_SA(0, 1), a2, 1, last);
            PG8_WAIT_L(8); PG8_BAR; PG8_WAIT_L(0); PG8_MMA(0, 0, At, B0); PG8_BAR; PG8_SCHED;
            PG8_LDB(B1, 1, 1); PG8_STAGE(PG8_SB(1, 0), b3, voffB);
            PG8_BAR; PG8_WAIT_L(0); PG8_MMA(0, 1, At, B1); PG8_BAR;
            PG8_LDA(At, 1, 1); PG8_STAGE_A(PG8_SA(1, 0), a3, 0, last);
            PG8_BAR; PG8_WAIT_L(0); PG8_MMA(1, 0, At, B0); PG8_BAR; PG8_SCHED;
            PG8_STAGE(PG8_SB(1, 1), b3 + hstep, voffB);
            PG8_WAIT_V(6); PG8_BAR; PG8_MMA(1, 1, At, B1); PG8_BAR;
            }
        }
        if constexpr (ALIGN_EPI) { if (wr == 0) PG8_BAR; }
        if constexpr (!Epi::AFTER_DRAIN) { E(acc, cur, wr, wc, fr, fq); S.done(cur); }
        if (!has_next) break;
#pragma unroll
        for (int a = 0; a < 2; ++a)
#pragma unroll
            for (int b = 0; b < 2; ++b)
#pragma unroll
                for (int m = 0; m < 4; ++m)
#pragma unroll
                    for (int n = 0; n < 2; ++n) acc[a][b][m][n] = (f32x4){0.f, 0.f, 0.f, 0.f};
        cur = nxt; cA = nA; cB = nB; ++ui;
        if constexpr (GATHER) { _Pragma("unroll") for (int _h = 0; _h < 2; ++_h) _Pragma("unroll") for (int _i = 0; _i < 2; ++_i) vA[_h][_i] = nvA[_h][_i]; }
        if constexpr (ALIGN_EPI) { if (wr == 1) PG8_BAR; }
    }
    PG8_WAIT_V(0);
    if constexpr (!ALIGN_EPI) { if (wr == 0) PG8_BAR; }
    PG8_BAR;
    if constexpr (Epi::AFTER_DRAIN) { E.fused(acc, cur, wr, wc, fr, fq, lds, wid, lane); S.done(cur); }
#undef PG8_SA
#undef PG8_SB
#undef PG8_STAGE
#undef PG8_GOFF
#undef PG8_STAGE_A
#undef PG8_LD1
#undef PG8_LDA
#undef PG8_LDB
#undef PG8_MMA
#undef PG8_WAIT_V
#undef PG8_WAIT_L
#undef PG8_BAR
#undef PG8_SCHED
}
}

constexpr int NWAVES = 8;
constexpr int T = 16384, D = 1024, NCH = 256, LDP = 3840, DIN = 3608, PLE = 256, NE = 32;
constexpr int C_GQ = 0, C_GK = 256, C_GV = 512, C_GR = 1024, C_DQ = 1536, C_DZ = 3072, C_GLR = 3584, C_DA = 3600, C_DB = 3604;
constexpr float EPS = 1e-6f;
constexpr int XS_ROWS = 65536 + NE * 256;

constexpr size_t MiB = 1u << 20;
constexpr size_t WS_CTL = 0, CTL_ZERO_BYTES = 1 * MiB;
constexpr size_t WS_WIN = 2 * MiB, WS_WPP = 10 * MiB, WS_WOUT = 11 * MiB, WS_WPG = 13 * MiB, WS_W1 = 16 * MiB, WS_W2 = 80 * MiB;
constexpr size_t WS_XN = 112 * MiB, WS_PB = 144 * MiB, WS_PROJ = 152 * MiB, WS_PERAW = 272 * MiB;
constexpr size_t WS_KVT = 304 * MiB, WS_DVEC = 336 * MiB, WS_SGLA = 337 * MiB, WS_WF = 353 * MiB, WS_KDF = 369 * MiB, WS_UF = 385 * MiB, WS_CDEC = 417 * MiB;
constexpr size_t WS_QDEC = 418 * MiB, WS_AQK = 434 * MiB, WS_SGDN = 442 * MiB, WS_DELTA = 474 * MiB, WS_MIX = 490 * MiB;
constexpr size_t WS_TOKE = 522 * MiB, WS_TOKS = WS_TOKE + 256 * 1024, WS_TOKG = WS_TOKS + 256 * 1024, WS_TOKP = WS_TOKG + 256 * 1024;
constexpr size_t WS_GPOS = 523 * MiB, WS_PERSTD = 524 * MiB, WS_XS = 525 * MiB, WS_TOKQ = WS_XS  , WS_HS = 597 * MiB, WS_YS = 669 * MiB;
constexpr size_t WS_PEND = 813 * MiB, WS_SLE = 821 * MiB, WS_SST = 837 * MiB, WS_GSLE = 853 * MiB, WS_GPD = 861 * MiB, WS_GSST = 869 * MiB, WS_QT = 877 * MiB, WS_OI = 885 * MiB, WS_WRF = 901 * MiB, WS_RSTD = 902 * MiB, WS_RPOS = 903 * MiB, WS_END = 904 * MiB;
static_assert(WS_XS + (size_t)XS_ROWS * 1024 <= WS_HS && WS_HS + (size_t)XS_ROWS * 1024 <= WS_YS && WS_YS + (size_t)XS_ROWS * 2048 <= WS_PEND, "d_ws map");
constexpr int GRP = 4, NGRP = NCH / GRP;
constexpr int CW_TMO = 0, CW_CODE = 1, CW_BAR = 4096, CW_CNT = 8192;

constexpr int RING_OFF = 0, RING_BYTES = 131072;
constexpr int LDSCTL_OFF = RING_BYTES, MISC_OFF = LDSCTL_OFF + 320;
constexpr int TILEE_OFF = MISC_OFF + 128;
constexpr int BASE_OFF = TILEE_OFF + 320 * 4;
constexpr int ROUTE_OFF = BASE_OFF + 128;
constexpr int LDS_BYTES = 147456;
static_assert(ROUTE_OFF + 256 + 3072 <= LDS_BYTES, "LDS map");

#define GAS __attribute__((address_space(1)))
#define LAS __attribute__((address_space(3)))
typedef unsigned short bf16;
typedef unsigned v4u __attribute__((ext_vector_type(4)));
typedef float f32x4 __attribute__((ext_vector_type(4)));
typedef short bf16x8 __attribute__((ext_vector_type(8)));
typedef GAS unsigned gu32;
typedef GAS unsigned long long gu64;
#define RLX_AGENT __ATOMIC_RELAXED, __HIP_MEMORY_SCOPE_AGENT
#define LDS_WAIT() asm volatile("s_waitcnt lgkmcnt(0)" ::: "memory")
#define VM_WAIT() asm volatile("s_waitcnt vmcnt(0)" ::: "memory")
__device__ __forceinline__ unsigned long long rt() { return __builtin_amdgcn_s_memrealtime(); }
__device__ __forceinline__ unsigned f2bf(float f) { unsigned u = __builtin_bit_cast(unsigned, f); return (u + 0x7fffu + ((u >> 16) & 1u)) >> 16; }
__device__ __forceinline__ unsigned pk2(float lo, float hi) { return f2bf(lo) | (f2bf(hi) << 16); }

#define XB_TMO      128
#define XB_XCNT(j)  (256  + 64 * (j))
#define XB_XSUB(j)  (1280 + 64 * (j))
#define XB_XGEN(j)  (2304 + 64 * (j))
#define XB_TOP      3328
#define XB_TOPGEN   3392
#define XCD_BAR_WORDS 3456
#define XB_SPIN_CAP (1u << 18)

__device__ __forceinline__ unsigned xb_ld(unsigned* p)              { return __hip_atomic_load(p, __ATOMIC_RELAXED, __HIP_MEMORY_SCOPE_AGENT); }
__device__ __forceinline__ unsigned xb_add(unsigned* p, unsigned v) { return __hip_atomic_fetch_add(p, v, __ATOMIC_RELAXED, __HIP_MEMORY_SCOPE_AGENT); }
__device__ __forceinline__ unsigned xb_xcc_id() { return (unsigned)__builtin_amdgcn_s_getreg((3 << 11) | 20) & 0xFu; }
#define XB_SPIN(cond, bar) do { unsigned _sp = 0; while (cond) { __builtin_amdgcn_s_sleep(1); \
    if ((++_sp & 255u) == 0u) { if (xb_ld(&(bar)[XB_TMO])) break; if (_sp > XB_SPIN_CAP) { atomicAdd(&(bar)[XB_TMO], 1u); break; } } } } while (0)

struct XcdBarrier {
    unsigned* bar; unsigned x;
    volatile LAS unsigned* st;
};

__device__ __forceinline__ XcdBarrier xcd_barrier_post(unsigned* bar, volatile LAS unsigned* st) {
    XcdBarrier b; b.bar = bar; b.x = xb_xcc_id(); b.st = st;
    if (threadIdx.x == 0) (void)xb_add(&bar[XB_XCNT(b.x)], 1u);
    return b;
}
__device__ __forceinline__ void xcd_barrier_complete(unsigned* bar, unsigned x, unsigned& nloc, unsigned& nx) {
    const unsigned G = gridDim.x * gridDim.y * gridDim.z;
    unsigned sum, cnt, mine, sp = 0u;
    for (;;) {
        sum = 0u; cnt = 0u; mine = 0u;
#pragma unroll
        for (unsigned j = 0; j < 16; ++j) { const unsigned c = xb_ld(&bar[XB_XCNT(j)]); sum += c; cnt += (c > 0u) ? 1u : 0u; mine = (j == x) ? c : mine; }
        if (sum == G) break;
        __builtin_amdgcn_s_sleep(1);
        if ((++sp & 255u) == 0u) { if (xb_ld(&bar[XB_TMO])) break; if (sp > XB_SPIN_CAP) { atomicAdd(&bar[XB_TMO], 1u); break; } }
    }
    nloc = mine > 0u ? mine : 1u; nx = cnt > 0u ? cnt : 1u;
}

__device__ __forceinline__ void xcd_barrier(const XcdBarrier& b) {
    asm volatile("s_waitcnt vmcnt(0)" ::: "memory");
    __syncthreads();
    if (threadIdx.x == 0) {
        unsigned* bar = b.bar;
        __builtin_amdgcn_s_waitcnt(0);
        unsigned nloc = b.st[0], nx = b.st[1];
        if (nloc == 0u) { xcd_barrier_complete(bar, b.x, nloc, nx); b.st[0] = nloc; b.st[1] = nx; }
        const unsigned old = xb_add(&bar[XB_XSUB(b.x)], 1u);
        const unsigned gen = old / nloc;
        if (old + 1u == (gen + 1u) * nloc) {
            __builtin_amdgcn_fence(__ATOMIC_RELEASE, "agent");
            asm volatile("s_waitcnt vmcnt(0)" ::: "memory");
            const unsigned og = xb_add(&bar[XB_TOP], 1u);
            const unsigned tg = og / nx;
            if (og + 1u == (tg + 1u) * nx) xb_add(&bar[XB_TOPGEN], 1u);
            else XB_SPIN(xb_ld(&bar[XB_TOPGEN]) == tg, bar);
            __builtin_amdgcn_fence(__ATOMIC_ACQUIRE, "agent");
            xb_add(&bar[XB_XGEN(b.x)], 1u);
            asm volatile("s_waitcnt vmcnt(0)" ::: "memory");
        } else {
            XB_SPIN(xb_ld(&bar[XB_XGEN(b.x)]) == gen, bar);
            __builtin_amdgcn_fence(__ATOMIC_ACQUIRE, "agent");
            asm volatile("s_waitcnt vmcnt(0)" ::: "memory");
        }
    }
    __syncthreads();
}


__device__ __forceinline__ float bflo(unsigned w) { return __uint_as_float(w << 16); }
__device__ __forceinline__ float bfhi(unsigned w) { return __uint_as_float(w & 0xffff0000u); }
__device__ __forceinline__ float bf2f(bf16 h) { return __uint_as_float((unsigned)h << 16); }
using pg8::cvtpk;
__device__ __forceinline__ bf16 f2bf1(float f) { return (bf16)(cvtpk(f, 0.f) & 0xffffu); }
__device__ __forceinline__ float wave_sum(float v) {
#pragma unroll
    for (int o = 1; o < 64; o <<= 1) v += __shfl_xor(v, o);
    return v;
}
__device__ __forceinline__ void lds_barrier() { asm volatile("s_waitcnt lgkmcnt(0)" ::: "memory"); __builtin_amdgcn_s_barrier(); asm volatile("" ::: "memory"); }
__device__ __forceinline__ float sigm(float x) { return __builtin_amdgcn_rcpf(1.0f + __expf(-x)); }
__device__ __forceinline__ float siluf_(float x) { return x * sigm(x); }
__device__ __forceinline__ float softplusf_(float x) { return fmaxf(x, 0.f) + __logf(1.0f + __expf(-fabsf(x))); }
__device__ __forceinline__ float logsigf_(float x) { return fminf(x, 0.f) - __logf(1.0f + __expf(-fabsf(x))); }
#define MFMA16(a, b, c) __builtin_amdgcn_mfma_f32_16x16x32_bf16((a), (b), (c), 0, 0, 0)
typedef short bf16x4 __attribute__((ext_vector_type(4)));
typedef unsigned u32x2 __attribute__((ext_vector_type(2)));
__device__ __forceinline__ bf16x8 cat8(bf16x4 lo, bf16x4 hi) { return __builtin_shufflevector(lo, hi, 0, 1, 2, 3, 4, 5, 6, 7); }
__device__ __forceinline__ bf16x8 pack8(const f32x4& a, const f32x4& b) {
    v4u w; w.x = cvtpk(a[0], a[1]); w.y = cvtpk(a[2], a[3]); w.z = cvtpk(b[0], b[1]); w.w = cvtpk(b[2], b[3]); return __builtin_bit_cast(bf16x8, w);
}
__device__ __forceinline__ u32x2 pack4(const f32x4& a) { u32x2 w; w.x = cvtpk(a[0], a[1]); w.y = cvtpk(a[2], a[3]); return w; }

struct Frame {
    LAS unsigned char* lds;
    volatile LAS unsigned* MISC;
    gu32* ctl;
    int tid, lane, wave;
    int vcu, G;
    unsigned char* ws;
    const float* in[24];
    float* out;
};
#define WSP(T_, off) ((T_*)(F.ws + (off)))

__device__ __forceinline__ void titem_load(const float* W0, size_t wstride, int K, int N, int nblk, int ipm, int it, int lane, f32x4 (&v)[8]) {
    const int m = it / ipm, li = it - m * ipm, kb = li / nblk, nb = li - kb * nblk, k0 = 64 * kb, n0 = 32 * nb, cq = (lane & 7) * 4, rr = lane >> 3;
    const float* W = W0 + (size_t)m * wstride;
#pragma unroll
    for (int i = 0; i < 8; ++i) { v[i] = (f32x4){0.f, 0.f, 0.f, 0.f}; if (n0 + cq < N) v[i] = *(const GAS f32x4*)(W + (size_t)(k0 + 8 * i + rr) * N + n0 + cq); }
}
template <bool FP8, class RowMap>
__device__ __forceinline__ void transpose_set(const float* W0, size_t wstride, unsigned char* WT0, size_t wtstride, int K, int N, int nmat, LAS float* scr, int gw, int NGW, int lane, RowMap rm) {
    const int nblk = (N + 31) >> 5, ipm = (K >> 6) * nblk, total = nmat * ipm;
    int it = gw; if (it >= total) return;
    f32x4 cur[8], nxt[8];
    titem_load(W0, wstride, K, N, nblk, ipm, it, lane, cur);
    for (; it < total; it += NGW) {
        const bool more = it + NGW < total;
        if (more) titem_load(W0, wstride, K, N, nblk, ipm, it + NGW, lane, nxt);
        const int m = it / ipm, li = it - m * ipm, kb = li / nblk, nb = li - kb * nblk, k0 = 64 * kb, n0 = 32 * nb, cq = (lane & 7) * 4, rr = lane >> 3, c = lane & 7;
        const float sc = FP8 ? 64.f : 1.f;
#pragma unroll
        for (int i = 0; i < 8; ++i) { LAS float* s = scr + (8 * i + rr) * 33 + cq; s[0] = cur[i][0] * sc; s[1] = cur[i][1] * sc; s[2] = cur[i][2] * sc; s[3] = cur[i][3] * sc; }
        LDS_WAIT(); asm volatile("" ::: "memory");
        unsigned char* WT = WT0 + (size_t)m * wtstride;
#pragma unroll
        for (int j = 0; j < 4; ++j) { const int n = (lane >> 3) + 8 * j; const LAS float* s = scr + (8 * c) * 33 + n;
            if (n0 + n < N) {
                if (FP8) { u32x2 o; o.x = pg8::cvt4_fp8(s[0 * 33], s[1 * 33], s[2 * 33], s[3 * 33]); o.y = pg8::cvt4_fp8(s[4 * 33], s[5 * 33], s[6 * 33], s[7 * 33]);
                    *(GAS u32x2*)(WT + (size_t)rm(n0 + n) * K + k0 + 8 * c) = o; }
                else { v4u o; o.x = cvtpk(s[0 * 33], s[1 * 33]); o.y = cvtpk(s[2 * 33], s[3 * 33]); o.z = cvtpk(s[4 * 33], s[5 * 33]); o.w = cvtpk(s[6 * 33], s[7 * 33]);
                    *(GAS v4u*)((bf16*)WT + (size_t)rm(n0 + n) * K + k0 + 8 * c) = o; } } }
        LDS_WAIT(); asm volatile("" ::: "memory");
        if (more) {
#pragma unroll
            for (int i = 0; i < 8; ++i) cur[i] = nxt[i]; }
    }
}
__device__ __forceinline__ void titem_load_w(const float* W0, size_t wstride, int N, int nblk, int ipm, int it, int lane, f32x4 (&v)[16]) {
    const int m = it / ipm, li = it - m * ipm, kb = li / nblk, nb = li - kb * nblk, k0 = 64 * kb, n0 = 64 * nb, cq = (lane & 7) * 4, rr = lane >> 3;
    const float* W = W0 + (size_t)m * wstride;
#pragma unroll
    for (int i = 0; i < 8; ++i) { const GAS f32x4* p = (const GAS f32x4*)(W + (size_t)(k0 + 8 * i + rr) * N + n0 + cq); v[2 * i] = __builtin_nontemporal_load(p); v[2 * i + 1] = __builtin_nontemporal_load(p + 8); }
}
template <class RowMap>
__device__ __forceinline__ void transpose_set_w(const float* W0, size_t wstride, unsigned char* WT0, size_t wtstride, int K, int N, int nmat, LAS float* scr, int gw, int NGW, int lane, RowMap rm) {
    const int nblk = N >> 6, ipm = (K >> 6) * nblk, total = nmat * ipm;
    int it = gw; if (it >= total) return;
    f32x4 cur[16], nxt[16];
    titem_load_w(W0, wstride, N, nblk, ipm, it, lane, cur);
    for (; it < total; it += NGW) {
        const bool more = it + NGW < total;
        if (more) titem_load_w(W0, wstride, N, nblk, ipm, it + NGW, lane, nxt);
        const int m = it / ipm, li = it - m * ipm, kb = li / nblk, nb = li - kb * nblk, k0 = 64 * kb, n0 = 64 * nb, cq = (lane & 7) * 4, rr = lane >> 3, c = lane & 7;
        unsigned char* WT = WT0 + (size_t)m * wtstride;
#pragma unroll
        for (int hf = 0; hf < 2; ++hf) {
#pragma unroll
            for (int i = 0; i < 8; ++i) { LAS float* s = scr + (8 * i + rr) * 33 + cq; const f32x4 x = cur[2 * i + hf]; s[0] = x[0] * 64.f; s[1] = x[1] * 64.f; s[2] = x[2] * 64.f; s[3] = x[3] * 64.f; }
            LDS_WAIT(); asm volatile("" ::: "memory");
#pragma unroll
            for (int j = 0; j < 4; ++j) { const int n = (lane >> 3) + 8 * j; const LAS float* s = scr + (8 * c) * 33 + n;
                u32x2 o; o.x = pg8::cvt4_fp8(s[0 * 33], s[1 * 33], s[2 * 33], s[3 * 33]); o.y = pg8::cvt4_fp8(s[4 * 33], s[5 * 33], s[6 * 33], s[7 * 33]);
                __builtin_nontemporal_store(o, (GAS u32x2*)(WT + (size_t)rm(n0 + 32 * hf + n) * K + k0 + 8 * c)); }
            LDS_WAIT(); asm volatile("" ::: "memory");
        }
        if (more) {
#pragma unroll
            for (int i = 0; i < 16; ++i) cur[i] = nxt[i]; }
    }
}
struct RmId { __device__ __forceinline__ int operator()(int n) const { return n; } };
struct RmWin { __device__ __forceinline__ int operator()(int c) const { return c < 1536 ? c : (c < 1552 ? c + 2048 : (c < 3600 ? c - 16 : c)); } };
struct RmW1 { __device__ __forceinline__ int operator()(int c) const { const int j = c & 1023, up = c >> 10; return (j >> 7) * 256 + up * 128 + (j & 127); } };

__device__ __forceinline__ void rms_row_to_bf16(const float* xrow, const float* g, bf16* orow, int lane) {
    const GAS f32x4* xr = (const GAS f32x4*)xrow + lane; const GAS f32x4* gr = (const GAS f32x4*)g + lane;
    f32x4 v[4]; float s = 0.f;
#pragma unroll
    for (int j = 0; j < 4; ++j) { v[j] = xr[64 * j]; s += (v[j].x * v[j].x + v[j].y * v[j].y) + (v[j].z * v[j].z + v[j].w * v[j].w); }
    const float rstd = 1.f / sqrtf(wave_sum(s) * (1.f / D) + EPS);
    GAS u32x2* o8 = (GAS u32x2*)orow + lane;
#pragma unroll
    for (int j = 0; j < 4; ++j) { const f32x4 gg = gr[64 * j]; u32x2 w; w.x = cvtpk(v[j].x * rstd * gg.x, v[j].y * rstd * gg.y); w.y = cvtpk(v[j].z * rstd * gg.z, v[j].w * rstd * gg.w); o8[64 * j] = w; }
}

__device__ __forceinline__ void p0_prologue(Frame& F) {
    LAS float* scr = (LAS float*)(F.lds + RING_OFF + F.wave * 16384);
    const int gw = F.vcu * NWAVES + F.wave, NGW = F.G * NWAVES, lane = F.lane;
    bf16* Win_t = WSP(bf16, WS_WIN);
    transpose_set<false>(F.in[3], 0, (unsigned char*)Win_t, 0, 1024, DIN, 1, scr, gw, NGW, lane, RmWin());
    for (int r = DIN + gw; r < LDP; r += NGW) { GAS v4u* o = (GAS v4u*)(Win_t + (size_t)r * 1024) + lane; o[0] = (v4u){0, 0, 0, 0}; o[64] = (v4u){0, 0, 0, 0}; }
    transpose_set<false>(F.in[21], 0, WSP(unsigned char, WS_WPP), 0, PLE, D, 1, scr, gw, NGW, lane, RmId());
    transpose_set<false>(F.in[11], 0, WSP(unsigned char, WS_WOUT), 0, D, D, 1, scr, gw, NGW, lane, RmId());
    transpose_set<false>(F.in[20], 0, WSP(unsigned char, WS_WPG), 0, D, D, 1, scr, gw, NGW, lane, RmId());
    transpose_set_w(F.in[15], (size_t)1024 * 2048, WSP(unsigned char, WS_W1), (size_t)2048 * 1024, 1024, 2048, NE, scr, gw, NGW, lane, RmW1());
    transpose_set_w(F.in[17], (size_t)1024 * 1024, WSP(unsigned char, WS_W2), (size_t)1024 * 1024, 1024, 1024, NE, scr, gw, NGW, lane, RmId());
    for (int id = F.vcu * NWAVES * 64 + F.tid; id < 32 * 2 * 64; id += F.G * NWAVES * 64) { const int ln = id & 63, nt = (id >> 6) & 1, ks = id >> 7, n = ln & 15, kq = ln >> 4;
        float hi[8], lo[8];
#pragma unroll
        for (int j = 0; j < 8; ++j) { const int d = 32 * ks + 8 * kq + j; const float v = F.in[12][d] * F.in[13][(size_t)d * 32 + 16 * nt + n]; hi[j] = bf2f(f2bf1(v)); lo[j] = v - hi[j]; }
        v4u oh, ol;
#pragma unroll
        for (int j = 0; j < 4; ++j) { oh[j] = cvtpk(hi[2 * j], hi[2 * j + 1]); ol[j] = cvtpk(lo[2 * j], lo[2 * j + 1]); }
        GAS v4u* W = (GAS v4u*)WSP(bf16, WS_WRF) + (size_t)((ks * 2 + nt) * 2) * 64 + ln; W[0] = oh; W[64] = ol; }
    for (int m0 = gw; m0 < T; m0 += 4 * NGW) {
        f32x4 v[4][4];
#pragma unroll
        for (int q = 0; q < 4; ++q) { const int m = m0 + q * NGW; const GAS f32x4* xr = (const GAS f32x4*)(F.in[0] + (size_t)(m < T ? m : 0) * D) + lane;
#pragma unroll
            for (int j = 0; j < 4; ++j) v[q][j] = __builtin_nontemporal_load(xr + 64 * j); }
#pragma unroll
        for (int q = 0; q < 4; ++q) { const int m = m0 + q * NGW; if (m >= T) break;
            float s2 = 0.f;
#pragma unroll
            for (int j = 0; j < 4; ++j) s2 += (v[q][j].x * v[q][j].x + v[q][j].y * v[q][j].y) + (v[q][j].z * v[q][j].z + v[q][j].w * v[q][j].w);
            const float rstd = 1.f / sqrtf(wave_sum(s2) * (1.f / D) + EPS);
            const GAS f32x4* gr = (const GAS f32x4*)F.in[2] + lane; GAS u32x2* o8 = (GAS u32x2*)(WSP(bf16, WS_XN) + (size_t)m * D) + lane;
#pragma unroll
            for (int j = 0; j < 4; ++j) { const f32x4 gg = gr[64 * j]; u32x2 w; w.x = cvtpk(v[q][j].x * rstd * gg.x, v[q][j].y * rstd * gg.y); w.y = cvtpk(v[q][j].z * rstd * gg.z, v[q][j].w * rstd * gg.w); o8[64 * j] = w; } }
    }
    for (int m0 = gw; m0 < T; m0 += 8 * NGW) {
        f32x4 v[8];
#pragma unroll
        for (int q = 0; q < 8; ++q) { const int m = m0 + q * NGW; v[q] = __builtin_nontemporal_load((const GAS f32x4*)(F.in[1] + (size_t)(m < T ? m : 0) * PLE) + lane); }
#pragma unroll
        for (int q = 0; q < 8; ++q) { const int m = m0 + q * NGW; if (m >= T) break; u32x2 w; w.x = cvtpk(v[q].x, v[q].y); w.y = cvtpk(v[q].z, v[q].w); *((GAS u32x2*)(WSP(bf16, WS_PB) + (size_t)m * PLE) + lane) = w; }
    }
}

constexpr int GL_B = 0, GL_GLR = 16640, GL_T1 = 20992, GL_T2 = 30208, GL_T3 = 39424, GL_VT = 48640;
__device__ __forceinline__ void gla_b(Frame& F, int n, int h) {
    LAS float* bL = (LAS float*)(F.lds + GL_B); LAS float* glrL = (LAS float*)(F.lds + GL_GLR);
    const bf16* PROJ = WSP(bf16, WS_PROJ); const int tid = F.tid, t0 = n * 64;
    { const int idx = tid * 2, t = idx >> 4, r = idx & 15; const unsigned w = *(const GAS unsigned*)(PROJ + (size_t)(t0 + t) * LDP + C_GLR + r); glrL[t * 17 + r] = bflo(w); glrL[t * 17 + r + 1] = bfhi(w); }
    const int d = tid & 63, tg = tid >> 6;
    float wg[16];
#pragma unroll
    for (int r = 0; r < 16; ++r) wg[r] = F.in[4][r * 256 + h * 64 + d];
    const float bias = F.in[5][h * 64 + d];
    lds_barrier();
#pragma unroll
    for (int tt = 0; tt < 8; ++tt) { const int t = tg * 8 + tt; float a = bias;
#pragma unroll
        for (int r = 0; r < 16; ++r) a += glrL[t * 17 + r] * wg[r];
        bL[t * 65 + d] = logsigf_(a) * 0.0625f; }
    lds_barrier();
    if (tid < 64) { float run = 0.f;
#pragma unroll 16
        for (int t = 0; t < 64; ++t) { run += bL[t * 65 + tid]; bL[t * 65 + tid] = run; } }
    lds_barrier();
}
__device__ __forceinline__ void gla_load_vT(Frame& F, int n, int h) {
    LAS bf16* vT = (LAS bf16*)(F.lds + GL_VT); const bf16* PROJ = WSP(bf16, WS_PROJ);
    const int t = F.tid >> 3, eg = F.tid & 7;
    const GAS v4u* src = (const GAS v4u*)(PROJ + (size_t)(n * 64 + t) * LDP + C_GV + h * 128 + eg * 16);
#pragma unroll
    for (int half = 0; half < 2; ++half) { const v4u w = src[half];
#pragma unroll
        for (int i = 0; i < 4; ++i) { const int e = eg * 16 + half * 8 + 2 * i; vT[e * 72 + t] = (bf16)(w[i] & 0xffffu); vT[(e + 1) * 72 + t] = (bf16)(w[i] >> 16); } }
}

__device__ __forceinline__ void gla_prep_item(Frame& F, int n, int h) {
    gla_b(F, n, h);
    LAS float* bL = (LAS float*)(F.lds + GL_B); LAS bf16* T1 = (LAS bf16*)(F.lds + GL_T1); LAS bf16* T2 = (LAS bf16*)(F.lds + GL_T2); LAS bf16* T3 = (LAS bf16*)(F.lds + GL_T3); LAS bf16* vT = (LAS bf16*)(F.lds + GL_VT);
    const bf16* PROJ = WSP(bf16, WS_PROJ); const int tid = F.tid, lane = F.lane, w = F.wave;
    const size_t nh = (size_t)(n * 4 + h);
    { const int t = tid >> 3, dg = tid & 7;
        const v4u qw = *(const GAS v4u*)(PROJ + (size_t)(n * 64 + t) * LDP + C_GQ + h * 64 + dg * 8); const v4u kw = *(const GAS v4u*)(PROJ + (size_t)(n * 64 + t) * LDP + C_GK + h * 64 + dg * 8);
        v4u qo, ko;
#pragma unroll
        for (int i = 0; i < 4; ++i) { const int d0 = dg * 8 + 2 * i; const float b0 = bL[t * 65 + d0], b1 = bL[t * 65 + d0 + 1], l0 = bL[63 * 65 + d0], l1 = bL[63 * 65 + d0 + 1];
            qo[i] = cvtpk(bflo(qw[i]) * 0.125f * __expf(b0), bfhi(qw[i]) * 0.125f * __expf(b1));
            ko[i] = cvtpk(bflo(kw[i]) * __expf(-b0), bfhi(kw[i]) * __expf(-b1));
            T3[d0 * 72 + t] = f2bf1(bflo(kw[i]) * __expf(l0 - b0)); T3[(d0 + 1) * 72 + t] = f2bf1(bfhi(kw[i]) * __expf(l1 - b1)); }
        *(LAS v4u*)(T1 + t * 72 + dg * 8) = qo; *(LAS v4u*)(T2 + t * 72 + dg * 8) = ko;
        *(GAS v4u*)(WSP(bf16, WS_QT) + (nh * 64 + t) * 64 + dg * 8) = qo; }
    gla_load_vT(F, n, h);
    lds_barrier();
    const int c = lane & 15, kq = lane >> 4;
    {
        bf16x8 a[2];
#pragma unroll
        for (int ks = 0; ks < 2; ++ks) a[ks] = *(const LAS bf16x8*)(vT + (16 * w + c) * 72 + 32 * ks + 8 * kq);
        float* KVT = WSP(float, WS_KVT) + nh * 128 * 64;
#pragma unroll
        for (int dt = 0; dt < 4; ++dt) { f32x4 acc = {0.f, 0.f, 0.f, 0.f};
#pragma unroll
            for (int ks = 0; ks < 2; ++ks) { const bf16x8 b = *(const LAS bf16x8*)(T3 + (16 * dt + c) * 72 + 32 * ks + 8 * kq); acc = MFMA16(a[ks], b, acc); }
#pragma unroll
            for (int r = 0; r < 4; ++r) KVT[(16 * w + 4 * kq + r) * 64 + 16 * dt + c] = acc[r]; }
        if (tid < 64) WSP(float, WS_DVEC)[nh * 64 + tid] = __expf(bL[63 * 65 + tid]);
    }
    {
        const int it = w & 3, eh = w >> 2;
        bf16x8 bq[2];
#pragma unroll
        for (int ks = 0; ks < 2; ++ks) bq[ks] = *(const LAS bf16x8*)(T1 + (16 * it + c) * 72 + 32 * ks + 8 * kq);
        f32x4 at[4];
#pragma unroll
        for (int jt = 0; jt < 4; ++jt) { f32x4 acc = {0.f, 0.f, 0.f, 0.f};
            if (jt <= it) {
#pragma unroll
                for (int ks = 0; ks < 2; ++ks) { const bf16x8 a = *(const LAS bf16x8*)(T2 + (16 * jt + c) * 72 + 32 * ks + 8 * kq); acc = MFMA16(a, bq[ks], acc); }
                if (jt == it) {
#pragma unroll
                    for (int r = 0; r < 4; ++r) if (4 * kq + r > c) acc[r] = 0.f; }
            }
            at[jt] = acc; }
        bf16x8 pb[2]; pb[0] = pack8(at[0], at[1]); pb[1] = pack8(at[2], at[3]);
        u32x2* OI = (u32x2*)WSP(bf16, WS_OI) + nh * 32 * 64;
#pragma unroll
        for (int q = 0; q < 4; ++q) { const int et = 4 * eh + q; f32x4 acc = {0.f, 0.f, 0.f, 0.f};
#pragma unroll
            for (int s2 = 0; s2 < 2; ++s2) { const bf16x4 lo = *(const LAS bf16x4*)(vT + (16 * et + c) * 72 + 32 * s2 + 4 * kq), hi = *(const LAS bf16x4*)(vT + (16 * et + c) * 72 + 32 * s2 + 16 + 4 * kq);
                acc = MFMA16(cat8(lo, hi), pb[s2], acc); }
            *(GAS u32x2*)(OI + (et * 4 + it) * 64 + lane) = pack4(acc); }
    }
    lds_barrier();
}

__device__ __forceinline__ void mix_epilogue_w(Frame& F, const f32x4 (&o)[8], int n, int it, const float* gain, int gate_col, int mix_col) {
    const int lane = F.lane, c = lane & 15, kq = lane >> 4;
    float ss = 0.f;
#pragma unroll
    for (int q = 0; q < 8; ++q)
#pragma unroll
        for (int r = 0; r < 4; ++r) ss += o[q][r] * o[q][r];
    ss += __shfl_xor(ss, 16); ss += __shfl_xor(ss, 32);
    const float rstd = 1.f / sqrtf(ss * (1.f / 128.f) + EPS);
    const int t = n * 64 + 16 * it + c;
    const bf16* PROJ = WSP(bf16, WS_PROJ); bf16* MIX = WSP(bf16, WS_MIX);
    u32x2 gw[8];
#pragma unroll
    for (int q = 0; q < 8; ++q) gw[q] = *(const GAS u32x2*)(PROJ + (size_t)t * LDP + gate_col + 16 * q + 4 * kq);
#pragma unroll
    for (int q = 0; q < 8; ++q) { const int e = 16 * q + 4 * kq; const f32x4 gn = *(const GAS f32x4*)(gain + e);
        f32x4 v; v[0] = o[q][0] * rstd * gn[0] * siluf_(bflo(gw[q].x)); v[1] = o[q][1] * rstd * gn[1] * siluf_(bfhi(gw[q].x)); v[2] = o[q][2] * rstd * gn[2] * siluf_(bflo(gw[q].y)); v[3] = o[q][3] * rstd * gn[3] * siluf_(bfhi(gw[q].y));
        *(GAS u32x2*)(MIX + (size_t)t * D + mix_col + e) = pack4(v); }
}
__device__ __forceinline__ void gla_out_wave(Frame& F, int n, int h, int it) {
    const int lane = F.lane, c = lane & 15, kq = lane >> 4; const size_t nh = (size_t)(n * 4 + h);
    const bf16* QT = WSP(bf16, WS_QT) + (nh * 64 + 16 * it + c) * 64; const bf16* ST = WSP(bf16, WS_SGLA) + nh * 128 * 64; const u32x2* OI = (const u32x2*)WSP(bf16, WS_OI) + nh * 32 * 64;
    bf16x8 bq[2], as[8][2]; u32x2 oi[8];
#pragma unroll
    for (int ks = 0; ks < 2; ++ks) bq[ks] = *(const GAS bf16x8*)(QT + 32 * ks + 8 * kq);
#pragma unroll
    for (int q = 0; q < 8; ++q) { oi[q] = *(const GAS u32x2*)(OI + (q * 4 + it) * 64 + lane);
#pragma unroll
        for (int ks = 0; ks < 2; ++ks) as[q][ks] = *(const GAS bf16x8*)(ST + (16 * q + c) * 64 + 32 * ks + 8 * kq); }
    __builtin_amdgcn_sched_barrier(0);
    f32x4 o[8];
#pragma unroll
    for (int q = 0; q < 8; ++q) { f32x4 acc = {bflo(oi[q].x), bfhi(oi[q].x), bflo(oi[q].y), bfhi(oi[q].y)};
#pragma unroll
        for (int ks = 0; ks < 2; ++ks) acc = MFMA16(as[q][ks], bq[ks], acc);
        o[q] = acc; }
    mix_epilogue_w(F, o, n, it, F.in[6], C_GR + h * 128, h * 128);
}
__device__ __forceinline__ void gdn_out_wave(Frame& F, int n, int h, int it) {
    const int lane = F.lane, c = lane & 15, kq = lane >> 4; const size_t nh = (size_t)(n * 4 + h);
    const bf16* QD = WSP(bf16, WS_QDEC) + (nh * 64 + 16 * it + c) * 128; const bf16* AQ = WSP(bf16, WS_AQK) + (nh * 64 + 16 * it + c) * 64;
    const bf16* ST = WSP(bf16, WS_SGDN) + nh * 128 * 128; const bf16* DT = WSP(bf16, WS_DELTA) + nh * 128 * 64;
    bf16x8 bqd[4], baq[2];
#pragma unroll
    for (int ks = 0; ks < 4; ++ks) bqd[ks] = *(const GAS bf16x8*)(QD + 32 * ks + 8 * kq);
#pragma unroll
    for (int s2 = 0; s2 < 2; ++s2) baq[s2] = *(const GAS bf16x8*)(AQ + 32 * s2 + 8 * kq);
    f32x4 o[8];
#pragma unroll
    for (int hf = 0; hf < 2; ++hf) {
        bf16x8 as[4][4], ad[4][2];
#pragma unroll
        for (int q = 0; q < 4; ++q) { const int et = 4 * hf + q;
#pragma unroll
            for (int ks = 0; ks < 4; ++ks) as[q][ks] = *(const GAS bf16x8*)(ST + (16 * et + c) * 128 + 32 * ks + 8 * kq);
#pragma unroll
            for (int s2 = 0; s2 < 2; ++s2) ad[q][s2] = *(const GAS bf16x8*)(DT + (16 * et + c) * 64 + 32 * s2 + 8 * kq); }
        __builtin_amdgcn_sched_barrier(0);
#pragma unroll
        for (int q = 0; q < 4; ++q) { f32x4 acc = {0.f, 0.f, 0.f, 0.f};
#pragma unroll
            for (int ks = 0; ks < 4; ++ks) acc = MFMA16(as[q][ks], bqd[ks], acc);
#pragma unroll
            for (int s2 = 0; s2 < 2; ++s2) acc = MFMA16(ad[q][s2], baq[s2], acc);
            o[4 * hf + q] = acc; }
        __builtin_amdgcn_sched_barrier(0);
    }
    mix_epilogue_w(F, o, n, it, F.in[10], C_DZ + h * 128, 512 + h * 128);
}

constexpr int GD_QB = 0, GD_KB = 17408, GD_VB = 34816, GD_LS = 52224, GD_LB = 68608, GD_TB = 77824, GD_XT = 80896, GD_SC = 117760;
__device__ __forceinline__ void gdn_prep_item(Frame& F, int n, int h) {
    LAS bf16* qb = (LAS bf16*)(F.lds + GD_QB); LAS bf16* kb = (LAS bf16*)(F.lds + GD_KB); LAS bf16* vb = (LAS bf16*)(F.lds + GD_VB);
    LAS float* Ls = (LAS float*)(F.lds + GD_LS); LAS bf16* Lb = (LAS bf16*)(F.lds + GD_LB); LAS bf16* Tb = (LAS bf16*)(F.lds + GD_TB); LAS bf16* XT = (LAS bf16*)(F.lds + GD_XT);
    LAS float* bS = (LAS float*)(F.lds + GD_SC); LAS float* betaS = bS + 64; LAS float* ebS = bS + 128;
    const bf16* PROJ = WSP(bf16, WS_PROJ); const int tid = F.tid, lane = F.lane, w = F.wave, t0 = n * 64;
    const size_t nh = (size_t)(n * 4 + h);
    if (tid < 64) {
        const float da = bf2f(PROJ[(size_t)(t0 + tid) * LDP + C_DA + h]), db = bf2f(PROJ[(size_t)(t0 + tid) * LDP + C_DB + h]);
        float g = -__expf(F.in[8][h]) * softplusf_(da + F.in[9][h]);
#pragma unroll
        for (int off = 1; off < 64; off <<= 1) { const float v = __shfl_up(g, off); if (lane >= off) g += v; }
        bS[tid] = g; betaS[tid] = sigm(db); ebS[tid] = __expf(g);
    }
    if (!(MK_DBG & 2) && lane < 48) {
        const int grp = lane >> 4, c8 = (lane & 15) * 8;
        const int colP = C_DQ + grp * 512 + h * 128 + c8;
        f32x4 wc[4][2];
#pragma unroll
        for (int j = 0; j < 4; ++j) { const GAS f32x4* wp = (const GAS f32x4*)(F.in[7] + (size_t)j * 1536 + grp * 512 + h * 128 + c8); wc[j][0] = wp[0]; wc[j][1] = wp[1]; }
        v4u xin[11];
#pragma unroll
        for (int rr = 0; rr < 11; ++rr) { const int r = t0 + w * 8 - 3 + rr; xin[rr] = (v4u){0, 0, 0, 0}; if (r >= 0) xin[rr] = *(const GAS v4u*)(PROJ + (size_t)r * LDP + colP); }
#pragma unroll
        for (int tt = 0; tt < 8; ++tt) {
            float y[8];
#pragma unroll
            for (int i = 0; i < 8; ++i) y[i] = 0.f;
#pragma unroll
            for (int j = 0; j < 4; ++j)
#pragma unroll
                for (int i = 0; i < 4; ++i) { const unsigned xw = xin[tt + j][i]; y[2 * i] += wc[j][i >> 1][(2 * i) & 3] * bflo(xw); y[2 * i + 1] += wc[j][i >> 1][(2 * i + 1) & 3] * bfhi(xw); }
            float ss = 0.f;
#pragma unroll
            for (int i = 0; i < 8; ++i) { y[i] = siluf_(y[i]); ss += y[i] * y[i]; }
            ss += __shfl_xor(ss, 1); ss += __shfl_xor(ss, 2); ss += __shfl_xor(ss, 4); ss += __shfl_xor(ss, 8);
            const int row = w * 8 + tt;
            const float sc = grp == 2 ? 1.0f : (1.f / sqrtf(ss + EPS)) * (grp == 0 ? 0.08838834764831845f : 1.0f);
            v4u o; o.x = cvtpk(y[0] * sc, y[1] * sc); o.y = cvtpk(y[2] * sc, y[3] * sc); o.z = cvtpk(y[4] * sc, y[5] * sc); o.w = cvtpk(y[6] * sc, y[7] * sc);
            *(LAS v4u*)((grp == 0 ? qb : (grp == 1 ? kb : vb)) + row * 136 + c8) = o;
        }
    }
    lds_barrier();
    if (!(MK_DBG & 4)) {
        const int c = lane & 15, kq = lane >> 4;
        bf16* AQ = WSP(bf16, WS_AQK) + nh * 64 * 64;
        for (int job = w; job < 20; job += 8) {
            const int kind = job >= 10 ? 1 : 0, idx = job - 10 * kind;
            const int it = idx >= 6 ? 3 : (idx >= 3 ? 2 : (idx >= 1 ? 1 : 0)), jt = idx - (it * (it + 1)) / 2;
            const LAS bf16* Am = kind ? qb : kb;
            f32x4 acc = {0.f, 0.f, 0.f, 0.f};
#pragma unroll
            for (int ks = 0; ks < 4; ++ks) { const bf16x8 a = *(const LAS bf16x8*)(Am + (16 * it + c) * 136 + 32 * ks + 8 * kq), b = *(const LAS bf16x8*)(kb + (16 * jt + c) * 136 + 32 * ks + 8 * kq); acc = MFMA16(a, b, acc); }
            const int j = 16 * jt + c; const float bj = bS[j];
#pragma unroll
            for (int r = 0; r < 4; ++r) { const int i = 16 * it + 4 * kq + r; const float dec = __expf(fminf(bS[i] - bj, 0.f));
                if (kind == 0) Ls[i * 64 + j] = (j < i) ? betaS[i] * dec * acc[r] : 0.f;
                else { AQ[i * 64 + j] = (j <= i) ? f2bf1(dec * acc[r]) : (bf16)0; if (jt < it) AQ[(16 * jt + 4 * kq + r) * 64 + 16 * it + c] = (bf16)0; } }
        }
    }
    lds_barrier();
    { const int i = tid >> 3, c0 = (tid & 7) * 8; v4u o;
#pragma unroll
      for (int x = 0; x < 4; ++x) { const int col = c0 + 2 * x; const bool up = (col >> 4) > (i >> 4); o[x] = up ? 0u : cvtpk(-Ls[i * 64 + col], -Ls[i * 64 + col + 1]); }
      *(LAS v4u*)(Lb + i * 72 + c0) = o;
      for (int x = tid; x < 256 * 72 / 8; x += 512) *(LAS v4u*)(XT + x * 8) = (v4u){0u, 0u, 0u, 0u}; }
    if ((MK_DBG & 8) && tid < 64) {} else if (tid < 64) { const int b = tid >> 4, cc = tid & 15; float x[16];
#pragma unroll
        for (int i = 0; i < 16; ++i) { float a = (i == cc) ? 1.f : 0.f;
#pragma unroll
            for (int j = 0; j < i; ++j) a -= Ls[(16 * b + i) * 64 + 16 * b + j] * x[j];
            x[i] = a; Tb[(16 * b + i) * 24 + cc] = f2bf1(a); }
    } else if (!(MK_DBG & 16) && tid >= 256) {
        const int tt = tid - 256; const float bl = bS[63];
        bf16* QD = WSP(bf16, WS_QDEC) + nh * 64 * 128;
#pragma unroll 1
        for (int j = 0; j < 4; ++j) { const int id = tt + 256 * j, i = id >> 4, c8 = (id & 15) * 8; const v4u qw = *(const LAS v4u*)(qb + i * 136 + c8); const float e = ebS[i];
            v4u o; o.x = cvtpk(bflo(qw.x) * e, bfhi(qw.x) * e); o.y = cvtpk(bflo(qw.y) * e, bfhi(qw.y) * e); o.z = cvtpk(bflo(qw.z) * e, bfhi(qw.z) * e); o.w = cvtpk(bflo(qw.w) * e, bfhi(qw.w) * e);
            *(GAS v4u*)(QD + i * 128 + c8) = o; }
        bf16* KDF = WSP(bf16, WS_KDF) + nh * 16 * 512;
#pragma unroll 1
        for (int j = 0; j < 4; ++j) { const int id = tt + 256 * j, f = id >> 6, ln = id & 63, dt = f >> 1, ks2 = f & 1, q = ln >> 4, m = ln & 15, d = 16 * dt + m;
            float v[8];
#pragma unroll
            for (int x = 0; x < 8; ++x) { const int i = 32 * ks2 + (x < 4 ? 4 * q + x : 16 + 4 * q + (x - 4)); v[x] = bf2f(kb[i * 136 + d]) * __expf(bl - bS[i]); }
            v4u o; o.x = cvtpk(v[0], v[1]); o.y = cvtpk(v[2], v[3]); o.z = cvtpk(v[4], v[5]); o.w = cvtpk(v[6], v[7]);
            *(GAS v4u*)(KDF + ((size_t)f * 64 + ln) * 8) = o; }
        if (tt == 0) WSP(float, WS_CDEC)[nh] = __expf(bl);
    }
    lds_barrier();
    if (!(MK_DBG & 32)) { const int c = lane & 15, kq = lane >> 4;
      f32x4* UFp = (f32x4*)WSP(float, WS_UF) + nh * 8 * 4 * 64;
      const f32x4 z4 = {0.f, 0.f, 0.f, 0.f};
#pragma unroll
      for (int b = 0; b < 4; ++b) {
          const bf16x4 tlo = *(const LAS bf16x4*)(Tb + (16 * b + c) * 24 + 4 * kq); const bf16x8 ta = cat8(tlo, (bf16x4){0, 0, 0, 0});
#pragma unroll
          for (int t2 = 0; t2 < 2; ++t2) { const int ct = 2 * w + t2, col = 16 * ct + c; const bool isu = ct < 8;
              f32x4 acc;
#pragma unroll
              for (int r = 0; r < 4; ++r) { const int i = 16 * b + 4 * kq + r; acc[r] = isu ? betaS[i] * bf2f(vb[i * 136 + (col & 127)]) : betaS[i] * ebS[i] * bf2f(kb[i * 136 + (col & 127)]); }
#pragma unroll
              for (int ks = 0; ks < (b + 1) / 2; ++ks) acc = MFMA16(*(const LAS bf16x8*)(Lb + (16 * b + c) * 72 + 32 * ks + 8 * kq), *(const LAS bf16x8*)(XT + col * 72 + 32 * ks + 8 * kq), acc);
              const f32x4 x = MFMA16(ta, pack8(acc, z4), z4);
              *(LAS u32x2*)(XT + col * 72 + 16 * b + 4 * kq) = pack4(x);
              if (isu) UFp[(ct * 4 + b) * 64 + lane] = x;
          }
      }
    }
    lds_barrier();
    { bf16* WF = WSP(bf16, WS_WF) + nh * 16 * 512;
#pragma unroll
      for (int j = 0; j < 2; ++j) { const int id = tid + 512 * j, f = id >> 6, ln = id & 63, mt = f >> 2, ks = f & 3, q = ln >> 4, m = ln & 15, i = 16 * mt + m;
          unsigned wv[4];
#pragma unroll
          for (int x = 0; x < 4; ++x) { const int d0 = 32 * ks + (x < 2 ? 4 * q + 2 * x : 16 + 4 * q + 2 * (x - 2));
              const unsigned lo = XT[(128 + d0) * 72 + i], hi = XT[(128 + d0 + 1) * 72 + i]; wv[x] = (lo | (hi << 16)) ^ 0x80008000u; }
          *(GAS v4u*)(WF + ((size_t)f * 64 + ln) * 8) = (v4u){wv[0], wv[1], wv[2], wv[3]}; } }
}

template <int MODE>
__device__ __forceinline__ void gdn_group_scan(Frame& F, int grp, int h) {
    const int tid = F.tid, lane = F.lane, w = F.wave, c = lane & 15, kq = lane >> 4, n0 = grp * GRP;
    const v4u* WF = (const v4u*)WSP(bf16, WS_WF); const v4u* KDF = (const v4u*)WSP(bf16, WS_KDF); const f32x4* UF = (const f32x4*)WSP(float, WS_UF);
    const float* CDEC = WSP(float, WS_CDEC); bf16* SG = WSP(bf16, WS_SGDN); bf16* DL = WSP(bf16, WS_DELTA);
    {   v4u t[GRP][4];
#pragma unroll
        for (int i = 0; i < GRP; ++i) { const size_t nh = (size_t)((n0 + i) * 4 + h);
#pragma unroll
            for (int j = 0; j < 2; ++j) { t[i][j] = WF[nh * 1024 + tid + 512 * j]; t[i][2 + j] = KDF[nh * 1024 + tid + 512 * j]; } }
#pragma unroll
        for (int i = 0; i < GRP; ++i)
#pragma unroll
            for (int j = 0; j < 2; ++j) { *(LAS v4u*)(F.lds + i * 32768 + (tid + 512 * j) * 16) = t[i][j]; *(LAS v4u*)(F.lds + i * 32768 + 16384 + (tid + 512 * j) * 16) = t[i][2 + j]; } }
    f32x4 S[8], P[8];
    if (MODE == 1) { const f32x4* SST = (const f32x4*)WSP(float, WS_SST) + (size_t)(((grp * 4 + h) * 8 + w) * 8) * 64;
#pragma unroll
        for (int i = 0; i < 8; ++i) S[i] = SST[i * 64 + lane];
    } else {
#pragma unroll
        for (int i = 0; i < 8; ++i) { S[i] = (f32x4){0.f, 0.f, 0.f, 0.f};
#pragma unroll
            for (int r = 0; r < 4; ++r) P[i][r] = ((16 * i + 4 * kq + r) == 16 * w + c) ? 1.f : 0.f; }
    }
    f32x4 u[GRP][4]; float cd[GRP];
#pragma unroll
    for (int i = 0; i < GRP; ++i) { const size_t nh = (size_t)((n0 + i) * 4 + h); cd[i] = CDEC[nh];
#pragma unroll
        for (int mt = 0; mt < 4; ++mt) u[i][mt] = UF[((nh * 8 + w) * 4 + mt) * 64 + lane]; }
    lds_barrier();
#pragma unroll
    for (int i = 0; i < GRP; ++i) {
        const size_t nh = (size_t)((n0 + i) * 4 + h);
        const LAS unsigned char* wl = F.lds + i * 32768 + lane * 16; const LAS unsigned char* kl = wl + 16384;
        if (MODE == 1) { bf16* sg = SG + (nh * 128 + 16 * w + c) * 128 + 4 * kq;
#pragma unroll
            for (int dt = 0; dt < 8; ++dt) *(GAS u32x2*)(sg + 16 * dt) = pack4(S[dt]); }
        f32x4 dl[4], dp[4];
#pragma unroll
        for (int mt = 0; mt < 4; ++mt) { dl[mt] = u[i][mt]; dp[mt] = (f32x4){0.f, 0.f, 0.f, 0.f}; }
#pragma unroll
        for (int ks = 0; ks < 4; ++ks) { const bf16x8 sb = pack8(S[2 * ks], S[2 * ks + 1]); bf16x8 pb; if (MODE == 0) pb = pack8(P[2 * ks], P[2 * ks + 1]);
#pragma unroll
            for (int mt = 0; mt < 4; ++mt) { const bf16x8 a = *(const LAS bf16x8*)(wl + (mt * 4 + ks) * 1024); dl[mt] = MFMA16(a, sb, dl[mt]); if (MODE == 0) dp[mt] = MFMA16(a, pb, dp[mt]); } }
        if (MODE == 1) { bf16* dq = DL + (nh * 128 + 16 * w + c) * 64 + 4 * kq;
#pragma unroll
            for (int mt = 0; mt < 4; ++mt) *(GAS u32x2*)(dq + 16 * mt) = pack4(dl[mt]); }
#pragma unroll
        for (int dt = 0; dt < 8; ++dt) { S[dt] = S[dt] * cd[i]; if (MODE == 0) P[dt] = P[dt] * cd[i]; }
#pragma unroll
        for (int ks2 = 0; ks2 < 2; ++ks2) { const bf16x8 db = pack8(dl[2 * ks2], dl[2 * ks2 + 1]); bf16x8 qb; if (MODE == 0) qb = pack8(dp[2 * ks2], dp[2 * ks2 + 1]);
#pragma unroll
            for (int dt = 0; dt < 8; ++dt) { const bf16x8 a = *(const LAS bf16x8*)(kl + (dt * 2 + ks2) * 1024); S[dt] = MFMA16(a, db, S[dt]); if (MODE == 0) P[dt] = MFMA16(a, qb, P[dt]); } }
    }
    if (MODE == 0) {
        f32x4* SLE = (f32x4*)WSP(float, WS_SLE) + (size_t)(((grp * 4 + h) * 8 + w) * 8) * 64;
#pragma unroll
        for (int dt = 0; dt < 8; ++dt) SLE[dt * 64 + lane] = S[dt];
        bf16* PE = WSP(bf16, WS_PEND) + (size_t)(grp * 4 + h) * 32 * 512; const int ks = w >> 1, lq = (2 * (w & 1) + (c >> 3)) * 16 + 4 * kq, idx = c & 7;
#pragma unroll
        for (int dt = 0; dt < 8; ++dt)
#pragma unroll
            for (int r = 0; r < 4; ++r) PE[((size_t)(dt * 4 + ks) * 64 + lq + r) * 8 + idx] = f2bf1(P[dt][r]);
    }
    lds_barrier();
}
__device__ __forceinline__ void gdn_scan_groups(Frame& F, int h, int s) {
    const int lane = F.lane, w = F.wave, c = lane & 15, kq = lane >> 4;
    LAS bf16* STb = (LAS bf16*)F.lds;
    const bf16x8* PEND = (const bf16x8*)WSP(bf16, WS_PEND); const f32x4* SLE = (const f32x4*)WSP(float, WS_SLE); f32x4* SST = (f32x4*)WSP(float, WS_SST);
    f32x4 S = {0.f, 0.f, 0.f, 0.f};
    *(LAS u32x2*)(STb + c * 136 + 16 * w + 4 * kq) = (u32x2){0u, 0u};
    bf16x8 pe[4], pn[4]; f32x4 sle, sln;
#pragma unroll
    for (int ks = 0; ks < 4; ++ks) pe[ks] = PEND[((size_t)h * 32 + w * 4 + ks) * 64 + lane];
    sle = SLE[(((size_t)h * 8 + s) * 8 + w) * 64 + lane];
    lds_barrier();
    for (int g = 0; g < NGRP; ++g) {
        const size_t gh = (size_t)(g * 4 + h);
        SST[((gh * 8 + s) * 8 + w) * 64 + lane] = S;
        if (g + 1 == NGRP) break;
        { const size_t gh1 = (size_t)((g + 1) * 4 + h);
#pragma unroll
          for (int ks = 0; ks < 4; ++ks) pn[ks] = PEND[(gh1 * 32 + w * 4 + ks) * 64 + lane];
          sln = SLE[((gh1 * 8 + s) * 8 + w) * 64 + lane]; }
        const LAS bf16* st = STb + (g & 1) * 16 * 136 + c * 136 + 8 * kq;
        f32x4 acc = sle;
#pragma unroll
        for (int ks = 0; ks < 4; ++ks) acc = MFMA16(pe[ks], *(const LAS bf16x8*)(st + 32 * ks), acc);
        S = acc;
        *(LAS u32x2*)(STb + ((g + 1) & 1) * 16 * 136 + c * 136 + 16 * w + 4 * kq) = pack4(S);
#pragma unroll
        for (int ks = 0; ks < 4; ++ks) pe[ks] = pn[ks];
        sle = sln;
        lds_barrier();
    }
    lds_barrier();
}
template <int MODE>
__device__ __forceinline__ void gla_scan_range(Frame& F, int grp, int gid) {
    const int h = gid >> 11, rem = gid & 2047, e = rem >> 4, dg = rem & 15, n0 = grp * GRP;
    const float* KVT = WSP(float, WS_KVT); const float* DV = WSP(float, WS_DVEC); bf16* SG = WSP(bf16, WS_SGLA);
    f32x4 kv[GRP], dv[GRP];
#pragma unroll
    for (int i = 0; i < GRP; ++i) { const size_t nh = (size_t)((n0 + i) * 4 + h); kv[i] = *(const GAS f32x4*)(KVT + (nh * 128 + e) * 64 + 4 * dg); dv[i] = *(const GAS f32x4*)(DV + nh * 64 + 4 * dg); }
    f32x4 S = {0.f, 0.f, 0.f, 0.f}, P = {1.f, 1.f, 1.f, 1.f};
    if (MODE == 1) S = *((const GAS f32x4*)WSP(float, WS_GSST) + (size_t)grp * 8192 + gid);
#pragma unroll
    for (int i = 0; i < GRP; ++i) { const size_t nh = (size_t)((n0 + i) * 4 + h);
        if (MODE == 1) *(GAS u32x2*)(SG + (nh * 128 + e) * 64 + 4 * dg) = pack4(S);
        S = dv[i] * S + kv[i]; if (MODE == 0) P = P * dv[i]; }
    if (MODE == 0) { *((GAS f32x4*)WSP(float, WS_GSLE) + (size_t)grp * 8192 + gid) = S; *((GAS f32x4*)WSP(float, WS_GPD) + (size_t)grp * 8192 + gid) = P; }
}
__device__ __forceinline__ void gla_scan_groups(Frame& F, int gid) {
    f32x4 S = {0.f, 0.f, 0.f, 0.f};
    for (int g0 = 0; g0 < NGRP; g0 += 16) {
        f32x4 sl[16], pd[16];
#pragma unroll
        for (int g = 0; g < 16; ++g) { sl[g] = *((const GAS f32x4*)WSP(float, WS_GSLE) + (size_t)(g0 + g) * 8192 + gid); pd[g] = *((const GAS f32x4*)WSP(float, WS_GPD) + (size_t)(g0 + g) * 8192 + gid); }
#pragma unroll
        for (int g = 0; g < 16; ++g) { *((GAS f32x4*)WSP(float, WS_GSST) + (size_t)(g0 + g) * 8192 + gid) = S; S = pd[g] * S + sl[g]; }
    }
}

__device__ __forceinline__ void route_phase(Frame& F, int rep) {
    const int tid = F.tid, lane = F.lane, w = F.wave, c = lane & 15, kq = lane >> 4, tile = w & 3, kh = w >> 2;
    unsigned* cnt = (unsigned*)(F.ctl + CW_CNT) + rep * 32;
    LAS int* lcnt = (LAS int*)(F.lds + ROUTE_OFF); LAS int* gbase = lcnt + 32; LAS int* te = lcnt + 64; LAS int* ts = te + 256; LAS float* tg = (LAS float*)(ts + 256);
    LAS float* part = (LAS float*)(F.lds + RING_OFF);
    const size_t roff = (size_t)rep * (WS_PROJ - WS_TOKE), xoff = (size_t)rep * (WS_PROJ + 8 * MiB - WS_XN), soff = (size_t)rep * (WS_PROJ + 40 * MiB - WS_RSTD);
    const v4u* WRF = (const v4u*)WSP(bf16, WS_WRF);
    for (int blk = F.vcu; blk < T / 64; blk += F.G) {
        if (tid < 32) lcnt[tid] = 0;
        const int t = blk * 64 + tile * 16 + c;
        const GAS f32x4* xr = (const GAS f32x4*)(F.out + (size_t)t * D) + 2 * kq; const GAS f32x4* gr = (const GAS f32x4*)F.in[12] + 2 * kq;
        GAS u32x2* xq = (GAS u32x2*)(WSP(unsigned char, WS_XN + xoff) + (size_t)t * D) + kq;
        f32x4 acc0 = {0.f, 0.f, 0.f, 0.f}, acc1 = {0.f, 0.f, 0.f, 0.f}; float ss = 0.f;
#pragma unroll 4
        for (int ks = kh * 16; ks < kh * 16 + 16; ++ks) {
            const f32x4 x0 = xr[8 * ks], x1 = xr[8 * ks + 1], g0 = gr[8 * ks], g1 = gr[8 * ks + 1];
            const v4u bh0 = WRF[(size_t)((ks * 2 + 0) * 2 + 0) * 64 + lane], bl0 = WRF[(size_t)((ks * 2 + 0) * 2 + 1) * 64 + lane], bh1 = WRF[(size_t)((ks * 2 + 1) * 2 + 0) * 64 + lane], bl1 = WRF[(size_t)((ks * 2 + 1) * 2 + 1) * 64 + lane];
            ss += (x0[0] * x0[0] + x0[1] * x0[1]) + (x0[2] * x0[2] + x0[3] * x0[3]) + (x1[0] * x1[0] + x1[1] * x1[1]) + (x1[2] * x1[2] + x1[3] * x1[3]);
            v4u hi; hi[0] = cvtpk(x0[0], x0[1]); hi[1] = cvtpk(x0[2], x0[3]); hi[2] = cvtpk(x1[0], x1[1]); hi[3] = cvtpk(x1[2], x1[3]);
            v4u lo; lo[0] = cvtpk(x0[0] - bflo(hi[0]), x0[1] - bfhi(hi[0])); lo[1] = cvtpk(x0[2] - bflo(hi[1]), x0[3] - bfhi(hi[1])); lo[2] = cvtpk(x1[0] - bflo(hi[2]), x1[1] - bfhi(hi[2])); lo[3] = cvtpk(x1[2] - bflo(hi[3]), x1[3] - bfhi(hi[3]));
            u32x2 q8; q8.x = pg8::cvt4_fp8(x0[0] * g0[0], x0[1] * g0[1], x0[2] * g0[2], x0[3] * g0[3]); q8.y = pg8::cvt4_fp8(x1[0] * g1[0], x1[1] * g1[1], x1[2] * g1[2], x1[3] * g1[3]);
            xq[4 * ks] = q8;
            const bf16x8 ah = __builtin_bit_cast(bf16x8, hi), al = __builtin_bit_cast(bf16x8, lo);
            acc0 = MFMA16(ah, __builtin_bit_cast(bf16x8, bh0), acc0); acc0 = MFMA16(ah, __builtin_bit_cast(bf16x8, bl0), acc0); acc0 = MFMA16(al, __builtin_bit_cast(bf16x8, bh0), acc0);
            acc1 = MFMA16(ah, __builtin_bit_cast(bf16x8, bh1), acc1); acc1 = MFMA16(ah, __builtin_bit_cast(bf16x8, bl1), acc1); acc1 = MFMA16(al, __builtin_bit_cast(bf16x8, bh1), acc1);
        }
        ss += __shfl_xor(ss, 16); ss += __shfl_xor(ss, 32);
        if (kh == 1) { LAS float* p = part + (tile * 64 + lane) * 12; *(LAS f32x4*)p = acc0; *(LAS f32x4*)(p + 4) = acc1; p[8] = ss; }
        lds_barrier();
        if (kh == 0) {
            const LAS float* p = part + (tile * 64 + lane) * 12; acc0 = acc0 + *(const LAS f32x4*)p; acc1 = acc1 + *(const LAS f32x4*)(p + 4); ss += p[8];
            const float rstd = 1.f / sqrtf(ss * (1.f / D) + EPS);
            if (kq == 0) WSP(float, WS_RSTD + soff)[t] = rstd;
            const float b0 = F.in[14][c], b1 = F.in[14][16 + c];
#pragma unroll
            for (int r = 0; r < 4; ++r) {
                const int tr = 4 * kq + r, tl = tile * 16 + tr;
                const float rs = __shfl(rstd, tr);
                const float l0 = acc0[r] * rs + b0, l1 = acc1[r] * rs + b1;
                unsigned k0, k1; { const unsigned u0 = __float_as_uint(l0), u1 = __float_as_uint(l1);
                    k0 = (((u0 & 0x80000000u) ? ~u0 : (u0 | 0x80000000u)) & ~31u) | (unsigned)(31 - c); k1 = (((u1 & 0x80000000u) ? ~u1 : (u1 | 0x80000000u)) & ~31u) | (unsigned)(15 - c); }
                int sel[4]; float val[4];
#pragma unroll
                for (int k = 0; k < 4; ++k) { unsigned m = k0 > k1 ? k0 : k1;
#pragma unroll
                    for (int o = 1; o < 16; o <<= 1) { const unsigned other = (unsigned)__shfl_xor((int)m, o); m = other > m ? other : m; }
                    const int bi = 31 - (int)(m & 31u); sel[k] = bi;
                    const float v0 = __shfl(l0, (lane & 48) + (bi & 15)), v1 = __shfl(l1, (lane & 48) + (bi & 15)); val[k] = bi < 16 ? v0 : v1;
                    if (c == (bi & 15)) { if (bi < 16) k0 = 0u; else k1 = 0u; } }
                const float e1 = __expf(val[1] - val[0]), e2 = __expf(val[2] - val[0]), e3 = __expf(val[3] - val[0]); const float inv = 1.f / (1.f + e1 + e2 + e3);
                if (c < 4) { const int ek = c == 0 ? sel[0] : (c == 1 ? sel[1] : (c == 2 ? sel[2] : sel[3])); const float gk = (c == 0 ? 1.f : (c == 1 ? e1 : (c == 2 ? e2 : e3))) * inv;
                    const int ls = __hip_atomic_fetch_add(lcnt + ek, 1, __ATOMIC_RELAXED, __HIP_MEMORY_SCOPE_WORKGROUP);
                    te[tl * 4 + c] = ek; ts[tl * 4 + c] = ls; tg[tl * 4 + c] = gk; }
            }
        }
        lds_barrier();
        if (tid < 32) gbase[tid] = (int)atomicAdd(cnt + tid * 64, (unsigned)lcnt[tid]);
        lds_barrier();
        if (tid < 256) { const int tt = blk * 64 + (tid >> 2), k = tid & 3, e = te[tid];
            WSP(int, WS_TOKE + roff)[tt * 4 + k] = e; WSP(int, WS_TOKS + roff)[tt * 4 + k] = gbase[e] + ts[tid]; WSP(float, WS_TOKG + roff)[tt * 4 + k] = tg[tid]; }
        lds_barrier();
    }
}
__device__ __forceinline__ void moe_tables(Frame& F) {
    LAS int* tile_e = (LAS int*)(F.lds + TILEE_OFF); LAS int* baseL = (LAS int*)(F.lds + BASE_OFF);
    if (F.tid < 64) { const int e = F.lane & 31; const unsigned c = __hip_atomic_load((unsigned*)(F.ctl + CW_CNT) + e * 64, RLX_AGENT);
        const int nt = (int)((c + 255u) >> 8); int incl = nt;
#pragma unroll
        for (int off = 1; off < 32; off <<= 1) { const int v = __shfl_up(incl, off); if ((F.lane & 31) >= off) incl += v; }
        const int tb = incl - nt;
        if (F.lane < 32) { baseL[e] = tb * 256; for (int i = 0; i < nt; ++i) tile_e[tb + i] = e; if (e == 31) tile_e[319] = incl; } }
    lds_barrier();
}
__device__ __forceinline__ void scatter_phase(Frame& F) {
    moe_tables(F);
    LAS int* baseL = (LAS int*)(F.lds + BASE_OFF);
    const int gt = F.vcu * NWAVES * 64 + F.tid, NGT = F.G * NWAVES * 64;
    for (int i = gt; i < T * 4; i += NGT) { const int e = WSP(int, WS_TOKE)[i], pos = baseL[e] + WSP(int, WS_TOKS)[i];
        WSP(int, WS_TOKP)[i] = pos; WSP(float, WS_GPOS)[pos] = WSP(float, WS_TOKG)[i]; WSP(int, WS_TOKQ)[pos] = i >> 2; WSP(float, WS_RPOS)[pos] = WSP(float, WS_RSTD)[i >> 2]; }
    if (F.vcu < NE) { const int e = F.vcu; const unsigned c = __hip_atomic_load((unsigned*)(F.ctl + CW_CNT) + e * 64, RLX_AGENT); const int lo = baseL[e] + (int)c, hi = baseL[e] + (int)((c + 255u) & ~255u);
        for (int p = lo + F.tid; p < hi; p += NWAVES * 64) WSP(int, WS_TOKQ)[p] = 0; }
}
__device__ __forceinline__ void combine_phase(Frame& F, int rep) {
    const int gw = F.vcu * NWAVES + F.wave, NGW = F.G * NWAVES, lane = F.lane;
    const size_t xoff = (size_t)rep * (WS_PROJ + 64 * MiB - WS_XN), poff = (size_t)rep * (WS_PROJ + 100 * MiB - WS_PERSTD);
    for (int t0 = gw; t0 < T; t0 += 2 * NGW) {
        int pk[2][4]; f32x4 v[2][4]; u32x2 y[2][4][4], pr[2][4];
#pragma unroll
        for (int q = 0; q < 2; ++q) { const int t = (t0 + q * NGW < T) ? t0 + q * NGW : 0;
#pragma unroll
            for (int k = 0; k < 4; ++k) pk[q][k] = WSP(int, WS_TOKP)[t * 4 + k];
            const GAS f32x4* xr = (const GAS f32x4*)(F.out + (size_t)t * D) + lane; const GAS u32x2* pp = (const GAS u32x2*)(WSP(bf16, WS_PERAW) + (size_t)t * D) + lane;
#pragma unroll
            for (int j = 0; j < 4; ++j) { v[q][j] = xr[64 * j]; pr[q][j] = pp[64 * j]; } }
#pragma unroll
        for (int q = 0; q < 2; ++q)
#pragma unroll
            for (int k = 0; k < 4; ++k) { const GAS u32x2* yr = (const GAS u32x2*)(WSP(bf16, WS_YS) + (size_t)pk[q][k] * D) + lane;
#pragma unroll
                for (int j = 0; j < 4; ++j) y[q][k][j] = yr[64 * j]; }
#pragma unroll
        for (int q = 0; q < 2; ++q) { const int t = t0 + q * NGW; if (t >= T) break;
            GAS f32x4* xw = rep ? (GAS f32x4*)(WSP(float, WS_PROJ) + (size_t)t * D) + lane : (GAS f32x4*)(F.out + (size_t)t * D) + lane;
            float s = 0.f, ps = 0.f;
#pragma unroll
            for (int j = 0; j < 4; ++j) {
#pragma unroll
                for (int k = 0; k < 4; ++k) { const u32x2 w = y[q][k][j]; v[q][j].x += bflo(w.x); v[q][j].y += bfhi(w.x); v[q][j].z += bflo(w.y); v[q][j].w += bfhi(w.y); }
                xw[64 * j] = v[q][j]; s += (v[q][j].x * v[q][j].x + v[q][j].y * v[q][j].y) + (v[q][j].z * v[q][j].z + v[q][j].w * v[q][j].w);
                const u32x2 w = pr[q][j]; const float a = bflo(w.x), b = bfhi(w.x), c = bflo(w.y), d = bfhi(w.y); ps += (a * a + b * b) + (c * c + d * d); }
            const float rstd = 1.f / sqrtf(wave_sum(s) * (1.f / D) + EPS);
            const GAS f32x4* gr = (const GAS f32x4*)F.in[19] + lane; GAS u32x2* o8 = (GAS u32x2*)(WSP(bf16, WS_XN + xoff) + (size_t)t * D) + lane;
#pragma unroll
            for (int j = 0; j < 4; ++j) { const f32x4 gg = gr[64 * j]; f32x4 a = {v[q][j].x * rstd * gg.x, v[q][j].y * rstd * gg.y, v[q][j].z * rstd * gg.z, v[q][j].w * rstd * gg.w}; o8[64 * j] = pack4(a); }
            ps = wave_sum(ps);
            if (lane == 0) WSP(float, WS_PERSTD + poff)[t] = 1.f / sqrtf(ps * (1.f / D) + EPS); }
    }
}
__device__ __forceinline__ void final_phase(Frame& F, int rep) {
    const int gw = F.vcu * NWAVES + F.wave, NGW = F.G * NWAVES, lane = F.lane;
    for (int t0 = gw; t0 < T; t0 += 4 * NGW) {
        f32x4 v[4][4];
#pragma unroll
        for (int q = 0; q < 4; ++q) { const int t = (t0 + q * NGW < T) ? t0 + q * NGW : 0; const GAS f32x4* xr = (const GAS f32x4*)(F.out + (size_t)t * D) + lane;
#pragma unroll
            for (int j = 0; j < 4; ++j) v[q][j] = xr[64 * j]; }
#pragma unroll
        for (int q = 0; q < 4; ++q) { const int t = t0 + q * NGW; if (t >= T) break;
            float s = 0.f;
#pragma unroll
            for (int j = 0; j < 4; ++j) s += (v[q][j].x * v[q][j].x + v[q][j].y * v[q][j].y) + (v[q][j].z * v[q][j].z + v[q][j].w * v[q][j].w);
            const float rstd = 1.f / sqrtf(wave_sum(s) * (1.f / D) + EPS);
            const GAS f32x4* gr = (const GAS f32x4*)F.in[23] + lane;
            GAS f32x4* xw = rep ? (GAS f32x4*)(WSP(float, WS_PROJ) + (size_t)t * D) + lane : (GAS f32x4*)(F.out + (size_t)t * D) + lane;
#pragma unroll
            for (int j = 0; j < 4; ++j) { const f32x4 gg = gr[64 * j]; xw[64 * j] = (f32x4){v[q][j].x * rstd * gg.x, v[q][j].y * rstd * gg.y, v[q][j].z * rstd * gg.z, v[q][j].w * rstd * gg.w}; } }
    }
}

constexpr int NPH = 13;
struct Args { const float* in[24]; float* out; unsigned char* ws; int ph_lo, ph_hi; };
static_assert(sizeof(Args) == 24 * 8 + 8 + 8 + 8, "Args has no padding");
__global__ void __launch_bounds__(NWAVES * 64, 2) fwd_kernel(Args args) {
    extern __shared__ __attribute__((aligned(16))) unsigned char lds[];
    Frame F;
    F.lds = (LAS unsigned char*)lds;
    F.MISC = (volatile LAS unsigned*)(F.lds + MISC_OFF);
    F.tid = threadIdx.x; F.lane = F.tid & 63; F.wave = __builtin_amdgcn_readfirstlane(F.tid >> 6);
    F.G = gridDim.x; { const int bx = blockIdx.x; F.vcu = (F.G % 8 == 0) ? (bx % 8) * (F.G / 8) + bx / 8 : bx; }
    F.ws = args.ws; F.ctl = (gu32*)(args.ws + WS_CTL); F.out = args.out;
#pragma unroll
    for (int i = 0; i < 24; ++i) F.in[i] = args.in[i];
    for (int u = F.tid; u < (LDS_BYTES - LDSCTL_OFF) / 4; u += NWAVES * 64) ((LAS unsigned*)(F.lds + LDSCTL_OFF))[u] = 0u;
    __syncthreads();
    const int lo = args.ph_lo, hi = args.ph_hi;
    XcdBarrier bar; bar.bar = (unsigned*)(F.ctl + CW_BAR); bar.x = 0; bar.st = nullptr;
    bar = xcd_barrier_post((unsigned*)(F.ctl + CW_BAR), F.MISC + 8);
#define IN(k) (lo <= (k) && (k) < hi && !((MK_SKIP >> (k)) & 1))
#define SEAM(k) do { if ((lo <= (k)) && ((k) + 1 < hi)) xcd_barrier(bar); } while (0)

    if (IN(0)) {
#if MK_REP & 1
        p0_prologue(F);
#endif
        p0_prologue(F); SEAM(0); }
    if (IN(1)) {
#if (MK_REP >> 1) & 1
        {
        { pg8::Gemm g{WSP(bf16, WS_XN), WSP(bf16, WS_WIN), T, LDP, D, nullptr}; pg8::StaticOrder S; S.init(T, LDP, F.G, (int)blockIdx.x);
          pg8::EpiBf16P E{WSP(bf16, WS_PROJ), LDP};
          pg8::gemm_phase<pg8::EpiBf16P, pg8::StaticOrder, true, true>(F.lds + RING_OFF, g, S, E); }
        { pg8::Gemm g{WSP(bf16, WS_PB), WSP(bf16, WS_WPP), T, D, PLE, nullptr}; pg8::StaticOrder S; S.init(T, D, F.G, (int)blockIdx.x);
          pg8::EpiBf16P E{WSP(bf16, WS_PERAW), D};
          pg8::gemm_phase<pg8::EpiBf16P, pg8::StaticOrder, true, true>(F.lds + RING_OFF, g, S, E); }
        }
#endif
        {
        { pg8::Gemm g{WSP(bf16, WS_XN), WSP(bf16, WS_WIN), T, LDP, D, nullptr}; pg8::StaticOrder S; S.init(T, LDP, F.G, (int)blockIdx.x);
          pg8::EpiBf16P E{WSP(bf16, WS_PROJ), LDP};
          pg8::gemm_phase<pg8::EpiBf16P, pg8::StaticOrder, true, true>(F.lds + RING_OFF, g, S, E); }
        { pg8::Gemm g{WSP(bf16, WS_PB), WSP(bf16, WS_WPP), T, D, PLE, nullptr}; pg8::StaticOrder S; S.init(T, D, F.G, (int)blockIdx.x);
          pg8::EpiBf16P E{WSP(bf16, WS_PERAW), D};
          pg8::gemm_phase<pg8::EpiBf16P, pg8::StaticOrder, true, true>(F.lds + RING_OFF, g, S, E); }
        }
        SEAM(1);
    }
    if (IN(2)) { for (int rep_ = 0; rep_ <= ((MK_REP >> 2) & 1); ++rep_) {
        for (int i = blockIdx.x; i < NCH * 8; i += F.G) { const int n = i >> 3, hh = (i + (i >> 8)) & 7;
            if (hh < 4) { gla_prep_item(F, n, hh); if ((MK_REP >> 18) & 1) gla_prep_item(F, n, hh); } else { gdn_prep_item(F, n, hh - 4); if ((MK_REP >> 19) & 1) gdn_prep_item(F, n, hh - 4); } }
        }
        SEAM(2);
    }
    if (IN(3)) { for (int rep_ = 0; rep_ <= ((MK_REP >> 3) & 1); ++rep_) {
        for (int r3_ = 0; r3_ <= ((MK_REP >> 13) & 1); ++r3_) {
        for (int it = F.vcu; it < NGRP * 4; it += F.G) gdn_group_scan<0>(F, it >> 2, it & 3);
        for (int id = F.vcu * 8 + F.wave; id < NGRP * 128; id += F.G * 8) gla_scan_range<0>(F, id >> 7, (id & 127) * 64 + F.lane); }
        xcd_barrier(bar);
        for (int r3_ = 0; r3_ <= ((MK_REP >> 14) & 1); ++r3_) {
        if (F.vcu < 32) gdn_scan_groups(F, F.vcu >> 3, F.vcu & 7);
        else if (F.vcu < 160 && F.wave == 0) gla_scan_groups(F, (F.vcu - 32) * 64 + F.lane); }
        xcd_barrier(bar);
        for (int r3_ = 0; r3_ <= ((MK_REP >> 15) & 1); ++r3_) {
        for (int it = F.vcu; it < NGRP * 4; it += F.G) gdn_group_scan<1>(F, it >> 2, it & 3);
        for (int id = F.vcu * 8 + F.wave; id < NGRP * 128; id += F.G * 8) gla_scan_range<1>(F, id >> 7, (id & 127) * 64 + F.lane); }
        }
        SEAM(3);
    }
    if (IN(4)) { for (int rep_ = 0; rep_ <= ((MK_REP >> 4) & 1); ++rep_) {
        for (int id = (int)blockIdx.x * 8 + F.wave; id < NCH * 32; id += F.G * 8) { const int item = id >> 2, it = id & 3, n = item >> 3, hh = (item + (item >> 8)) & 7;
            if (hh < 4) gla_out_wave(F, n, hh, it); else gdn_out_wave(F, n, hh - 4, it); }
        }
        SEAM(4);
    }
    if (IN(5)) {
#if (MK_REP >> 5) & 1
        {
        pg8::Gemm g{WSP(bf16, WS_MIX), WSP(bf16, WS_WOUT), T, D, D, nullptr}; pg8::StaticOrder S; S.init(T, D, F.G, (int)blockIdx.x);
        pg8::EpiResF32 E{F.in[0], F.out, D};
        pg8::gemm_phase<pg8::EpiResF32, pg8::StaticOrder, true, true>(F.lds + RING_OFF, g, S, E);
        }
#endif
        {
        pg8::Gemm g{WSP(bf16, WS_MIX), WSP(bf16, WS_WOUT), T, D, D, nullptr}; pg8::StaticOrder S; S.init(T, D, F.G, (int)blockIdx.x);
        pg8::EpiResF32 E{F.in[0], F.out, D};
        pg8::gemm_phase<pg8::EpiResF32, pg8::StaticOrder, true, true>(F.lds + RING_OFF, g, S, E);
        }
        SEAM(5);
    }
    if (IN(6)) { for (int rep_ = 0; rep_ <= ((MK_REP >> 6) & 1); ++rep_) { route_phase(F, rep_); } SEAM(6); }
    if (IN(7)) { for (int rep_ = 0; rep_ <= ((MK_REP >> 7) & 1); ++rep_) { scatter_phase(F); } SEAM(7); }
    if (IN(8)) {
#if (MK_REP >> 8) & 1
        {
        moe_tables(F);
        const LAS int* tile_e = (const LAS int*)(F.lds + TILEE_OFF); const int ntiles = __builtin_amdgcn_readfirstlane(tile_e[319]);
        pg8::Gemm g{WSP(bf16, WS_XN), WSP(bf16, WS_W1), XS_ROWS, 2048, D / 2, WSP(int, WS_TOKQ)}; pg8::MoeOrder S{tile_e, ntiles, 8, F.G, (int)blockIdx.x};
        pg8::EpiMoeAct E{WSP(bf16, WS_HS), F.in[16], WSP(float, WS_RPOS)};
        pg8::gemm_phase<pg8::EpiMoeAct, pg8::MoeOrder, true, true, true, true>(F.lds + RING_OFF, g, S, E);
        }
#endif
        {
        moe_tables(F);
        const LAS int* tile_e = (const LAS int*)(F.lds + TILEE_OFF); const int ntiles = __builtin_amdgcn_readfirstlane(tile_e[319]);
        pg8::Gemm g{WSP(bf16, WS_XN), WSP(bf16, WS_W1), XS_ROWS, 2048, D / 2, WSP(int, WS_TOKQ)}; pg8::MoeOrder S{tile_e, ntiles, 8, F.G, (int)blockIdx.x};
        pg8::EpiMoeAct E{WSP(bf16, WS_HS), F.in[16], WSP(float, WS_RPOS)};
        pg8::gemm_phase<pg8::EpiMoeAct, pg8::MoeOrder, true, true, true, true>(F.lds + RING_OFF, g, S, E);
        }
        SEAM(8);
    }
    if (IN(9)) {
#if (MK_REP >> 9) & 1
        {
        moe_tables(F);
        const LAS int* tile_e = (const LAS int*)(F.lds + TILEE_OFF); const int ntiles = __builtin_amdgcn_readfirstlane(tile_e[319]);
        pg8::Gemm g{WSP(bf16, WS_HS), WSP(bf16, WS_W2), XS_ROWS, D, D / 2, nullptr}; pg8::MoeOrder S{tile_e, ntiles, 4, F.G, (int)blockIdx.x};
        pg8::EpiMoeDown E{WSP(bf16, WS_YS), F.in[18], WSP(float, WS_GPOS)};
        pg8::gemm_phase<pg8::EpiMoeDown, pg8::MoeOrder, true, true, true>(F.lds + RING_OFF, g, S, E);
        }
#endif
        {
        moe_tables(F);
        const LAS int* tile_e = (const LAS int*)(F.lds + TILEE_OFF); const int ntiles = __builtin_amdgcn_readfirstlane(tile_e[319]);
        pg8::Gemm g{WSP(bf16, WS_HS), WSP(bf16, WS_W2), XS_ROWS, D, D / 2, nullptr}; pg8::MoeOrder S{tile_e, ntiles, 4, F.G, (int)blockIdx.x};
        pg8::EpiMoeDown E{WSP(bf16, WS_YS), F.in[18], WSP(float, WS_GPOS)};
        pg8::gemm_phase<pg8::EpiMoeDown, pg8::MoeOrder, true, true, true>(F.lds + RING_OFF, g, S, E);
        }
        SEAM(9);
    }
    if (IN(10)) { for (int rep_ = 0; rep_ <= ((MK_REP >> 10) & 1); ++rep_) { combine_phase(F, rep_); } SEAM(10); }
    if (IN(11)) {
#if (MK_REP >> 11) & 1
        {
        pg8::Gemm g{WSP(bf16, WS_XN), WSP(bf16, WS_WPG), T, D, D, nullptr}; pg8::StaticOrder S; S.init(T, D, F.G, (int)blockIdx.x);
        pg8::EpiPle E{F.out, WSP(bf16, WS_PERAW), WSP(float, WS_PERSTD), F.in[22]};
        pg8::gemm_phase<pg8::EpiPle, pg8::StaticOrder, true, true>(F.lds + RING_OFF, g, S, E);
        }
#endif
        {
        pg8::Gemm g{WSP(bf16, WS_XN), WSP(bf16, WS_WPG), T, D, D, nullptr}; pg8::StaticOrder S; S.init(T, D, F.G, (int)blockIdx.x);
        pg8::EpiPle E{F.out, WSP(bf16, WS_PERAW), WSP(float, WS_PERSTD), F.in[22]};
        pg8::gemm_phase<pg8::EpiPle, pg8::StaticOrder, true, true>(F.lds + RING_OFF, g, S, E);
        }
        SEAM(11);
    }
    if (IN(12)) { for (int rep_ = 0; rep_ <= ((MK_REP >> 12) & 1); ++rep_) { final_phase(F, rep_); } }
#undef IN
#undef SEAM
}

extern "C" void kernel_launch(void* const* d_in, const int* in_sizes, int n_in, void* d_out, int out_size, void* d_ws, size_t ws_size, hipStream_t stream) {
    static int grid = 0;
    if (grid == 0) {
        if (n_in != 24 || in_sizes[0] != T * D || out_size != T * D || ws_size < WS_END) { fprintf(stderr, "kernel_launch: unexpected shapes (n_in %d, in0 %d, out %d, ws %zu); nothing launched\n", n_in, n_in > 0 ? in_sizes[0] : -1, out_size, ws_size); grid = -1; return; }
        int dev = 0, cus = 0;
        if (hipGetDevice(&dev) != hipSuccess || hipDeviceGetAttribute(&cus, hipDeviceAttributeMultiprocessorCount, dev) != hipSuccess) { grid = -1; return; }
        if (hipFuncSetAttribute((const void*)fwd_kernel, hipFuncAttributeMaxDynamicSharedMemorySize, LDS_BYTES) != hipSuccess) { fprintf(stderr, "kernel_launch: hipFuncSetAttribute failed\n"); grid = -1; return; }
        int per_cu = 0;
        if (hipOccupancyMaxActiveBlocksPerMultiprocessor(&per_cu, (const void*)fwd_kernel, NWAVES * 64, LDS_BYTES) != hipSuccess || per_cu < 1) fprintf(stderr, "kernel_launch: occupancy query reports %d blocks per CU\n", per_cu);
        (void)hipGetLastError();
        grid = cus;
    }
    if (grid < 0) return;
    if (hipMemsetAsync((char*)d_ws + WS_CTL, 0, CTL_ZERO_BYTES, stream) != hipSuccess) return;
    Args a{};
    for (int i = 0; i < 24; ++i) a.in[i] = (const float*)d_in[i];
    a.out = (float*)d_out; a.ws = (unsigned char*)d_ws;
#if MK_ONE_LAUNCH
    a.ph_lo = 0; a.ph_hi = NPH;
    hipLaunchKernelGGL(fwd_kernel, dim3(grid), dim3(NWAVES * 64), LDS_BYTES, stream, a);
#else
    for (int p = 0; p < NPH; ++p) { a.ph_lo = p; a.ph_hi = p + 1; hipLaunchKernelGGL(fwd_kernel, dim3(grid), dim3(NWAVES * 64), LDS_BYTES, stream, a); }
#endif
}
```

```cpp
#include <hip/hip_runtime.h>
#include <cstdio>
#include <cstdint>
#ifndef MK_ONE_LAUNCH
#define MK_ONE_LAUNCH 1
#endif
#ifndef MK_SKIP
#define MK_SKIP 0
#endif
#ifndef MK_DBG
#define MK_DBG 0
#endif
#ifndef MK_REP
#define MK_REP 0
#endif
namespace pg8 {
#define PG8_LAS __attribute__((address_space(3)))
typedef unsigned short bf16_t;
typedef short bf16x8 __attribute__((ext_vector_type(8)));
typedef float f32x4 __attribute__((ext_vector_type(4)));
typedef unsigned u32x4 __attribute__((ext_vector_type(4)));
constexpr int BM = 256, BK = 64, HALF = 128, HTB = HALF * BK * 2  , STAGE_BYTES = 8 * HTB, NXCD = 8, WGM = 8;

__host__ __device__ __forceinline__ int lds_byte(int r, int c) { const int st = (r >> 4) * 2 + (c >> 5), rr = r & 15, cc = c & 31, ob = rr * 64 + cc * 2; return st * 1024 + (ob ^ (((ob >> 9) & 1) << 5)); }
__host__ __device__ __forceinline__ void stage_rc(int b, int& R, int& C) { const int st = b / 1024, sb = b % 1024, swz = sb ^ (((sb >> 9) & 1) << 5); R = (st >> 1) * 16 + swz / 64; C = (st & 1) * 32 + (swz % 64) / 2; }
__host__ __device__ __forceinline__ int perm32(int rho) { const int n = rho >> 4, i = rho & 15; return 8 * (i >> 2) + 4 * n + (i & 3); }

struct Unit { int pm, pn, pb, e; };
struct Gemm { const bf16_t* A; const bf16_t* Bt; int M, N, K; const int* rowmap; };

struct StaticOrder {
    int nM, nN, nwg, G, c;
    __host__ __device__ void init(int M, int N, int G_, int c_) { nM = M / BM; nN = N / BM; nwg = nM * nN; G = G_; c = c_; }
    __host__ __device__ bool next(int i, Unit& u) const {
        const long L = (long)i * G + c; if (L >= nwg) return false;
        int wgid = (int)L; { const int q = nwg / NXCD, r = nwg % NXCD, xcd = wgid % NXCD, off = wgid / NXCD; wgid = (xcd < r ? xcd * (q + 1) : r * (q + 1) + (xcd - r) * q) + off; }
        const int nig = WGM * nN, gid = wgid / nig, fm = gid * WGM, gsz = (nM - fm) < WGM ? (nM - fm) : WGM;
        u.pm = fm + ((wgid % nig) % gsz); u.pn = (wgid % nig) / gsz; u.pb = u.pn; u.e = 0; return true;
    }
    __device__ __forceinline__ void a_ready(const Unit&) const {}
    __device__ __forceinline__ void done(const Unit&) const {}
};

__device__ __forceinline__ unsigned cvt_pk_bf16(float lo, float hi) { unsigned r; asm volatile("v_cvt_pk_bf16_f32 %0, %1, %2" : "=v"(r) : "v"(lo), "v"(hi)); return r; }

typedef float f32x2 __attribute__((ext_vector_type(2)));
typedef unsigned u32x2 __attribute__((ext_vector_type(2)));
typedef __bf16 bf16x2v __attribute__((ext_vector_type(2)));
__device__ __forceinline__ unsigned cvtpk(float lo, float hi) { f32x2 v = {lo, hi}; bf16x2v b = __builtin_convertvector(v, bf16x2v); return __builtin_bit_cast(unsigned, b); }
typedef int v4i_t __attribute__((ext_vector_type(4)));
typedef int v8i_t __attribute__((ext_vector_type(8)));
__device__ __forceinline__ v8i_t cat16(bf16x8 lo, bf16x8 hi) { return __builtin_shufflevector(__builtin_bit_cast(v4i_t, lo), __builtin_bit_cast(v4i_t, hi), 0, 1, 2, 3, 4, 5, 6, 7); }
__device__ __forceinline__ unsigned cvt4_fp8(float a, float b, float c, float d) { int w = __builtin_amdgcn_cvt_pk_fp8_f32(a, b, 0, false); w = __builtin_amdgcn_cvt_pk_fp8_f32(c, d, w, true); return (unsigned)w; }
__device__ __forceinline__ float sigmoidf_(float x) { return __builtin_amdgcn_rcpf(1.0f + __expf(-x)); }

struct EpiBf16P {
    static constexpr bool PERM = true, AFTER_DRAIN = false;
    bf16_t* O; int ldc;
    __device__ __forceinline__ void operator()(const f32x4 (&acc)[2][2][4][2], const Unit& u, int wr, int wc, int fr, int fq) const {
        const int row0 = u.pm * BM + wr * 64 + fr, col0 = u.pn * BM + wc * 32 + 8 * fq;
#pragma unroll
        for (int ai = 0; ai < 2; ++ai)
#pragma unroll
            for (int m = 0; m < 4; ++m) { bf16_t* rowp = O + (size_t)(row0 + ai * HALF + m * 16) * ldc + col0;
#pragma unroll
                for (int bj = 0; bj < 2; ++bj) { const f32x4 v0 = acc[ai][bj][m][0], v1 = acc[ai][bj][m][1];
                    u32x4 w; w.x = cvtpk(v0[0], v0[1]); w.y = cvtpk(v0[2], v0[3]); w.z = cvtpk(v1[0], v1[1]); w.w = cvtpk(v1[2], v1[3]);
                    *(u32x4*)(rowp + bj * HALF) = w; } }
    }
};
struct EpiResF32 {
    static constexpr bool PERM = false, AFTER_DRAIN = false;
    const float* base; float* out; int ldc;
    __device__ __forceinline__ void operator()(const f32x4 (&acc)[2][2][4][2], const Unit& u, int wr, int wc, int fr, int fq) const {
        const int row0 = u.pm * BM + wr * 64 + fr, col0 = u.pn * BM + wc * 32 + 4 * fq;
#pragma unroll
        for (int ai = 0; ai < 2; ++ai)
#pragma unroll
            for (int m = 0; m < 4; ++m) { const size_t off = (size_t)(row0 + ai * HALF + m * 16) * ldc + col0;
#pragma unroll
                for (int bj = 0; bj < 2; ++bj)
#pragma unroll
                    for (int n = 0; n < 2; ++n) *(f32x4*)(out + off + bj * HALF + n * 16) = *(const f32x4*)(base + off + bj * HALF + n * 16) + acc[ai][bj][m][n]; }
    }
};
struct EpiMoeAct {
    static constexpr bool PERM = true, AFTER_DRAIN = false;
    bf16_t* O; const float* bgu; const float* rpos;
    __device__ __forceinline__ void operator()(const f32x4 (&acc)[2][2][4][2], const Unit& u, int wr, int wc, int fr, int fq) const {
        const int row0 = u.pm * BM + wr * 64 + fr, ch0 = u.pn * HALF + wc * 32 + 8 * fq;
        const float* bb = bgu + (size_t)u.e * 2048 + ch0;
        f32x4 bg[2], bu[2];
#pragma unroll
        for (int n = 0; n < 2; ++n) { bg[n] = *(const f32x4*)(bb + 4 * n); bu[n] = *(const f32x4*)(bb + 1024 + 4 * n); }
#pragma unroll
        for (int ai = 0; ai < 2; ++ai)
#pragma unroll
            for (int m = 0; m < 4; ++m) { const float rs = rpos[row0 + ai * HALF + m * 16];
                float a[8];
#pragma unroll
                for (int n = 0; n < 2; ++n)
#pragma unroll
                    for (int i = 0; i < 4; ++i) {
                        float g = acc[ai][0][m][n][i] * rs + bg[n][i], up = acc[ai][1][m][n][i] * rs + bu[n][i];
                        g = fminf(g, 7.0f); up = fminf(fmaxf(up, -7.0f), 7.0f);
                        a[n * 4 + i] = (up + 1.0f) * g * sigmoidf_(1.702f * g);
                    }
                u32x2 w; w.x = cvt4_fp8(a[0], a[1], a[2], a[3]); w.y = cvt4_fp8(a[4], a[5], a[6], a[7]);
                *(u32x2*)((unsigned char*)O + (size_t)(row0 + ai * HALF + m * 16) * 1024 + ch0) = w;
            }
    }
};
struct EpiMoeDown {
    static constexpr bool PERM = true, AFTER_DRAIN = false;
    bf16_t* O; const float* bd; const float* gpos;
    __device__ __forceinline__ void operator()(const f32x4 (&acc)[2][2][4][2], const Unit& u, int wr, int wc, int fr, int fq) const {
        const int row0 = u.pm * BM + wr * 64 + fr, col0 = u.pn * BM + wc * 32 + 8 * fq;
        const float* bb = bd + (size_t)u.e * 1024 + col0;
        f32x4 bv[2][2];
#pragma unroll
        for (int bj = 0; bj < 2; ++bj)
#pragma unroll
            for (int n = 0; n < 2; ++n) bv[bj][n] = *(const f32x4*)(bb + bj * HALF + 4 * n);
#pragma unroll
        for (int ai = 0; ai < 2; ++ai)
#pragma unroll
            for (int m = 0; m < 4; ++m) { const int r = row0 + ai * HALF + m * 16; const float gt = gpos[r];
#pragma unroll
                for (int bj = 0; bj < 2; ++bj) { const f32x4 v0 = (acc[ai][bj][m][0] + bv[bj][0]) * gt, v1 = (acc[ai][bj][m][1] + bv[bj][1]) * gt;
                    u32x4 w; w.x = cvtpk(v0[0], v0[1]); w.y = cvtpk(v0[2], v0[3]); w.z = cvtpk(v1[0], v1[1]); w.w = cvtpk(v1[2], v1[3]);
                    *(u32x4*)(O + (size_t)r * 1024 + col0 + bj * HALF) = w; } }
    }
};
struct EpiPle {
    static constexpr bool PERM = false, AFTER_DRAIN = false;
    float* out; const bf16_t* pe; const float* rstd; const float* gpost;
    __device__ __forceinline__ void operator()(const f32x4 (&acc)[2][2][4][2], const Unit& u, int wr, int wc, int fr, int fq) const {
        const int row0 = u.pm * BM + wr * 64 + fr, col0 = u.pn * BM + wc * 32 + 4 * fq;
        f32x4 gp[2][2];
#pragma unroll
        for (int bj = 0; bj < 2; ++bj)
#pragma unroll
            for (int n = 0; n < 2; ++n) gp[bj][n] = *(const f32x4*)(gpost + col0 + bj * HALF + n * 16);
#pragma unroll
        for (int ai = 0; ai < 2; ++ai)
#pragma unroll
            for (int m = 0; m < 4; ++m) { const int r = row0 + ai * HALF + m * 16; const float rs = rstd[r];
#pragma unroll
                for (int bj = 0; bj < 2; ++bj)
#pragma unroll
                    for (int n = 0; n < 2; ++n) { const size_t off = (size_t)r * 1024 + col0 + bj * HALF + n * 16;
                        const u32x2 pw = *(const u32x2*)(pe + off); const f32x4 a = acc[ai][bj][m][n];
                        f32x4 p4; p4[0] = __uint_as_float(pw.x << 16); p4[1] = __uint_as_float(pw.x & 0xffff0000u); p4[2] = __uint_as_float(pw.y << 16); p4[3] = __uint_as_float(pw.y & 0xffff0000u);
                        f32x4 o = *(const f32x4*)(out + off);
#pragma unroll
                        for (int i = 0; i < 4; ++i) o[i] += sigmoidf_(a[i]) * p4[i] * rs * gp[bj][n][i];
                        *(f32x4*)(out + off) = o; } }
    }
};
struct MoeOrder {
    const PG8_LAS int* tile_e; int ntiles, NT, G, c;
    __device__ __forceinline__ bool next(int i, Unit& u) const {
        const int L = (G % 8 == 0) ? i * G + (c & 7) * (G >> 3) + (c >> 3) : i * G + c;
        if (L >= ntiles * NT) return false;
        const int mt = L / NT, nt = L - mt * NT;
        const int e = __builtin_amdgcn_readfirstlane(tile_e[mt]);
        u.pm = mt; u.pn = nt; u.e = e; u.pb = e * NT + nt; return true;
    }
    __device__ __forceinline__ void a_ready(const Unit&) const {}
    __device__ __forceinline__ void done(const Unit&) const {}
};
template <class Epi, class Sched, bool ALIGN_EPI = false, bool SP2 = false, bool FP8 = false, bool GATHER = false>
__device__ __forceinline__ void gemm_phase(PG8_LAS unsigned char* lds, const Gemm g, const Sched& S, const Epi& E) {
    const int tid = threadIdx.x, wid = __builtin_amdgcn_readfirstlane(tid >> 6), lane = tid & 63, wr = wid >> 2, wc = wid & 3, fr = lane & 15, fq = lane >> 4;
    const int K = g.K, nt = K / BK;
    unsigned voffA[2], voffB[2]; int Rr[2]; unsigned cb2[2];
#pragma unroll
    for (int i = 0; i < 2; ++i) { int R, C; stage_rc(tid * 16 + i * 8192, R, C); const int Rb = Epi::PERM ? ((R & ~31) + perm32(R & 31)) : R;
        voffA[i] = (unsigned)(R * K + C) * 2u; voffB[i] = (unsigned)(Rb * K + C) * 2u; Rr[i] = R; cb2[i] = (unsigned)C * 2u; }
    const size_t kstep = (size_t)(BK * 2);
    const size_t hstep = (size_t)HALF * K * 2;
    const size_t tstep = 2 * hstep;
    const unsigned ldsw = (unsigned)wid * 1024u;
    const int aoff = lds_byte(wr * 64 + fr, fq * 8), boff = lds_byte(wc * 32 + fr, fq * 8);
#define PG8_SA(b, h) (((b) * 2 + (h)) * HTB)
#define PG8_SB(b, h) ((4 + (b) * 2 + (h)) * HTB)
#define PG8_STAGE(bufoff, gbase, voff) do { _Pragma("unroll") for (int _i = 0; _i < 2; ++_i) \
        __builtin_amdgcn_global_load_lds((const unsigned*)((const char*)(gbase) + (voff)[_i]), (PG8_LAS unsigned*)(lds + (bufoff) + ldsw + _i * 8192), 16, 0, 0); } while (0)
#define PG8_GOFF(dst, pm_) do { _Pragma("unroll") for (int _h = 0; _h < 2; ++_h) _Pragma("unroll") for (int _i = 0; _i < 2; ++_i) dst[_h][_i] = (unsigned)g.rowmap[(pm_) * BM + _h * HALF + Rr[_i]] * (unsigned)(K * 2) + cb2[_i]; } while (0)
#define PG8_STAGE_A(bufoff, ptr, half, nsel) do { if constexpr (GATHER) { unsigned _v[2]; _v[0] = (nsel) ? nvA[half][0] : vA[half][0]; _v[1] = (nsel) ? nvA[half][1] : vA[half][1]; PG8_STAGE(bufoff, ptr, _v); } \
        else { PG8_STAGE(bufoff, (ptr) + ((half) ? hstep : 0), voffA); } } while (0)
#define PG8_LD1(off) (*(const PG8_LAS bf16x8*)(lds + (off)))
#define PG8_LDA(dst, b, h) do { if constexpr (FP8) { _Pragma("unroll") for (int m = 0; m < 4; ++m) dst##8[m] = cat16(PG8_LD1(PG8_SA(b, h) + aoff + m * 2048), PG8_LD1(PG8_SA(b, h) + aoff + m * 2048 + 1024)); } \
        else { _Pragma("unroll") for (int m = 0; m < 4; ++m) _Pragma("unroll") for (int k = 0; k < 2; ++k) dst[m][k] = PG8_LD1(PG8_SA(b, h) + aoff + m * 2048 + k * 1024); } } while (0)
#define PG8_LDB(dst, b, h) do { if constexpr (FP8) { _Pragma("unroll") for (int n = 0; n < 2; ++n) dst##8[n] = cat16(PG8_LD1(PG8_SB(b, h) + boff + n * 2048), PG8_LD1(PG8_SB(b, h) + boff + n * 2048 + 1024)); } \
        else { _Pragma("unroll") for (int n = 0; n < 2; ++n) _Pragma("unroll") for (int k = 0; k < 2; ++k) dst[n][k] = PG8_LD1(PG8_SB(b, h) + boff + n * 2048 + k * 1024); } } while (0)
#define PG8_MMA(ai, bj, At, Bt) do { if constexpr (FP8) __builtin_amdgcn_sched_barrier(0); __builtin_amdgcn_s_setprio(1); _Pragma("unroll") for (int m = 0; m < 4; ++m) _Pragma("unroll") for (int n = 0; n < 2; ++n) { \
        if constexpr (FP8) { acc[ai][bj][m][n] = __builtin_amdgcn_mfma_scale_f32_16x16x128_f8f6f4(Bt##8[n], At##8[m], acc[ai][bj][m][n], 0, 0, 0, 0x79797979, 0, 0x7f7f7f7f); } \
        else { _Pragma("unroll") for (int k = 0; k < 2; ++k) acc[ai][bj][m][n] = __builtin_amdgcn_mfma_f32_16x16x32_bf16(Bt[n][k], At[m][k], acc[ai][bj][m][n], 0, 0, 0); } } \
        if constexpr (FP8) { _Pragma("unroll") for (int m = 0; m < 4; ++m) _Pragma("unroll") for (int n = 0; n < 2; ++n) asm volatile("" : "+v"(acc[ai][bj][m][n])); }     \
        __builtin_amdgcn_s_setprio(0); if constexpr (FP8) __builtin_amdgcn_sched_barrier(0); } while (0)
#define PG8_WAIT_V(n) asm volatile("s_waitcnt vmcnt(" #n ")" ::: "memory")
#define PG8_WAIT_L(n) asm volatile("s_waitcnt lgkmcnt(" #n ")" ::: "memory")
#define PG8_BAR __builtin_amdgcn_s_barrier()
#define PG8_SCHED __builtin_amdgcn_sched_barrier(0)
    Unit cur, nxt; int ui = 0;
    if (!S.next(0, cur)) return;
    f32x4 acc[2][2][4][2];
#pragma unroll
    for (int a = 0; a < 2; ++a)
#pragma unroll
        for (int b = 0; b < 2; ++b)
#pragma unroll
            for (int m = 0; m < 4; ++m)
#pragma unroll
                for (int n = 0; n < 2; ++n) acc[a][b][m][n] = (f32x4){0.f, 0.f, 0.f, 0.f};
    bf16x8 At[4][2], B0[2][2], B1[2][2]; v8i_t At8[4], B08[2], B18[2];
    unsigned vA[2][2], nvA[2][2];
    if constexpr (GATHER) { PG8_GOFF(vA, cur.pm); }
    const char* cA = (const char*)g.A + (GATHER ? (size_t)0 : (size_t)cur.pm * tstep); const char* cB = (const char*)g.Bt + (size_t)cur.pb * tstep;
    S.a_ready(cur);
    if constexpr (SP2) {
        PG8_STAGE(PG8_SB(0, 0), cB, voffB); PG8_STAGE(PG8_SB(0, 1), cB + hstep, voffB); PG8_STAGE_A(PG8_SA(0, 0), cA, 0, false); PG8_STAGE_A(PG8_SA(0, 1), cA, 1, false);
        if (wr == 1) PG8_BAR;
        PG8_WAIT_V(2); PG8_BAR;
        PG8_STAGE(PG8_SB(1, 0), cB + kstep, voffB); PG8_STAGE_A(PG8_SA(1, 0), cA + kstep, 0, false); PG8_STAGE(PG8_SB(1, 1), cB + hstep + kstep, voffB);
        PG8_WAIT_V(6); PG8_BAR;
    } else {
        PG8_STAGE(PG8_SB(0, 0), cB, voffB); PG8_STAGE_A(PG8_SA(0, 0), cA, 0, false); PG8_STAGE(PG8_SB(0, 1), cB + hstep, voffB); PG8_STAGE_A(PG8_SA(0, 1), cA, 1, false);
        if (wr == 1) PG8_BAR;
        PG8_WAIT_V(4); PG8_BAR;
        PG8_STAGE(PG8_SB(1, 0), cB + kstep, voffB); PG8_STAGE_A(PG8_SA(1, 0), cA + kstep, 0, false); PG8_STAGE(PG8_SB(1, 1), cB + hstep + kstep, voffB);
        PG8_WAIT_V(6); PG8_BAR;
    }
    for (;;) {
        const bool has_next = S.next(ui + 1, nxt);
        if constexpr (GATHER) { if (has_next) { PG8_GOFF(nvA, nxt.pm); } else { _Pragma("unroll") for (int _h = 0; _h < 2; ++_h) _Pragma("unroll") for (int _i = 0; _i < 2; ++_i) nvA[_h][_i] = vA[_h][_i]; } }
        const char* nA = (has_next && !GATHER) ? (const char*)g.A + (size_t)nxt.pm * tstep : cA; const char* nB = has_next ? (const char*)g.Bt + (size_t)nxt.pb * tstep : cB;
        for (int t = 0; t < nt; t += 2) {
            const bool last = (t == nt - 2);
            const char* a1 = cA + (size_t)(t + 1) * kstep;
            const char* a2 = last ? nA : cA + (size_t)(t + 2) * kstep; const char* b2 = last ? nB : cB + (size_t)(t + 2) * kstep;
            const char* a3 = a2 + kstep; const char* b3 = b2 + kstep;
            if (last && has_next) S.a_ready(nxt);
            if constexpr (SP2) {
            PG8_LDB(B0, 0, 0); PG8_LDB(B1, 0, 1); PG8_SCHED; PG8_LDA(At, 0, 0); PG8_STAGE_A(PG8_SA(1, 1), a1, 1, false);
            PG8_WAIT_V(8); PG8_WAIT_L(0); PG8_BAR; PG8_MMA(0, 0, At, B0); PG8_MMA(0, 1, At, B1); PG8_BAR; PG8_SCHED;
            PG8_LDA(At, 0, 1); PG8_STAGE(PG8_SB(0, 0), b2, voffB); PG8_STAGE(PG8_SB(0, 1), b2 + hstep, voffB); PG8_STAGE_A(PG8_SA(0, 0), a2, 0, last);
            PG8_WAIT_V(8); PG8_WAIT_L(0); PG8_BAR; PG8_MMA(1, 0, At, B0); PG8_MMA(1, 1, At, B1); PG8_BAR; PG8_SCHED;
            PG8_LDB(B0, 1, 0); PG8_LDB(B1, 1, 1); PG8_SCHED; PG8_LDA(At, 1, 0); PG8_STAGE_A(PG8_SA(0, 1), a2, 1, last);
            PG8_WAIT_V(8); PG8_WAIT_L(0); PG8_BAR; PG8_MMA(0, 0, At, B0); PG8_MMA(0, 1, At, B1); PG8_BAR; PG8_SCHED;
            PG8_LDA(At, 1, 1); PG8_STAGE(PG8_SB(1, 0), b3, voffB); PG8_STAGE(PG8_SB(1, 1), b3 + hstep, voffB); PG8_STAGE_A(PG8_SA(1, 0), a3, 0, last);
            PG8_WAIT_V(8); PG8_WAIT_L(0); PG8_BAR; PG8_MMA(1, 0, At, B0); PG8_MMA(1, 1, At, B1); PG8_BAR; PG8_SCHED;
            } else {
            PG8_LDB(B0, 0, 0); PG8_SCHED; PG8_LDA(At, 0, 0); PG8_STAGE_A(PG8_SA(1, 1), a1, 1, false);
            PG8_WAIT_L(8); PG8_BAR; PG8_WAIT_L(0); PG8_MMA(0, 0, At, B0); PG8_BAR; PG8_SCHED;
            PG8_LDB(B1, 0, 1); PG8_STAGE(PG8_SB(0, 0), b2, voffB);
            PG8_BAR; PG8_WAIT_L(0); PG8_MMA(0, 1, At, B1); PG8_BAR;
            PG8_LDA(At, 0, 1); PG8_STAGE_A(PG8_SA(0, 0), a2, 0, last);
            PG8_BAR; PG8_WAIT_L(0); PG8_MMA(1, 0, At, B0); PG8_BAR; PG8_SCHED;
            PG8_STAGE(PG8_SB(0, 1), b2 + hstep, voffB);
            PG8_WAIT_V(6); PG8_BAR; PG8_MMA(1, 1, At, B1); PG8_BAR;
            PG8_LDB(B0, 1, 0); PG8_SCHED; PG8_LDA(At, 1, 0); PG8_STAGE_A(PG8_SA(0, 1), a2, 1, last);
            PG8_WAIT_L(8); PG8_BAR; PG8_WAIT_L(0); PG8_MMA(0, 0, At, B0); PG8_BAR; PG8_SCHED;
            PG8_LDB(B1, 1, 1); PG8_STAGE(PG8_SB(1, 0), b3, voffB);
            PG8_BAR; PG8_WAIT_L(0); PG8_MMA(0, 1, At, B1); PG8_BAR;
            PG8_LDA(At, 1, 1); PG8_STAGE_A(PG8_SA(1, 0), a3, 0, last);
            PG8_BAR; PG8_WAIT_L(0); PG8_MMA(1, 0, At, B0); PG8_BAR; PG8_SCHED;
            PG8_STAGE(PG8_SB(1, 1), b3 + hstep, voffB);
            PG8_WAIT_V(6); PG8_BAR; PG8_MMA(1, 1, At, B1); PG8_BAR;
            }
        }
        if constexpr (ALIGN_EPI) { if (wr == 0) PG8_BAR; }
        if constexpr (!Epi::AFTER_DRAIN) { E(acc, cur, wr, wc, fr, fq); S.done(cur); }
        if (!has_next) break;
#pragma unroll
        for (int a = 0; a < 2; ++a)
#pragma unroll
            for (int b = 0; b < 2; ++b)
#pragma unroll
                for (int m = 0; m < 4; ++m)
#pragma unroll
                    for (int n = 0; n < 2; ++n) acc[a][b][m][n] = (f32x4){0.f, 0.f, 0.f, 0.f};
        cur = nxt; cA = nA; cB = nB; ++ui;
        if constexpr (GATHER) { _Pragma("unroll") for (int _h = 0; _h < 2; ++_h) _Pragma("unroll") for (int _i = 0; _i < 2; ++_i) vA[_h][_i] = nvA[_h][_i]; }
        if constexpr (ALIGN_EPI) { if (wr == 1) PG8_BAR; }
    }
    PG8_WAIT_V(0);
    if constexpr (!ALIGN_EPI) { if (wr == 0) PG8_BAR; }
    PG8_BAR;
    if constexpr (Epi::AFTER_DRAIN) { E.fused(acc, cur, wr, wc, fr, fq, lds, wid, lane); S.done(cur); }
#undef PG8_SA
#undef PG8_SB
#undef PG8_STAGE
#undef PG8_GOFF
#undef PG8_STAGE_A
#undef PG8_LD1
#undef PG8_LDA
#undef PG8_LDB
#undef PG8_MMA
#undef PG8_WAIT_V
#undef PG8_WAIT_L
#undef PG8_BAR
#undef PG8_SCHED
}
}

constexpr int NWAVES = 8;
constexpr int T = 16384, D = 1024, NCH = 256, LDP = 3840, DIN = 3608, PLE = 256, NE = 32;
constexpr int C_GQ = 0, C_GK = 256, C_GV = 512, C_GR = 1024, C_DQ = 1536, C_DZ = 3072, C_GLR = 3584, C_DA = 3600, C_DB = 3604;
constexpr float EPS = 1e-6f;
constexpr int XS_ROWS = 65536 + NE * 256;

constexpr size_t MiB = 1u << 20;
constexpr size_t WS_CTL = 0, CTL_ZERO_BYTES = 1 * MiB;
constexpr size_t WS_WIN = 2 * MiB, WS_WPP = 10 * MiB, WS_WOUT = 11 * MiB, WS_WPG = 13 * MiB, WS_W1 = 16 * MiB, WS_W2 = 80 * MiB;
constexpr size_t WS_XN = 112 * MiB, WS_PB = 144 * MiB, WS_PROJ = 152 * MiB, WS_PERAW = 272 * MiB;
constexpr size_t WS_KVT = 304 * MiB, WS_DVEC = 336 * MiB, WS_SGLA = 337 * MiB, WS_WF = 353 * MiB, WS_KDF = 369 * MiB, WS_UF = 385 * MiB, WS_CDEC = 417 * MiB;
constexpr size_t WS_QDEC = 418 * MiB, WS_AQK = 434 * MiB, WS_SGDN = 442 * MiB, WS_DELTA = 474 * MiB, WS_MIX = 490 * MiB;
constexpr size_t WS_TOKE = 522 * MiB, WS_TOKS = WS_TOKE + 256 * 1024, WS_TOKG = WS_TOKS + 256 * 1024, WS_TOKP = WS_TOKG + 256 * 1024;
constexpr size_t WS_GPOS = 523 * MiB, WS_PERSTD = 524 * MiB, WS_XS = 525 * MiB, WS_TOKQ = WS_XS  , WS_HS = 597 * MiB, WS_YS = 669 * MiB;
constexpr size_t WS_PEND = 813 * MiB, WS_SLE = 821 * MiB, WS_SST = 837 * MiB, WS_GSLE = 853 * MiB, WS_GPD = 861 * MiB, WS_GSST = 869 * MiB, WS_QT = 877 * MiB, WS_OI = 885 * MiB, WS_WRF = 901 * MiB, WS_RSTD = 902 * MiB, WS_RPOS = 903 * MiB, WS_END = 904 * MiB;
static_assert(WS_XS + (size_t)XS_ROWS * 1024 <= WS_HS && WS_HS + (size_t)XS_ROWS * 1024 <= WS_YS && WS_YS + (size_t)XS_ROWS * 2048 <= WS_PEND, "d_ws map");
constexpr int GRP = 4, NGRP = NCH / GRP;
constexpr int CW_TMO = 0, CW_CODE = 1, CW_BAR = 4096, CW_CNT = 8192;

constexpr int RING_OFF = 0, RING_BYTES = 131072;
constexpr int LDSCTL_OFF = RING_BYTES, MISC_OFF = LDSCTL_OFF + 320;
constexpr int TILEE_OFF = MISC_OFF + 128;
constexpr int BASE_OFF = TILEE_OFF + 320 * 4;
constexpr int ROUTE_OFF = BASE_OFF + 128;
constexpr int LDS_BYTES = 147456;
static_assert(ROUTE_OFF + 256 + 3072 <= LDS_BYTES, "LDS map");

#define GAS __attribute__((address_space(1)))
#define LAS __attribute__((address_space(3)))
typedef unsigned short bf16;
typedef unsigned v4u __attribute__((ext_vector_type(4)));
typedef float f32x4 __attribute__((ext_vector_type(4)));
typedef short bf16x8 __attribute__((ext_vector_type(8)));
typedef GAS unsigned gu32;
typedef GAS unsigned long long gu64;
#define RLX_AGENT __ATOMIC_RELAXED, __HIP_MEMORY_SCOPE_AGENT
#define LDS_WAIT() asm volatile("s_waitcnt lgkmcnt(0)" ::: "memory")
#define VM_WAIT() asm volatile("s_waitcnt vmcnt(0)" ::: "memory")
__device__ __forceinline__ unsigned long long rt() { return __builtin_amdgcn_s_memrealtime(); }
__device__ __forceinline__ unsigned f2bf(float f) { unsigned u = __builtin_bit_cast(unsigned, f); return (u + 0x7fffu + ((u >> 16) & 1u)) >> 16; }
__device__ __forceinline__ unsigned pk2(float lo, float hi) { return f2bf(lo) | (f2bf(hi) << 16); }

#define XB_TMO      128
#define XB_XCNT(j)  (256  + 64 * (j))
#define XB_XSUB(j)  (1280 + 64 * (j))
#define XB_XGEN(j)  (2304 + 64 * (j))
#define XB_TOP      3328
#define XB_TOPGEN   3392
#define XCD_BAR_WORDS 3456
#define XB_SPIN_CAP (1u << 18)

__device__ __forceinline__ unsigned xb_ld(unsigned* p)              { return __hip_atomic_load(p, __ATOMIC_RELAXED, __HIP_MEMORY_SCOPE_AGENT); }
__device__ __forceinline__ unsigned xb_add(unsigned* p, unsigned v) { return __hip_atomic_fetch_add(p, v, __ATOMIC_RELAXED, __HIP_MEMORY_SCOPE_AGENT); }
__device__ __forceinline__ unsigned xb_xcc_id() { return (unsigned)__builtin_amdgcn_s_getreg((3 << 11) | 20) & 0xFu; }
#define XB_SPIN(cond, bar) do { unsigned _sp = 0; while (cond) { __builtin_amdgcn_s_sleep(1); \
    if ((++_sp & 255u) == 0u) { if (xb_ld(&(bar)[XB_TMO])) break; if (_sp > XB_SPIN_CAP) { atomicAdd(&(bar)[XB_TMO], 1u); break; } } } } while (0)

struct XcdBarrier {
    unsigned* bar; unsigned x;
    volatile LAS unsigned* st;
};

__device__ __forceinline__ XcdBarrier xcd_barrier_post(unsigned* bar, volatile LAS unsigned* st) {
    XcdBarrier b; b.bar = bar; b.x = xb_xcc_id(); b.st = st;
    if (threadIdx.x == 0) (void)xb_add(&bar[XB_XCNT(b.x)], 1u);
    return b;
}
__device__ __forceinline__ void xcd_barrier_complete(unsigned* bar, unsigned x, unsigned& nloc, unsigned& nx) {
    const unsigned G = gridDim.x * gridDim.y * gridDim.z;
    unsigned sum, cnt, mine, sp = 0u;
    for (;;) {
        sum = 0u; cnt = 0u; mine = 0u;
#pragma unroll
        for (unsigned j = 0; j < 16; ++j) { const unsigned c = xb_ld(&bar[XB_XCNT(j)]); sum += c; cnt += (c > 0u) ? 1u : 0u; mine = (j == x) ? c : mine; }
        if (sum == G) break;
        __builtin_amdgcn_s_sleep(1);
        if ((++sp & 255u) == 0u) { if (xb_ld(&bar[XB_TMO])) break; if (sp > XB_SPIN_CAP) { atomicAdd(&bar[XB_TMO], 1u); break; } }
    }
    nloc = mine > 0u ? mine : 1u; nx = cnt > 0u ? cnt : 1u;
}

__device__ __forceinline__ void xcd_barrier(const XcdBarrier& b) {
    asm volatile("s_waitcnt vmcnt(0)" ::: "memory");
    __syncthreads();
    if (threadIdx.x == 0) {
        unsigned* bar = b.bar;
        __builtin_amdgcn_s_waitcnt(0);
        unsigned nloc = b.st[0], nx = b.st[1];
        if (nloc == 0u) { xcd_barrier_complete(bar, b.x, nloc, nx); b.st[0] = nloc; b.st[1] = nx; }
        const unsigned old = xb_add(&bar[XB_XSUB(b.x)], 1u);
        const unsigned gen = old / nloc;
        if (old + 1u == (gen + 1u) * nloc) {
            __builtin_amdgcn_fence(__ATOMIC_RELEASE, "agent");
            asm volatile("s_waitcnt vmcnt(0)" ::: "memory");
            const unsigned og = xb_add(&bar[XB_TOP], 1u);
            const unsigned tg = og / nx;
            if (og + 1u == (tg + 1u) * nx) xb_add(&bar[XB_TOPGEN], 1u);
            else XB_SPIN(xb_ld(&bar[XB_TOPGEN]) == tg, bar);
            __builtin_amdgcn_fence(__ATOMIC_ACQUIRE, "agent");
            xb_add(&bar[XB_XGEN(b.x)], 1u);
            asm volatile("s_waitcnt vmcnt(0)" ::: "memory");
        } else {
            XB_SPIN(xb_ld(&bar[XB_XGEN(b.x)]) == gen, bar);
            __builtin_amdgcn_fence(__ATOMIC_ACQUIRE, "agent");
            asm volatile("s_waitcnt vmcnt(0)" ::: "memory");
        }
    }
    __syncthreads();
}


__device__ __forceinline__ float bflo(unsigned w) { return __uint_as_float(w << 16); }
__device__ __forceinline__ float bfhi(unsigned w) { return __uint_as_float(w & 0xffff0000u); }
__device__ __forceinline__ float bf2f(bf16 h) { return __uint_as_float((unsigned)h << 16); }
using pg8::cvtpk;
__device__ __forceinline__ bf16 f2bf1(float f) { return (bf16)(cvtpk(f, 0.f) & 0xffffu); }
__device__ __forceinline__ float wave_sum(float v) {
#pragma unroll
    for (int o = 1; o < 64; o <<= 1) v += __shfl_xor(v, o);
    return v;
}
__device__ __forceinline__ void lds_barrier() { asm volatile("s_waitcnt lgkmcnt(0)" ::: "memory"); __builtin_amdgcn_s_barrier(); asm volatile("" ::: "memory"); }
__device__ __forceinline__ float sigm(float x) { return __builtin_amdgcn_rcpf(1.0f + __expf(-x)); }
__device__ __forceinline__ float siluf_(float x) { return x * sigm(x); }
__device__ __forceinline__ float softplusf_(float x) { return fmaxf(x, 0.f) + __logf(1.0f + __expf(-fabsf(x))); }
__device__ __forceinline__ float logsigf_(float x) { return fminf(x, 0.f) - __logf(1.0f + __expf(-fabsf(x))); }
#define MFMA16(a, b, c) __builtin_amdgcn_mfma_f32_16x16x32_bf16((a), (b), (c), 0, 0, 0)
typedef short bf16x4 __attribute__((ext_vector_type(4)));
typedef unsigned u32x2 __attribute__((ext_vector_type(2)));
__device__ __forceinline__ bf16x8 cat8(bf16x4 lo, bf16x4 hi) { return __builtin_shufflevector(lo, hi, 0, 1, 2, 3, 4, 5, 6, 7); }
__device__ __forceinline__ bf16x8 pack8(const f32x4& a, const f32x4& b) {
    v4u w; w.x = cvtpk(a[0], a[1]); w.y = cvtpk(a[2], a[3]); w.z = cvtpk(b[0], b[1]); w.w = cvtpk(b[2], b[3]); return __builtin_bit_cast(bf16x8, w);
}
__device__ __forceinline__ u32x2 pack4(const f32x4& a) { u32x2 w; w.x = cvtpk(a[0], a[1]); w.y = cvtpk(a[2], a[3]); return w; }

struct Frame {
    LAS unsigned char* lds;
    volatile LAS unsigned* MISC;
    gu32* ctl;
    int tid, lane, wave;
    int vcu, G;
    unsigned char* ws;
    const float* in[24];
    float* out;
};
#define WSP(T_, off) ((T_*)(F.ws + (off)))

__device__ __forceinline__ void titem_load(const float* W0, size_t wstride, int K, int N, int nblk, int ipm, int it, int lane, f32x4 (&v)[8]) {
    const int m = it / ipm, li = it - m * ipm, kb = li / nblk, nb = li - kb * nblk, k0 = 64 * kb, n0 = 32 * nb, cq = (lane & 7) * 4, rr = lane >> 3;
    const float* W = W0 + (size_t)m * wstride;
#pragma unroll
    for (int i = 0; i < 8; ++i) { v[i] = (f32x4){0.f, 0.f, 0.f, 0.f}; if (n0 + cq < N) v[i] = *(const GAS f32x4*)(W + (size_t)(k0 + 8 * i + rr) * N + n0 + cq); }
}
template <bool FP8, class RowMap>
__device__ __forceinline__ void transpose_set(const float* W0, size_t wstride, unsigned char* WT0, size_t wtstride, int K, int N, int nmat, LAS float* scr, int gw, int NGW, int lane, RowMap rm) {
    const int nblk = (N + 31) >> 5, ipm = (K >> 6) * nblk, total = nmat * ipm;
    int it = gw; if (it >= total) return;
    f32x4 cur[8], nxt[8];
    titem_load(W0, wstride, K, N, nblk, ipm, it, lane, cur);
    for (; it < total; it += NGW) {
        const bool more = it + NGW < total;
        if (more) titem_load(W0, wstride, K, N, nblk, ipm, it + NGW, lane, nxt);
        const int m = it / ipm, li = it - m * ipm, kb = li / nblk, nb = li - kb * nblk, k0 = 64 * kb, n0 = 32 * nb, cq = (lane & 7) * 4, rr = lane >> 3, c = lane & 7;
        const float sc = FP8 ? 64.f : 1.f;
#pragma unroll
        for (int i = 0; i < 8; ++i) { LAS float* s = scr + (8 * i + rr) * 33 + cq; s[0] = cur[i][0] * sc; s[1] = cur[i][1] * sc; s[2] = cur[i][2] * sc; s[3] = cur[i][3] * sc; }
        LDS_WAIT(); asm volatile("" ::: "memory");
        unsigned char* WT = WT0 + (size_t)m * wtstride;
#pragma unroll
        for (int j = 0; j < 4; ++j) { const int n = (lane >> 3) + 8 * j; const LAS float* s = scr + (8 * c) * 33 + n;
            if (n0 + n < N) {
                if (FP8) { u32x2 o; o.x = pg8::cvt4_fp8(s[0 * 33], s[1 * 33], s[2 * 33], s[3 * 33]); o.y = pg8::cvt4_fp8(s[4 * 33], s[5 * 33], s[6 * 33], s[7 * 33]);
                    *(GAS u32x2*)(WT + (size_t)rm(n0 + n) * K + k0 + 8 * c) = o; }
                else { v4u o; o.x = cvtpk(s[0 * 33], s[1 * 33]); o.y = cvtpk(s[2 * 33], s[3 * 33]); o.z = cvtpk(s[4 * 33], s[5 * 33]); o.w = cvtpk(s[6 * 33], s[7 * 33]);
                    *(GAS v4u*)((bf16*)WT + (size_t)rm(n0 + n) * K + k0 + 8 * c) = o; } } }
        LDS_WAIT(); asm volatile("" ::: "memory");
        if (more) {
#pragma unroll
            for (int i = 0; i < 8; ++i) cur[i] = nxt[i]; }
    }
}
__device__ __forceinline__ void titem_load_w(const float* W0, size_t wstride, int N, int nblk, int ipm, int it, int lane, f32x4 (&v)[16]) {
    const int m = it / ipm, li = it - m * ipm, kb = li / nblk, nb = li - kb * nblk, k0 = 64 * kb, n0 = 64 * nb, cq = (lane & 7) * 4, rr = lane >> 3;
    const float* W = W0 + (size_t)m * wstride;
#pragma unroll
    for (int i = 0; i < 8; ++i) { const GAS f32x4* p = (const GAS f32x4*)(W + (size_t)(k0 + 8 * i + rr) * N + n0 + cq); v[2 * i] = __builtin_nontemporal_load(p); v[2 * i + 1] = __builtin_nontemporal_load(p + 8); }
}
template <class RowMap>
__device__ __forceinline__ void transpose_set_w(const float* W0, size_t wstride, unsigned char* WT0, size_t wtstride, int K, int N, int nmat, LAS float* scr, int gw, int NGW, int lane, RowMap rm) {
    const int nblk = N >> 6, ipm = (K >> 6) * nblk, total = nmat * ipm;
    int it = gw; if (it >= total) return;
    f32x4 cur[16], nxt[16];
    titem_load_w(W0, wstride, N, nblk, ipm, it, lane, cur);
    for (; it < total; it += NGW) {
        const bool more = it + NGW < total;
        if (more) titem_load_w(W0, wstride, N, nblk, ipm, it + NGW, lane, nxt);
        const int m = it / ipm, li = it - m * ipm, kb = li / nblk, nb = li - kb * nblk, k0 = 64 * kb, n0 = 64 * nb, cq = (lane & 7) * 4, rr = lane >> 3, c = lane & 7;
        unsigned char* WT = WT0 + (size_t)m * wtstride;
#pragma unroll
        for (int hf = 0; hf < 2; ++hf) {
#pragma unroll
            for (int i = 0; i < 8; ++i) { LAS float* s = scr + (8 * i + rr) * 33 + cq; const f32x4 x = cur[2 * i + hf]; s[0] = x[0] * 64.f; s[1] = x[1] * 64.f; s[2] = x[2] * 64.f; s[3] = x[3] * 64.f; }
            LDS_WAIT(); asm volatile("" ::: "memory");
#pragma unroll
            for (int j = 0; j < 4; ++j) { const int n = (lane >> 3) + 8 * j; const LAS float* s = scr + (8 * c) * 33 + n;
                u32x2 o; o.x = pg8::cvt4_fp8(s[0 * 33], s[1 * 33], s[2 * 33], s[3 * 33]); o.y = pg8::cvt4_fp8(s[4 * 33], s[5 * 33], s[6 * 33], s[7 * 33]);
                __builtin_nontemporal_store(o, (GAS u32x2*)(WT + (size_t)rm(n0 + 32 * hf + n) * K + k0 + 8 * c)); }
            LDS_WAIT(); asm volatile("" ::: "memory");
        }
        if (more) {
#pragma unroll
            for (int i = 0; i < 16; ++i) cur[i] = nxt[i]; }
    }
}
struct RmId { __device__ __forceinline__ int operator()(int n) const { return n; } };
struct RmWin { __device__ __forceinline__ int operator()(int c) const { return c < 1536 ? c : (c < 1552 ? c + 2048 : (c < 3600 ? c - 16 : c)); } };
struct RmW1 { __device__ __forceinline__ int operator()(int c) const { const int j = c & 1023, up = c >> 10; return (j >> 7) * 256 + up * 128 + (j & 127); } };

__device__ __forceinline__ void rms_row_to_bf16(const float* xrow, const float* g, bf16* orow, int lane) {
    const GAS f32x4* xr = (const GAS f32x4*)xrow + lane; const GAS f32x4* gr = (const GAS f32x4*)g + lane;
    f32x4 v[4]; float s = 0.f;
#pragma unroll
    for (int j = 0; j < 4; ++j) { v[j] = xr[64 * j]; s += (v[j].x * v[j].x + v[j].y * v[j].y) + (v[j].z * v[j].z + v[j].w * v[j].w); }
    const float rstd = 1.f / sqrtf(wave_sum(s) * (1.f / D) + EPS);
    GAS u32x2* o8 = (GAS u32x2*)orow + lane;
#pragma unroll
    for (int j = 0; j < 4; ++j) { const f32x4 gg = gr[64 * j]; u32x2 w; w.x = cvtpk(v[j].x * rstd * gg.x, v[j].y * rstd * gg.y); w.y = cvtpk(v[j].z * rstd * gg.z, v[j].w * rstd * gg.w); o8[64 * j] = w; }
}

__device__ __forceinline__ void p0_prologue(Frame& F) {
    LAS float* scr = (LAS float*)(F.lds + RING_OFF + F.wave * 16384);
    const int gw = F.vcu * NWAVES + F.wave, NGW = F.G * NWAVES, lane = F.lane;
    bf16* Win_t = WSP(bf16, WS_WIN);
    transpose_set<false>(F.in[3], 0, (unsigned char*)Win_t, 0, 1024, DIN, 1, scr, gw, NGW, lane, RmWin());
    for (int r = DIN + gw; r < LDP; r += NGW) { GAS v4u* o = (GAS v4u*)(Win_t + (size_t)r * 1024) + lane; o[0] = (v4u){0, 0, 0, 0}; o[64] = (v4u){0, 0, 0, 0}; }
    transpose_set<false>(F.in[21], 0, WSP(unsigned char, WS_WPP), 0, PLE, D, 1, scr, gw, NGW, lane, RmId());
    transpose_set<false>(F.in[11], 0, WSP(unsigned char, WS_WOUT), 0, D, D, 1, scr, gw, NGW, lane, RmId());
    transpose_set<false>(F.in[20], 0, WSP(unsigned char, WS_WPG), 0, D, D, 1, scr, gw, NGW, lane, RmId());
    transpose_set_w(F.in[15], (size_t)1024 * 2048, WSP(unsigned char, WS_W1), (size_t)2048 * 1024, 1024, 2048, NE, scr, gw, NGW, lane, RmW1());
    transpose_set_w(F.in[17], (size_t)1024 * 1024, WSP(unsigned char, WS_W2), (size_t)1024 * 1024, 1024, 1024, NE, scr, gw, NGW, lane, RmId());
    for (int id = F.vcu * NWAVES * 64 + F.tid; id < 32 * 2 * 64; id += F.G * NWAVES * 64) { const int ln = id & 63, nt = (id >> 6) & 1, ks = id >> 7, n = ln & 15, kq = ln >> 4;
        float hi[8], lo[8];
#pragma unroll
        for (int j = 0; j < 8; ++j) { const int d = 32 * ks + 8 * kq + j; const float v = F.in[12][d] * F.in[13][(size_t)d * 32 + 16 * nt + n]; hi[j] = bf2f(f2bf1(v)); lo[j] = v - hi[j]; }
        v4u oh, ol;
#pragma unroll
        for (int j = 0; j < 4; ++j) { oh[j] = cvtpk(hi[2 * j], hi[2 * j + 1]); ol[j] = cvtpk(lo[2 * j], lo[2 * j + 1]); }
        GAS v4u* W = (GAS v4u*)WSP(bf16, WS_WRF) + (size_t)((ks * 2 + nt) * 2) * 64 + ln; W[0] = oh; W[64] = ol; }
    for (int m0 = gw; m0 < T; m0 += 4 * NGW) {
        f32x4 v[4][4];
#pragma unroll
        for (int q = 0; q < 4; ++q) { const int m = m0 + q * NGW; const GAS f32x4* xr = (const GAS f32x4*)(F.in[0] + (size_t)(m < T ? m : 0) * D) + lane;
#pragma unroll
            for (int j = 0; j < 4; ++j) v[q][j] = __builtin_nontemporal_load(xr + 64 * j); }
#pragma unroll
        for (int q = 0; q < 4; ++q) { const int m = m0 + q * NGW; if (m >= T) break;
            float s2 = 0.f;
#pragma unroll
            for (int j = 0; j < 4; ++j) s2 += (v[q][j].x * v[q][j].x + v[q][j].y * v[q][j].y) + (v[q][j].z * v[q][j].z + v[q][j].w * v[q][j].w);
            const float rstd = 1.f / sqrtf(wave_sum(s2) * (1.f / D) + EPS);
            const GAS f32x4* gr = (const GAS f32x4*)F.in[2] + lane; GAS u32x2* o8 = (GAS u32x2*)(WSP(bf16, WS_XN) + (size_t)m * D) + lane;
#pragma unroll
            for (int j = 0; j < 4; ++j) { const f32x4 gg = gr[64 * j]; u32x2 w; w.x = cvtpk(v[q][j].x * rstd * gg.x, v[q][j].y * rstd * gg.y); w.y = cvtpk(v[q][j].z * rstd * gg.z, v[q][j].w * rstd * gg.w); o8[64 * j] = w; } }
    }
    for (int m0 = gw; m0 < T; m0 += 8 * NGW) {
        f32x4 v[8];
#pragma unroll
        for (int q = 0; q < 8; ++q) { const int m = m0 + q * NGW; v[q] = __builtin_nontemporal_load((const GAS f32x4*)(F.in[1] + (size_t)(m < T ? m : 0) * PLE) + lane); }
#pragma unroll
        for (int q = 0; q < 8; ++q) { const int m = m0 + q * NGW; if (m >= T) break; u32x2 w; w.x = cvtpk(v[q].x, v[q].y); w.y = cvtpk(v[q].z, v[q].w); *((GAS u32x2*)(WSP(bf16, WS_PB) + (size_t)m * PLE) + lane) = w; }
    }
}

constexpr int GL_B = 0, GL_GLR = 16640, GL_T1 = 20992, GL_T2 = 30208, GL_T3 = 39424, GL_VT = 48640;
__device__ __forceinline__ void gla_b(Frame& F, int n, int h) {
    LAS float* bL = (LAS float*)(F.lds + GL_B); LAS float* glrL = (LAS float*)(F.lds + GL_GLR);
    const bf16* PROJ = WSP(bf16, WS_PROJ); const int tid = F.tid, t0 = n * 64;
    { const int idx = tid * 2, t = idx >> 4, r = idx & 15; const unsigned w = *(const GAS unsigned*)(PROJ + (size_t)(t0 + t) * LDP + C_GLR + r); glrL[t * 17 + r] = bflo(w); glrL[t * 17 + r + 1] = bfhi(w); }
    const int d = tid & 63, tg = tid >> 6;
    float wg[16];
#pragma unroll
    for (int r = 0; r < 16; ++r) wg[r] = F.in[4][r * 256 + h * 64 + d];
    const float bias = F.in[5][h * 64 + d];
    lds_barrier();
#pragma unroll
    for (int tt = 0; tt < 8; ++tt) { const int t = tg * 8 + tt; float a = bias;
#pragma unroll
        for (int r = 0; r < 16; ++r) a += glrL[t * 17 + r] * wg[r];
        bL[t * 65 + d] = logsigf_(a) * 0.0625f; }
    lds_barrier();
    if (tid < 64) { float run = 0.f;
#pragma unroll 16
        for (int t = 0; t < 64; ++t) { run += bL[t * 65 + tid]; bL[t * 65 + tid] = run; } }
    lds_barrier();
}
__device__ __forceinline__ void gla_load_vT(Frame& F, int n, int h) {
    LAS bf16* vT = (LAS bf16*)(F.lds + GL_VT); const bf16* PROJ = WSP(bf16, WS_PROJ);
    const int t = F.tid >> 3, eg = F.tid & 7;
    const GAS v4u* src = (const GAS v4u*)(PROJ + (size_t)(n * 64 + t) * LDP + C_GV + h * 128 + eg * 16);
#pragma unroll
    for (int half = 0; half < 2; ++half) { const v4u w = src[half];
#pragma unroll
        for (int i = 0; i < 4; ++i) { const int e = eg * 16 + half * 8 + 2 * i; vT[e * 72 + t] = (bf16)(w[i] & 0xffffu); vT[(e + 1) * 72 + t] = (bf16)(w[i] >> 16); } }
}

__device__ __forceinline__ void gla_prep_item(Frame& F, int n, int h) {
    gla_b(F, n, h);
    LAS float* bL = (LAS float*)(F.lds + GL_B); LAS bf16* T1 = (LAS bf16*)(F.lds + GL_T1); LAS bf16* T2 = (LAS bf16*)(F.lds + GL_T2); LAS bf16* T3 = (LAS bf16*)(F.lds + GL_T3); LAS bf16* vT = (LAS bf16*)(F.lds + GL_VT);
    const bf16* PROJ = WSP(bf16, WS_PROJ); const int tid = F.tid, lane = F.lane, w = F.wave;
    const size_t nh = (size_t)(n * 4 + h);
    { const int t = tid >> 3, dg = tid & 7;
        const v4u qw = *(const GAS v4u*)(PROJ + (size_t)(n * 64 + t) * LDP + C_GQ + h * 64 + dg * 8); const v4u kw = *(const GAS v4u*)(PROJ + (size_t)(n * 64 + t) * LDP + C_GK + h * 64 + dg * 8);
        v4u qo, ko;
#pragma unroll
        for (int i = 0; i < 4; ++i) { const int d0 = dg * 8 + 2 * i; const float b0 = bL[t * 65 + d0], b1 = bL[t * 65 + d0 + 1], l0 = bL[63 * 65 + d0], l1 = bL[63 * 65 + d0 + 1];
            qo[i] = cvtpk(bflo(qw[i]) * 0.125f * __expf(b0), bfhi(qw[i]) * 0.125f * __expf(b1));
            ko[i] = cvtpk(bflo(kw[i]) * __expf(-b0), bfhi(kw[i]) * __expf(-b1));
            T3[d0 * 72 + t] = f2bf1(bflo(kw[i]) * __expf(l0 - b0)); T3[(d0 + 1) * 72 + t] = f2bf1(bfhi(kw[i]) * __expf(l1 - b1)); }
        *(LAS v4u*)(T1 + t * 72 + dg * 8) = qo; *(LAS v4u*)(T2 + t * 72 + dg * 8) = ko;
        *(GAS v4u*)(WSP(bf16, WS_QT) + (nh * 64 + t) * 64 + dg * 8) = qo; }
    gla_load_vT(F, n, h);
    lds_barrier();
    const int c = lane & 15, kq = lane >> 4;
    {
        bf16x8 a[2];
#pragma unroll
        for (int ks = 0; ks < 2; ++ks) a[ks] = *(const LAS bf16x8*)(vT + (16 * w + c) * 72 + 32 * ks + 8 * kq);
        float* KVT = WSP(float, WS_KVT) + nh * 128 * 64;
#pragma unroll
        for (int dt = 0; dt < 4; ++dt) { f32x4 acc = {0.f, 0.f, 0.f, 0.f};
#pragma unroll
            for (int ks = 0; ks < 2; ++ks) { const bf16x8 b = *(const LAS bf16x8*)(T3 + (16 * dt + c) * 72 + 32 * ks + 8 * kq); acc = MFMA16(a[ks], b, acc); }
#pragma unroll
            for (int r = 0; r < 4; ++r) KVT[(16 * w + 4 * kq + r) * 64 + 16 * dt + c] = acc[r]; }
        if (tid < 64) WSP(float, WS_DVEC)[nh * 64 + tid] = __expf(bL[63 * 65 + tid]);
    }
    {
        const int it = w & 3, eh = w >> 2;
        bf16x8 bq[2];
#pragma unroll
        for (int ks = 0; ks < 2; ++ks) bq[ks] = *(const LAS bf16x8*)(T1 + (16 * it + c) * 72 + 32 * ks + 8 * kq);
        f32x4 at[4];
#pragma unroll
        for (int jt = 0; jt < 4; ++jt) { f32x4 acc = {0.f, 0.f, 0.f, 0.f};
            if (jt <= it) {
#pragma unroll
                for (int ks = 0; ks < 2; ++ks) { const bf16x8 a = *(const LAS bf16x8*)(T2 + (16 * jt + c) * 72 + 32 * ks + 8 * kq); acc = MFMA16(a, bq[ks], acc); }
                if (jt == it) {
#pragma unroll
                    for (int r = 0; r < 4; ++r) if (4 * kq + r > c) acc[r] = 0.f; }
            }
            at[jt] = acc; }
        bf16x8 pb[2]; pb[0] = pack8(at[0], at[1]); pb[1] = pack8(at[2], at[3]);
        u32x2* OI = (u32x2*)WSP(bf16, WS_OI) + nh * 32 * 64;
#pragma unroll
        for (int q = 0; q < 4; ++q) { const int et = 4 * eh + q; f32x4 acc = {0.f, 0.f, 0.f, 0.f};
#pragma unroll
            for (int s2 = 0; s2 < 2; ++s2) { const bf16x4 lo = *(const LAS bf16x4*)(vT + (16 * et + c) * 72 + 32 * s2 + 4 * kq), hi = *(const LAS bf16x4*)(vT + (16 * et + c) * 72 + 32 * s2 + 16 + 4 * kq);
                acc = MFMA16(cat8(lo, hi), pb[s2], acc); }
            *(GAS u32x2*)(OI + (et * 4 + it) * 64 + lane) = pack4(acc); }
    }
    lds_barrier();
}

__device__ __forceinline__ void mix_epilogue_w(Frame& F, const f32x4 (&o)[8], int n, int it, const float* gain, int gate_col, int mix_col) {
    const int lane = F.lane, c = lane & 15, kq = lane >> 4;
    float ss = 0.f;
#pragma unroll
    for (int q = 0; q < 8; ++q)
#pragma unroll
        for (int r = 0; r < 4; ++r) ss += o[q][r] * o[q][r];
    ss += __shfl_xor(ss, 16); ss += __shfl_xor(ss, 32);
    const float rstd = 1.f / sqrtf(ss * (1.f / 128.f) + EPS);
    const int t = n * 64 + 16 * it + c;
    const bf16* PROJ = WSP(bf16, WS_PROJ); bf16* MIX = WSP(bf16, WS_MIX);
    u32x2 gw[8];
#pragma unroll
    for (int q = 0; q < 8; ++q) gw[q] = *(const GAS u32x2*)(PROJ + (size_t)t * LDP + gate_col + 16 * q + 4 * kq);
#pragma unroll
    for (int q = 0; q < 8; ++q) { const int e = 16 * q + 4 * kq; const f32x4 gn = *(const GAS f32x4*)(gain + e);
        f32x4 v; v[0] = o[q][0] * rstd * gn[0] * siluf_(bflo(gw[q].x)); v[1] = o[q][1] * rstd * gn[1] * siluf_(bfhi(gw[q].x)); v[2] = o[q][2] * rstd * gn[2] * siluf_(bflo(gw[q].y)); v[3] = o[q][3] * rstd * gn[3] * siluf_(bfhi(gw[q].y));
        *(GAS u32x2*)(MIX + (size_t)t * D + mix_col + e) = pack4(v); }
}
__device__ __forceinline__ void gla_out_wave(Frame& F, int n, int h, int it) {
    const int lane = F.lane, c = lane & 15, kq = lane >> 4; const size_t nh = (size_t)(n * 4 + h);
    const bf16* QT = WSP(bf16, WS_QT) + (nh * 64 + 16 * it + c) * 64; const bf16* ST = WSP(bf16, WS_SGLA) + nh * 128 * 64; const u32x2* OI = (const u32x2*)WSP(bf16, WS_OI) + nh * 32 * 64;
    bf16x8 bq[2], as[8][2]; u32x2 oi[8];
#pragma unroll
    for (int ks = 0; ks < 2; ++ks) bq[ks] = *(const GAS bf16x8*)(QT + 32 * ks + 8 * kq);
#pragma unroll
    for (int q = 0; q < 8; ++q) { oi[q] = *(const GAS u32x2*)(OI + (q * 4 + it) * 64 + lane);
#pragma unroll
        for (int ks = 0; ks < 2; ++ks) as[q][ks] = *(const GAS bf16x8*)(ST + (16 * q + c) * 64 + 32 * ks + 8 * kq); }
    __builtin_amdgcn_sched_barrier(0);
    f32x4 o[8];
#pragma unroll
    for (int q = 0; q < 8; ++q) { f32x4 acc = {bflo(oi[q].x), bfhi(oi[q].x), bflo(oi[q].y), bfhi(oi[q].y)};
#pragma unroll
        for (int ks = 0; ks < 2; ++ks) acc = MFMA16(as[q][ks], bq[ks], acc);
        o[q] = acc; }
    mix_epilogue_w(F, o, n, it, F.in[6], C_GR + h * 128, h * 128);
}
__device__ __forceinline__ void gdn_out_wave(Frame& F, int n, int h, int it) {
    const int lane = F.lane, c = lane & 15, kq = lane >> 4; const size_t nh = (size_t)(n * 4 + h);
    const bf16* QD = WSP(bf16, WS_QDEC) + (nh * 64 + 16 * it + c) * 128; const bf16* AQ = WSP(bf16, WS_AQK) + (nh * 64 + 16 * it + c) * 64;
    const bf16* ST = WSP(bf16, WS_SGDN) + nh * 128 * 128; const bf16* DT = WSP(bf16, WS_DELTA) + nh * 128 * 64;
    bf16x8 bqd[4], baq[2];
#pragma unroll
    for (int ks = 0; ks < 4; ++ks) bqd[ks] = *(const GAS bf16x8*)(QD + 32 * ks + 8 * kq);
#pragma unroll
    for (int s2 = 0; s2 < 2; ++s2) baq[s2] = *(const GAS bf16x8*)(AQ + 32 * s2 + 8 * kq);
    f32x4 o[8];
#pragma unroll
    for (int hf = 0; hf < 2; ++hf) {
        bf16x8 as[4][4], ad[4][2];
#pragma unroll
        for (int q = 0; q < 4; ++q) { const int et = 4 * hf + q;
#pragma unroll
            for (int ks = 0; ks < 4; ++ks) as[q][ks] = *(const GAS bf16x8*)(ST + (16 * et + c) * 128 + 32 * ks + 8 * kq);
#pragma unroll
            for (int s2 = 0; s2 < 2; ++s2) ad[q][s2] = *(const GAS bf16x8*)(DT + (16 * et + c) * 64 + 32 * s2 + 8 * kq); }
        __builtin_amdgcn_sched_barrier(0);
#pragma unroll
        for (int q = 0; q < 4; ++q) { f32x4 acc = {0.f, 0.f, 0.f, 0.f};
#pragma unroll
            for (int ks = 0; ks < 4; ++ks) acc = MFMA16(as[q][ks], bqd[ks], acc);
#pragma unroll
            for (int s2 = 0; s2 < 2; ++s2) acc = MFMA16(ad[q][s2], baq[s2], acc);
            o[4 * hf + q] = acc; }
        __builtin_amdgcn_sched_barrier(0);
    }
    mix_epilogue_w(F, o, n, it, F.in[10], C_DZ + h * 128, 512 + h * 128);
}

constexpr int GD_QB = 0, GD_KB = 17408, GD_VB = 34816, GD_LS = 52224, GD_LB = 68608, GD_TB = 77824, GD_XT = 80896, GD_SC = 117760;
__device__ __forceinline__ void gdn_prep_item(Frame& F, int n, int h) {
    LAS bf16* qb = (LAS bf16*)(F.lds + GD_QB); LAS bf16* kb = (LAS bf16*)(F.lds + GD_KB); LAS bf16* vb = (LAS bf16*)(F.lds + GD_VB);
    LAS float* Ls = (LAS float*)(F.lds + GD_LS); LAS bf16* Lb = (LAS bf16*)(F.lds + GD_LB); LAS bf16* Tb = (LAS bf16*)(F.lds + GD_TB); LAS bf16* XT = (LAS bf16*)(F.lds + GD_XT);
    LAS float* bS = (LAS float*)(F.lds + GD_SC); LAS float* betaS = bS + 64; LAS float* ebS = bS + 128;
    const bf16* PROJ = WSP(bf16, WS_PROJ); const int tid = F.tid, lane = F.lane, w = F.wave, t0 = n * 64;
    const size_t nh = (size_t)(n * 4 + h);
    if (tid < 64) {
        const float da = bf2f(PROJ[(size_t)(t0 + tid) * LDP + C_DA + h]), db = bf2f(PROJ[(size_t)(t0 + tid) * LDP + C_DB + h]);
        float g = -__expf(F.in[8][h]) * softplusf_(da + F.in[9][h]);
#pragma unroll
        for (int off = 1; off < 64; off <<= 1) { const float v = __shfl_up(g, off); if (lane >= off) g += v; }
        bS[tid] = g; betaS[tid] = sigm(db); ebS[tid] = __expf(g);
    }
    if (!(MK_DBG & 2) && lane < 48) {
        const int grp = lane >> 4, c8 = (lane & 15) * 8;
        const int colP = C_DQ + grp * 512 + h * 128 + c8;
        f32x4 wc[4][2];
#pragma unroll
        for (int j = 0; j < 4; ++j) { const GAS f32x4* wp = (const GAS f32x4*)(F.in[7] + (size_t)j * 1536 + grp * 512 + h * 128 + c8); wc[j][0] = wp[0]; wc[j][1] = wp[1]; }
        v4u xin[11];
#pragma unroll
        for (int rr = 0; rr < 11; ++rr) { const int r = t0 + w * 8 - 3 + rr; xin[rr] = (v4u){0, 0, 0, 0}; if (r >= 0) xin[rr] = *(const GAS v4u*)(PROJ + (size_t)r * LDP + colP); }
#pragma unroll
        for (int tt = 0; tt < 8; ++tt) {
            float y[8];
#pragma unroll
            for (int i = 0; i < 8; ++i) y[i] = 0.f;
#pragma unroll
            for (int j = 0; j < 4; ++j)
#pragma unroll
                for (int i = 0; i < 4; ++i) { const unsigned xw = xin[tt + j][i]; y[2 * i] += wc[j][i >> 1][(2 * i) & 3] * bflo(xw); y[2 * i + 1] += wc[j][i >> 1][(2 * i + 1) & 3] * bfhi(xw); }
            float ss = 0.f;
#pragma unroll
            for (int i = 0; i < 8; ++i) { y[i] = siluf_(y[i]); ss += y[i] * y[i]; }
            ss += __shfl_xor(ss, 1); ss += __shfl_xor(ss, 2); ss += __shfl_xor(ss, 4); ss += __shfl_xor(ss, 8);
            const int row = w * 8 + tt;
            const float sc = grp == 2 ? 1.0f : (1.f / sqrtf(ss + EPS)) * (grp == 0 ? 0.08838834764831845f : 1.0f);
            v4u o; o.x = cvtpk(y[0] * sc, y[1] * sc); o.y = cvtpk(y[2] * sc, y[3] * sc); o.z = cvtpk(y[4] * sc, y[5] * sc); o.w = cvtpk(y[6] * sc, y[7] * sc);
            *(LAS v4u*)((grp == 0 ? qb : (grp == 1 ? kb : vb)) + row * 136 + c8) = o;
        }
    }
    lds_barrier();
    if (!(MK_DBG & 4)) {
        const int c = lane & 15, kq = lane >> 4;
        bf16* AQ = WSP(bf16, WS_AQK) + nh * 64 * 64;
        for (int job = w; job < 20; job += 8) {
            const int kind = job >= 10 ? 1 : 0, idx = job - 10 * kind;
            const int it = idx >= 6 ? 3 : (idx >= 3 ? 2 : (idx >= 1 ? 1 : 0)), jt = idx - (it * (it + 1)) / 2;
            const LAS bf16* Am = kind ? qb : kb;
            f32x4 acc = {0.f, 0.f, 0.f, 0.f};
#pragma unroll
            for (int ks = 0; ks < 4; ++ks) { const bf16x8 a = *(const LAS bf16x8*)(Am + (16 * it + c) * 136 + 32 * ks + 8 * kq), b = *(const LAS bf16x8*)(kb + (16 * jt + c) * 136 + 32 * ks + 8 * kq); acc = MFMA16(a, b, acc); }
            const int j = 16 * jt + c; const float bj = bS[j];
#pragma unroll
            for (int r = 0; r < 4; ++r) { const int i = 16 * it + 4 * kq + r; const float dec = __expf(fminf(bS[i] - bj, 0.f));
                if (kind == 0) Ls[i * 64 + j] = (j < i) ? betaS[i] * dec * acc[r] : 0.f;
                else { AQ[i * 64 + j] = (j <= i) ? f2bf1(dec * acc[r]) : (bf16)0; if (jt < it) AQ[(16 * jt + 4 * kq + r) * 64 + 16 * it + c] = (bf16)0; } }
        }
    }
    lds_barrier();
    { const int i = tid >> 3, c0 = (tid & 7) * 8; v4u o;
#pragma unroll
      for (int x = 0; x < 4; ++x) { const int col = c0 + 2 * x; const bool up = (col >> 4) > (i >> 4); o[x] = up ? 0u : cvtpk(-Ls[i * 64 + col], -Ls[i * 64 + col + 1]); }
      *(LAS v4u*)(Lb + i * 72 + c0) = o;
      for (int x = tid; x < 256 * 72 / 8; x += 512) *(LAS v4u*)(XT + x * 8) = (v4u){0u, 0u, 0u, 0u}; }
    if ((MK_DBG & 8) && tid < 64) {} else if (tid < 64) { const int b = tid >> 4, cc = tid & 15; float x[16];
#pragma unroll
        for (int i = 0; i < 16; ++i) { float a = (i == cc) ? 1.f : 0.f;
#pragma unroll
            for (int j = 0; j < i; ++j) a -= Ls[(16 * b + i) * 64 + 16 * b + j] * x[j];
            x[i] = a; Tb[(16 * b + i) * 24 + cc] = f2bf1(a); }
    } else if (!(MK_DBG & 16) && tid >= 256) {
        const int tt = tid - 256; const float bl = bS[63];
        bf16* QD = WSP(bf16, WS_QDEC) + nh * 64 * 128;
#pragma unroll 1
        for (int j = 0; j < 4; ++j) { const int id = tt + 256 * j, i = id >> 4, c8 = (id & 15) * 8; const v4u qw = *(const LAS v4u*)(qb + i * 136 + c8); const float e = ebS[i];
            v4u o; o.x = cvtpk(bflo(qw.x) * e, bfhi(qw.x) * e); o.y = cvtpk(bflo(qw.y) * e, bfhi(qw.y) * e); o.z = cvtpk(bflo(qw.z) * e, bfhi(qw.z) * e); o.w = cvtpk(bflo(qw.w) * e, bfhi(qw.w) * e);
            *(GAS v4u*)(QD + i * 128 + c8) = o; }
        bf16* KDF = WSP(bf16, WS_KDF) + nh * 16 * 512;
#pragma unroll 1
        for (int j = 0; j < 4; ++j) { const int id = tt + 256 * j, f = id >> 6, ln = id & 63, dt = f >> 1, ks2 = f & 1, q = ln >> 4, m = ln & 15, d = 16 * dt + m;
            float v[8];
#pragma unroll
            for (int x = 0; x < 8; ++x) { const int i = 32 * ks2 + (x < 4 ? 4 * q + x : 16 + 4 * q + (x - 4)); v[x] = bf2f(kb[i * 136 + d]) * __expf(bl - bS[i]); }
            v4u o; o.x = cvtpk(v[0], v[1]); o.y = cvtpk(v[2], v[3]); o.z = cvtpk(v[4], v[5]); o.w = cvtpk(v[6], v[7]);
            *(GAS v4u*)(KDF + ((size_t)f * 64 + ln) * 8) = o; }
        if (tt == 0) WSP(float, WS_CDEC)[nh] = __expf(bl);
    }
    lds_barrier();
    if (!(MK_DBG & 32)) { const int c = lane & 15, kq = lane >> 4;
      f32x4* UFp = (f32x4*)WSP(float, WS_UF) + nh * 8 * 4 * 64;
      const f32x4 z4 = {0.f, 0.f, 0.f, 0.f};
#pragma unroll
      for (int b = 0; b < 4; ++b) {
          const bf16x4 tlo = *(const LAS bf16x4*)(Tb + (16 * b + c) * 24 + 4 * kq); const bf16x8 ta = cat8(tlo, (bf16x4){0, 0, 0, 0});
#pragma unroll
          for (int t2 = 0; t2 < 2; ++t2) { const int ct = 2 * w + t2, col = 16 * ct + c; const bool isu = ct < 8;
              f32x4 acc;
#pragma unroll
              for (int r = 0; r < 4; ++r) { const int i = 16 * b + 4 * kq + r; acc[r] = isu ? betaS[i] * bf2f(vb[i * 136 + (col & 127)]) : betaS[i] * ebS[i] * bf2f(kb[i * 136 + (col & 127)]); }
#pragma unroll
              for (int ks = 0; ks < (b + 1) / 2; ++ks) acc = MFMA16(*(const LAS bf16x8*)(Lb + (16 * b + c) * 72 + 32 * ks + 8 * kq), *(const LAS bf16x8*)(XT + col * 72 + 32 * ks + 8 * kq), acc);
              const f32x4 x = MFMA16(ta, pack8(acc, z4), z4);
              *(LAS u32x2*)(XT + col * 72 + 16 * b + 4 * kq) = pack4(x);
              if (isu) UFp[(ct * 4 + b) * 64 + lane] = x;
          }
      }
    }
    lds_barrier();
    { bf16* WF = WSP(bf16, WS_WF) + nh * 16 * 512;
#pragma unroll
      for (int j = 0; j < 2; ++j) { const int id = tid + 512 * j, f = id >> 6, ln = id & 63, mt = f >> 2, ks = f & 3, q = ln >> 4, m = ln & 15, i = 16 * mt + m;
          unsigned wv[4];
#pragma unroll
          for (int x = 0; x < 4; ++x) { const int d0 = 32 * ks + (x < 2 ? 4 * q + 2 * x : 16 + 4 * q + 2 * (x - 2));
              const unsigned lo = XT[(128 + d0) * 72 + i], hi = XT[(128 + d0 + 1) * 72 + i]; wv[x] = (lo | (hi << 16)) ^ 0x80008000u; }
          *(GAS v4u*)(WF + ((size_t)f * 64 + ln) * 8) = (v4u){wv[0], wv[1], wv[2], wv[3]}; } }
}

template <int MODE>
__device__ __forceinline__ void gdn_group_scan(Frame& F, int grp, int h) {
    const int tid = F.tid, lane = F.lane, w = F.wave, c = lane & 15, kq = lane >> 4, n0 = grp * GRP;
    const v4u* WF = (const v4u*)WSP(bf16, WS_WF); const v4u* KDF = (const v4u*)WSP(bf16, WS_KDF); const f32x4* UF = (const f32x4*)WSP(float, WS_UF);
    const float* CDEC = WSP(float, WS_CDEC); bf16* SG = WSP(bf16, WS_SGDN); bf16* DL = WSP(bf16, WS_DELTA);
    {   v4u t[GRP][4];
#pragma unroll
        for (int i = 0; i < GRP; ++i) { const size_t nh = (size_t)((n0 + i) * 4 + h);
#pragma unroll
            for (int j = 0; j < 2; ++j) { t[i][j] = WF[nh * 1024 + tid + 512 * j]; t[i][2 + j] = KDF[nh * 1024 + tid + 512 * j]; } }
#pragma unroll
        for (int i = 0; i < GRP; ++i)
#pragma unroll
            for (int j = 0; j < 2; ++j) { *(LAS v4u*)(F.lds + i * 32768 + (tid + 512 * j) * 16) = t[i][j]; *(LAS v4u*)(F.lds + i * 32768 + 16384 + (tid + 512 * j) * 16) = t[i][2 + j]; } }
    f32x4 S[8], P[8];
    if (MODE == 1) { const f32x4* SST = (const f32x4*)WSP(float, WS_SST) + (size_t)(((grp * 4 + h) * 8 + w) * 8) * 64;
#pragma unroll
        for (int i = 0; i < 8; ++i) S[i] = SST[i * 64 + lane];
    } else {
#pragma unroll
        for (int i = 0; i < 8; ++i) { S[i] = (f32x4){0.f, 0.f, 0.f, 0.f};
#pragma unroll
            for (int r = 0; r < 4; ++r) P[i][r] = ((16 * i + 4 * kq + r) == 16 * w + c) ? 1.f : 0.f; }
    }
    f32x4 u[GRP][4]; float cd[GRP];
#pragma unroll
    for (int i = 0; i < GRP; ++i) { const size_t nh = (size_t)((n0 + i) * 4 + h); cd[i] = CDEC[nh];
#pragma unroll
        for (int mt = 0; mt < 4; ++mt) u[i][mt] = UF[((nh * 8 + w) * 4 + mt) * 64 + lane]; }
    lds_barrier();
#pragma unroll
    for (int i = 0; i < GRP; ++i) {
        const size_t nh = (size_t)((n0 + i) * 4 + h);
        const LAS unsigned char* wl = F.lds + i * 32768 + lane * 16; const LAS unsigned char* kl = wl + 16384;
        if (MODE == 1) { bf16* sg = SG + (nh * 128 + 16 * w + c) * 128 + 4 * kq;
#pragma unroll
            for (int dt = 0; dt < 8; ++dt) *(GAS u32x2*)(sg + 16 * dt) = pack4(S[dt]); }
        f32x4 dl[4], dp[4];
#pragma unroll
        for (int mt = 0; mt < 4; ++mt) { dl[mt] = u[i][mt]; dp[mt] = (f32x4){0.f, 0.f, 0.f, 0.f}; }
#pragma unroll
        for (int ks = 0; ks < 4; ++ks) { const bf16x8 sb = pack8(S[2 * ks], S[2 * ks + 1]); bf16x8 pb; if (MODE == 0) pb = pack8(P[2 * ks], P[2 * ks + 1]);
#pragma unroll
            for (int mt = 0; mt < 4; ++mt) { const bf16x8 a = *(const LAS bf16x8*)(wl + (mt * 4 + ks) * 1024); dl[mt] = MFMA16(a, sb, dl[mt]); if (MODE == 0) dp[mt] = MFMA16(a, pb, dp[mt]); } }
        if (MODE == 1) { bf16* dq = DL + (nh * 128 + 16 * w + c) * 64 + 4 * kq;
#pragma unroll
            for (int mt = 0; mt < 4; ++mt) *(GAS u32x2*)(dq + 16 * mt) = pack4(dl[mt]); }
#pragma unroll
        for (int dt = 0; dt < 8; ++dt) { S[dt] = S[dt] * cd[i]; if (MODE == 0) P[dt] = P[dt] * cd[i]; }
#pragma unroll
        for (int ks2 = 0; ks2 < 2; ++ks2) { const bf16x8 db = pack8(dl[2 * ks2], dl[2 * ks2 + 1]); bf16x8 qb; if (MODE == 0) qb = pack8(dp[2 * ks2], dp[2 * ks2 + 1]);
#pragma unroll
            for (int dt = 0; dt < 8; ++dt) { const bf16x8 a = *(const LAS bf16x8*)(kl + (dt * 2 + ks2) * 1024); S[dt] = MFMA16(a, db, S[dt]); if (MODE == 0) P[dt] = MFMA16(a, qb, P[dt]); } }
    }
    if (MODE == 0) {
        f32x4* SLE = (f32x4*)WSP(float, WS_SLE) + (size_t)(((grp * 4 + h) * 8 + w) * 8) * 64;
#pragma unroll
        for (int dt = 0; dt < 8; ++dt) SLE[dt * 64 + lane] = S[dt];
        bf16* PE = WSP(bf16, WS_PEND) + (size_t)(grp * 4 + h) * 32 * 512; const int ks = w >> 1, lq = (2 * (w & 1) + (c >> 3)) * 16 + 4 * kq, idx = c & 7;
#pragma unroll
        for (int dt = 0; dt < 8; ++dt)
#pragma unroll
            for (int r = 0; r < 4; ++r) PE[((size_t)(dt * 4 + ks) * 64 + lq + r) * 8 + idx] = f2bf1(P[dt][r]);
    }
    lds_barrier();
}
__device__ __forceinline__ void gdn_scan_groups(Frame& F, int h, int s) {
    const int lane = F.lane, w = F.wave, c = lane & 15, kq = lane >> 4;
    LAS bf16* STb = (LAS bf16*)F.lds;
    const bf16x8* PEND = (const bf16x8*)WSP(bf16, WS_PEND); const f32x4* SLE = (const f32x4*)WSP(float, WS_SLE); f32x4* SST = (f32x4*)WSP(float, WS_SST);
    f32x4 S = {0.f, 0.f, 0.f, 0.f};
    *(LAS u32x2*)(STb + c * 136 + 16 * w + 4 * kq) = (u32x2){0u, 0u};
    bf16x8 pe[4], pn[4]; f32x4 sle, sln;
#pragma unroll
    for (int ks = 0; ks < 4; ++ks) pe[ks] = PEND[((size_t)h * 32 + w * 4 + ks) * 64 + lane];
    sle = SLE[(((size_t)h * 8 + s) * 8 + w) * 64 + lane];
    lds_barrier();
    for (int g = 0; g < NGRP; ++g) {
        const size_t gh = (size_t)(g * 4 + h);
        SST[((gh * 8 + s) * 8 + w) * 64 + lane] = S;
        if (g + 1 == NGRP) break;
        { const size_t gh1 = (size_t)((g + 1) * 4 + h);
#pragma unroll
          for (int ks = 0; ks < 4; ++ks) pn[ks] = PEND[(gh1 * 32 + w * 4 + ks) * 64 + lane];
          sln = SLE[((gh1 * 8 + s) * 8 + w) * 64 + lane]; }
        const LAS bf16* st = STb + (g & 1) * 16 * 136 + c * 136 + 8 * kq;
        f32x4 acc = sle;
#pragma unroll
        for (int ks = 0; ks < 4; ++ks) acc = MFMA16(pe[ks], *(const LAS bf16x8*)(st + 32 * ks), acc);
        S = acc;
        *(LAS u32x2*)(STb + ((g + 1) & 1) * 16 * 136 + c * 136 + 16 * w + 4 * kq) = pack4(S);
#pragma unroll
        for (int ks = 0; ks < 4; ++ks) pe[ks] = pn[ks];
        sle = sln;
        lds_barrier();
    }
    lds_barrier();
}
template <int MODE>
__device__ __forceinline__ void gla_scan_range(Frame& F, int grp, int gid) {
    const int h = gid >> 11, rem = gid & 2047, e = rem >> 4, dg = rem & 15, n0 = grp * GRP;
    const float* KVT = WSP(float, WS_KVT); const float* DV = WSP(float, WS_DVEC); bf16* SG = WSP(bf16, WS_SGLA);
    f32x4 kv[GRP], dv[GRP];
#pragma unroll
    for (int i = 0; i < GRP; ++i) { const size_t nh = (size_t)((n0 + i) * 4 + h); kv[i] = *(const GAS f32x4*)(KVT + (nh * 128 + e) * 64 + 4 * dg); dv[i] = *(const GAS f32x4*)(DV + nh * 64 + 4 * dg); }
    f32x4 S = {0.f, 0.f, 0.f, 0.f}, P = {1.f, 1.f, 1.f, 1.f};
    if (MODE == 1) S = *((const GAS f32x4*)WSP(float, WS_GSST) + (size_t)grp * 8192 + gid);
#pragma unroll
    for (int i = 0; i < GRP; ++i) { const size_t nh = (size_t)((n0 + i) * 4 + h);
        if (MODE == 1) *(GAS u32x2*)(SG + (nh * 128 + e) * 64 + 4 * dg) = pack4(S);
        S = dv[i] * S + kv[i]; if (MODE == 0) P = P * dv[i]; }
    if (MODE == 0) { *((GAS f32x4*)WSP(float, WS_GSLE) + (size_t)grp * 8192 + gid) = S; *((GAS f32x4*)WSP(float, WS_GPD) + (size_t)grp * 8192 + gid) = P; }
}
__device__ __forceinline__ void gla_scan_groups(Frame& F, int gid) {
    f32x4 S = {0.f, 0.f, 0.f, 0.f};
    for (int g0 = 0; g0 < NGRP; g0 += 16) {
        f32x4 sl[16], pd[16];
#pragma unroll
        for (int g = 0; g < 16; ++g) { sl[g] = *((const GAS f32x4*)WSP(float, WS_GSLE) + (size_t)(g0 + g) * 8192 + gid); pd[g] = *((const GAS f32x4*)WSP(float, WS_GPD) + (size_t)(g0 + g) * 8192 + gid); }
#pragma unroll
        for (int g = 0; g < 16; ++g) { *((GAS f32x4*)WSP(float, WS_GSST) + (size_t)(g0 + g) * 8192 + gid) = S; S = pd[g] * S + sl[g]; }
    }
}

__device__ __forceinline__ void route_phase(Frame& F, int rep) {
    const int tid = F.tid, lane = F.lane, w = F.wave, c = lane & 15, kq = lane >> 4, tile = w & 3, kh = w >> 2;
    unsigned* cnt = (unsigned*)(F.ctl + CW_CNT) + rep * 32;
    LAS int* lcnt = (LAS int*)(F.lds + ROUTE_OFF); LAS int* gbase = lcnt + 32; LAS int* te = lcnt + 64; LAS int* ts = te + 256; LAS float* tg = (LAS float*)(ts + 256);
    LAS float* part = (LAS float*)(F.lds + RING_OFF);
    const size_t roff = (size_t)rep * (WS_PROJ - WS_TOKE), xoff = (size_t)rep * (WS_PROJ + 8 * MiB - WS_XN), soff = (size_t)rep * (WS_PROJ + 40 * MiB - WS_RSTD);
    const v4u* WRF = (const v4u*)WSP(bf16, WS_WRF);
    for (int blk = F.vcu; blk < T / 64; blk += F.G) {
        if (tid < 32) lcnt[tid] = 0;
        const int t = blk * 64 + tile * 16 + c;
        const GAS f32x4* xr = (const GAS f32x4*)(F.out + (size_t)t * D) + 2 * kq; const GAS f32x4* gr = (const GAS f32x4*)F.in[12] + 2 * kq;
        GAS u32x2* xq = (GAS u32x2*)(WSP(unsigned char, WS_XN + xoff) + (size_t)t * D) + kq;
        f32x4 acc0 = {0.f, 0.f, 0.f, 0.f}, acc1 = {0.f, 0.f, 0.f, 0.f}; float ss = 0.f;
#pragma unroll 4
        for (int ks = kh * 16; ks < kh * 16 + 16; ++ks) {
            const f32x4 x0 = xr[8 * ks], x1 = xr[8 * ks + 1], g0 = gr[8 * ks], g1 = gr[8 * ks + 1];
            const v4u bh0 = WRF[(size_t)((ks * 2 + 0) * 2 + 0) * 64 + lane], bl0 = WRF[(size_t)((ks * 2 + 0) * 2 + 1) * 64 + lane], bh1 = WRF[(size_t)((ks * 2 + 1) * 2 + 0) * 64 + lane], bl1 = WRF[(size_t)((ks * 2 + 1) * 2 + 1) * 64 + lane];
            ss += (x0[0] * x0[0] + x0[1] * x0[1]) + (x0[2] * x0[2] + x0[3] * x0[3]) + (x1[0] * x1[0] + x1[1] * x1[1]) + (x1[2] * x1[2] + x1[3] * x1[3]);
            v4u hi; hi[0] = cvtpk(x0[0], x0[1]); hi[1] = cvtpk(x0[2], x0[3]); hi[2] = cvtpk(x1[0], x1[1]); hi[3] = cvtpk(x1[2], x1[3]);
            v4u lo; lo[0] = cvtpk(x0[0] - bflo(hi[0]), x0[1] - bfhi(hi[0])); lo[1] = cvtpk(x0[2] - bflo(hi[1]), x0[3] - bfhi(hi[1])); lo[2] = cvtpk(x1[0] - bflo(hi[2]), x1[1] - bfhi(hi[2])); lo[3] = cvtpk(x1[2] - bflo(hi[3]), x1[3] - bfhi(hi[3]));
            u32x2 q8; q8.x = pg8::cvt4_fp8(x0[0] * g0[0], x0[1] * g0[1], x0[2] * g0[2], x0[3] * g0[3]); q8.y = pg8::cvt4_fp8(x1[0] * g1[0], x1[1] * g1[1], x1[2] * g1[2], x1[3] * g1[3]);
            xq[4 * ks] = q8;
            const bf16x8 ah = __builtin_bit_cast(bf16x8, hi), al = __builtin_bit_cast(bf16x8, lo);
            acc0 = MFMA16(ah, __builtin_bit_cast(bf16x8, bh0), acc0); acc0 = MFMA16(ah, __builtin_bit_cast(bf16x8, bl0), acc0); acc0 = MFMA16(al, __builtin_bit_cast(bf16x8, bh0), acc0);
            acc1 = MFMA16(ah, __builtin_bit_cast(bf16x8, bh1), acc1); acc1 = MFMA16(ah, __builtin_bit_cast(bf16x8, bl1), acc1); acc1 = MFMA16(al, __builtin_bit_cast(bf16x8, bh1), acc1);
        }
        ss += __shfl_xor(ss, 16); ss += __shfl_xor(ss, 32);
        if (kh == 1) { LAS float* p = part + (tile * 64 + lane) * 12; *(LAS f32x4*)p = acc0; *(LAS f32x4*)(p + 4) = acc1; p[8] = ss; }
        lds_barrier();
        if (kh == 0) {
            const LAS float* p = part + (tile * 64 + lane) * 12; acc0 = acc0 + *(const LAS f32x4*)p; acc1 = acc1 + *(const LAS f32x4*)(p + 4); ss += p[8];
            const float rstd = 1.f / sqrtf(ss * (1.f / D) + EPS);
            if (kq == 0) WSP(float, WS_RSTD + soff)[t] = rstd;
            const float b0 = F.in[14][c], b1 = F.in[14][16 + c];
#pragma unroll
            for (int r = 0; r < 4; ++r) {
                const int tr = 4 * kq + r, tl = tile * 16 + tr;
                const float rs = __shfl(rstd, tr);
                const float l0 = acc0[r] * rs + b0, l1 = acc1[r] * rs + b1;
                unsigned k0, k1; { const unsigned u0 = __float_as_uint(l0), u1 = __float_as_uint(l1);
                    k0 = (((u0 & 0x80000000u) ? ~u0 : (u0 | 0x80000000u)) & ~31u) | (unsigned)(31 - c); k1 = (((u1 & 0x80000000u) ? ~u1 : (u1 | 0x80000000u)) & ~31u) | (unsigned)(15 - c); }
                int sel[4]; float val[4];
#pragma unroll
                for (int k = 0; k < 4; ++k) { unsigned m = k0 > k1 ? k0 : k1;
#pragma unroll
                    for (int o = 1; o < 16; o <<= 1) { const unsigned other = (unsigned)__shfl_xor((int)m, o); m = other > m ? other : m; }
                    const int bi = 31 - (int)(m & 31u); sel[k] = bi;
                    const float v0 = __shfl(l0, (lane & 48) + (bi & 15)), v1 = __shfl(l1, (lane & 48) + (bi & 15)); val[k] = bi < 16 ? v0 : v1;
                    if (c == (bi & 15)) { if (bi < 16) k0 = 0u; else k1 = 0u; } }
                const float e1 = __expf(val[1] - val[0]), e2 = __expf(val[2] - val[0]), e3 = __expf(val[3] - val[0]); const float inv = 1.f / (1.f + e1 + e2 + e3);
                if (c < 4) { const int ek = c == 0 ? sel[0] : (c == 1 ? sel[1] : (c == 2 ? sel[2] : sel[3])); const float gk = (c == 0 ? 1.f : (c == 1 ? e1 : (c == 2 ? e2 : e3))) * inv;
                    const int ls = __hip_atomic_fetch_add(lcnt + ek, 1, __ATOMIC_RELAXED, __HIP_MEMORY_SCOPE_WORKGROUP);
                    te[tl * 4 + c] = ek; ts[tl * 4 + c] = ls; tg[tl * 4 + c] = gk; }
            }
        }
        lds_barrier();
        if (tid < 32) gbase[tid] = (int)atomicAdd(cnt + tid * 64, (unsigned)lcnt[tid]);
        lds_barrier();
        if (tid < 256) { const int tt = blk * 64 + (tid >> 2), k = tid & 3, e = te[tid];
            WSP(int, WS_TOKE + roff)[tt * 4 + k] = e; WSP(int, WS_TOKS + roff)[tt * 4 + k] = gbase[e] + ts[tid]; WSP(float, WS_TOKG + roff)[tt * 4 + k] = tg[tid]; }
        lds_barrier();
    }
}
__device__ __forceinline__ void moe_tables(Frame& F) {
    LAS int* tile_e = (LAS int*)(F.lds + TILEE_OFF); LAS int* baseL = (LAS int*)(F.lds + BASE_OFF);
    if (F.tid < 64) { const int e = F.lane & 31; const unsigned c = __hip_atomic_load((unsigned*)(F.ctl + CW_CNT) + e * 64, RLX_AGENT);
        const int nt = (int)((c + 255u) >> 8); int incl = nt;
#pragma unroll
        for (int off = 1; off < 32; off <<= 1) { const int v = __shfl_up(incl, off); if ((F.lane & 31) >= off) incl += v; }
        const int tb = incl - nt;
        if (F.lane < 32) { baseL[e] = tb * 256; for (int i = 0; i < nt; ++i) tile_e[tb + i] = e; if (e == 31) tile_e[319] = incl; } }
    lds_barrier();
}
__device__ __forceinline__ void scatter_phase(Frame& F) {
    moe_tables(F);
    LAS int* baseL = (LAS int*)(F.lds + BASE_OFF);
    const int gt = F.vcu * NWAVES * 64 + F.tid, NGT = F.G * NWAVES * 64;
    for (int i = gt; i < T * 4; i += NGT) { const int e = WSP(int, WS_TOKE)[i], pos = baseL[e] + WSP(int, WS_TOKS)[i];
        WSP(int, WS_TOKP)[i] = pos; WSP(float, WS_GPOS)[pos] = WSP(float, WS_TOKG)[i]; WSP(int, WS_TOKQ)[pos] = i >> 2; WSP(float, WS_RPOS)[pos] = WSP(float, WS_RSTD)[i >> 2]; }
    if (F.vcu < NE) { const int e = F.vcu; const unsigned c = __hip_atomic_load((unsigned*)(F.ctl + CW_CNT) + e * 64, RLX_AGENT); const int lo = baseL[e] + (int)c, hi = baseL[e] + (int)((c + 255u) & ~255u);
        for (int p = lo + F.tid; p < hi; p += NWAVES * 64) WSP(int, WS_TOKQ)[p] = 0; }
}
__device__ __forceinline__ void combine_phase(Frame& F, int rep) {
    const int gw = F.vcu * NWAVES + F.wave, NGW = F.G * NWAVES, lane = F.lane;
    const size_t xoff = (size_t)rep * (WS_PROJ + 64 * MiB - WS_XN), poff = (size_t)rep * (WS_PROJ + 100 * MiB - WS_PERSTD);
    for (int t0 = gw; t0 < T; t0 += 2 * NGW) {
        int pk[2][4]; f32x4 v[2][4]; u32x2 y[2][4][4], pr[2][4];
#pragma unroll
        for (int q = 0; q < 2; ++q) { const int t = (t0 + q * NGW < T) ? t0 + q * NGW : 0;
#pragma unroll
            for (int k = 0; k < 4; ++k) pk[q][k] = WSP(int, WS_TOKP)[t * 4 + k];
            const GAS f32x4* xr = (const GAS f32x4*)(F.out + (size_t)t * D) + lane; const GAS u32x2* pp = (const GAS u32x2*)(WSP(bf16, WS_PERAW) + (size_t)t * D) + lane;
#pragma unroll
            for (int j = 0; j < 4; ++j) { v[q][j] = xr[64 * j]; pr[q][j] = pp[64 * j]; } }
#pragma unroll
        for (int q = 0; q < 2; ++q)
#pragma unroll
            for (int k = 0; k < 4; ++k) { const GAS u32x2* yr = (const GAS u32x2*)(WSP(bf16, WS_YS) + (size_t)pk[q][k] * D) + lane;
#pragma unroll
                for (int j = 0; j < 4; ++j) y[q][k][j] = __builtin_nontemporal_load(yr + 64 * j); }
#pragma unroll
        for (int q = 0; q < 2; ++q) { const int t = t0 + q * NGW; if (t >= T) break;
            GAS f32x4* xw = rep ? (GAS f32x4*)(WSP(float, WS_PROJ) + (size_t)t * D) + lane : (GAS f32x4*)(F.out + (size_t)t * D) + lane;
            float s = 0.f, ps = 0.f;
#pragma unroll
            for (int j = 0; j < 4; ++j) {
#pragma unroll
                for (int k = 0; k < 4; ++k) { const u32x2 w = y[q][k][j]; v[q][j].x += bflo(w.x); v[q][j].y += bfhi(w.x); v[q][j].z += bflo(w.y); v[q][j].w += bfhi(w.y); }
                xw[64 * j] = v[q][j]; s += (v[q][j].x * v[q][j].x + v[q][j].y * v[q][j].y) + (v[q][j].z * v[q][j].z + v[q][j].w * v[q][j].w);
                const u32x2 w = pr[q][j]; const float a = bflo(w.x), b = bfhi(w.x), c = bflo(w.y), d = bfhi(w.y); ps += (a * a + b * b) + (c * c + d * d); }
            const float rstd = 1.f / sqrtf(wave_sum(s) * (1.f / D) + EPS);
            const GAS f32x4* gr = (const GAS f32x4*)F.in[19] + lane; GAS u32x2* o8 = (GAS u32x2*)(WSP(bf16, WS_XN + xoff) + (size_t)t * D) + lane;
#pragma unroll
            for (int j = 0; j < 4; ++j) { const f32x4 gg = gr[64 * j]; f32x4 a = {v[q][j].x * rstd * gg.x, v[q][j].y * rstd * gg.y, v[q][j].z * rstd * gg.z, v[q][j].w * rstd * gg.w}; o8[64 * j] = pack4(a); }
            ps = wave_sum(ps);
            if (lane == 0) WSP(float, WS_PERSTD + poff)[t] = 1.f / sqrtf(ps * (1.f / D) + EPS); }
    }
}
__device__ __forceinline__ void final_phase(Frame& F, int rep) {
    const int gw = F.vcu * NWAVES + F.wave, NGW = F.G * NWAVES, lane = F.lane;
    for (int t0 = gw; t0 < T; t0 += 4 * NGW) {
        f32x4 v[4][4];
#pragma unroll
        for (int q = 0; q < 4; ++q) { const int t = (t0 + q * NGW < T) ? t0 + q * NGW : 0; const GAS f32x4* xr = (const GAS f32x4*)(F.out + (size_t)t * D) + lane;
#pragma unroll
            for (int j = 0; j < 4; ++j) v[q][j] = xr[64 * j]; }
#pragma unroll
        for (int q = 0; q < 4; ++q) { const int t = t0 + q * NGW; if (t >= T) break;
            float s = 0.f;
#pragma unroll
            for (int j = 0; j < 4; ++j) s += (v[q][j].x * v[q][j].x + v[q][j].y * v[q][j].y) + (v[q][j].z * v[q][j].z + v[q][j].w * v[q][j].w);
            const float rstd = 1.f / sqrtf(wave_sum(s) * (1.f / D) + EPS);
            const GAS f32x4* gr = (const GAS f32x4*)F.in[23] + lane;
            GAS f32x4* xw = rep ? (GAS f32x4*)(WSP(float, WS_PROJ) + (size_t)t * D) + lane : (GAS f32x4*)(F.out + (size_t)t * D) + lane;
#pragma unroll
            for (int j = 0; j < 4; ++j) { const f32x4 gg = gr[64 * j]; __builtin_nontemporal_store((f32x4){v[q][j].x * rstd * gg.x, v[q][j].y * rstd * gg.y, v[q][j].z * rstd * gg.z, v[q][j].w * rstd * gg.w}, xw + 64 * j); } }
    }
}

constexpr int NPH = 13;
struct Args { const float* in[24]; float* out; unsigned char* ws; int ph_lo, ph_hi; };
static_assert(sizeof(Args) == 24 * 8 + 8 + 8 + 8, "Args has no padding");
__global__ void __launch_bounds__(NWAVES * 64, 2) fwd_kernel(Args args) {
    extern __shared__ __attribute__((aligned(16))) unsigned char lds[];
    Frame F;
    F.lds = (LAS unsigned char*)lds;
    F.MISC = (volatile LAS unsigned*)(F.lds + MISC_OFF);
    F.tid = threadIdx.x; F.lane = F.tid & 63; F.wave = __builtin_amdgcn_readfirstlane(F.tid >> 6);
    F.G = gridDim.x; { const int bx = blockIdx.x; F.vcu = (F.G % 8 == 0) ? (bx % 8) * (F.G / 8) + bx / 8 : bx; }
    F.ws = args.ws; F.ctl = (gu32*)(args.ws + WS_CTL); F.out = args.out;
#pragma unroll
    for (int i = 0; i < 24; ++i) F.in[i] = args.in[i];
    for (int u = F.tid; u < (LDS_BYTES - LDSCTL_OFF) / 4; u += NWAVES * 64) ((LAS unsigned*)(F.lds + LDSCTL_OFF))[u] = 0u;
    __syncthreads();
    const int lo = args.ph_lo, hi = args.ph_hi;
    XcdBarrier bar; bar.bar = (unsigned*)(F.ctl + CW_BAR); bar.x = 0; bar.st = nullptr;
    bar = xcd_barrier_post((unsigned*)(F.ctl + CW_BAR), F.MISC + 8);
#define IN(k) (lo <= (k) && (k) < hi && !((MK_SKIP >> (k)) & 1))
#define SEAM(k) do { if ((lo <= (k)) && ((k) + 1 < hi)) xcd_barrier(bar); } while (0)

    if (IN(0)) {
#if MK_REP & 1
        p0_prologue(F);
#endif
        p0_prologue(F); SEAM(0); }
    if (IN(1)) {
#if (MK_REP >> 1) & 1
        {
        { pg8::Gemm g{WSP(bf16, WS_XN), WSP(bf16, WS_WIN), T, LDP, D, nullptr}; pg8::StaticOrder S; S.init(T, LDP, F.G, (int)blockIdx.x);
          pg8::EpiBf16P E{WSP(bf16, WS_PROJ), LDP};
          pg8::gemm_phase<pg8::EpiBf16P, pg8::StaticOrder, true, true>(F.lds + RING_OFF, g, S, E); }
        { pg8::Gemm g{WSP(bf16, WS_PB), WSP(bf16, WS_WPP), T, D, PLE, nullptr}; pg8::StaticOrder S; S.init(T, D, F.G, (int)blockIdx.x);
          pg8::EpiBf16P E{WSP(bf16, WS_PERAW), D};
          pg8::gemm_phase<pg8::EpiBf16P, pg8::StaticOrder, true, true>(F.lds + RING_OFF, g, S, E); }
        }
#endif
        {
        { pg8::Gemm g{WSP(bf16, WS_XN), WSP(bf16, WS_WIN), T, LDP, D, nullptr}; pg8::StaticOrder S; S.init(T, LDP, F.G, (int)blockIdx.x);
          pg8::EpiBf16P E{WSP(bf16, WS_PROJ), LDP};
          pg8::gemm_phase<pg8::EpiBf16P, pg8::StaticOrder, true, true>(F.lds + RING_OFF, g, S, E); }
        { pg8::Gemm g{WSP(bf16, WS_PB), WSP(bf16, WS_WPP), T, D, PLE, nullptr}; pg8::StaticOrder S; S.init(T, D, F.G, (int)blockIdx.x);
          pg8::EpiBf16P E{WSP(bf16, WS_PERAW), D};
          pg8::gemm_phase<pg8::EpiBf16P, pg8::StaticOrder, true, true>(F.lds + RING_OFF, g, S, E); }
        }
        SEAM(1);
    }
    if (IN(2)) { for (int rep_ = 0; rep_ <= ((MK_REP >> 2) & 1); ++rep_) {
        for (int i = blockIdx.x; i < NCH * 8; i += F.G) { const int n = i >> 3, hh = (i + (i >> 8)) & 7;
            if (hh < 4) { gla_prep_item(F, n, hh); if ((MK_REP >> 18) & 1) gla_prep_item(F, n, hh); } else { gdn_prep_item(F, n, hh - 4); if ((MK_REP >> 19) & 1) gdn_prep_item(F, n, hh - 4); } }
        }
        SEAM(2);
    }
    if (IN(3)) { for (int rep_ = 0; rep_ <= ((MK_REP >> 3) & 1); ++rep_) {
        for (int r3_ = 0; r3_ <= ((MK_REP >> 13) & 1); ++r3_) {
        for (int it = F.vcu; it < NGRP * 4; it += F.G) gdn_group_scan<0>(F, it >> 2, it & 3);
        for (int id = F.vcu * 8 + F.wave; id < NGRP * 128; id += F.G * 8) gla_scan_range<0>(F, id >> 7, (id & 127) * 64 + F.lane); }
        xcd_barrier(bar);
        for (int r3_ = 0; r3_ <= ((MK_REP >> 14) & 1); ++r3_) {
        if (F.vcu < 32) gdn_scan_groups(F, F.vcu >> 3, F.vcu & 7);
        else if (F.vcu < 160 && F.wave == 0) gla_scan_groups(F, (F.vcu - 32) * 64 + F.lane); }
        xcd_barrier(bar);
        for (int r3_ = 0; r3_ <= ((MK_REP >> 15) & 1); ++r3_) {
        for (int it = F.vcu; it < NGRP * 4; it += F.G) gdn_group_scan<1>(F, it >> 2, it & 3);
        for (int id = F.vcu * 8 + F.wave; id < NGRP * 128; id += F.G * 8) gla_scan_range<1>(F, id >> 7, (id & 127) * 64 + F.lane); }
        }
        SEAM(3);
    }
    if (IN(4)) { for (int rep_ = 0; rep_ <= ((MK_REP >> 4) & 1); ++rep_) {
        for (int id = (int)blockIdx.x * 8 + F.wave; id < NCH * 32; id += F.G * 8) { const int item = id >> 2, it = id & 3, n = item >> 3, hh = (item + (item >> 8)) & 7;
            if (hh < 4) gla_out_wave(F, n, hh, it); else gdn_out_wave(F, n, hh - 4, it); }
        }
        SEAM(4);
    }
    if (IN(5)) {
#if (MK_REP >> 5) & 1
        {
        pg8::Gemm g{WSP(bf16, WS_MIX), WSP(bf16, WS_WOUT), T, D, D, nullptr}; pg8::StaticOrder S; S.init(T, D, F.G, (int)blockIdx.x);
        pg8::EpiResF32 E{F.in[0], F.out, D};
        pg8::gemm_phase<pg8::EpiResF32, pg8::StaticOrder, true, true>(F.lds + RING_OFF, g, S, E);
        }
#endif
        {
        pg8::Gemm g{WSP(bf16, WS_MIX), WSP(bf16, WS_WOUT), T, D, D, nullptr}; pg8::StaticOrder S; S.init(T, D, F.G, (int)blockIdx.x);
        pg8::EpiResF32 E{F.in[0], F.out, D};
        pg8::gemm_phase<pg8::EpiResF32, pg8::StaticOrder, true, true>(F.lds + RING_OFF, g, S, E);
        }
        SEAM(5);
    }
    if (IN(6)) { for (int rep_ = 0; rep_ <= ((MK_REP >> 6) & 1); ++rep_) { route_phase(F, rep_); } SEAM(6); }
    if (IN(7)) { for (int rep_ = 0; rep_ <= ((MK_REP >> 7) & 1); ++rep_) { scatter_phase(F); } SEAM(7); }
    if (IN(8)) {
#if (MK_REP >> 8) & 1
        {
        moe_tables(F);
        const LAS int* tile_e = (const LAS int*)(F.lds + TILEE_OFF); const int ntiles = __builtin_amdgcn_readfirstlane(tile_e[319]);
        pg8::Gemm g{WSP(bf16, WS_XN), WSP(bf16, WS_W1), XS_ROWS, 2048, D / 2, WSP(int, WS_TOKQ)}; pg8::MoeOrder S{tile_e, ntiles, 8, F.G, (int)blockIdx.x};
        pg8::EpiMoeAct E{WSP(bf16, WS_HS), F.in[16], WSP(float, WS_RPOS)};
        pg8::gemm_phase<pg8::EpiMoeAct, pg8::MoeOrder, true, true, true, true>(F.lds + RING_OFF, g, S, E);
        }
#endif
        {
        moe_tables(F);
        const LAS int* tile_e = (const LAS int*)(F.lds + TILEE_OFF); const int ntiles = __builtin_amdgcn_readfirstlane(tile_e[319]);
        pg8::Gemm g{WSP(bf16, WS_XN), WSP(bf16, WS_W1), XS_ROWS, 2048, D / 2, WSP(int, WS_TOKQ)}; pg8::MoeOrder S{tile_e, ntiles, 8, F.G, (int)blockIdx.x};
        pg8::EpiMoeAct E{WSP(bf16, WS_HS), F.in[16], WSP(float, WS_RPOS)};
        pg8::gemm_phase<pg8::EpiMoeAct, pg8::MoeOrder, true, true, true, true>(F.lds + RING_OFF, g, S, E);
        }
        SEAM(8);
    }
    if (IN(9)) {
#if (MK_REP >> 9) & 1
        {
        moe_tables(F);
        const LAS int* tile_e = (const LAS int*)(F.lds + TILEE_OFF); const int ntiles = __builtin_amdgcn_readfirstlane(tile_e[319]);
        pg8::Gemm g{WSP(bf16, WS_HS), WSP(bf16, WS_W2), XS_ROWS, D, D / 2, nullptr}; pg8::MoeOrder S{tile_e, ntiles, 4, F.G, (int)blockIdx.x};
        pg8::EpiMoeDown E{WSP(bf16, WS_YS), F.in[18], WSP(float, WS_GPOS)};
        pg8::gemm_phase<pg8::EpiMoeDown, pg8::MoeOrder, true, true, true>(F.lds + RING_OFF, g, S, E);
        }
#endif
        {
        moe_tables(F);
        const LAS int* tile_e = (const LAS int*)(F.lds + TILEE_OFF); const int ntiles = __builtin_amdgcn_readfirstlane(tile_e[319]);
        pg8::Gemm g{WSP(bf16, WS_HS), WSP(bf16, WS_W2), XS_ROWS, D, D / 2, nullptr}; pg8::MoeOrder S{tile_e, ntiles, 4, F.G, (int)blockIdx.x};
        pg8::EpiMoeDown E{WSP(bf16, WS_YS), F.in[18], WSP(float, WS_GPOS)};
        pg8::gemm_phase<pg8::EpiMoeDown, pg8::MoeOrder, true, true, true>(F.lds + RING_OFF, g, S, E);
        }
        SEAM(9);
    }
    if (IN(10)) { for (int rep_ = 0; rep_ <= ((MK_REP >> 10) & 1); ++rep_) { combine_phase(F, rep_); } SEAM(10); }
    if (IN(11)) {
#if (MK_REP >> 11) & 1
        {
        pg8::Gemm g{WSP(bf16, WS_XN), WSP(bf16, WS_WPG), T, D, D, nullptr}; pg8::StaticOrder S; S.init(T, D, F.G, (int)blockIdx.x);
        pg8::EpiPle E{F.out, WSP(bf16, WS_PERAW), WSP(float, WS_PERSTD), F.in[22]};
        pg8::gemm_phase<pg8::EpiPle, pg8::StaticOrder, true, true>(F.lds + RING_OFF, g, S, E);
        }
#endif
        {
        pg8::Gemm g{WSP(bf16, WS_XN), WSP(bf16, WS_WPG), T, D, D, nullptr}; pg8::StaticOrder S; S.init(T, D, F.G, (int)blockIdx.x);
        pg8::EpiPle E{F.out, WSP(bf16, WS_PERAW), WSP(float, WS_PERSTD), F.in[22]};
        pg8::gemm_phase<pg8::EpiPle, pg8::StaticOrder, true, true>(F.lds + RING_OFF, g, S, E);
        }
        SEAM(11);
    }
    if (IN(12)) { for (int rep_ = 0; rep_ <= ((MK_REP >> 12) & 1); ++rep_) { final_phase(F, rep_); } }
#undef IN
#undef SEAM
}

extern "C" void kernel_launch(void* const* d_in, const int* in_sizes, int n_in, void* d_out, int out_size, void* d_ws, size_t ws_size, hipStream_t stream) {
    static int grid = 0;
    if (grid == 0) {
        if (n_in != 24 || in_sizes[0] != T * D || out_size != T * D || ws_size < WS_END) { fprintf(stderr, "kernel_launch: unexpected shapes (n_in %d, in0 %d, out %d, ws %zu); nothing launched\n", n_in, n_in > 0 ? in_sizes[0] : -1, out_size, ws_size); grid = -1; return; }
        int dev = 0, cus = 0;
        if (hipGetDevice(&dev) != hipSuccess || hipDeviceGetAttribute(&cus, hipDeviceAttributeMultiprocessorCount, dev) != hipSuccess) { grid = -1; return; }
        if (hipFuncSetAttribute((const void*)fwd_kernel, hipFuncAttributeMaxDynamicSharedMemorySize, LDS_BYTES) != hipSuccess) { fprintf(stderr, "kernel_launch: hipFuncSetAttribute failed\n"); grid = -1; return; }
        int per_cu = 0;
        if (hipOccupancyMaxActiveBlocksPerMultiprocessor(&per_cu, (const void*)fwd_kernel, NWAVES * 64, LDS_BYTES) != hipSuccess || per_cu < 1) fprintf(stderr, "kernel_launch: occupancy query reports %d blocks per CU\n", per_cu);
        (void)hipGetLastError();
        grid = cus;
    }
    if (grid < 0) return;
    if (hipMemsetAsync((char*)d_ws + WS_CTL, 0, CTL_ZERO_BYTES, stream) != hipSuccess) return;
    Args a{};
    for (int i = 0; i < 24; ++i) a.in[i] = (const float*)d_in[i];
    a.out = (float*)d_out; a.ws = (unsigned char*)d_ws;
#if MK_ONE_LAUNCH
    a.ph_lo = 0; a.ph_hi = NPH;
    hipLaunchKernelGGL(fwd_kernel, dim3(grid), dim3(NWAVES * 64), LDS_BYTES, stream, a);
#else
    for (int p = 0; p < NPH; ++p) { a.ph_lo = p; a.ph_hi = p + 1; hipLaunchKernelGGL(fwd_kernel, dim3(grid), dim3(NWAVES * 64), LDS_BYTES, stream, a); }
#endif
}
```
